# Optimizing an MI355X kernel written in HIP

```python
import math
import numpy as np
import jax, jax.numpy as jnp
from jax import lax

D_MODEL = 1024
BATCH = 4
SEQ = 4096
DEPTH = 1

D_MIX = D_MODEL
D_PLE = 256
DA = D_MIX // 2
HA = 4
DA_V = DA // HA
DA_QK = DA_V // 2
DB = D_MIX - DA
HB = 16
DB_H = DB // HB
D_IN = 3 * DA + 3 * DB
GRID_W = 64
WIN_R = 8
WIN_C = 16
Q_COLS = 16
K_COLS = 32
ROPE_THETA = 10000.0
EPS = 1e-6
Q_BLOCK = 128
NEG = -1e30
N_GROUPS = 4
EXPERTS_PER_GROUP = 8
N_EXPERTS = N_GROUPS * EXPERTS_PER_GROUP
TOP_K = 2
D_EXPERT = 512
MOE_BLOCK = 128

kernel_name = 'hybrid_diffattn_natten_hmoe_encoder'


def rms_norm(x, g):
    xf = x.astype(jnp.float32)
    y = xf * lax.rsqrt(jnp.mean(xf * xf, axis=-1, keepdims=True) + EPS)
    return (y * g.astype(jnp.float32)).astype(x.dtype)


def rope_tables(seq, dim):
    inv = ROPE_THETA ** (-jnp.arange(0, dim, 2, dtype=jnp.float32) / dim)
    ang = jnp.arange(seq, dtype=jnp.float32)[:, None] * inv[None, :]
    return jnp.cos(ang), jnp.sin(ang)


def apply_rope(x, cos, sin):
    s = x.shape[1]
    bshape = (s,) + (1,) * (x.ndim - 3) + (-1,)
    c = cos.reshape(bshape)
    sn = sin.reshape(bshape)
    x1, x2 = jnp.split(x.astype(jnp.float32), 2, axis=-1)
    return jnp.concatenate([x1 * c - x2 * sn, x2 * c + x1 * sn], axis=-1).astype(x.dtype)


def diff_attention(q, k, v, g_q, g_k, lam_q1, lam_k1, lam_q2, lam_k2, g_sub, lam_init):
    b, s = q.shape[:2]
    cos, sin = rope_tables(s, DA_QK)
    q = apply_rope(rms_norm(q, g_q), cos, sin)
    k = apply_rope(rms_norm(k, g_k), cos, sin)
    lam = (jnp.exp(jnp.sum(lam_q1.astype(jnp.float32) * lam_k1.astype(jnp.float32)))
           - jnp.exp(jnp.sum(lam_q2.astype(jnp.float32) * lam_k2.astype(jnp.float32)))
           + lam_init)
    scale = DA_QK ** -0.5
    qt = q.transpose(0, 2, 1, 3, 4)
    kt = k.transpose(0, 2, 1, 3, 4)
    vt = v.transpose(0, 2, 1, 3)
    k1, k2 = kt[..., 0, :], kt[..., 1, :]
    nqb = s // Q_BLOCK
    qb = qt.reshape(b, HA, nqb, Q_BLOCK, 2, DA_QK).transpose(2, 0, 1, 3, 4, 5)

    def block(qblk):
        s1 = jnp.einsum('bhqd,bhkd->bhqk', qblk[..., 0, :], k1).astype(jnp.float32) * scale
        s2 = jnp.einsum('bhqd,bhkd->bhqk', qblk[..., 1, :], k2).astype(jnp.float32) * scale
        w = (jax.nn.softmax(s1, axis=-1) - lam * jax.nn.softmax(s2, axis=-1)).astype(vt.dtype)
        return jnp.einsum('bhqk,bhkd->bhqd', w, vt)

    o = lax.map(block, qb)
    o = o.transpose(1, 0, 3, 2, 4).reshape(b, s, HA, DA_V)
    o = rms_norm(o, g_sub) * (1.0 - lam_init)
    return o.reshape(b, s, HA * DA_V)


def neighbourhood_attention(q, k, v, g_q, g_k, rpb):
    b, s, h, d = q.shape
    rows = s // GRID_W
    kr = min(WIN_R, rows)
    ncb = GRID_W // Q_COLS
    q = rms_norm(q, g_q)
    k = rms_norm(k, g_k)
    r = np.arange(rows)
    rs = np.clip(r - kr // 2, 0, rows - kr)
    key_rows = rs[:, None] + np.arange(kr)[None, :]
    row_off = (key_rows - r[:, None] + (WIN_R - 1)).astype(np.int32)
    c = np.arange(GRID_W).reshape(ncb, Q_COLS)
    cs = np.clip(c - WIN_C // 2, 0, GRID_W - WIN_C)
    kb = np.minimum(cs[:, 0], GRID_W - K_COLS)
    key_cols = kb[:, None] + np.arange(K_COLS)[None, :]
    col_valid = ((key_cols[:, None, :] >= cs[:, :, None])
                 & (key_cols[:, None, :] < cs[:, :, None] + WIN_C))
    col_off = np.clip(key_cols[:, None, :] - c[:, :, None] + (WIN_C - 1), 0, 2 * WIN_C - 2)
    key_idx = (key_rows[:, None, :, None] * GRID_W + key_cols[None, :, None, :])
    key_idx = key_idx.reshape(rows, ncb * kr * K_COLS).astype(np.int32)
    bias_cols = rpb.astype(jnp.float32)[:, :, col_off]
    bias_cols = jnp.where(col_valid, bias_cols, NEG)
    scale = d ** -0.5
    q_rows = q.reshape(b, rows, GRID_W, h, d).transpose(1, 0, 2, 3, 4)

    def row_step(args):
        q_row, idx, roff = args
        qb = q_row.reshape(b, ncb, Q_COLS, h, d)
        kg = k[:, idx].reshape(b, ncb, kr * K_COLS, h, d)
        vg = v[:, idx].reshape(b, ncb, kr * K_COLS, h, d)
        bias = bias_cols[:, roff]
        bias = bias.transpose(0, 2, 3, 1, 4).reshape(h, ncb, Q_COLS, kr * K_COLS)
        sc = jnp.einsum('bjqhd,bjkhd->bhjqk', qb, kg).astype(jnp.float32) * scale + bias
        pr = jax.nn.softmax(sc, axis=-1).astype(vg.dtype)
        o = jnp.einsum('bhjqk,bjkhd->bjqhd', pr, vg)
        return o.reshape(b, GRID_W, h, d)

    o = lax.map(row_step, (q_rows, jnp.asarray(key_idx), jnp.asarray(row_off)))
    return o.transpose(1, 0, 2, 3, 4).reshape(b, s, h * d)


def hier_moe(x, w_rg, w_re, w1, w3, w2):
    b, s, dm = x.shape
    t = b * s
    xf = x.reshape(t, dm)
    g_prob = jax.nn.softmax((xf @ w_rg).astype(jnp.float32), axis=-1)
    g_gate, g_idx = lax.top_k(g_prob, 1)
    e_logits = (xf @ w_re).astype(jnp.float32).reshape(t, N_GROUPS, EXPERTS_PER_GROUP)
    e_logits = jnp.take_along_axis(e_logits, g_idx[:, :, None], axis=1)[:, 0]
    e_w, e_i = lax.top_k(jax.nn.softmax(e_logits, axis=-1), TOP_K)
    weights = g_gate * (e_w / jnp.sum(e_w, axis=-1, keepdims=True))
    experts = (g_idx * EXPERTS_PER_GROUP + e_i).astype(jnp.int32)
    n = t * TOP_K
    slot_e = experts.reshape(n)
    slot_tok = jnp.repeat(jnp.arange(t, dtype=jnp.int32), TOP_K)
    slot_w = weights.reshape(n)
    order = jnp.argsort(slot_e)
    se = slot_e[order]
    counts = jnp.zeros((N_EXPERTS,), jnp.int32).at[slot_e].add(1)
    starts = jnp.cumsum(counts) - counts
    padded = (counts + MOE_BLOCK - 1) // MOE_BLOCK * MOE_BLOCK
    pad_end = jnp.cumsum(padded)
    pad_start = pad_end - padded
    dest = pad_start[se] + jnp.arange(n, dtype=jnp.int32) - starts[se]
    n_blocks = n // MOE_BLOCK + N_EXPERTS
    p_len = n_blocks * MOE_BLOCK
    pad_tok = jnp.full((p_len,), t, jnp.int32).at[dest].set(slot_tok[order])
    pad_w = jnp.zeros((p_len,), jnp.float32).at[dest].set(slot_w[order])
    block_e = jnp.minimum(jnp.searchsorted(pad_end, jnp.arange(n_blocks, dtype=jnp.int32) * MOE_BLOCK,
                                           side='right'), N_EXPERTS - 1).astype(jnp.int32)
    xf_pad = jnp.concatenate([xf, jnp.zeros((1, dm), xf.dtype)], axis=0)
    xs = xf_pad[pad_tok].reshape(n_blocks, MOE_BLOCK, dm)

    def expert_block(args):
        xb, e = args
        hdn = jax.nn.silu(xb @ w1[e]) * (xb @ w3[e])
        return hdn @ w2[e]

    ys = lax.map(expert_block, (xs, block_e)).reshape(p_len, dm)
    out = jnp.zeros((t + 1, dm), ys.dtype).at[pad_tok].add(ys * pad_w[:, None].astype(ys.dtype))
    return out[:t].reshape(b, s, dm).astype(x.dtype)


def setup_inputs(seed: int = 0) -> dict:
    key = jax.random.key(seed)
    ks = jax.random.split(key, 25)
    f = jnp.float32

    def nrm(k, shape, scale):
        return jax.random.normal(k, shape, f) * scale

    return {
        'x': nrm(ks[0], (BATCH, SEQ, D_MODEL), 1.0),
        'p': nrm(ks[1], (DEPTH, BATCH, SEQ, D_PLE), 1.0),
        'g_mix': 1.0 + nrm(ks[2], (DEPTH, D_MODEL), 0.02),
        'w_in': nrm(ks[3], (DEPTH, D_MODEL, D_IN), D_MODEL ** -0.5),
        'g_qa': 1.0 + nrm(ks[4], (DEPTH, DA_QK), 0.02),
        'g_ka': 1.0 + nrm(ks[5], (DEPTH, DA_QK), 0.02),
        'lam_q1': nrm(ks[6], (DEPTH, DA_QK), 0.1),
        'lam_k1': nrm(ks[7], (DEPTH, DA_QK), 0.1),
        'lam_q2': nrm(ks[8], (DEPTH, DA_QK), 0.1),
        'lam_k2': nrm(ks[9], (DEPTH, DA_QK), 0.1),
        'g_sub': 1.0 + nrm(ks[10], (DEPTH, DA_V), 0.02),
        'g_qb': 1.0 + nrm(ks[11], (DEPTH, DB_H), 0.02),
        'g_kb': 1.0 + nrm(ks[12], (DEPTH, DB_H), 0.02),
        'rpb': nrm(ks[13], (DEPTH, HB, 2 * WIN_R - 1, 2 * WIN_C - 1), 0.1),
        'w_out': nrm(ks[14], (DEPTH, D_MIX, D_MODEL), D_MIX ** -0.5),
        'g_ffn': 1.0 + nrm(ks[15], (DEPTH, D_MODEL), 0.02),
        'w_rg': nrm(ks[16], (DEPTH, D_MODEL, N_GROUPS), D_MODEL ** -0.5),
        'w_re': nrm(ks[17], (DEPTH, D_MODEL, N_EXPERTS), D_MODEL ** -0.5),
        'w1': nrm(ks[18], (DEPTH, N_EXPERTS, D_MODEL, D_EXPERT), D_MODEL ** -0.5),
        'w3': nrm(ks[19], (DEPTH, N_EXPERTS, D_MODEL, D_EXPERT), D_MODEL ** -0.5),
        'w2': nrm(ks[20], (DEPTH, N_EXPERTS, D_EXPERT, D_MODEL), D_EXPERT ** -0.5),
        'g_plg': 1.0 + nrm(ks[21], (DEPTH, D_MODEL), 0.02),
        'w_plg': nrm(ks[22], (DEPTH, D_MODEL, D_MODEL), D_MODEL ** -0.5),
        'w_ple': nrm(ks[23], (DEPTH, D_PLE, D_MODEL), D_PLE ** -0.5),
        'g_ple': 1.0 + nrm(ks[24], (DEPTH, D_MODEL), 0.02),
    }


def reference(x, p, g_mix, w_in, g_qa, g_ka, lam_q1, lam_k1, lam_q2, lam_k2, g_sub, g_qb, g_kb,
              rpb, w_out, g_ffn, w_rg, w_re, w1, w3, w2, g_plg, w_plg, w_ple, g_ple):
    b, s, _ = x.shape
    h = x
    for i in range(DEPTH):
        lam_init = 0.8 - 0.6 * math.exp(-0.3 * i)
        a = rms_norm(h, g_mix[i])
        proj = a @ w_in[i]
        qa, ka, va, qb, kb, vb = jnp.split(proj, np.cumsum([DA, DA, DA, DB, DB])[:5].tolist(), axis=-1)
        oa = diff_attention(qa.reshape(b, s, HA, 2, DA_QK), ka.reshape(b, s, HA, 2, DA_QK),
                            va.reshape(b, s, HA, DA_V), g_qa[i], g_ka[i],
                            lam_q1[i], lam_k1[i], lam_q2[i], lam_k2[i], g_sub[i], lam_init)
        ob = neighbourhood_attention(qb.reshape(b, s, HB, DB_H), kb.reshape(b, s, HB, DB_H),
                                     vb.reshape(b, s, HB, DB_H), g_qb[i], g_kb[i], rpb[i])
        h = h + jnp.concatenate([oa, ob], axis=-1) @ w_out[i]
        h = h + hier_moe(rms_norm(h, g_ffn[i]), w_rg[i], w_re[i], w1[i], w3[i], w2[i])
        h = h + rms_norm(p[i] @ w_ple[i], g_ple[i]) * jax.nn.sigmoid(rms_norm(h, g_plg[i]) @ w_plg[i])
    return h
```

```cpp
#define NPH 9
#define ONE_LAUNCH 1
#define OPT_MASK 0x1ff
#include <hip/hip_runtime.h>
#include <cstdio>
#include <cstdint>

typedef unsigned short u16;
#define DI __device__ __forceinline__

constexpr int T = 16384, S = 4096, DM = 1024, NB = 4;
constexpr int DIN = 3072, DPLE = 256;
constexpr int HA = 4, HB = 16;
constexpr int NE = 32, DE = 512;
constexpr float EPS = 1e-6f;
constexpr float LOG2E = 1.4426950408889634f;
constexpr float LAM_INIT = 0.2f;

constexpr size_t MiB = 1ull << 20;
constexpr size_t WS_WIN = 0, WS_WOUT = 6 * MiB, WS_W13 = 8 * MiB, WS_W2 = 72 * MiB, WS_WPLG = 104 * MiB,
                 WS_WPLE = 106 * MiB, WS_WR = 106 * MiB + 512 * 1024, WS_ROPE = 107 * MiB;
constexpr size_t WS_SMALL = 108 * MiB;
constexpr size_t WS_RSTDX = WS_SMALL;
constexpr size_t WS_SSQ1P = WS_RSTDX + 65536;
constexpr size_t WS_SSQEP = WS_SSQ1P + 524288;
constexpr size_t WS_RSTD1 = WS_SSQEP + 524288;
constexpr size_t WS_RSTD2 = WS_RSTD1 + 65536;
constexpr size_t WS_SCAL  = WS_RSTD2 + 65536;
constexpr size_t WS_CNT   = WS_SCAL + 256;
constexpr size_t WS_PADST = WS_CNT + 256;
constexpr size_t WS_CTL   = WS_PADST + 256;
constexpr size_t WS_RSTDE = WS_CTL + 16384;
constexpr size_t WS_TOKL  = WS_SMALL + 2 * MiB;
constexpr size_t WS_WL    = WS_SMALL + 4 * MiB;
constexpr size_t WS_ACT   = 114 * MiB;
constexpr size_t A_XB = WS_ACT, A_AO = WS_ACT, A_HID = WS_ACT, A_H2B = WS_ACT;
constexpr size_t A_PB = WS_ACT + 32 * MiB;
constexpr size_t A_QA = WS_ACT + 40 * MiB, A_KA = WS_ACT + 56 * MiB, A_VAT = WS_ACT + 72 * MiB,
                 A_QB = WS_ACT + 88 * MiB, A_KB = WS_ACT + 104 * MiB, A_VBT = WS_ACT + 120 * MiB;
constexpr size_t A_H1B = WS_ACT + 40 * MiB, A_EBF = WS_ACT + 72 * MiB, A_Y0 = WS_ACT + 104 * MiB, A_Y1 = WS_ACT + 40 * MiB;
constexpr size_t WS_END = WS_ACT + 136 * MiB;

DI float bf2f(u16 u) { return __uint_as_float(((unsigned)u) << 16); }
DI u16 f2bf(float f) { __bf16 b = (__bf16)f; return __builtin_bit_cast(u16, b); }
DI int permpos(int s) { return (s & ~12) | ((s & 8) >> 1) | ((s & 4) << 1); }

struct Ptrs {
  const float *x, *p, *g_mix, *w_in, *g_qa, *g_ka, *lam_q1, *lam_k1, *lam_q2, *lam_k2, *g_sub, *g_qb, *g_kb, *rpb, *w_out,
      *g_ffn, *w_rg, *w_re, *w1, *w3, *w2, *g_plg, *w_plg, *w_ple, *g_ple;
  float* out;
  unsigned char* ws;
};

__global__ void nv_scal(Ptrs P) {
  if (threadIdx.x == 0) {
    float s1 = 0, s2 = 0, mq = 0, mk = 0;
    for (int i = 0; i < 64; ++i) {
      s1 += P.lam_q1[i] * P.lam_k1[i]; s2 += P.lam_q2[i] * P.lam_k2[i];
      mq = fmaxf(mq, fabsf(P.g_qa[i])); mk = fmaxf(mk, fabsf(P.g_ka[i]));
    }
    float* sc = (float*)(P.ws + WS_SCAL);
    sc[0] = expf(s1) - expf(s2) + LAM_INIT;
    sc[1] = 8.0f * mq * mk * LOG2E;
    int* cnt = (int*)(P.ws + WS_CNT);
    for (int i = 0; i < 32; ++i) cnt[i] = 0;
  }
}

__global__ void nv_rope(Ptrs P) {
  int idx = blockIdx.x * 256 + threadIdx.x;
  int s = idx >> 5, i = idx & 31;
  float inv = powf(10000.0f, -(float)(2 * i) / 64.0f);
  float ang = (float)s * inv;
  float2* tab = (float2*)(P.ws + WS_ROPE);
  double a = (double)ang;
  tab[idx] = make_float2((float)cos(a), (float)sin(a));
}

__global__ void __launch_bounds__(256) nv_inproj(Ptrs P) {
  __shared__ float sa[4][1024];
  __shared__ float so[4][3072];
  const int tid = threadIdx.x, t0 = blockIdx.x * 4;
  __shared__ float sred[4][256];
  for (int tt = 0; tt < 4; ++tt) {
    float ss = 0;
    for (int k = tid; k < 1024; k += 256) { float v = P.x[(size_t)(t0 + tt) * 1024 + k]; sa[tt][k] = v; ss += v * v; }
    sred[tt][tid] = ss;
  }
  __syncthreads();
  for (int st = 128; st > 0; st >>= 1) { if (tid < st) for (int tt = 0; tt < 4; ++tt) sred[tt][tid] += sred[tt][tid + st]; __syncthreads(); }
  for (int tt = 0; tt < 4; ++tt) {
    float rstd = rsqrtf(sred[tt][0] / 1024.0f + EPS);
    for (int k = tid; k < 1024; k += 256) sa[tt][k] = sa[tt][k] * rstd * P.g_mix[k];
  }
  __syncthreads();
  for (int j = 0; j < 12; ++j) {
    int n = tid + 256 * j;
    float a0 = 0, a1 = 0, a2 = 0, a3 = 0;
    for (int k = 0; k < 1024; ++k) {
      float w = P.w_in[(size_t)k * DIN + n];
      a0 += sa[0][k] * w; a1 += sa[1][k] * w; a2 += sa[2][k] * w; a3 += sa[3][k] * w;
    }
    so[0][n] = a0; so[1][n] = a1; so[2][n] = a2; so[3][n] = a3;
  }
  __syncthreads();
  u16* qA = (u16*)(P.ws + A_QA); u16* kA = (u16*)(P.ws + A_KA); u16* vAt = (u16*)(P.ws + A_VAT);
  u16* qB = (u16*)(P.ws + A_QB); u16* kB = (u16*)(P.ws + A_KB); u16* vBt = (u16*)(P.ws + A_VBT);
  const float2* rope = (const float2*)(P.ws + WS_ROPE);
  const float qsA = 0.125f * LOG2E, qsB = 0.17677669529663687f * LOG2E;
  for (int tt = 0; tt < 4; ++tt) {
    const int t = t0 + tt, b = t >> 12, s = t & 4095;
    const float* o = so[tt];
    for (int n = tid; n < 3072; n += 256) {
      if (n < 1024) {
        const int isk = n >= 512, nn = n & 511, g = nn >> 6, i = nn & 63, h = g >> 1, comp = g & 1;
        const float* grp = o + (n - i);
        float ss = 0; for (int e = 0; e < 64; ++e) ss += grp[e] * grp[e];
        const float rstd = rsqrtf(ss / 64.0f + EPS);
        const float* gg = isk ? P.g_ka : P.g_qa;
        const int i1 = i & 31;
        const float y1 = grp[i1] * rstd * gg[i1], y2 = grp[i1 + 32] * rstd * gg[i1 + 32];
        const float2 cs = rope[s * 32 + i1];
        float v = (i < 32) ? (y1 * cs.x - y2 * cs.y) : (y2 * cs.x + y1 * cs.y);
        if (!isk) v *= qsA;
        (isk ? kA : qA)[((size_t)(b * 4 + h) * 4096 + s) * 128 + comp * 64 + i] = f2bf(v);
      } else if (n < 1536) {
        const int nn = n - 1024, h = nn >> 7, d = nn & 127;
        vAt[((size_t)(b * 4 + h) * 128 + d) * 4096 + permpos(s)] = f2bf(o[n]);
      } else if (n < 2560) {
        const int isk = n >= 2048, nn = (n - 1536) & 511, h = nn >> 5, i = nn & 31;
        const float* grp = o + (n - i);
        float ss = 0; for (int e = 0; e < 32; ++e) ss += grp[e] * grp[e];
        const float rstd = rsqrtf(ss / 32.0f + EPS);
        float v = grp[i] * rstd * (isk ? P.g_kb : P.g_qb)[i];
        if (!isk) v *= qsB;
        (isk ? kB : qB)[((size_t)(b * 16 + h) * 4096 + s) * 32 + i] = f2bf(v);
      } else {
        const int nn = n - 2560, h = nn >> 5, d = nn & 31;
        vBt[((size_t)(b * 16 + h) * 32 + d) * 4096 + s] = f2bf(o[n]);
      }
    }
  }
}

__global__ void __launch_bounds__(256) nv_da(Ptrs P) {
  __shared__ float sq[8][128];
  __shared__ float sp[16][256];
  __shared__ float sL[16];
  __shared__ float so[8][128];
  const int tid = threadIdx.x, bh = blockIdx.x >> 9, q0 = (blockIdx.x & 511) * 8;
  const u16* qA = (const u16*)(P.ws + A_QA) + (size_t)bh * 4096 * 128;
  const u16* kA = (const u16*)(P.ws + A_KA) + (size_t)bh * 4096 * 128;
  const u16* vAt = (const u16*)(P.ws + A_VAT) + (size_t)bh * 128 * 4096;
  const float* sc = (const float*)(P.ws + WS_SCAL);
  const float lam = sc[0], m2 = sc[1];
  for (int i = tid; i < 1024; i += 256) sq[i >> 7][i & 127] = bf2f(qA[(size_t)(q0 + (i >> 7)) * 128 + (i & 127)]);
  __syncthreads();
  float lsum[16];
  for (int i = 0; i < 16; ++i) lsum[i] = 0;
  float acc[8];
  for (int i = 0; i < 8; ++i) acc[i] = 0;
  const int d = tid & 127, half = tid >> 7;
  for (int kt = 0; kt < 16; ++kt) {
    const int key = kt * 256 + tid;
#pragma unroll
    for (int c = 0; c < 2; ++c) {
      float kk[64];
#pragma unroll
      for (int i = 0; i < 64; ++i) kk[i] = bf2f(kA[(size_t)key * 128 + c * 64 + i]);
#pragma unroll
      for (int q = 0; q < 8; ++q) {
        float dot = 0;
#pragma unroll
        for (int i = 0; i < 64; ++i) dot += sq[q][c * 64 + i] * kk[i];
        float p = exp2f(dot - m2);
        sp[c * 8 + q][tid] = p; lsum[c * 8 + q] += p;
      }
    }
    __syncthreads();
    for (int j = 0; j < 256; ++j) {
      const float v = bf2f(vAt[(size_t)d * 4096 + kt * 256 + j]);
      const int kl = permpos(j);
#pragma unroll
      for (int qq = 0; qq < 4; ++qq) {
        acc[qq] += sp[4 * half + qq][kl] * v;
        acc[4 + qq] += sp[8 + 4 * half + qq][kl] * v;
      }
    }
    __syncthreads();
  }
  for (int i = 0; i < 16; ++i) sp[i][tid] = lsum[i];
  __syncthreads();
  if (tid < 16) { float s = 0; for (int j = 0; j < 256; ++j) s += sp[tid][j]; sL[tid] = s; }
  __syncthreads();
  for (int qq = 0; qq < 4; ++qq) {
    const int q = 4 * half + qq;
    so[q][d] = acc[qq] / sL[q] - lam * acc[4 + qq] / sL[8 + q];
  }
  __syncthreads();
  u16* ao = (u16*)(P.ws + A_AO);
  const int b = bh >> 2, h = bh & 3;
  for (int qq = 0; qq < 4; ++qq) {
    const int q = 4 * half + qq;
    float ss = 0; for (int e = 0; e < 128; ++e) ss += so[q][e] * so[q][e];
    const float y = so[q][d] * rsqrtf(ss / 128.0f + EPS) * P.g_sub[d] * (1.0f - LAM_INIT);
    ao[((size_t)b * 4096 + q0 + q) * 1024 + h * 128 + d] = f2bf(y);
  }
}

__global__ void __launch_bounds__(256) nv_na(Ptrs P) {
  const int idx = blockIdx.x * 256 + threadIdx.x;
  const int s = idx & 4095, h = (idx >> 12) & 15, b = idx >> 16;
  const int r = s >> 6, c = s & 63;
  const int rs = min(max(r - 4, 0), 56), cs = min(max(c - 8, 0), 48);
  const u16* qB = (const u16*)(P.ws + A_QB) + (size_t)(b * 16 + h) * 4096 * 32;
  const u16* kB = (const u16*)(P.ws + A_KB) + (size_t)(b * 16 + h) * 4096 * 32;
  const u16* vBt = (const u16*)(P.ws + A_VBT) + (size_t)(b * 16 + h) * 32 * 4096;
  float q[32], o[32];
  for (int i = 0; i < 32; ++i) { q[i] = bf2f(qB[(size_t)s * 32 + i]); o[i] = 0; }
  float m = -1e30f, l = 0;
  for (int kr = rs; kr < rs + 8; ++kr)
    for (int kc = cs; kc < cs + 16; ++kc) {
      const int ks = kr * 64 + kc;
      float dot = 0;
      for (int i = 0; i < 32; ++i) dot += q[i] * bf2f(kB[(size_t)ks * 32 + i]);
      const float sc = dot + P.rpb[(h * 15 + (kr - r + 7)) * 31 + (kc - c + 15)] * LOG2E;
      const float mn = fmaxf(m, sc), al = exp2f(m - mn), p = exp2f(sc - mn);
      l = l * al + p;
      for (int i = 0; i < 32; ++i) o[i] = o[i] * al + p * bf2f(vBt[(size_t)i * 4096 + ks]);
      m = mn;
    }
  u16* ao = (u16*)(P.ws + A_AO);
  for (int i = 0; i < 32; ++i) ao[((size_t)b * 4096 + s) * 1024 + 512 + h * 32 + i] = f2bf(o[i] / l);
}

__global__ void __launch_bounds__(256) nv_outproj(Ptrs P) {
  __shared__ float sa[4][1024];
  __shared__ float sred[4][256];
  const int tid = threadIdx.x, t0 = blockIdx.x * 4;
  const u16* ao = (const u16*)(P.ws + A_AO);
  for (int tt = 0; tt < 4; ++tt) for (int k = tid; k < 1024; k += 256) sa[tt][k] = bf2f(ao[(size_t)(t0 + tt) * 1024 + k]);
  __syncthreads();
  float* h1 = P.out; u16* h1b = (u16*)(P.ws + A_H1B); float* ssq1p = (float*)(P.ws + WS_SSQ1P);
  float ss[4] = {0, 0, 0, 0};
  for (int j = 0; j < 4; ++j) {
    const int n = tid + 256 * j;
    float a[4] = {0, 0, 0, 0};
    for (int k = 0; k < 1024; ++k) { const float w = P.w_out[(size_t)k * 1024 + n]; for (int tt = 0; tt < 4; ++tt) a[tt] += sa[tt][k] * w; }
    for (int tt = 0; tt < 4; ++tt) {
      const float v = P.x[(size_t)(t0 + tt) * 1024 + n] + a[tt];
      h1[(size_t)(t0 + tt) * 1024 + n] = v; h1b[(size_t)(t0 + tt) * 1024 + n] = f2bf(v); ss[tt] += v * v;
    }
  }
  for (int tt = 0; tt < 4; ++tt) sred[tt][tid] = ss[tt];
  __syncthreads();
  for (int st = 128; st > 0; st >>= 1) { if (tid < st) for (int tt = 0; tt < 4; ++tt) sred[tt][tid] += sred[tt][tid + st]; __syncthreads(); }
  if (tid < 32) { const int tt = tid >> 3, j = tid & 7; ssq1p[(size_t)(t0 + tt) * 8 + j] = (j == 0) ? sred[tt][0] : 0.0f; }
}

__global__ void __launch_bounds__(64) nv_router(Ptrs P) {
  __shared__ float sl[36];
  const int t = blockIdx.x, tid = threadIdx.x;
  const float* h1 = P.out + (size_t)t * 1024;
  const float* ssq1p = (const float*)(P.ws + WS_SSQ1P) + (size_t)t * 8;
  float ssq = 0; for (int j = 0; j < 8; ++j) ssq += ssq1p[j];
  const float rstd = rsqrtf(ssq / 1024.0f + EPS);
  if (tid < 36) {
    float a = 0;
    for (int k = 0; k < 1024; ++k) {
      const float w = (tid < 4) ? P.w_rg[k * 4 + tid] : P.w_re[k * 32 + (tid - 4)];
      a += h1[k] * rstd * P.g_ffn[k] * w;
    }
    sl[tid] = a;
  }
  __syncthreads();
  if (tid == 0) {
    ((float*)(P.ws + WS_RSTD1))[t] = rstd;
    int g = 0; float gm = sl[0];
    for (int i = 1; i < 4; ++i) if (sl[i] > gm) { gm = sl[i]; g = i; }
    float gs = 0; for (int i = 0; i < 4; ++i) gs += expf(sl[i] - gm);
    const float gate = 1.0f / gs;
    const float* el = sl + 4 + g * 8;
    int e1 = 0; float m1 = el[0];
    for (int i = 1; i < 8; ++i) if (el[i] > m1) { m1 = el[i]; e1 = i; }
    int e2 = -1; float m2v = -1e30f;
    for (int i = 0; i < 8; ++i) if (i != e1 && el[i] > m2v) { m2v = el[i]; e2 = i; }
    const float p2 = expf(m2v - m1);
    const float wa = gate / (1.0f + p2), wb = gate * p2 / (1.0f + p2);
    int* cnt = (int*)(P.ws + WS_CNT); int* tokl = (int*)(P.ws + WS_TOKL); float* wl = (float*)(P.ws + WS_WL);
    const int ea = g * 8 + e1, eb = g * 8 + e2;
    int pa = atomicAdd(&cnt[ea], 1); tokl[ea * 16384 + pa] = t * 2; wl[ea * 16384 + pa] = wa;
    int pb = atomicAdd(&cnt[eb], 1); tokl[eb * 16384 + pb] = t * 2 + 1; wl[eb * 16384 + pb] = wb;
  }
}

__global__ void nv_plan(Ptrs P) {
  if (threadIdx.x == 0) {
    const int* cnt = (const int*)(P.ws + WS_CNT); int* ps = (int*)(P.ws + WS_PADST);
    int a = 0; for (int e = 0; e < 32; ++e) { ps[e] = a; a += (cnt[e] + 127) / 128 * 128; } ps[32] = a;
  }
}

__global__ void __launch_bounds__(256) nv_up(Ptrs P) {
  __shared__ float sa[4][1024];
  const int tid = threadIdx.x, r0 = blockIdx.x * 4;
  const int* cnt = (const int*)(P.ws + WS_CNT); const int* ps = (const int*)(P.ws + WS_PADST);
  if (r0 >= ps[32]) return;
  int e = 0; while (r0 >= ps[e + 1]) ++e;
  const int i0 = r0 - ps[e];
  const int* tokl = (const int*)(P.ws + WS_TOKL) + e * 16384;
  const u16* h1b = (const u16*)(P.ws + A_H1B); const float* rstd1 = (const float*)(P.ws + WS_RSTD1);
  int valid[4];
  for (int rr = 0; rr < 4; ++rr) {
    valid[rr] = (i0 + rr) < cnt[e];
    const int tok = valid[rr] ? (tokl[i0 + rr] >> 1) : 0;
    const float rs = rstd1[tok];
    for (int k = tid; k < 1024; k += 256) sa[rr][k] = valid[rr] ? bf2f(h1b[(size_t)tok * 1024 + k]) * rs * P.g_ffn[k] : 0.0f;
  }
  __syncthreads();
  u16* hid = (u16*)(P.ws + A_HID);
  for (int jj = 0; jj < 2; ++jj) {
    const int j = tid + 256 * jj;
    float u[4] = {0, 0, 0, 0}, v[4] = {0, 0, 0, 0};
    for (int k = 0; k < 1024; ++k) {
      const float a = P.w1[((size_t)e * 1024 + k) * 512 + j], c = P.w3[((size_t)e * 1024 + k) * 512 + j];
      for (int rr = 0; rr < 4; ++rr) { u[rr] += sa[rr][k] * a; v[rr] += sa[rr][k] * c; }
    }
    for (int rr = 0; rr < 4; ++rr) { const float sg = u[rr] / (1.0f + expf(-u[rr])); hid[(size_t)(r0 + rr) * 512 + j] = f2bf(sg * v[rr]); }
  }
}

__global__ void __launch_bounds__(256) nv_down(Ptrs P) {
  __shared__ float sa[4][512];
  const int tid = threadIdx.x, r0 = blockIdx.x * 4;
  const int* cnt = (const int*)(P.ws + WS_CNT); const int* ps = (const int*)(P.ws + WS_PADST);
  if (r0 >= ps[32]) return;
  int e = 0; while (r0 >= ps[e + 1]) ++e;
  const int i0 = r0 - ps[e];
  const int* tokl = (const int*)(P.ws + WS_TOKL) + e * 16384; const float* wl = (const float*)(P.ws + WS_WL) + e * 16384;
  const u16* hid = (const u16*)(P.ws + A_HID);
  for (int rr = 0; rr < 4; ++rr) for (int k = tid; k < 512; k += 256) sa[rr][k] = bf2f(hid[(size_t)(r0 + rr) * 512 + k]);
  __syncthreads();
  for (int jj = 0; jj < 4; ++jj) {
    const int n = tid + 256 * jj;
    float a[4] = {0, 0, 0, 0};
    for (int k = 0; k < 512; ++k) { const float w = P.w2[((size_t)e * 512 + k) * 1024 + n]; for (int rr = 0; rr < 4; ++rr) a[rr] += sa[rr][k] * w; }
    for (int rr = 0; rr < 4; ++rr) if (i0 + rr < cnt[e]) {
      const int tk = tokl[i0 + rr]; const float w = wl[i0 + rr];
      u16* y = (u16*)(P.ws + ((tk & 1) ? A_Y1 : A_Y0));
      y[(size_t)(tk >> 1) * 1024 + n] = f2bf(a[rr] * w);
    }
  }
}

__global__ void __launch_bounds__(256) nv_combine(Ptrs P) {
  __shared__ float sred[256];
  const int t = blockIdx.x, tid = threadIdx.x;
  const u16* y0 = (const u16*)(P.ws + A_Y0); const u16* y1 = (const u16*)(P.ws + A_Y1); u16* h2b = (u16*)(P.ws + A_H2B);
  float ss = 0;
  for (int k = tid; k < 1024; k += 256) {
    const size_t o = (size_t)t * 1024 + k;
    const float v = P.out[o] + bf2f(y0[o]) + bf2f(y1[o]);
    h2b[o] = f2bf(v); ss += v * v;
  }
  sred[tid] = ss; __syncthreads();
  for (int st = 128; st > 0; st >>= 1) { if (tid < st) sred[tid] += sred[tid + st]; __syncthreads(); }
  if (tid == 0) ((float*)(P.ws + WS_RSTD2))[t] = rsqrtf(sred[0] / 1024.0f + EPS);
}

__global__ void __launch_bounds__(256) nv_ple(Ptrs P) {
  __shared__ float sa[4][256];
  __shared__ float sred[4][256];
  const int tid = threadIdx.x, t0 = blockIdx.x * 4;
  for (int tt = 0; tt < 4; ++tt) sa[tt][tid] = P.p[(size_t)(t0 + tt) * 256 + tid];
  __syncthreads();
  u16* ebf = (u16*)(P.ws + A_EBF); float* ssqEp = (float*)(P.ws + WS_SSQEP);
  float ss[4] = {0, 0, 0, 0};
  for (int j = 0; j < 4; ++j) {
    const int n = tid + 256 * j;
    float a[4] = {0, 0, 0, 0};
    for (int k = 0; k < 256; ++k) { const float w = P.w_ple[(size_t)k * 1024 + n]; for (int tt = 0; tt < 4; ++tt) a[tt] += sa[tt][k] * w; }
    for (int tt = 0; tt < 4; ++tt) { ebf[(size_t)(t0 + tt) * 1024 + n] = f2bf(a[tt]); ss[tt] += a[tt] * a[tt]; }
  }
  for (int tt = 0; tt < 4; ++tt) sred[tt][tid] = ss[tt];
  __syncthreads();
  for (int st = 128; st > 0; st >>= 1) { if (tid < st) for (int tt = 0; tt < 4; ++tt) sred[tt][tid] += sred[tt][tid + st]; __syncthreads(); }
  if (tid < 32) { const int tt = tid >> 3, j = tid & 7; ssqEp[(size_t)(t0 + tt) * 8 + j] = (j == 0) ? sred[tt][0] : 0.0f; }
}

__global__ void __launch_bounds__(256) nv_final(Ptrs P) {
  __shared__ float sa[4][1024];
  const int tid = threadIdx.x, t0 = blockIdx.x * 4;
  const u16* h2b = (const u16*)(P.ws + A_H2B); const float* rstd2 = (const float*)(P.ws + WS_RSTD2);
  for (int tt = 0; tt < 4; ++tt) { const float rs = rstd2[t0 + tt]; for (int k = tid; k < 1024; k += 256) sa[tt][k] = bf2f(h2b[(size_t)(t0 + tt) * 1024 + k]) * rs * P.g_plg[k]; }
  __syncthreads();
  const u16* y0 = (const u16*)(P.ws + A_Y0); const u16* y1 = (const u16*)(P.ws + A_Y1); const u16* ebf = (const u16*)(P.ws + A_EBF);
  const float* ssqEp = (const float*)(P.ws + WS_SSQEP);
  for (int j = 0; j < 4; ++j) {
    const int n = tid + 256 * j;
    float a[4] = {0, 0, 0, 0};
    for (int k = 0; k < 1024; ++k) { const float w = P.w_plg[(size_t)k * 1024 + n]; for (int tt = 0; tt < 4; ++tt) a[tt] += sa[tt][k] * w; }
    for (int tt = 0; tt < 4; ++tt) {
      const size_t o = (size_t)(t0 + tt) * 1024 + n;
      float se = 0; for (int q = 0; q < 8; ++q) se += ssqEp[(size_t)(t0 + tt) * 8 + q];
      const float rE = rsqrtf(se / 1024.0f + EPS);
      const float h2 = P.out[o] + bf2f(y0[o]) + bf2f(y1[o]);
      const float sg = 1.0f / (1.0f + expf(-a[tt]));
      P.out[o] = h2 + bf2f(ebf[o]) * rE * P.g_ple[n] * sg;
    }
  }
}

#define GAS __attribute__((address_space(1)))
#define LAS __attribute__((address_space(3)))
typedef LAS unsigned char* ldsp;
typedef __attribute__((ext_vector_type(8))) short bf16x8;
typedef __attribute__((ext_vector_type(16))) float f32x16;
typedef __attribute__((ext_vector_type(4))) float f32x4;
typedef __attribute__((ext_vector_type(2))) float f32x2v;
typedef __attribute__((ext_vector_type(2))) __bf16 bf16x2v;
constexpr int CT_LD = 132;
constexpr int LDS_EXTRA = 128 * CT_LD * 4;
constexpr int LDS_BYTES = LDS_EXTRA + 2048;

DI unsigned pk2(float a, float b) { bf16x2v v = __builtin_convertvector((f32x2v){a, b}, bf16x2v); return __builtin_bit_cast(unsigned, v); }
DI float wave_sum(float v) {
#pragma unroll
  for (int o = 1; o < 64; o <<= 1) v += __shfl_xor(v, o);
  return v;
}
DI float half_sum32(float v) {
#pragma unroll
  for (int o = 1; o < 32; o <<= 1) v += __shfl_xor(v, o);
  return v;
}
DI int crow(int e, int h) { return (e & 3) + 8 * (e >> 2) + 4 * h; }
DI void glds16(const void* g, ldsp l) { __builtin_amdgcn_global_load_lds((const GAS unsigned*)g, (LAS unsigned*)l, 16, 0, 0); }
DI void lds_wave_sync() { asm volatile("s_waitcnt lgkmcnt(0)" ::: "memory"); }

#define XB_TMO      128
#define XB_XCNT(j)  (256  + 64 * (j))
#define XB_XSUB(j)  (1280 + 64 * (j))
#define XB_XGEN(j)  (2304 + 64 * (j))
#define XB_TOP      3328
#define XB_TOPGEN   3392
#define XCD_BAR_WORDS 3456
#define XB_SPIN_CAP (1u << 22)
DI unsigned xb_ld(unsigned* p) { return __hip_atomic_load(p, __ATOMIC_RELAXED, __HIP_MEMORY_SCOPE_AGENT); }
DI unsigned xb_add(unsigned* p, unsigned v) { return __hip_atomic_fetch_add(p, v, __ATOMIC_RELAXED, __HIP_MEMORY_SCOPE_AGENT); }
DI unsigned xb_xcc_id() { return (unsigned)__builtin_amdgcn_s_getreg((3 << 11) | 20) & 0xFu; }
#define XB_SPIN(cond, bar) do { unsigned _sp = 0; while (cond) { __builtin_amdgcn_s_sleep(1); \
    if ((++_sp & 255u) == 0u) { if (xb_ld(&(bar)[XB_TMO])) break; if (_sp > XB_SPIN_CAP) { atomicAdd(&(bar)[XB_TMO], 1u); break; } } } } while (0)
struct XcdBarrier { unsigned* bar; unsigned x; volatile LAS unsigned* st; };
DI XcdBarrier xcd_barrier_post(unsigned* bar, volatile LAS unsigned* st) {
  XcdBarrier b; b.bar = bar; b.x = xb_xcc_id(); b.st = st;
  if (threadIdx.x == 0) (void)xb_add(&bar[XB_XCNT(b.x)], 1u);
  return b;
}
DI void xcd_barrier_complete(unsigned* bar, unsigned x, unsigned& nloc, unsigned& nx) {
  const unsigned G = gridDim.x;
  unsigned sum, cnt, mine, sp = 0u;
  for (;;) {
    sum = 0u; cnt = 0u; mine = 0u;
#pragma unroll
    for (unsigned j = 0; j < 16; ++j) { const unsigned c = xb_ld(&bar[XB_XCNT(j)]); sum += c; cnt += (c > 0u) ? 1u : 0u; mine = (j == x) ? c : mine; }
    if (sum == G) break;
    __builtin_amdgcn_s_sleep(1);
    if ((++sp & 255u) == 0u) { if (xb_ld(&bar[XB_TMO])) break; if (sp > XB_SPIN_CAP) { atomicAdd(&bar[XB_TMO], 1u); break; } }
  }
  nloc = mine > 0u ? mine : 1u; nx = cnt > 0u ? cnt : 1u;
}
DI void xcd_barrier(const XcdBarrier& b) {
  asm volatile("s_waitcnt vmcnt(0)" ::: "memory");
  __syncthreads();
  if (threadIdx.x == 0) {
    unsigned* bar = b.bar;
    __builtin_amdgcn_s_waitcnt(0);
    unsigned nloc = b.st[0], nx = b.st[1];
    if (nloc == 0u) { xcd_barrier_complete(bar, b.x, nloc, nx); b.st[0] = nloc; b.st[1] = nx; }
    const unsigned old = xb_add(&bar[XB_XSUB(b.x)], 1u);
    const unsigned gen = old / nloc;
    if (old + 1u == (gen + 1u) * nloc) {
      __builtin_amdgcn_fence(__ATOMIC_RELEASE, "agent");
      asm volatile("s_waitcnt vmcnt(0)" ::: "memory");
      const unsigned og = xb_add(&bar[XB_TOP], 1u);
      const unsigned tg = og / nx;
      if (og + 1u == (tg + 1u) * nx) xb_add(&bar[XB_TOPGEN], 1u);
      else XB_SPIN(xb_ld(&bar[XB_TOPGEN]) == tg, bar);
      __builtin_amdgcn_fence(__ATOMIC_ACQUIRE, "agent");
      xb_add(&bar[XB_XGEN(b.x)], 1u);
      asm volatile("s_waitcnt vmcnt(0)" ::: "memory");
    } else {
      XB_SPIN(xb_ld(&bar[XB_XGEN(b.x)]) == gen, bar);
      __builtin_amdgcn_fence(__ATOMIC_ACQUIRE, "agent");
      asm volatile("s_waitcnt vmcnt(0)" ::: "memory");
    }
  }
  __syncthreads();
}

DI void gemm_core(const u16* const (&arow)[4], const u16* const (&brow)[4], int nk, f32x16 (&acc)[2][2], ldsp lds) {
  const int tid = threadIdx.x, lane = tid & 63, wave = __builtin_amdgcn_readfirstlane(tid >> 6);
  const int wm = wave >> 1, wn = wave & 1;
  auto stage = [&](int buf, int kt) {
    ldsp la = lds + buf * 32768 + wave * 4096;
    ldsp lb = la + 16384;
#pragma unroll
    for (int qq = 0; qq < 4; ++qq) {
      const int r = 32 * wave + 8 * qq + (lane >> 3);
      const int c = (lane & 7) ^ ((r >> 1) & 7);
      glds16(arow[qq] + kt * 64 + c * 8, la + qq * 1024);
      glds16(brow[qq] + kt * 64 + c * 8, lb + qq * 1024);
    }
  };
  stage(0, 0);
  asm volatile("s_waitcnt vmcnt(0)" ::: "memory");
  __syncthreads();
  const int r31 = lane & 31, h = lane >> 5;
  for (int kt = 0; kt < nk; ++kt) {
    const int buf = kt & 1;
    if (kt + 1 < nk) stage(buf ^ 1, kt + 1);
    ldsp la = lds + buf * 32768;
    ldsp lb = la + 16384;
#pragma unroll
    for (int s = 0; s < 4; ++s) {
      bf16x8 a[2], b[2];
#pragma unroll
      for (int i = 0; i < 2; ++i) {
        const int ra = 64 * wm + 32 * i + r31, rb = 64 * wn + 32 * i + r31;
        a[i] = *(LAS bf16x8*)(la + ra * 128 + (((2 * s + h) ^ ((ra >> 1) & 7)) << 4));
        b[i] = *(LAS bf16x8*)(lb + rb * 128 + (((2 * s + h) ^ ((rb >> 1) & 7)) << 4));
      }
#pragma unroll
      for (int i = 0; i < 2; ++i)
#pragma unroll
        for (int j = 0; j < 2; ++j) acc[i][j] = __builtin_amdgcn_mfma_f32_32x32x16_bf16(a[i], b[j], acc[i][j], 0, 0, 0);
    }
    asm volatile("s_waitcnt vmcnt(0)" ::: "memory");
    __syncthreads();
  }
}
DI void zero_acc(f32x16 (&acc)[2][2]) {
#pragma unroll
  for (int i = 0; i < 2; ++i)
#pragma unroll
    for (int j = 0; j < 2; ++j)
#pragma unroll
      for (int e = 0; e < 16; ++e) acc[i][j][e] = 0.0f;
}

DI void tr_item(const float* W, int ldw, int k0, int n0, const float* gk, u16* dst, int ldd, LAS float* scr, int lane) {
#pragma unroll 8
  for (int i = 0; i < 32; ++i) {
    const int kk = 2 * i + (lane >> 5);
    float v = W[(size_t)(k0 + kk) * ldw + n0 + (lane & 31)];
    if (gk) v *= gk[k0 + kk];
    scr[kk * 33 + (lane & 31)] = v;
  }
  lds_wave_sync();
  const int c = lane & 7;
#pragma unroll
  for (int j = 0; j < 4; ++j) {
    const int n = (lane >> 3) + 8 * j;
    const LAS float* s = scr + (8 * c) * 33 + n;
    uint4 o;
    o.x = pk2(s[0 * 33], s[1 * 33]); o.y = pk2(s[2 * 33], s[3 * 33]); o.z = pk2(s[4 * 33], s[5 * 33]); o.w = pk2(s[6 * 33], s[7 * 33]);
    *(uint4*)(dst + (size_t)n * ldd + k0 + 8 * c) = o;
  }
  lds_wave_sync();
}

DI void ph0_prep(const Ptrs& P, ldsp lds, int bid, int G) {
  const int tid = threadIdx.x, lane = tid & 63, wave = tid >> 6;
  LAS float* scr = (LAS float*)(lds + wave * 8704);
  const int gw = bid * 4 + wave, NGW = G * 4;
  constexpr int I_W1 = 8192, I_W3 = 8192, I_W2 = 8192, I_X = 16384, I_WIN = 1536, I_P = 4096, I_WOUT = 512, I_PLG = 512, I_PLE = 128,
                I_WR = 768, I_ROPE = 2048, I_SC = 1;
  constexpr int TOTAL = I_W1 + I_W3 + I_W2 + I_X + I_WIN + I_P + I_WOUT + I_PLG + I_PLE + I_WR + I_ROPE + I_SC;
  u16* W13T = (u16*)(P.ws + WS_W13); u16* W2T = (u16*)(P.ws + WS_W2);
  for (int it = gw; it < TOTAL; it += NGW) {
    int r = it;
    if (r < I_W1 + I_W3) {
      const int isw3 = r >= I_W1; if (isw3) r -= I_W1;
      const int e = r >> 8, q = r & 255, kb = q >> 4, nb = q & 15, j0 = nb * 32;
      const int row = (j0 >> 6) * 128 + ((((j0 >> 5) & 1) << 1) + isw3) * 32;
      tr_item((isw3 ? P.w3 : P.w1) + (size_t)e * 1024 * 512, 512, kb * 64, j0, P.g_ffn, W13T + ((size_t)e * 1024 + row) * 1024, 1024, scr, lane);
      continue;
    }
    r -= I_W1 + I_W3;
    if (r < I_W2) {
      const int e = r >> 8, q = r & 255, kb = q >> 5, nb = q & 31;
      tr_item(P.w2 + (size_t)e * 512 * 1024, 1024, kb * 64, nb * 32, nullptr, W2T + ((size_t)e * 1024 + nb * 32) * 512, 512, scr, lane);
      continue;
    }
    r -= I_W2;
    if (r < I_X) {
      const float4* xr = (const float4*)(P.x + (size_t)r * 1024) + lane;
      float4 v[4]; float ss = 0.f;
#pragma unroll
      for (int j = 0; j < 4; ++j) { v[j] = xr[64 * j]; ss += v[j].x * v[j].x + v[j].y * v[j].y + v[j].z * v[j].z + v[j].w * v[j].w; }
      ss = wave_sum(ss);
      if (lane == 0) ((float*)(P.ws + WS_RSTDX))[r] = rsqrtf(ss * (1.0f / 1024.0f) + EPS);
      uint2* o = (uint2*)((u16*)(P.ws + A_XB) + (size_t)r * 1024) + lane;
#pragma unroll
      for (int j = 0; j < 4; ++j) o[64 * j] = make_uint2(pk2(v[j].x, v[j].y), pk2(v[j].z, v[j].w));
      continue;
    }
    r -= I_X;
    if (r < I_WIN) {
      const int kb = r / 96, nb = r % 96;
      tr_item(P.w_in, DIN, kb * 64, nb * 32, P.g_mix, (u16*)(P.ws + WS_WIN) + (size_t)(nb * 32) * 1024, 1024, scr, lane);
      continue;
    }
    r -= I_WIN;
    if (r < I_P) {
      const float4* pr = (const float4*)P.p + (size_t)r * 256 + lane;
      uint2* o = (uint2*)(P.ws + A_PB) + (size_t)r * 256 + lane;
#pragma unroll
      for (int j = 0; j < 4; ++j) { const float4 v = pr[64 * j]; o[64 * j] = make_uint2(pk2(v.x, v.y), pk2(v.z, v.w)); }
      continue;
    }
    r -= I_P;
    if (r < I_WOUT) {
      const int kb = r >> 5, nb = r & 31;
      tr_item(P.w_out, 1024, kb * 64, nb * 32, nullptr, (u16*)(P.ws + WS_WOUT) + (size_t)(nb * 32) * 1024, 1024, scr, lane);
      continue;
    }
    r -= I_WOUT;
    if (r < I_PLG) {
      const int kb = r >> 5, nb = r & 31;
      tr_item(P.w_plg, 1024, kb * 64, nb * 32, P.g_plg, (u16*)(P.ws + WS_WPLG) + (size_t)(nb * 32) * 1024, 1024, scr, lane);
      continue;
    }
    r -= I_PLG;
    if (r < I_PLE) {
      const int kb = r >> 5, nb = r & 31;
      tr_item(P.w_ple, 1024, kb * 64, nb * 32, nullptr, (u16*)(P.ws + WS_WPLE) + (size_t)(nb * 32) * 256, 256, scr, lane);
      continue;
    }
    r -= I_PLE;
    if (r < I_WR) {
      const int idx = r * 64 + lane, rr = idx >> 10, k = idx & 1023;
      float v = 0.f;
      if (rr < 4) v = P.w_rg[k * 4 + rr]; else if (rr < 36) v = P.w_re[k * 32 + (rr - 4)];
      ((float*)(P.ws + WS_WR))[idx] = v * P.g_ffn[k];
      continue;
    }
    r -= I_WR;
    if (r < I_ROPE) {
      const int idx = r * 64 + lane, s = idx >> 5, i = idx & 31;
      const float inv = powf(10000.0f, -(float)(2 * i) / 64.0f);
      const float ang = (float)s * inv;
      float sn, cs; sincosf(ang, &sn, &cs);
      ((float2*)(P.ws + WS_ROPE))[idx] = make_float2(cs, sn);
      continue;
    }
    if (lane == 0) {
      float s1 = 0, s2 = 0, mq = 0, mk = 0;
      for (int i = 0; i < 64; ++i) {
        s1 += P.lam_q1[i] * P.lam_k1[i]; s2 += P.lam_q2[i] * P.lam_k2[i];
        mq = fmaxf(mq, fabsf(P.g_qa[i])); mk = fmaxf(mk, fabsf(P.g_ka[i]));
      }
      float* sc = (float*)(P.ws + WS_SCAL);
      sc[0] = expf(s1) - expf(s2) + LAM_INIT;
      sc[1] = 8.0f * mq * mk * LOG2E;
      int* cnt = (int*)(P.ws + WS_CNT);
      for (int i = 0; i < 32; ++i) cnt[i] = 0;
    }
  }
}

DI void acc_to_lds(const f32x16 (&acc)[2][2], ldsp lds) {
  const int tid = threadIdx.x, lane = tid & 63, wave = tid >> 6, wm = wave >> 1, wn = wave & 1, h = lane >> 5, i31 = lane & 31;
  LAS float* ct = (LAS float*)lds;
#pragma unroll
  for (int mi = 0; mi < 2; ++mi)
#pragma unroll
    for (int ni = 0; ni < 2; ++ni)
#pragma unroll
      for (int e = 0; e < 16; ++e) ct[(64 * wm + 32 * mi + crow(e, h)) * CT_LD + 64 * wn + 32 * ni + i31] = acc[mi][ni][e];
}
DI void ld_row64(const LAS float* src, float (&v)[64]) {
#pragma unroll
  for (int j = 0; j < 16; ++j) { const f32x4 q = *(const LAS f32x4*)(src + 4 * j); v[4 * j] = q[0]; v[4 * j + 1] = q[1]; v[4 * j + 2] = q[2]; v[4 * j + 3] = q[3]; }
}
DI void st_bf16x64(u16* dst, const float (&v)[64]) {
#pragma unroll
  for (int j = 0; j < 8; ++j)
    *(uint4*)(dst + 8 * j) = make_uint4(pk2(v[8 * j], v[8 * j + 1]), pk2(v[8 * j + 2], v[8 * j + 3]), pk2(v[8 * j + 4], v[8 * j + 5]), pk2(v[8 * j + 6], v[8 * j + 7]));
}

DI uint4 pk8(const f32x4 a, const f32x4 b) { return make_uint4(pk2(a[0], a[1]), pk2(a[2], a[3]), pk2(b[0], b[1]), pk2(b[2], b[3])); }
DI void ph1_inproj(const Ptrs& P, ldsp lds, int bid, int G) {
  const int tid = threadIdx.x, lane = tid & 63, wave = tid >> 6;
  const u16* xb = (const u16*)(P.ws + A_XB); const u16* WinT = (const u16*)(P.ws + WS_WIN);
  const float* rstdx = (const float*)(P.ws + WS_RSTDX);
  const float2* rope = (const float2*)(P.ws + WS_ROPE);
  u16* qA = (u16*)(P.ws + A_QA); u16* kA = (u16*)(P.ws + A_KA); u16* vAt = (u16*)(P.ws + A_VAT);
  u16* qB = (u16*)(P.ws + A_QB); u16* kB = (u16*)(P.ws + A_KB); u16* vBt = (u16*)(P.ws + A_VBT);
  const float qsA = 0.125f * LOG2E, qsB = 0.17677669529663687f * LOG2E;
  LAS float* ct = (LAS float*)lds;
  LAS float* rsl = (LAS float*)(lds + LDS_EXTRA);
  for (int it = bid; it < 3072; it += G) {
    const int xcd = it & 7, loc = it >> 3, grp = loc >> 6, w = loc & 63, mh = grp / 3, ng = grp % 3;
    const int mt = 16 * xcd + 8 * mh + (w & 7), nt = 8 * ng + (w >> 3);
    const int m0 = mt * 128, n0 = nt * 128;
    {
      const u16 *arow[4], *brow[4];
#pragma unroll
      for (int qq = 0; qq < 4; ++qq) { const int r = 32 * wave + 8 * qq + (lane >> 3); arow[qq] = xb + (size_t)(m0 + r) * 1024; brow[qq] = WinT + (size_t)(n0 + r) * 1024; }
      f32x16 acc[2][2]; zero_acc(acc);
      gemm_core(arow, brow, 16, acc, lds);
      acc_to_lds(acc, lds);
    }
    if (tid < 128) rsl[tid] = rstdx[m0 + tid];
    __syncthreads();
    const int b = m0 >> 12, sb = m0 & 4095;
    if (n0 < 1024) {
      const int isk = n0 >= 512, hh = (n0 & 511) >> 7, row = tid >> 1, comp = tid & 1, s = sb + row;
      const float* gg = isk ? P.g_ka : P.g_qa;
      const LAS float* src = ct + row * CT_LD + comp * 64;
      const float rs = rsl[row];
      float ss = 0.f;
#pragma unroll
      for (int j = 0; j < 16; ++j) { const f32x4 q = *(const LAS f32x4*)(src + 4 * j); ss += q[0] * q[0] + q[1] * q[1] + q[2] * q[2] + q[3] * q[3]; }
      const float rn = rsqrtf(ss * rs * rs * (1.0f / 64.0f) + EPS) * rs * (isk ? 1.0f : qsA);
      const float4* rp = (const float4*)(rope + (size_t)s * 32);
      u16* dst = (isk ? kA : qA) + ((size_t)(b * 4 + hh) * 4096 + s) * 128 + comp * 64;
#pragma unroll 1
      for (int c = 0; c < 4; ++c) {
        f32x4 o1[2], o2[2];
#pragma unroll
        for (int u = 0; u < 2; ++u) {
          const f32x4 x1 = *(const LAS f32x4*)(src + 8 * c + 4 * u), x2 = *(const LAS f32x4*)(src + 32 + 8 * c + 4 * u);
          const float4 ga = *(const float4*)(gg + 8 * c + 4 * u), gb = *(const float4*)(gg + 32 + 8 * c + 4 * u);
          const float4 csA = rp[4 * c + 2 * u], csB = rp[4 * c + 2 * u + 1];
          const float y0 = x1[0] * rn * ga.x, y1 = x1[1] * rn * ga.y, y2 = x1[2] * rn * ga.z, y3 = x1[3] * rn * ga.w;
          const float z0 = x2[0] * rn * gb.x, z1 = x2[1] * rn * gb.y, z2 = x2[2] * rn * gb.z, z3 = x2[3] * rn * gb.w;
          o1[u][0] = y0 * csA.x - z0 * csA.y; o2[u][0] = z0 * csA.x + y0 * csA.y;
          o1[u][1] = y1 * csA.z - z1 * csA.w; o2[u][1] = z1 * csA.z + y1 * csA.w;
          o1[u][2] = y2 * csB.x - z2 * csB.y; o2[u][2] = z2 * csB.x + y2 * csB.y;
          o1[u][3] = y3 * csB.z - z3 * csB.w; o2[u][3] = z3 * csB.z + y3 * csB.w;
        }
        *(uint4*)(dst + 8 * c) = pk8(o1[0], o1[1]);
        *(uint4*)(dst + 32 + 8 * c) = pk8(o2[0], o2[1]);
      }
    } else if (n0 < 1536 || n0 >= 2560) {
      const int isA = n0 < 1536, col = tid & 127, hf = tid >> 7;
      u16* dst;
      if (isA) dst = vAt + ((size_t)(b * 4 + ((n0 - 1024) >> 7)) * 128 + col) * 4096 + sb + 64 * hf;
      else dst = vBt + ((size_t)(b * 16 + ((n0 - 2560) >> 5) + (col >> 5)) * 32 + (col & 31)) * 4096 + sb + 64 * hf;
      const LAS float* src = ct + (64 * hf) * CT_LD + col;
      const LAS float* rsp = rsl + 64 * hf;
#pragma unroll 1
      for (int pc = 0; pc < 8; ++pc) {
        const int t0 = isA ? (16 * (pc >> 1) + 4 * (pc & 1)) : 8 * pc, t1 = isA ? t0 + 8 : t0 + 4;
        f32x4 a, c4;
#pragma unroll
        for (int k = 0; k < 4; ++k) { a[k] = src[(t0 + k) * CT_LD] * rsp[t0 + k]; c4[k] = src[(t1 + k) * CT_LD] * rsp[t1 + k]; }
        *(uint4*)(dst + 8 * pc) = pk8(a, c4);
      }
    } else {
      const int isk = n0 >= 2048;
      const float* gg = isk ? P.g_kb : P.g_qb;
#pragma unroll 1
      for (int u = 0; u < 2; ++u) {
        const int idx = tid + 256 * u, row = idx >> 2, hq = idx & 3, s = sb + row;
        const int hd = (((n0 - 1536) & 511) >> 5) + hq;
        const LAS float* src = ct + row * CT_LD + hq * 32;
        const float rs = rsl[row];
        float ss = 0.f;
#pragma unroll
        for (int j = 0; j < 8; ++j) { const f32x4 q = *(const LAS f32x4*)(src + 4 * j); ss += q[0] * q[0] + q[1] * q[1] + q[2] * q[2] + q[3] * q[3]; }
        const float rn = rsqrtf(ss * rs * rs * (1.0f / 32.0f) + EPS) * rs * (isk ? 1.0f : qsB);
        u16* dst = (isk ? kB : qB) + ((size_t)(b * 16 + hd) * 4096 + s) * 32;
#pragma unroll 1
        for (int j = 0; j < 4; ++j) {
          f32x4 a = *(const LAS f32x4*)(src + 8 * j), c4 = *(const LAS f32x4*)(src + 8 * j + 4);
          const float4 ga = *(const float4*)(gg + 8 * j), gb = *(const float4*)(gg + 8 * j + 4);
          a[0] *= rn * ga.x; a[1] *= rn * ga.y; a[2] *= rn * ga.z; a[3] *= rn * ga.w;
          c4[0] *= rn * gb.x; c4[1] *= rn * gb.y; c4[2] *= rn * gb.z; c4[3] *= rn * gb.w;
          *(uint4*)(dst + 8 * j) = pk8(a, c4);
        }
      }
    }
    __syncthreads();
  }
}
typedef __attribute__((ext_vector_type(4))) unsigned u32x4;
DI bf16x8 packp(const f32x16& x, int s) {
  u32x4 p;
  p[0] = pk2(x[8 * s + 0], x[8 * s + 1]); p[1] = pk2(x[8 * s + 2], x[8 * s + 3]);
  p[2] = pk2(x[8 * s + 4], x[8 * s + 5]); p[3] = pk2(x[8 * s + 6], x[8 * s + 7]);
  return __builtin_bit_cast(bf16x8, p);
}
template <bool SHIFT>
DI void da_item(const Ptrs& P, ldsp lds, int item, float lam, float m2) {
  const int tid = threadIdx.x, lane = tid & 63, wave = __builtin_amdgcn_readfirstlane(tid >> 6), h = lane >> 5, i31 = lane & 31;
  const int xcd = item & 7, loc = item >> 3, bh = 2 * xcd + (loc >> 5), qblk = loc & 31;
  const u16* qA = (const u16*)(P.ws + A_QA) + (size_t)bh * 4096 * 128;
  const u16* kA = (const u16*)(P.ws + A_KA) + (size_t)bh * 4096 * 128;
  const u16* vAt = (const u16*)(P.ws + A_VAT) + (size_t)bh * 128 * 4096;
  const int q = qblk * 128 + 32 * wave + i31;
  bf16x8 qf[2][4];
#pragma unroll
  for (int c = 0; c < 2; ++c)
#pragma unroll
    for (int s = 0; s < 4; ++s) qf[c][s] = *(const bf16x8*)(qA + (size_t)q * 128 + c * 64 + 16 * s + 8 * h);
  auto stage = [&](int buf, int tile) {
    int ln = lane; asm volatile("" : "+v"(ln));
    ldsp lk = lds + buf * 32768 + wave * 4096;
    ldsp lv = lk + 16384;
    const u16* kt = kA + (size_t)tile * 64 * 128;
    const u16* vt = vAt + tile * 64;
#pragma unroll
    for (int qq = 0; qq < 4; ++qq) {
      const int q4 = 4 * wave + qq;
      const int krow = 4 * q4 + (ln >> 4), kc = (ln & 15) ^ (krow & 15);
      const int vrow = 8 * q4 + (ln >> 3), vc = (ln & 7) ^ ((vrow >> 1) & 7);
      glds16(kt + krow * 128 + kc * 8, lk + qq * 1024);
      glds16(vt + vrow * 4096 + vc * 8, lv + qq * 1024);
    }
  };
  f32x16 O1[4], O2[4];
#pragma unroll
  for (int dt = 0; dt < 4; ++dt)
#pragma unroll
    for (int e = 0; e < 16; ++e) { O1[dt][e] = 0.f; O2[dt][e] = 0.f; }
  float l1 = 0.f, l2 = 0.f;
  stage(0, 0);
  asm volatile("s_waitcnt vmcnt(0)" ::: "memory");
  __syncthreads();
  for (int tile = 0; tile < 64; ++tile) {
    const int buf = tile & 1;
    if (tile + 1 < 64) stage(buf ^ 1, tile + 1);
    ldsp lk = lds + buf * 32768;
    ldsp lv = lk + 16384;
#pragma unroll 1
    for (int kt2 = 0; kt2 < 2; ++kt2) {
      bf16x8 pf[2][2];
      const int key = 32 * kt2 + i31;
#pragma unroll
      for (int c = 0; c < 2; ++c) {
        f32x16 sa;
#pragma unroll
        for (int e = 0; e < 16; ++e) sa[e] = 0.f;
#pragma unroll
        for (int s = 0; s < 4; ++s) {
          const bf16x8 kf = *(LAS bf16x8*)(lk + key * 256 + (((c * 8 + 2 * s + h) ^ (key & 15)) << 4));
          sa = __builtin_amdgcn_mfma_f32_32x32x16_bf16(kf, qf[c][s], sa, 0, 0, 0);
        }
        float ls = 0.f;
#pragma unroll
        for (int e = 0; e < 16; ++e) { sa[e] = __builtin_amdgcn_exp2f(SHIFT ? sa[e] - m2 : sa[e]); ls += sa[e]; }
        if (c == 0) l1 += ls; else l2 += ls;
        pf[c][0] = packp(sa, 0); pf[c][1] = packp(sa, 1);
      }
      __builtin_amdgcn_sched_barrier(0);
#pragma unroll
      for (int s2 = 0; s2 < 2; ++s2)
#pragma unroll
        for (int dt = 0; dt < 4; ++dt) {
          const int d = 32 * dt + i31, ks = 2 * kt2 + s2;
          const bf16x8 vf = *(LAS bf16x8*)(lv + d * 128 + (((2 * ks + h) ^ ((d >> 1) & 7)) << 4));
          O1[dt] = __builtin_amdgcn_mfma_f32_32x32x16_bf16(vf, pf[0][s2], O1[dt], 0, 0, 0);
          O2[dt] = __builtin_amdgcn_mfma_f32_32x32x16_bf16(vf, pf[1][s2], O2[dt], 0, 0, 0);
        }
    }
    asm volatile("s_waitcnt vmcnt(0)" ::: "memory");
    __syncthreads();
  }
  l1 += __shfl_xor(l1, 32); l2 += __shfl_xor(l2, 32);
  const float i1 = 1.0f / l1, i2 = lam / l2;
  float ss = 0.f;
#pragma unroll
  for (int dt = 0; dt < 4; ++dt)
#pragma unroll
    for (int e = 0; e < 16; ++e) { const float o = O1[dt][e] * i1 - O2[dt][e] * i2; O1[dt][e] = o; ss += o * o; }
  ss += __shfl_xor(ss, 32);
  const float rn = rsqrtf(ss * (1.0f / 128.0f) + EPS) * (1.0f - LAM_INIT);
  const int b = bh >> 2, hh = bh & 3;
  u16* dst = (u16*)(P.ws + A_AO) + ((size_t)b * 4096 + q) * 1024 + hh * 128;
#pragma unroll
  for (int dt = 0; dt < 4; ++dt)
#pragma unroll
    for (int g = 0; g < 4; ++g) {
      const int d0 = 32 * dt + 8 * g + 4 * h;
      const float4 gs = *(const float4*)(P.g_sub + d0);
      *(uint2*)(dst + d0) = make_uint2(pk2(O1[dt][4 * g] * rn * gs.x, O1[dt][4 * g + 1] * rn * gs.y), pk2(O1[dt][4 * g + 2] * rn * gs.z, O1[dt][4 * g + 3] * rn * gs.w));
    }
}

typedef __attribute__((ext_vector_type(4))) short s16x4;
DI void na_item(const Ptrs& P, ldsp lds, int item, int wave, int lane) {
  const int r = item & 63, hd = (item >> 6) & 15, b = item >> 10;
  const int qi = lane & 15, g = lane >> 4;
  const u16* qB = (const u16*)(P.ws + A_QB) + (size_t)(b * 16 + hd) * 4096 * 32;
  const u16* kB = (const u16*)(P.ws + A_KB) + (size_t)(b * 16 + hd) * 4096 * 32;
  const u16* vBt = (const u16*)(P.ws + A_VBT) + (size_t)(b * 16 + hd) * 32 * 4096;
  LAS float* rpl = (LAS float*)(lds + wave * 2048);
  lds_wave_sync();
  for (int i = lane; i < 465; i += 64) rpl[i] = P.rpb[hd * 465 + i] * LOG2E;
  lds_wave_sync();
  const int rs = min(max(r - 4, 0), 56);
  const int rb0 = rs - r + 7;
  u16* aob = (u16*)(P.ws + A_AO) + ((size_t)b * 4096 + r * 64) * 1024 + 512 + hd * 32;
#pragma unroll 1
  for (int j = 0; j < 4; ++j) {
    const int c = 16 * j + qi, cs = min(max(c - 8, 0), 48);
    const int kb = min(min(max(16 * j - 8, 0), 48), 32);
    const bf16x8 qf = *(const bf16x8*)(qB + (size_t)(r * 64 + c) * 32 + 8 * g);
    f32x4 sa[8][2];
    float mx = -1e30f;
#pragma unroll
    for (int ri = 0; ri < 8; ++ri)
#pragma unroll
      for (int t = 0; t < 2; ++t) {
        const bf16x8 kf = *(const bf16x8*)(kB + (size_t)((rs + ri) * 64 + kb + 16 * t + qi) * 32 + 8 * g);
        f32x4 z = {0.f, 0.f, 0.f, 0.f};
        z = __builtin_amdgcn_mfma_f32_16x16x32_bf16(kf, qf, z, 0, 0, 0);
#pragma unroll
        for (int i = 0; i < 4; ++i) {
          const int kc = kb + 16 * t + 4 * g + i;
          const bool valid = (kc >= cs) && (kc < cs + 16);
          const int co = min(max(kc - c + 15, 0), 30);
          const float sv = valid ? z[i] + rpl[(rb0 + ri) * 31 + co] : -1e30f;
          z[i] = sv; mx = fmaxf(mx, sv);
        }
        sa[ri][t] = z;
      }
    mx = fmaxf(mx, __shfl_xor(mx, 16)); mx = fmaxf(mx, __shfl_xor(mx, 32));
    float l = 0.f;
    f32x4 oa[2] = {{0.f, 0.f, 0.f, 0.f}, {0.f, 0.f, 0.f, 0.f}};
#pragma unroll
    for (int ri = 0; ri < 8; ++ri) {
      float p[8];
#pragma unroll
      for (int t = 0; t < 2; ++t)
#pragma unroll
        for (int i = 0; i < 4; ++i) { const float e = __builtin_amdgcn_exp2f(sa[ri][t][i] - mx); p[4 * t + i] = e; l += e; }
      u32x4 pp; pp[0] = pk2(p[0], p[1]); pp[1] = pk2(p[2], p[3]); pp[2] = pk2(p[4], p[5]); pp[3] = pk2(p[6], p[7]);
      const bf16x8 pfr = __builtin_bit_cast(bf16x8, pp);
#pragma unroll
      for (int dtl = 0; dtl < 2; ++dtl) {
        const u16* vp = vBt + (size_t)(16 * dtl + qi) * 4096 + (rs + ri) * 64 + kb + 4 * g;
        const s16x4 lo = *(const s16x4*)vp, hi = *(const s16x4*)(vp + 16);
        const bf16x8 vf = __builtin_shufflevector(lo, hi, 0, 1, 2, 3, 4, 5, 6, 7);
        oa[dtl] = __builtin_amdgcn_mfma_f32_16x16x32_bf16(vf, pfr, oa[dtl], 0, 0, 0);
      }
    }
    l += __shfl_xor(l, 16); l += __shfl_xor(l, 32);
    const float il = 1.0f / l;
    u16* dst = aob + (size_t)c * 1024;
#pragma unroll
    for (int dtl = 0; dtl < 2; ++dtl)
      *(uint2*)(dst + 16 * dtl + 4 * g) = make_uint2(pk2(oa[dtl][0] * il, oa[dtl][1] * il), pk2(oa[dtl][2] * il, oa[dtl][3] * il));
  }
}

DI void ph2_attn(const Ptrs& P, ldsp lds, int bid, int G) {
  {
    const float* sc = (const float*)(P.ws + WS_SCAL);
    const float lam = sc[0], m2 = sc[1];
    if (m2 < 64.0f) { for (int it = bid; it < 512; it += G) da_item<false>(P, lds, it, lam, m2); }
  }
  const int wave = threadIdx.x >> 6, lane = threadIdx.x & 63;
  for (int wi = bid * 4 + wave; wi < 4096; wi += G * 4) na_item(P, lds, wi, wave, lane);
}

DI void tile_map_1024(int t2, int& mt, int& nt) {
  const int xcd = t2 & 7, loc = t2 >> 3, grp = loc >> 6, w = loc & 63;
  mt = 16 * xcd + 8 * grp + (w & 7); nt = w >> 3;
}
DI void ph3_outproj(const Ptrs& P, ldsp lds, int bid, int G) {
  const int tid = threadIdx.x, lane = tid & 63, wave = tid >> 6;
  LAS float* ct = (LAS float*)lds;
  for (int it = bid; it < 2048; it += G) {
    const int isple = it >= 1024;
    int mt, nt; tile_map_1024(it & 1023, mt, nt);
    const int m0 = mt * 128, n0 = nt * 128;
    {
      const u16* A = isple ? (const u16*)(P.ws + A_PB) : (const u16*)(P.ws + A_AO);
      const u16* B = isple ? (const u16*)(P.ws + WS_WPLE) : (const u16*)(P.ws + WS_WOUT);
      const int ld = isple ? 256 : 1024;
      const u16 *arow[4], *brow[4];
#pragma unroll
      for (int qq = 0; qq < 4; ++qq) { const int r = 32 * wave + 8 * qq + (lane >> 3); arow[qq] = A + (size_t)(m0 + r) * ld; brow[qq] = B + (size_t)(n0 + r) * ld; }
      f32x16 acc[2][2]; zero_acc(acc);
      gemm_core(arow, brow, isple ? 4 : 16, acc, lds);
      acc_to_lds(acc, lds);
    }
    __syncthreads();
    const int row = tid >> 1, hf = tid & 1;
    const LAS float* src = ct + row * CT_LD + 64 * hf;
    const size_t go = (size_t)(m0 + row) * 1024 + n0 + 64 * hf;
    float ss = 0.f;
    if (!isple) {
      const float* xr = P.x + go; float* h1r = P.out + go; u16* hbr = (u16*)(P.ws + A_H1B) + go;
#pragma unroll 1
      for (int c = 0; c < 8; ++c) {
        f32x4 a = *(const LAS f32x4*)(src + 8 * c), c4 = *(const LAS f32x4*)(src + 8 * c + 4);
        const float4 xa = *(const float4*)(xr + 8 * c), xb4 = *(const float4*)(xr + 8 * c + 4);
        a[0] += xa.x; a[1] += xa.y; a[2] += xa.z; a[3] += xa.w; c4[0] += xb4.x; c4[1] += xb4.y; c4[2] += xb4.z; c4[3] += xb4.w;
        ss += a[0] * a[0] + a[1] * a[1] + a[2] * a[2] + a[3] * a[3] + c4[0] * c4[0] + c4[1] * c4[1] + c4[2] * c4[2] + c4[3] * c4[3];
        *(float4*)(h1r + 8 * c) = make_float4(a[0], a[1], a[2], a[3]); *(float4*)(h1r + 8 * c + 4) = make_float4(c4[0], c4[1], c4[2], c4[3]);
        *(uint4*)(hbr + 8 * c) = pk8(a, c4);
      }
    } else {
      u16* er = (u16*)(P.ws + A_EBF) + go;
#pragma unroll 1
      for (int c = 0; c < 8; ++c) {
        const f32x4 a = *(const LAS f32x4*)(src + 8 * c), c4 = *(const LAS f32x4*)(src + 8 * c + 4);
        ss += a[0] * a[0] + a[1] * a[1] + a[2] * a[2] + a[3] * a[3] + c4[0] * c4[0] + c4[1] * c4[1] + c4[2] * c4[2] + c4[3] * c4[3];
        *(uint4*)(er + 8 * c) = pk8(a, c4);
      }
    }
    ss += __shfl_xor(ss, 1);
    if (hf == 0) ((float*)(P.ws + (isple ? WS_SSQEP : WS_SSQ1P)))[(size_t)(m0 + row) * 8 + nt] = ss;
    __syncthreads();
  }
}

DI void ph4_router(const Ptrs& P, ldsp lds, int bid, int G) {
  const int tid = threadIdx.x, lane = tid & 63, wave = tid >> 6, t = lane & 15, kk = lane >> 4;
  LAS float* lg = (LAS float*)(lds + wave * 3072);
  const float* h1 = P.out; const float* WrT = (const float*)(P.ws + WS_WR);
  for (int item = bid * 4 + wave; item < 1024; item += G * 4) {
    const int tok0 = item * 16;
    f32x4 acc[3] = {{0.f, 0.f, 0.f, 0.f}, {0.f, 0.f, 0.f, 0.f}, {0.f, 0.f, 0.f, 0.f}};
    const float* ap = h1 + (size_t)(tok0 + t) * 1024 + 4 * kk;
    const float* bp = WrT + (size_t)t * 1024 + 4 * kk;
#pragma unroll 4
    for (int s = 0; s < 64; ++s) {
      const float4 a4 = *(const float4*)(ap + 16 * s);
      const float4 b0 = *(const float4*)(bp + 16 * s), b1 = *(const float4*)(bp + 16 * 1024 + 16 * s), b2 = *(const float4*)(bp + 32 * 1024 + 16 * s);
      acc[0] = __builtin_amdgcn_mfma_f32_16x16x4f32(a4.x, b0.x, acc[0], 0, 0, 0); acc[1] = __builtin_amdgcn_mfma_f32_16x16x4f32(a4.x, b1.x, acc[1], 0, 0, 0); acc[2] = __builtin_amdgcn_mfma_f32_16x16x4f32(a4.x, b2.x, acc[2], 0, 0, 0);
      acc[0] = __builtin_amdgcn_mfma_f32_16x16x4f32(a4.y, b0.y, acc[0], 0, 0, 0); acc[1] = __builtin_amdgcn_mfma_f32_16x16x4f32(a4.y, b1.y, acc[1], 0, 0, 0); acc[2] = __builtin_amdgcn_mfma_f32_16x16x4f32(a4.y, b2.y, acc[2], 0, 0, 0);
      acc[0] = __builtin_amdgcn_mfma_f32_16x16x4f32(a4.z, b0.z, acc[0], 0, 0, 0); acc[1] = __builtin_amdgcn_mfma_f32_16x16x4f32(a4.z, b1.z, acc[1], 0, 0, 0); acc[2] = __builtin_amdgcn_mfma_f32_16x16x4f32(a4.z, b2.z, acc[2], 0, 0, 0);
      acc[0] = __builtin_amdgcn_mfma_f32_16x16x4f32(a4.w, b0.w, acc[0], 0, 0, 0); acc[1] = __builtin_amdgcn_mfma_f32_16x16x4f32(a4.w, b1.w, acc[1], 0, 0, 0); acc[2] = __builtin_amdgcn_mfma_f32_16x16x4f32(a4.w, b2.w, acc[2], 0, 0, 0);
    }
    lds_wave_sync();
#pragma unroll
    for (int et = 0; et < 3; ++et)
#pragma unroll
      for (int i = 0; i < 4; ++i) lg[(4 * kk + i) * 48 + 16 * et + t] = acc[et][i];
    lds_wave_sync();
    if (lane < 16) {
      const int tok = tok0 + lane;
      const float* sp = (const float*)(P.ws + WS_SSQ1P) + (size_t)tok * 8;
      const float4 s0 = *(const float4*)sp, s1 = *(const float4*)(sp + 4);
      const float rstd = rsqrtf((s0.x + s0.y + s0.z + s0.w + s1.x + s1.y + s1.z + s1.w) * (1.0f / 1024.0f) + EPS);
      ((float*)(P.ws + WS_RSTD1))[tok] = rstd;
      const LAS float* L = lg + lane * 48;
      int gi = 0; float gm = L[0];
#pragma unroll
      for (int i = 1; i < 4; ++i) { const float v = L[i]; if (v > gm) { gm = v; gi = i; } }
      float gs = 0.f;
#pragma unroll
      for (int i = 0; i < 4; ++i) gs += expf((L[i] - gm) * rstd);
      const float gate = 1.0f / gs;
      const LAS float* el = L + 4 + 8 * gi;
      int e1 = 0; float m1 = el[0];
#pragma unroll
      for (int i = 1; i < 8; ++i) { const float v = el[i]; if (v > m1) { m1 = v; e1 = i; } }
      int e2 = 0; float m2v = -3.0e38f;
#pragma unroll
      for (int i = 0; i < 8; ++i) { const float v = el[i]; if (i != e1 && v > m2v) { m2v = v; e2 = i; } }
      const float p2 = expf((m2v - m1) * rstd);
      const float wa = gate / (1.0f + p2), wb = gate * p2 / (1.0f + p2);
      int* cnt = (int*)(P.ws + WS_CNT); int* tokl = (int*)(P.ws + WS_TOKL); float* wl = (float*)(P.ws + WS_WL);
      const int ea = gi * 8 + e1, eb = gi * 8 + e2;
      const int pa = atomicAdd(&cnt[ea], 1); tokl[ea * 16384 + pa] = tok * 2; wl[ea * 16384 + pa] = wa;
      const int pb = atomicAdd(&cnt[eb], 1); tokl[eb * 16384 + pb] = tok * 2 + 1; wl[eb * 16384 + pb] = wb;
    }
  }
}

DI int moe_plan(const Ptrs& P, ldsp lds) {
  LAS int* smb = (LAS int*)(lds + LDS_EXTRA + 1024);
  if (threadIdx.x == 0) {
    const int* cnt = (const int*)(P.ws + WS_CNT);
    int a = 0;
    for (int e = 0; e < 32; ++e) { smb[e] = a; a += (cnt[e] + 127) >> 7; }
    smb[32] = a;
  }
  __syncthreads();
  return smb[32];
}
DI void ph5_up(const Ptrs& P, ldsp lds, int bid, int G) {
  const int tid = threadIdx.x, lane = tid & 63, wave = tid >> 6;
  LAS float* ct = (LAS float*)lds;
  LAS float* rsl = (LAS float*)(lds + LDS_EXTRA);
  LAS int* smb = (LAS int*)(lds + LDS_EXTRA + 1024);
  const int MB = moe_plan(P, lds);
  const int* cnt = (const int*)(P.ws + WS_CNT); const int* tokl = (const int*)(P.ws + WS_TOKL);
  const u16* h1b = (const u16*)(P.ws + A_H1B); const u16* W13T = (const u16*)(P.ws + WS_W13);
  const float* rstd1 = (const float*)(P.ws + WS_RSTD1);
  u16* hid = (u16*)(P.ws + A_HID);
  for (int it = bid; it < MB * 8; it += G) {
    const int nb = it & 7, gmb = it >> 3;
    int e = 0; while (gmb >= smb[e + 1]) ++e;
    const int mb = gmb - smb[e], ce = cnt[e];
    {
      const u16 *arow[4], *brow[4];
#pragma unroll
      for (int qq = 0; qq < 4; ++qq) {
        const int r = 32 * wave + 8 * qq + (lane >> 3), i = mb * 128 + r;
        const int tok = (i < ce) ? (tokl[e * 16384 + i] >> 1) : 0;
        arow[qq] = h1b + (size_t)tok * 1024; brow[qq] = W13T + ((size_t)e * 1024 + nb * 128 + r) * 1024;
      }
      f32x16 acc[2][2]; zero_acc(acc);
      gemm_core(arow, brow, 16, acc, lds);
      acc_to_lds(acc, lds);
    }
    if (tid < 128) { const int i = mb * 128 + tid; rsl[tid] = (i < ce) ? rstd1[tokl[e * 16384 + i] >> 1] : 0.0f; }
    __syncthreads();
    const int row = tid >> 1, hf = tid & 1;
    const LAS float* src = ct + row * CT_LD + 64 * hf;
    const float rs = rsl[row];
    u16* dst = hid + (size_t)(gmb * 128 + row) * 512 + 64 * nb + 32 * hf;
#pragma unroll 1
    for (int c = 0; c < 4; ++c) {
      f32x4 u0 = *(const LAS f32x4*)(src + 8 * c), u1 = *(const LAS f32x4*)(src + 8 * c + 4);
      const f32x4 v0 = *(const LAS f32x4*)(src + 32 + 8 * c), v1 = *(const LAS f32x4*)(src + 32 + 8 * c + 4);
#pragma unroll
      for (int k = 0; k < 4; ++k) {
        const float a = u0[k] * rs, bq = u1[k] * rs;
        u0[k] = a / (1.0f + __expf(-a)) * (v0[k] * rs); u1[k] = bq / (1.0f + __expf(-bq)) * (v1[k] * rs);
      }
      *(uint4*)(dst + 8 * c) = pk8(u0, u1);
    }
    __syncthreads();
  }
}
DI void ph6_down(const Ptrs& P, ldsp lds, int bid, int G) {
  const int tid = threadIdx.x, lane = tid & 63, wave = tid >> 6;
  LAS float* ct = (LAS float*)lds;
  LAS float* wsl = (LAS float*)(lds + LDS_EXTRA);
  LAS int* tkl = (LAS int*)(lds + LDS_EXTRA + 512);
  LAS int* smb = (LAS int*)(lds + LDS_EXTRA + 1024);
  const int MB = moe_plan(P, lds);
  const int* cnt = (const int*)(P.ws + WS_CNT); const int* tokl = (const int*)(P.ws + WS_TOKL); const float* wl = (const float*)(P.ws + WS_WL);
  const u16* hid = (const u16*)(P.ws + A_HID); const u16* W2T = (const u16*)(P.ws + WS_W2);
  for (int it = bid; it < MB * 8; it += G) {
    const int nb = it & 7, gmb = it >> 3;
    int e = 0; while (gmb >= smb[e + 1]) ++e;
    const int mb = gmb - smb[e], ce = cnt[e];
    {
      const u16 *arow[4], *brow[4];
#pragma unroll
      for (int qq = 0; qq < 4; ++qq) {
        const int r = 32 * wave + 8 * qq + (lane >> 3);
        arow[qq] = hid + (size_t)(gmb * 128 + r) * 512; brow[qq] = W2T + ((size_t)e * 1024 + nb * 128 + r) * 512;
      }
      f32x16 acc[2][2]; zero_acc(acc);
      gemm_core(arow, brow, 8, acc, lds);
      acc_to_lds(acc, lds);
    }
    if (tid < 128) { const int i = mb * 128 + tid; const bool v = i < ce; tkl[tid] = v ? tokl[e * 16384 + i] : -1; wsl[tid] = v ? wl[e * 16384 + i] : 0.0f; }
    __syncthreads();
    const int row = tid >> 1, hf = tid & 1;
    const int tk = tkl[row];
    if (tk >= 0) {
      const float w = wsl[row];
      const LAS float* src = ct + row * CT_LD + 64 * hf;
      u16* dst = (u16*)(P.ws + ((tk & 1) ? A_Y1 : A_Y0)) + (size_t)(tk >> 1) * 1024 + nb * 128 + 64 * hf;
#pragma unroll 1
      for (int c = 0; c < 8; ++c) {
        f32x4 a = *(const LAS f32x4*)(src + 8 * c), c4 = *(const LAS f32x4*)(src + 8 * c + 4);
#pragma unroll
        for (int k = 0; k < 4; ++k) { a[k] *= w; c4[k] *= w; }
        *(uint4*)(dst + 8 * c) = pk8(a, c4);
      }
    }
    __syncthreads();
  }
}

DI void ph7_combine(const Ptrs& P, ldsp lds, int bid, int G) {
  const int lane = threadIdx.x & 63, wave = threadIdx.x >> 6;
  for (int tok = bid * 4 + wave; tok < T; tok += G * 4) {
    const float4* hr = (const float4*)(P.out + (size_t)tok * 1024) + lane;
    const uint2* y0 = (const uint2*)((const u16*)(P.ws + A_Y0) + (size_t)tok * 1024) + lane;
    const uint2* y1 = (const uint2*)((const u16*)(P.ws + A_Y1) + (size_t)tok * 1024) + lane;
    uint2* o = (uint2*)((u16*)(P.ws + A_H2B) + (size_t)tok * 1024) + lane;
    float ss = 0.f;
#pragma unroll
    for (int j = 0; j < 4; ++j) {
      const float4 hv = hr[64 * j]; const uint2 a = y0[64 * j], c = y1[64 * j];
      const float v0 = hv.x + __uint_as_float(a.x << 16) + __uint_as_float(c.x << 16);
      const float v1 = hv.y + __uint_as_float(a.x & 0xffff0000u) + __uint_as_float(c.x & 0xffff0000u);
      const float v2 = hv.z + __uint_as_float(a.y << 16) + __uint_as_float(c.y << 16);
      const float v3 = hv.w + __uint_as_float(a.y & 0xffff0000u) + __uint_as_float(c.y & 0xffff0000u);
      ss += v0 * v0 + v1 * v1 + v2 * v2 + v3 * v3;
      o[64 * j] = make_uint2(pk2(v0, v1), pk2(v2, v3));
    }
    ss = wave_sum(ss);
    float se = (lane < 8) ? ((const float*)(P.ws + WS_SSQEP))[(size_t)tok * 8 + lane] : 0.f;
    se = wave_sum(se);
    if (lane == 0) {
      ((float*)(P.ws + WS_RSTD2))[tok] = rsqrtf(ss * (1.0f / 1024.0f) + EPS);
      ((float*)(P.ws + WS_RSTDE))[tok] = rsqrtf(se * (1.0f / 1024.0f) + EPS);
    }
  }
}

DI void ph8_final(const Ptrs& P, ldsp lds, int bid, int G) {
  const int tid = threadIdx.x, lane = tid & 63, wave = tid >> 6;
  LAS float* ct = (LAS float*)lds;
  const u16* h2b = (const u16*)(P.ws + A_H2B); const u16* WplgT = (const u16*)(P.ws + WS_WPLG);
  for (int it = bid; it < 1024; it += G) {
    int mt, nt; tile_map_1024(it, mt, nt);
    const int m0 = mt * 128, n0 = nt * 128;
    {
      const u16 *arow[4], *brow[4];
#pragma unroll
      for (int qq = 0; qq < 4; ++qq) { const int r = 32 * wave + 8 * qq + (lane >> 3); arow[qq] = h2b + (size_t)(m0 + r) * 1024; brow[qq] = WplgT + (size_t)(n0 + r) * 1024; }
      f32x16 acc[2][2]; zero_acc(acc);
      gemm_core(arow, brow, 16, acc, lds);
      acc_to_lds(acc, lds);
    }
    __syncthreads();
    const int row = tid >> 1, hf = tid & 1;
    const LAS float* src = ct + row * CT_LD + 64 * hf;
    const size_t go = (size_t)(m0 + row) * 1024 + n0 + 64 * hf;
    const float rs2 = ((const float*)(P.ws + WS_RSTD2))[m0 + row], rE = ((const float*)(P.ws + WS_RSTDE))[m0 + row];
    float* outr = P.out + go;
    const u16* y0 = (const u16*)(P.ws + A_Y0) + go; const u16* y1 = (const u16*)(P.ws + A_Y1) + go; const u16* eb = (const u16*)(P.ws + A_EBF) + go;
    const float* gp = P.g_ple + n0 + 64 * hf;
#pragma unroll 1
    for (int c = 0; c < 8; ++c) {
      const f32x4 a = *(const LAS f32x4*)(src + 8 * c), c4 = *(const LAS f32x4*)(src + 8 * c + 4);
      const float4 ha = *(const float4*)(outr + 8 * c), hb = *(const float4*)(outr + 8 * c + 4);
      const float4 ga = *(const float4*)(gp + 8 * c), gb = *(const float4*)(gp + 8 * c + 4);
      const uint4 ya = *(const uint4*)(y0 + 8 * c), yb = *(const uint4*)(y1 + 8 * c), ee = *(const uint4*)(eb + 8 * c);
      float hv[8] = {ha.x, ha.y, ha.z, ha.w, hb.x, hb.y, hb.z, hb.w};
      const float gv[8] = {ga.x, ga.y, ga.z, ga.w, gb.x, gb.y, gb.z, gb.w};
      const float av[8] = {a[0], a[1], a[2], a[3], c4[0], c4[1], c4[2], c4[3]};
      const unsigned yau[4] = {ya.x, ya.y, ya.z, ya.w}, ybu[4] = {yb.x, yb.y, yb.z, yb.w}, eeu[4] = {ee.x, ee.y, ee.z, ee.w};
#pragma unroll
      for (int k = 0; k < 8; ++k) {
        const unsigned sh = (k & 1) ? 0u : 16u;
        const float yv = __uint_as_float((yau[k >> 1] << sh) & 0xffff0000u) + __uint_as_float((ybu[k >> 1] << sh) & 0xffff0000u);
        const float ev = __uint_as_float((eeu[k >> 1] << sh) & 0xffff0000u);
        const float sg = 1.0f / (1.0f + __expf(-av[k] * rs2));
        hv[k] = hv[k] + yv + ev * rE * gv[k] * sg;
      }
      *(float4*)(outr + 8 * c) = make_float4(hv[0], hv[1], hv[2], hv[3]); *(float4*)(outr + 8 * c + 4) = make_float4(hv[4], hv[5], hv[6], hv[7]);
    }
    __syncthreads();
  }
}
__global__ void __launch_bounds__(256, 2) mega(Ptrs P, int ph_lo, int ph_hi) {
  extern __shared__ __attribute__((aligned(16))) unsigned char smem[];
  ldsp lds = (ldsp)smem;
  const int bid = blockIdx.x, G = gridDim.x;
  volatile LAS unsigned* st = (volatile LAS unsigned*)(lds + LDS_EXTRA + 1280);
  XcdBarrier xb; xb.bar = (unsigned*)(P.ws + WS_CTL); xb.x = 0; xb.st = st;
  if (ph_hi - ph_lo > 1) {
    if (threadIdx.x == 0) { st[0] = 0u; st[1] = 0u; }
    __syncthreads();
    xb = xcd_barrier_post((unsigned*)(P.ws + WS_CTL), st);
  }
#define RUN_PHASE(k, call) if (ph_lo <= k && k < ph_hi) { call; if (k + 1 < ph_hi) xcd_barrier(xb); }
  RUN_PHASE(0, ph0_prep(P, lds, bid, G))
  RUN_PHASE(1, ph1_inproj(P, lds, bid, G))
  RUN_PHASE(2, ph2_attn(P, lds, bid, G))
  RUN_PHASE(3, ph3_outproj(P, lds, bid, G))
  RUN_PHASE(4, ph4_router(P, lds, bid, G))
  RUN_PHASE(5, ph5_up(P, lds, bid, G))
  RUN_PHASE(6, ph6_down(P, lds, bid, G))
  RUN_PHASE(7, ph7_combine(P, lds, bid, G))
  RUN_PHASE(8, ph8_final(P, lds, bid, G))
}

extern "C" void kernel_launch(void* const* d_in, const int* in_sizes, int n_in, void* d_out, int out_size, void* d_ws, size_t ws_size,
                              hipStream_t stream) {
  static int grid = 0;
  if (grid == 0) {
    if (n_in != 25 || ws_size < WS_END || out_size != T * DM) { fprintf(stderr, "kernel_launch: unexpected n_in %d / out %d / ws_size %zu (need %zu)\n", n_in, out_size, ws_size, (size_t)WS_END); grid = -1; return; }
    int dev = 0, cus = 0, per_cu = 0;
    hipGetDevice(&dev);
    hipDeviceGetAttribute(&cus, hipDeviceAttributeMultiprocessorCount, dev);
    hipFuncSetAttribute((const void*)mega, hipFuncAttributeMaxDynamicSharedMemorySize, LDS_BYTES);
    hipOccupancyMaxActiveBlocksPerMultiprocessor(&per_cu, (const void*)mega, 256, LDS_BYTES);
    if (per_cu < 1) { fprintf(stderr, "kernel_launch: occupancy query returned %d\n", per_cu); grid = -1; return; }
    if (per_cu > 2) per_cu = 2;
    grid = cus * per_cu;
    fprintf(stderr, "kernel_launch: cus %d per_cu %d grid %d\n", cus, per_cu, grid);
  }
  if (grid < 0) return;
  Ptrs P{};
  const float** pp = (const float**)&P;
  for (int i = 0; i < 25; ++i) pp[i] = (const float*)d_in[i];
  P.out = (float*)d_out; P.ws = (unsigned char*)d_ws;
  hipMemsetAsync((unsigned char*)d_ws + WS_CTL, 0, XCD_BAR_WORDS * 4, stream);
#if ONE_LAUNCH
  mega<<<grid, 256, LDS_BYTES, stream>>>(P, 0, 9);
#else
  for (int ph = 0; ph < 9; ++ph) {
    if (OPT_MASK & (1 << ph)) { mega<<<grid, 256, LDS_BYTES, stream>>>(P, ph, ph + 1); continue; }
    switch (ph) {
      case 0: nv_scal<<<1, 64, 0, stream>>>(P); nv_rope<<<S * 32 / 256, 256, 0, stream>>>(P); break;
      case 1: nv_inproj<<<T / 4, 256, 0, stream>>>(P); break;
      case 2: nv_da<<<16 * 512, 256, 0, stream>>>(P); nv_na<<<NB * HB * S / 256, 256, 0, stream>>>(P); break;
      case 3: nv_outproj<<<T / 4, 256, 0, stream>>>(P); nv_ple<<<T / 4, 256, 0, stream>>>(P); break;
      case 4: nv_router<<<T, 64, 0, stream>>>(P); nv_plan<<<1, 64, 0, stream>>>(P); break;
      case 5: nv_up<<<(32768 + 32 * 128) / 4, 256, 0, stream>>>(P); break;
      case 6: nv_down<<<(32768 + 32 * 128) / 4, 256, 0, stream>>>(P); break;
      case 7: nv_combine<<<T, 256, 0, stream>>>(P); break;
      case 8: nv_final<<<T / 4, 256, 0, stream>>>(P); break;
    }
  }
#endif
}
```

```cpp
#define ONE_LAUNCH 1
#define OPT_MASK 0x1ff
#define REPEAT_MASK 0x0
#define PROBE_ROUTER 0
#define WITH_NAIVE 0
#include <hip/hip_runtime.h>
#include <cstdio>
#include <cstdint>

typedef unsigned short u16;
#define DI __device__ __forceinline__

constexpr int T = 16384, S = 4096, DM = 1024, NB = 4;
constexpr int DIN = 3072, DPLE = 256;
constexpr int HA = 4, HB = 16;
constexpr int NE = 32, DE = 512;
constexpr float EPS = 1e-6f;
constexpr float LOG2E = 1.4426950408889634f;
constexpr float LAM_INIT = 0.2f;

constexpr size_t MiB = 1ull << 20;
constexpr size_t WS_WIN = 0, WS_WOUT = 6 * MiB, WS_W13 = 8 * MiB, WS_W2 = 72 * MiB, WS_WPLG = 104 * MiB,
                 WS_WPLE = 106 * MiB, WS_WR = 106 * MiB + 512 * 1024, WS_ROPE = 107 * MiB;
constexpr size_t WS_SMALL = 108 * MiB;
constexpr size_t WS_RSTDX = WS_SMALL;
constexpr size_t WS_SSQ1P = WS_RSTDX + 65536;
constexpr size_t WS_SSQEP = WS_SSQ1P + 524288;
constexpr size_t WS_RSTD1 = WS_SSQEP + 524288;
constexpr size_t WS_RSTD2 = WS_RSTD1 + 65536;
constexpr size_t WS_SCAL  = WS_RSTD2 + 65536;
constexpr size_t WS_CNT   = WS_SCAL + 256;
constexpr int CNT_STRIDE = 64;
constexpr size_t WS_PADST = WS_CNT + 8192;
constexpr size_t WS_CTL   = WS_PADST + 256;
constexpr size_t WS_RSTDE = WS_CTL + 16384;
constexpr size_t WS_TOKL  = WS_SMALL + 2 * MiB;
constexpr size_t WS_WL    = WS_SMALL + 4 * MiB;
constexpr size_t WS_ACT   = 114 * MiB;
constexpr size_t A_XB = WS_ACT, A_AO = WS_ACT, A_HID = WS_ACT, A_H2B = WS_ACT;
constexpr size_t A_PB = WS_ACT + 32 * MiB;
constexpr size_t A_QA = WS_ACT + 40 * MiB, A_KA = WS_ACT + 56 * MiB, A_VAT = WS_ACT + 72 * MiB,
                 A_QB = WS_ACT + 88 * MiB, A_KB = WS_ACT + 104 * MiB, A_VBT = WS_ACT + 120 * MiB;
constexpr size_t A_H1B = WS_ACT + 40 * MiB, A_EBF = WS_ACT + 72 * MiB, A_Y0 = WS_ACT + 104 * MiB, A_Y1 = WS_ACT + 40 * MiB;
constexpr size_t WS_END = WS_ACT + 136 * MiB;

DI float bf2f(u16 u) { return __uint_as_float(((unsigned)u) << 16); }
DI u16 f2bf(float f) { __bf16 b = (__bf16)f; return __builtin_bit_cast(u16, b); }
DI int permpos(int s) { return (s & ~12) | ((s & 8) >> 1) | ((s & 4) << 1); }

struct Ptrs {
  const float *x, *p, *g_mix, *w_in, *g_qa, *g_ka, *lam_q1, *lam_k1, *lam_q2, *lam_k2, *g_sub, *g_qb, *g_kb, *rpb, *w_out,
      *g_ffn, *w_rg, *w_re, *w1, *w3, *w2, *g_plg, *w_plg, *w_ple, *g_ple;
  float* out;
  unsigned char* ws;
};

#define GAS __attribute__((address_space(1)))
#define LAS __attribute__((address_space(3)))
typedef LAS unsigned char* ldsp;
typedef __attribute__((ext_vector_type(8))) short bf16x8;
typedef __attribute__((ext_vector_type(16))) float f32x16;
typedef __attribute__((ext_vector_type(4))) float f32x4;
typedef __attribute__((ext_vector_type(2))) float f32x2v;
typedef __attribute__((ext_vector_type(2))) __bf16 bf16x2v;
constexpr int CT_LD = 132;
constexpr int LDS_EXTRA = 128 * CT_LD * 4;
constexpr int LDS_BYTES = LDS_EXTRA + 2048;

DI unsigned pk2(float a, float b) { bf16x2v v = __builtin_convertvector((f32x2v){a, b}, bf16x2v); return __builtin_bit_cast(unsigned, v); }
DI float wave_sum(float v) {
#pragma unroll
  for (int o = 1; o < 64; o <<= 1) v += __shfl_xor(v, o);
  return v;
}
DI float half_sum32(float v) {
#pragma unroll
  for (int o = 1; o < 32; o <<= 1) v += __shfl_xor(v, o);
  return v;
}
DI int crow(int e, int h) { return (e & 3) + 8 * (e >> 2) + 4 * h; }
DI void glds16(const void* g, ldsp l) { __builtin_amdgcn_global_load_lds((const GAS unsigned*)g, (LAS unsigned*)l, 16, 0, 0); }
DI void lds_wave_sync() { asm volatile("s_waitcnt lgkmcnt(0)" ::: "memory"); }

#define XB_TMO      128
#define XB_XCNT(j)  (256  + 64 * (j))
#define XB_XSUB(j)  (1280 + 64 * (j))
#define XB_XGEN(j)  (2304 + 64 * (j))
#define XB_TOP      3328
#define XB_TOPGEN   3392
#define XCD_BAR_WORDS 3456
#define XB_SPIN_CAP (1u << 22)
DI unsigned xb_ld(unsigned* p) { return __hip_atomic_load(p, __ATOMIC_RELAXED, __HIP_MEMORY_SCOPE_AGENT); }
DI unsigned xb_add(unsigned* p, unsigned v) { return __hip_atomic_fetch_add(p, v, __ATOMIC_RELAXED, __HIP_MEMORY_SCOPE_AGENT); }
DI unsigned xb_xcc_id() { return (unsigned)__builtin_amdgcn_s_getreg((3 << 11) | 20) & 0xFu; }
#define XB_SPIN(cond, bar) do { unsigned _sp = 0; while (cond) { __builtin_amdgcn_s_sleep(1); \
    if ((++_sp & 255u) == 0u) { if (xb_ld(&(bar)[XB_TMO])) break; if (_sp > XB_SPIN_CAP) { atomicAdd(&(bar)[XB_TMO], 1u); break; } } } } while (0)
struct XcdBarrier { unsigned* bar; unsigned x; volatile LAS unsigned* st; };
DI XcdBarrier xcd_barrier_post(unsigned* bar, volatile LAS unsigned* st) {
  XcdBarrier b; b.bar = bar; b.x = xb_xcc_id(); b.st = st;
  if (threadIdx.x == 0) (void)xb_add(&bar[XB_XCNT(b.x)], 1u);
  return b;
}
DI void xcd_barrier_complete(unsigned* bar, unsigned x, unsigned& nloc, unsigned& nx) {
  const unsigned G = gridDim.x;
  unsigned sum, cnt, mine, sp = 0u;
  for (;;) {
    sum = 0u; cnt = 0u; mine = 0u;
#pragma unroll
    for (unsigned j = 0; j < 16; ++j) { const unsigned c = xb_ld(&bar[XB_XCNT(j)]); sum += c; cnt += (c > 0u) ? 1u : 0u; mine = (j == x) ? c : mine; }
    if (sum == G) break;
    __builtin_amdgcn_s_sleep(1);
    if ((++sp & 255u) == 0u) { if (xb_ld(&bar[XB_TMO])) break; if (sp > XB_SPIN_CAP) { atomicAdd(&bar[XB_TMO], 1u); break; } }
  }
  nloc = mine > 0u ? mine : 1u; nx = cnt > 0u ? cnt : 1u;
}
DI void xcd_barrier(const XcdBarrier& b) {
  asm volatile("s_waitcnt vmcnt(0)" ::: "memory");
  __syncthreads();
  if (threadIdx.x == 0) {
    unsigned* bar = b.bar;
    __builtin_amdgcn_s_waitcnt(0);
    unsigned nloc = b.st[0], nx = b.st[1];
    if (nloc == 0u) { xcd_barrier_complete(bar, b.x, nloc, nx); b.st[0] = nloc; b.st[1] = nx; }
    const unsigned old = xb_add(&bar[XB_XSUB(b.x)], 1u);
    const unsigned gen = old / nloc;
    if (old + 1u == (gen + 1u) * nloc) {
      __builtin_amdgcn_fence(__ATOMIC_RELEASE, "agent");
      asm volatile("s_waitcnt vmcnt(0)" ::: "memory");
      const unsigned og = xb_add(&bar[XB_TOP], 1u);
      const unsigned tg = og / nx;
      if (og + 1u == (tg + 1u) * nx) xb_add(&bar[XB_TOPGEN], 1u);
      else XB_SPIN(xb_ld(&bar[XB_TOPGEN]) == tg, bar);
      __builtin_amdgcn_fence(__ATOMIC_ACQUIRE, "agent");
      xb_add(&bar[XB_XGEN(b.x)], 1u);
      asm volatile("s_waitcnt vmcnt(0)" ::: "memory");
    } else {
      XB_SPIN(xb_ld(&bar[XB_XGEN(b.x)]) == gen, bar);
      __builtin_amdgcn_fence(__ATOMIC_ACQUIRE, "agent");
      asm volatile("s_waitcnt vmcnt(0)" ::: "memory");
    }
  }
  __syncthreads();
}

DI void gemm_core(const u16* const (&arow)[4], const u16* const (&brow)[4], int nk, f32x16 (&acc)[2][2], ldsp lds) {
  const int tid = threadIdx.x, lane = tid & 63, wave = __builtin_amdgcn_readfirstlane(tid >> 6);
  const int wm = wave >> 1, wn = wave & 1;
  auto stage = [&](int buf, int kt) {
    ldsp la = lds + buf * 32768 + wave * 4096;
    ldsp lb = la + 16384;
#pragma unroll
    for (int qq = 0; qq < 4; ++qq) {
      const int r = 32 * wave + 8 * qq + (lane >> 3);
      const int c = (lane & 7) ^ ((r >> 1) & 7);
      glds16(arow[qq] + kt * 64 + c * 8, la + qq * 1024);
      glds16(brow[qq] + kt * 64 + c * 8, lb + qq * 1024);
    }
  };
  stage(0, 0);
  asm volatile("s_waitcnt vmcnt(0)" ::: "memory");
  __syncthreads();
  const int r31 = lane & 31, h = lane >> 5;
  for (int kt = 0; kt < nk; ++kt) {
    const int buf = kt & 1;
    if (kt + 1 < nk) stage(buf ^ 1, kt + 1);
    ldsp la = lds + buf * 32768;
    ldsp lb = la + 16384;
#pragma unroll
    for (int s = 0; s < 4; ++s) {
      bf16x8 a[2], b[2];
#pragma unroll
      for (int i = 0; i < 2; ++i) {
        const int ra = 64 * wm + 32 * i + r31, rb = 64 * wn + 32 * i + r31;
        a[i] = *(LAS bf16x8*)(la + ra * 128 + (((2 * s + h) ^ ((ra >> 1) & 7)) << 4));
        b[i] = *(LAS bf16x8*)(lb + rb * 128 + (((2 * s + h) ^ ((rb >> 1) & 7)) << 4));
      }
#pragma unroll
      for (int i = 0; i < 2; ++i)
#pragma unroll
        for (int j = 0; j < 2; ++j) acc[i][j] = __builtin_amdgcn_mfma_f32_32x32x16_bf16(a[i], b[j], acc[i][j], 0, 0, 0);
    }
    asm volatile("s_waitcnt vmcnt(0)" ::: "memory");
    __syncthreads();
  }
}
DI void zero_acc(f32x16 (&acc)[2][2]) {
#pragma unroll
  for (int i = 0; i < 2; ++i)
#pragma unroll
    for (int j = 0; j < 2; ++j)
#pragma unroll
      for (int e = 0; e < 16; ++e) acc[i][j][e] = 0.0f;
}

DI void tr_item(const float* W, int ldw, int k0, int n0, const float* gk, u16* dst, int ldd, LAS float* scr, int lane) {
#pragma unroll 8
  for (int i = 0; i < 32; ++i) {
    const int kk = 2 * i + (lane >> 5);
    float v = W[(size_t)(k0 + kk) * ldw + n0 + (lane & 31)];
    if (gk) v *= gk[k0 + kk];
    scr[kk * 33 + (lane & 31)] = v;
  }
  lds_wave_sync();
  const int c = lane & 7;
#pragma unroll
  for (int j = 0; j < 4; ++j) {
    const int n = (lane >> 3) + 8 * j;
    const LAS float* s = scr + (8 * c) * 33 + n;
    uint4 o;
    o.x = pk2(s[0 * 33], s[1 * 33]); o.y = pk2(s[2 * 33], s[3 * 33]); o.z = pk2(s[4 * 33], s[5 * 33]); o.w = pk2(s[6 * 33], s[7 * 33]);
    *(uint4*)(dst + (size_t)n * ldd + k0 + 8 * c) = o;
  }
  lds_wave_sync();
}

DI void ph0_prep(const Ptrs& P, ldsp lds, int bid, int G) {
  const int tid = threadIdx.x, lane = tid & 63, wave = tid >> 6;
  LAS float* scr = (LAS float*)(lds + wave * 8704);
  const int gw = bid * 4 + wave, NGW = G * 4;
  constexpr int I_W1 = 8192, I_W3 = 8192, I_W2 = 8192, I_X = 16384, I_WIN = 1536, I_P = 4096, I_WOUT = 512, I_PLG = 512, I_PLE = 128,
                I_WR = 768, I_ROPE = 2048, I_SC = 1;
  constexpr int TOTAL = I_W1 + I_W3 + I_W2 + I_X + I_WIN + I_P + I_WOUT + I_PLG + I_PLE + I_WR + I_ROPE + I_SC;
  u16* W13T = (u16*)(P.ws + WS_W13); u16* W2T = (u16*)(P.ws + WS_W2);
  for (int it = gw; it < TOTAL; it += NGW) {
    int r = it;
    if (r < I_W1 + I_W3) {
      const int isw3 = r >= I_W1; if (isw3) r -= I_W1;
      const int e = r >> 8, q = r & 255, kb = q >> 4, nb = q & 15, j0 = nb * 32;
      const int row = (j0 >> 6) * 128 + ((((j0 >> 5) & 1) << 1) + isw3) * 32;
      tr_item((isw3 ? P.w3 : P.w1) + (size_t)e * 1024 * 512, 512, kb * 64, j0, P.g_ffn, W13T + ((size_t)e * 1024 + row) * 1024, 1024, scr, lane);
      continue;
    }
    r -= I_W1 + I_W3;
    if (r < I_W2) {
      const int e = r >> 8, q = r & 255, kb = q >> 5, nb = q & 31;
      tr_item(P.w2 + (size_t)e * 512 * 1024, 1024, kb * 64, nb * 32, nullptr, W2T + ((size_t)e * 1024 + nb * 32) * 512, 512, scr, lane);
      continue;
    }
    r -= I_W2;
    if (r < I_X) {
      const float4* xr = (const float4*)(P.x + (size_t)r * 1024) + lane;
      float4 v[4]; float ss = 0.f;
#pragma unroll
      for (int j = 0; j < 4; ++j) { v[j] = xr[64 * j]; ss += v[j].x * v[j].x + v[j].y * v[j].y + v[j].z * v[j].z + v[j].w * v[j].w; }
      ss = wave_sum(ss);
      if (lane == 0) ((float*)(P.ws + WS_RSTDX))[r] = rsqrtf(ss * (1.0f / 1024.0f) + EPS);
      uint2* o = (uint2*)((u16*)(P.ws + A_XB) + (size_t)r * 1024) + lane;
#pragma unroll
      for (int j = 0; j < 4; ++j) o[64 * j] = make_uint2(pk2(v[j].x, v[j].y), pk2(v[j].z, v[j].w));
      continue;
    }
    r -= I_X;
    if (r < I_WIN) {
      const int kb = r / 96, nb = r % 96;
      tr_item(P.w_in, DIN, kb * 64, nb * 32, P.g_mix, (u16*)(P.ws + WS_WIN) + (size_t)(nb * 32) * 1024, 1024, scr, lane);
      continue;
    }
    r -= I_WIN;
    if (r < I_P) {
      const float4* pr = (const float4*)P.p + (size_t)r * 256 + lane;
      uint2* o = (uint2*)(P.ws + A_PB) + (size_t)r * 256 + lane;
#pragma unroll
      for (int j = 0; j < 4; ++j) { const float4 v = pr[64 * j]; o[64 * j] = make_uint2(pk2(v.x, v.y), pk2(v.z, v.w)); }
      continue;
    }
    r -= I_P;
    if (r < I_WOUT) {
      const int kb = r >> 5, nb = r & 31;
      tr_item(P.w_out, 1024, kb * 64, nb * 32, nullptr, (u16*)(P.ws + WS_WOUT) + (size_t)(nb * 32) * 1024, 1024, scr, lane);
      continue;
    }
    r -= I_WOUT;
    if (r < I_PLG) {
      const int kb = r >> 5, nb = r & 31;
      tr_item(P.w_plg, 1024, kb * 64, nb * 32, P.g_plg, (u16*)(P.ws + WS_WPLG) + (size_t)(nb * 32) * 1024, 1024, scr, lane);
      continue;
    }
    r -= I_PLG;
    if (r < I_PLE) {
      const int kb = r >> 5, nb = r & 31;
      tr_item(P.w_ple, 1024, kb * 64, nb * 32, nullptr, (u16*)(P.ws + WS_WPLE) + (size_t)(nb * 32) * 256, 256, scr, lane);
      continue;
    }
    r -= I_PLE;
    if (r < I_WR) {
      const int idx = r * 64 + lane, rr = idx >> 10, k = idx & 1023;
      float v = 0.f;
      if (rr < 4) v = P.w_rg[k * 4 + rr]; else if (rr < 36) v = P.w_re[k * 32 + (rr - 4)];
      ((float*)(P.ws + WS_WR))[idx] = v * P.g_ffn[k];
      continue;
    }
    r -= I_WR;
    if (r < I_ROPE) {
      const int idx = r * 64 + lane, s = idx >> 5, i = idx & 31;
      const float inv = powf(10000.0f, -(float)(2 * i) / 64.0f);
      const float ang = (float)s * inv;
      float sn, cs; sincosf(ang, &sn, &cs);
      ((float2*)(P.ws + WS_ROPE))[idx] = make_float2(cs, sn);
      continue;
    }
    if (lane == 0) {
      float s1 = 0, s2 = 0, mq = 0, mk = 0;
      for (int i = 0; i < 64; ++i) {
        s1 += P.lam_q1[i] * P.lam_k1[i]; s2 += P.lam_q2[i] * P.lam_k2[i];
        mq = fmaxf(mq, fabsf(P.g_qa[i])); mk = fmaxf(mk, fabsf(P.g_ka[i]));
      }
      float* sc = (float*)(P.ws + WS_SCAL);
      sc[0] = expf(s1) - expf(s2) + LAM_INIT;
      sc[1] = 8.0f * mq * mk * LOG2E;
      int* cnt = (int*)(P.ws + WS_CNT);
      for (int i = 0; i < 32; ++i) cnt[i * CNT_STRIDE] = 0;
    }
  }
}

DI void acc_to_lds(const f32x16 (&acc)[2][2], ldsp lds) {
  const int tid = threadIdx.x, lane = tid & 63, wave = tid >> 6, wm = wave >> 1, wn = wave & 1, h = lane >> 5, i31 = lane & 31;
  LAS float* ct = (LAS float*)lds;
#pragma unroll
  for (int mi = 0; mi < 2; ++mi)
#pragma unroll
    for (int ni = 0; ni < 2; ++ni)
#pragma unroll
      for (int e = 0; e < 16; ++e) ct[(64 * wm + 32 * mi + crow(e, h)) * CT_LD + 64 * wn + 32 * ni + i31] = acc[mi][ni][e];
}
DI void acc_to_lds_T(const f32x16 (&acc)[2][2], ldsp lds) {
  const int tid = threadIdx.x, lane = tid & 63, wave = tid >> 6, wm = wave >> 1, wn = wave & 1, h = lane >> 5, i31 = lane & 31;
  LAS float* ct = (LAS float*)lds;
#pragma unroll
  for (int mi = 0; mi < 2; ++mi)
#pragma unroll
    for (int ni = 0; ni < 2; ++ni)
#pragma unroll
      for (int g = 0; g < 4; ++g) {
        f32x4 v = {acc[mi][ni][4 * g], acc[mi][ni][4 * g + 1], acc[mi][ni][4 * g + 2], acc[mi][ni][4 * g + 3]};
        *(LAS f32x4*)(ct + (64 * wn + 32 * ni + i31) * CT_LD + 64 * wm + 32 * mi + 8 * g + 4 * h) = v;
      }
}
DI uint4 pk8(const f32x4 a, const f32x4 b) { return make_uint4(pk2(a[0], a[1]), pk2(a[2], a[3]), pk2(b[0], b[1]), pk2(b[2], b[3])); }
DI void ph1_inproj(const Ptrs& P, ldsp lds, int bid, int G) {
  const int tid = threadIdx.x, lane = tid & 63, wave = tid >> 6;
  const u16* xb = (const u16*)(P.ws + A_XB); const u16* WinT = (const u16*)(P.ws + WS_WIN);
  const float* rstdx = (const float*)(P.ws + WS_RSTDX);
  const float2* rope = (const float2*)(P.ws + WS_ROPE);
  u16* qA = (u16*)(P.ws + A_QA); u16* kA = (u16*)(P.ws + A_KA); u16* vAt = (u16*)(P.ws + A_VAT);
  u16* qB = (u16*)(P.ws + A_QB); u16* kB = (u16*)(P.ws + A_KB); u16* vBt = (u16*)(P.ws + A_VBT);
  const float qsA = 0.125f * LOG2E, qsB = 0.17677669529663687f * LOG2E;
  LAS float* ct = (LAS float*)lds;
  LAS float* rsl = (LAS float*)(lds + LDS_EXTRA);
  for (int it = bid; it < 3072; it += G) {
    const int xcd = it & 7, loc = it >> 3, grp = loc >> 6, w = loc & 63, mh = grp / 3, ng = grp % 3;
    const int mt = 16 * xcd + 8 * mh + (w & 7), nt = 8 * ng + (w >> 3);
    const int m0 = mt * 128, n0 = nt * 128;
    {
      const u16 *arow[4], *brow[4];
#pragma unroll
      for (int qq = 0; qq < 4; ++qq) { const int r = 32 * wave + 8 * qq + (lane >> 3); arow[qq] = xb + (size_t)(m0 + r) * 1024; brow[qq] = WinT + (size_t)(n0 + r) * 1024; }
      f32x16 acc[2][2]; zero_acc(acc);
      gemm_core(arow, brow, 16, acc, lds);
      if ((n0 >= 1024 && n0 < 1536) || n0 >= 2560) acc_to_lds_T(acc, lds); else acc_to_lds(acc, lds);
    }
    if (tid < 128) rsl[tid] = rstdx[m0 + tid];
    __syncthreads();
    const int b = m0 >> 12, sb = m0 & 4095;
    if (n0 < 1024) {
      const int isk = n0 >= 512, hh = (n0 & 511) >> 7, c4 = tid & 3, comp = (tid >> 2) & 1;
      const float* gg = isk ? P.g_ka : P.g_qa;
      const float4 g1a = *(const float4*)(gg + 8 * c4), g1b = *(const float4*)(gg + 8 * c4 + 4), g2a = *(const float4*)(gg + 32 + 8 * c4), g2b = *(const float4*)(gg + 36 + 8 * c4);
      u16* dstb = (isk ? kA : qA) + (size_t)(b * 4 + hh) * 4096 * 128 + comp * 64 + 8 * c4;
#pragma unroll 2
      for (int p = 0; p < 4; ++p) {
        const int row = 32 * p + (tid >> 3), s = sb + row;
        const LAS float* src = ct + row * CT_LD + comp * 64 + 8 * c4;
        const f32x4 x1a = *(const LAS f32x4*)src, x1b = *(const LAS f32x4*)(src + 4), x2a = *(const LAS f32x4*)(src + 32), x2b = *(const LAS f32x4*)(src + 36);
        float ss = 0.f;
#pragma unroll
        for (int k = 0; k < 4; ++k) ss += x1a[k] * x1a[k] + x1b[k] * x1b[k] + x2a[k] * x2a[k] + x2b[k] * x2b[k];
        ss += __shfl_xor(ss, 1); ss += __shfl_xor(ss, 2);
        const float rs = rsl[row];
        const float rn = rsqrtf(ss * rs * rs * (1.0f / 64.0f) + EPS) * rs * (isk ? 1.0f : qsA);
        const float4* rp = (const float4*)(rope + (size_t)s * 32 + 8 * c4);
        const float4 csA = rp[0], csB = rp[1], csC = rp[2], csD = rp[3];
        f32x4 o1a, o1b, o2a, o2b;
        { const float y = x1a[0] * rn * g1a.x, z = x2a[0] * rn * g2a.x; o1a[0] = y * csA.x - z * csA.y; o2a[0] = z * csA.x + y * csA.y; }
        { const float y = x1a[1] * rn * g1a.y, z = x2a[1] * rn * g2a.y; o1a[1] = y * csA.z - z * csA.w; o2a[1] = z * csA.z + y * csA.w; }
        { const float y = x1a[2] * rn * g1a.z, z = x2a[2] * rn * g2a.z; o1a[2] = y * csB.x - z * csB.y; o2a[2] = z * csB.x + y * csB.y; }
        { const float y = x1a[3] * rn * g1a.w, z = x2a[3] * rn * g2a.w; o1a[3] = y * csB.z - z * csB.w; o2a[3] = z * csB.z + y * csB.w; }
        { const float y = x1b[0] * rn * g1b.x, z = x2b[0] * rn * g2b.x; o1b[0] = y * csC.x - z * csC.y; o2b[0] = z * csC.x + y * csC.y; }
        { const float y = x1b[1] * rn * g1b.y, z = x2b[1] * rn * g2b.y; o1b[1] = y * csC.z - z * csC.w; o2b[1] = z * csC.z + y * csC.w; }
        { const float y = x1b[2] * rn * g1b.z, z = x2b[2] * rn * g2b.z; o1b[2] = y * csD.x - z * csD.y; o2b[2] = z * csD.x + y * csD.y; }
        { const float y = x1b[3] * rn * g1b.w, z = x2b[3] * rn * g2b.w; o1b[3] = y * csD.z - z * csD.w; o2b[3] = z * csD.z + y * csD.w; }
        u16* dst = dstb + (size_t)s * 128;
        *(uint4*)dst = pk8(o1a, o1b);
        *(uint4*)(dst + 32) = pk8(o2a, o2b);
      }
    } else if (n0 < 1536 || n0 >= 2560) {
      const int isA = n0 < 1536, cc = tid & 15;
      const int t0 = isA ? (16 * (cc >> 1) + 4 * (cc & 1)) : 8 * cc, t1 = isA ? t0 + 8 : t0 + 4;
      const f32x4 ra = *(const LAS f32x4*)(rsl + t0), rb = *(const LAS f32x4*)(rsl + t1);
#pragma unroll 2
      for (int p = 0; p < 8; ++p) {
        const int col = 16 * p + (tid >> 4);
        u16* dst;
        if (isA) dst = vAt + ((size_t)(b * 4 + ((n0 - 1024) >> 7)) * 128 + col) * 4096 + sb;
        else dst = vBt + ((size_t)(b * 16 + ((n0 - 2560) >> 5) + (col >> 5)) * 32 + (col & 31)) * 4096 + sb;
        f32x4 a = *(const LAS f32x4*)(ct + col * CT_LD + t0), c4v = *(const LAS f32x4*)(ct + col * CT_LD + t1);
#pragma unroll
        for (int k = 0; k < 4; ++k) { a[k] *= ra[k]; c4v[k] *= rb[k]; }
        *(uint4*)(dst + 8 * cc) = pk8(a, c4v);
      }
    } else {
      const int isk = n0 >= 2048, c4 = tid & 3, hq = (tid >> 2) & 3;
      const float* gg = isk ? P.g_kb : P.g_qb;
      const float4 ga = *(const float4*)(gg + 8 * c4), gb = *(const float4*)(gg + 8 * c4 + 4);
      const int hd = (((n0 - 1536) & 511) >> 5) + hq;
      u16* dstb = (isk ? kB : qB) + (size_t)(b * 16 + hd) * 4096 * 32 + 8 * c4;
#pragma unroll 2
      for (int p = 0; p < 8; ++p) {
        const int row = 16 * p + (tid >> 4), s = sb + row;
        const LAS float* src = ct + row * CT_LD + hq * 32 + 8 * c4;
        f32x4 a = *(const LAS f32x4*)src, c4v = *(const LAS f32x4*)(src + 4);
        float ss = 0.f;
#pragma unroll
        for (int k = 0; k < 4; ++k) ss += a[k] * a[k] + c4v[k] * c4v[k];
        ss += __shfl_xor(ss, 1); ss += __shfl_xor(ss, 2);
        const float rs = rsl[row];
        const float rn = rsqrtf(ss * rs * rs * (1.0f / 32.0f) + EPS) * rs * (isk ? 1.0f : qsB);
        a[0] *= rn * ga.x; a[1] *= rn * ga.y; a[2] *= rn * ga.z; a[3] *= rn * ga.w;
        c4v[0] *= rn * gb.x; c4v[1] *= rn * gb.y; c4v[2] *= rn * gb.z; c4v[3] *= rn * gb.w;
        *(uint4*)(dstb + (size_t)s * 32) = pk8(a, c4v);
      }
    }
    __syncthreads();
  }
}
typedef __attribute__((ext_vector_type(4))) unsigned u32x4;
DI bf16x8 packp(const f32x16& x, int s) {
  u32x4 p;
  p[0] = pk2(x[8 * s + 0], x[8 * s + 1]); p[1] = pk2(x[8 * s + 2], x[8 * s + 3]);
  p[2] = pk2(x[8 * s + 4], x[8 * s + 5]); p[3] = pk2(x[8 * s + 6], x[8 * s + 7]);
  return __builtin_bit_cast(bf16x8, p);
}
template <bool SHIFT>
DI void da_item(const Ptrs& P, ldsp lds, int item, float lam, float m2) {
  const int tid = threadIdx.x, lane = tid & 63, wave = __builtin_amdgcn_readfirstlane(tid >> 6), h = lane >> 5, i31 = lane & 31;
  const int xcd = item & 7, loc = item >> 3, bh = 2 * xcd + (loc >> 5), qblk = loc & 31;
  const u16* qA = (const u16*)(P.ws + A_QA) + (size_t)bh * 4096 * 128;
  const u16* kA = (const u16*)(P.ws + A_KA) + (size_t)bh * 4096 * 128;
  const u16* vAt = (const u16*)(P.ws + A_VAT) + (size_t)bh * 128 * 4096;
  const int q = qblk * 128 + 32 * wave + i31;
  bf16x8 qf[2][4];
#pragma unroll
  for (int c = 0; c < 2; ++c)
#pragma unroll
    for (int s = 0; s < 4; ++s) qf[c][s] = *(const bf16x8*)(qA + (size_t)q * 128 + c * 64 + 16 * s + 8 * h);
  auto stage = [&](int buf, int tile) {
    int ln = lane; asm volatile("" : "+v"(ln));
    ldsp lk = lds + buf * 32768 + wave * 4096;
    ldsp lv = lk + 16384;
    const u16* kt = kA + (size_t)tile * 64 * 128;
    const u16* vt = vAt + tile * 64;
#pragma unroll
    for (int qq = 0; qq < 4; ++qq) {
      const int q4 = 4 * wave + qq;
      const int krow = 4 * q4 + (ln >> 4), kc = (ln & 15) ^ (krow & 15);
      const int vrow = 8 * q4 + (ln >> 3), vc = (ln & 7) ^ ((vrow >> 1) & 7);
      glds16(kt + krow * 128 + kc * 8, lk + qq * 1024);
      glds16(vt + vrow * 4096 + vc * 8, lv + qq * 1024);
    }
  };
  f32x16 O1[4], O2[4];
#pragma unroll
  for (int dt = 0; dt < 4; ++dt)
#pragma unroll
    for (int e = 0; e < 16; ++e) { O1[dt][e] = 0.f; O2[dt][e] = 0.f; }
  float l1 = 0.f, l2 = 0.f;
  stage(0, 0);
  asm volatile("s_waitcnt vmcnt(0)" ::: "memory");
  __syncthreads();
  for (int tile = 0; tile < 64; ++tile) {
    const int buf = tile & 1;
    if (tile + 1 < 64) stage(buf ^ 1, tile + 1);
    ldsp lk = lds + buf * 32768;
    ldsp lv = lk + 16384;
#pragma unroll 1
    for (int kt2 = 0; kt2 < 2; ++kt2) {
      bf16x8 pf[2][2];
      const int key = 32 * kt2 + i31;
#pragma unroll
      for (int c = 0; c < 2; ++c) {
        f32x16 sa;
#pragma unroll
        for (int e = 0; e < 16; ++e) sa[e] = 0.f;
#pragma unroll
        for (int s = 0; s < 4; ++s) {
          const bf16x8 kf = *(LAS bf16x8*)(lk + key * 256 + (((c * 8 + 2 * s + h) ^ (key & 15)) << 4));
          sa = __builtin_amdgcn_mfma_f32_32x32x16_bf16(kf, qf[c][s], sa, 0, 0, 0);
        }
        float ls = 0.f;
#pragma unroll
        for (int e = 0; e < 16; ++e) { sa[e] = __builtin_amdgcn_exp2f(SHIFT ? sa[e] - m2 : sa[e]); ls += sa[e]; }
        if (c == 0) l1 += ls; else l2 += ls;
        pf[c][0] = packp(sa, 0); pf[c][1] = packp(sa, 1);
      }
      __builtin_amdgcn_sched_barrier(0);
#pragma unroll
      for (int s2 = 0; s2 < 2; ++s2)
#pragma unroll
        for (int dt = 0; dt < 4; ++dt) {
          const int d = 32 * dt + i31, ks = 2 * kt2 + s2;
          const bf16x8 vf = *(LAS bf16x8*)(lv + d * 128 + (((2 * ks + h) ^ ((d >> 1) & 7)) << 4));
          O1[dt] = __builtin_amdgcn_mfma_f32_32x32x16_bf16(vf, pf[0][s2], O1[dt], 0, 0, 0);
          O2[dt] = __builtin_amdgcn_mfma_f32_32x32x16_bf16(vf, pf[1][s2], O2[dt], 0, 0, 0);
        }
    }
    asm volatile("s_waitcnt vmcnt(0)" ::: "memory");
    __syncthreads();
  }
  l1 += __shfl_xor(l1, 32); l2 += __shfl_xor(l2, 32);
  const float i1 = 1.0f / l1, i2 = lam / l2;
  float ss = 0.f;
#pragma unroll
  for (int dt = 0; dt < 4; ++dt)
#pragma unroll
    for (int e = 0; e < 16; ++e) { const float o = O1[dt][e] * i1 - O2[dt][e] * i2; O1[dt][e] = o; ss += o * o; }
  ss += __shfl_xor(ss, 32);
  const float rn = rsqrtf(ss * (1.0f / 128.0f) + EPS) * (1.0f - LAM_INIT);
  const int b = bh >> 2, hh = bh & 3;
  u16* dst = (u16*)(P.ws + A_AO) + ((size_t)b * 4096 + q) * 1024 + hh * 128;
#pragma unroll
  for (int dt = 0; dt < 4; ++dt)
#pragma unroll
    for (int g = 0; g < 4; ++g) {
      const int d0 = 32 * dt + 8 * g + 4 * h;
      const float4 gs = *(const float4*)(P.g_sub + d0);
      *(uint2*)(dst + d0) = make_uint2(pk2(O1[dt][4 * g] * rn * gs.x, O1[dt][4 * g + 1] * rn * gs.y), pk2(O1[dt][4 * g + 2] * rn * gs.z, O1[dt][4 * g + 3] * rn * gs.w));
    }
}

typedef __attribute__((ext_vector_type(4))) short s16x4;
DI void na_item(const Ptrs& P, ldsp lds, int item, int wave, int lane) {
  const int r = item & 63, hd = (item >> 6) & 15, b = item >> 10;
  const int qi = lane & 15, g = lane >> 4;
  const u16* qB = (const u16*)(P.ws + A_QB) + (size_t)(b * 16 + hd) * 4096 * 32;
  const u16* kB = (const u16*)(P.ws + A_KB) + (size_t)(b * 16 + hd) * 4096 * 32;
  const u16* vBt = (const u16*)(P.ws + A_VBT) + (size_t)(b * 16 + hd) * 32 * 4096;
  LAS float* rpl = (LAS float*)(lds + wave * 2048);
  lds_wave_sync();
  for (int i = lane; i < 465; i += 64) rpl[i] = P.rpb[hd * 465 + i] * LOG2E;
  lds_wave_sync();
  const int rs = min(max(r - 4, 0), 56);
  const int rb0 = rs - r + 7;
  u16* aob = (u16*)(P.ws + A_AO) + ((size_t)b * 4096 + r * 64) * 1024 + 512 + hd * 32;
#pragma unroll 1
  for (int j = 0; j < 4; ++j) {
    const int c = 16 * j + qi, cs = min(max(c - 8, 0), 48);
    const int kb = min(min(max(16 * j - 8, 0), 48), 32);
    const bf16x8 qf = *(const bf16x8*)(qB + (size_t)(r * 64 + c) * 32 + 8 * g);
    f32x4 sa[8][2];
    float mx = -1e30f;
#pragma unroll
    for (int ri = 0; ri < 8; ++ri)
#pragma unroll
      for (int t = 0; t < 2; ++t) {
        const bf16x8 kf = *(const bf16x8*)(kB + (size_t)((rs + ri) * 64 + kb + 16 * t + qi) * 32 + 8 * g);
        f32x4 z = {0.f, 0.f, 0.f, 0.f};
        z = __builtin_amdgcn_mfma_f32_16x16x32_bf16(kf, qf, z, 0, 0, 0);
#pragma unroll
        for (int i = 0; i < 4; ++i) {
          const int kc = kb + 16 * t + 4 * g + i;
          const bool valid = (kc >= cs) && (kc < cs + 16);
          const int co = min(max(kc - c + 15, 0), 30);
          const float sv = valid ? z[i] + rpl[(rb0 + ri) * 31 + co] : -1e30f;
          z[i] = sv; mx = fmaxf(mx, sv);
        }
        sa[ri][t] = z;
      }
    mx = fmaxf(mx, __shfl_xor(mx, 16)); mx = fmaxf(mx, __shfl_xor(mx, 32));
    float l = 0.f;
    f32x4 oa[2] = {{0.f, 0.f, 0.f, 0.f}, {0.f, 0.f, 0.f, 0.f}};
#pragma unroll
    for (int ri = 0; ri < 8; ++ri) {
      float p[8];
#pragma unroll
      for (int t = 0; t < 2; ++t)
#pragma unroll
        for (int i = 0; i < 4; ++i) { const float e = __builtin_amdgcn_exp2f(sa[ri][t][i] - mx); p[4 * t + i] = e; l += e; }
      u32x4 pp; pp[0] = pk2(p[0], p[1]); pp[1] = pk2(p[2], p[3]); pp[2] = pk2(p[4], p[5]); pp[3] = pk2(p[6], p[7]);
      const bf16x8 pfr = __builtin_bit_cast(bf16x8, pp);
#pragma unroll
      for (int dtl = 0; dtl < 2; ++dtl) {
        const u16* vp = vBt + (size_t)(16 * dtl + qi) * 4096 + (rs + ri) * 64 + kb + 4 * g;
        const s16x4 lo = *(const s16x4*)vp, hi = *(const s16x4*)(vp + 16);
        const bf16x8 vf = __builtin_shufflevector(lo, hi, 0, 1, 2, 3, 4, 5, 6, 7);
        oa[dtl] = __builtin_amdgcn_mfma_f32_16x16x32_bf16(vf, pfr, oa[dtl], 0, 0, 0);
      }
    }
    l += __shfl_xor(l, 16); l += __shfl_xor(l, 32);
    const float il = 1.0f / l;
    u16* dst = aob + (size_t)c * 1024;
#pragma unroll
    for (int dtl = 0; dtl < 2; ++dtl)
      *(uint2*)(dst + 16 * dtl + 4 * g) = make_uint2(pk2(oa[dtl][0] * il, oa[dtl][1] * il), pk2(oa[dtl][2] * il, oa[dtl][3] * il));
  }
}

DI void ph2_attn(const Ptrs& P, ldsp lds, int bid, int G) {
  {
    const float* sc = (const float*)(P.ws + WS_SCAL);
    const float lam = sc[0], m2 = sc[1];
    if (m2 < 64.0f) { for (int it = bid; it < 512; it += G) da_item<false>(P, lds, it, lam, m2); }
  }
  const int wave = threadIdx.x >> 6, lane = threadIdx.x & 63;
  for (int wi = bid * 4 + wave; wi < 4096; wi += G * 4) na_item(P, lds, wi, wave, lane);
}

DI void tile_map_1024(int t2, int& mt, int& nt) {
  const int xcd = t2 & 7, loc = t2 >> 3, grp = loc >> 6, w = loc & 63;
  mt = 16 * xcd + 8 * grp + (w & 7); nt = w >> 3;
}
DI void ph3_outproj(const Ptrs& P, ldsp lds, int bid, int G) {
  const int tid = threadIdx.x, lane = tid & 63, wave = tid >> 6;
  LAS float* ct = (LAS float*)lds;
  for (int it = bid; it < 2048; it += G) {
    const int isple = it >= 1024;
    int mt, nt; tile_map_1024(it & 1023, mt, nt);
    const int m0 = mt * 128, n0 = nt * 128;
    {
      const u16* A = isple ? (const u16*)(P.ws + A_PB) : (const u16*)(P.ws + A_AO);
      const u16* B = isple ? (const u16*)(P.ws + WS_WPLE) : (const u16*)(P.ws + WS_WOUT);
      const int ld = isple ? 256 : 1024;
      const u16 *arow[4], *brow[4];
#pragma unroll
      for (int qq = 0; qq < 4; ++qq) { const int r = 32 * wave + 8 * qq + (lane >> 3); arow[qq] = A + (size_t)(m0 + r) * ld; brow[qq] = B + (size_t)(n0 + r) * ld; }
      f32x16 acc[2][2]; zero_acc(acc);
      gemm_core(arow, brow, isple ? 4 : 16, acc, lds);
      acc_to_lds(acc, lds);
    }
    __syncthreads();
    const int cc = tid & 15;
    float* ssqp = (float*)(P.ws + (isple ? WS_SSQEP : WS_SSQ1P));
#pragma unroll 2
    for (int p = 0; p < 8; ++p) {
      const int row = 16 * p + (tid >> 4);
      const LAS float* src = ct + row * CT_LD + 8 * cc;
      const size_t go = (size_t)(m0 + row) * 1024 + n0 + 8 * cc;
      f32x4 a = *(const LAS f32x4*)src, c4 = *(const LAS f32x4*)(src + 4);
      if (!isple) {
        const float4 xa = *(const float4*)(P.x + go), xb4 = *(const float4*)(P.x + go + 4);
        a[0] += xa.x; a[1] += xa.y; a[2] += xa.z; a[3] += xa.w; c4[0] += xb4.x; c4[1] += xb4.y; c4[2] += xb4.z; c4[3] += xb4.w;
        *(float4*)(P.out + go) = make_float4(a[0], a[1], a[2], a[3]); *(float4*)(P.out + go + 4) = make_float4(c4[0], c4[1], c4[2], c4[3]);
        *(uint4*)((u16*)(P.ws + A_H1B) + go) = pk8(a, c4);
      } else {
        *(uint4*)((u16*)(P.ws + A_EBF) + go) = pk8(a, c4);
      }
      float ss = a[0] * a[0] + a[1] * a[1] + a[2] * a[2] + a[3] * a[3] + c4[0] * c4[0] + c4[1] * c4[1] + c4[2] * c4[2] + c4[3] * c4[3];
      ss += __shfl_xor(ss, 1); ss += __shfl_xor(ss, 2); ss += __shfl_xor(ss, 4); ss += __shfl_xor(ss, 8);
      if (cc == 0) ssqp[(size_t)(m0 + row) * 8 + nt] = ss;
    }
    __syncthreads();
  }
}

template <bool DRY>
DI void ph4_router_t(const Ptrs& P, ldsp lds, int bid, int G) {
  const int tid = threadIdx.x, lane = tid & 63, wave = tid >> 6, t = lane & 15, kk = lane >> 4;
  LAS float* lg = (LAS float*)(lds + wave * 3072);
  const float* h1 = P.out; const float* WrT = (const float*)(P.ws + WS_WR);
  for (int item = bid * 4 + wave; item < 1024; item += G * 4) {
    const int tok0 = item * 16;
    f32x4 acc[3] = {{0.f, 0.f, 0.f, 0.f}, {0.f, 0.f, 0.f, 0.f}, {0.f, 0.f, 0.f, 0.f}};
    const float* ap = h1 + (size_t)(tok0 + t) * 1024 + 4 * kk;
    const float* bp = WrT + (size_t)t * 1024 + 4 * kk;
#pragma unroll 4
    for (int s = 0; s < 64; ++s) {
      const float4 a4 = *(const float4*)(ap + 16 * s);
      const float4 b0 = *(const float4*)(bp + 16 * s), b1 = *(const float4*)(bp + 16 * 1024 + 16 * s), b2 = *(const float4*)(bp + 32 * 1024 + 16 * s);
      acc[0] = __builtin_amdgcn_mfma_f32_16x16x4f32(a4.x, b0.x, acc[0], 0, 0, 0); acc[1] = __builtin_amdgcn_mfma_f32_16x16x4f32(a4.x, b1.x, acc[1], 0, 0, 0); acc[2] = __builtin_amdgcn_mfma_f32_16x16x4f32(a4.x, b2.x, acc[2], 0, 0, 0);
      acc[0] = __builtin_amdgcn_mfma_f32_16x16x4f32(a4.y, b0.y, acc[0], 0, 0, 0); acc[1] = __builtin_amdgcn_mfma_f32_16x16x4f32(a4.y, b1.y, acc[1], 0, 0, 0); acc[2] = __builtin_amdgcn_mfma_f32_16x16x4f32(a4.y, b2.y, acc[2], 0, 0, 0);
      acc[0] = __builtin_amdgcn_mfma_f32_16x16x4f32(a4.z, b0.z, acc[0], 0, 0, 0); acc[1] = __builtin_amdgcn_mfma_f32_16x16x4f32(a4.z, b1.z, acc[1], 0, 0, 0); acc[2] = __builtin_amdgcn_mfma_f32_16x16x4f32(a4.z, b2.z, acc[2], 0, 0, 0);
      acc[0] = __builtin_amdgcn_mfma_f32_16x16x4f32(a4.w, b0.w, acc[0], 0, 0, 0); acc[1] = __builtin_amdgcn_mfma_f32_16x16x4f32(a4.w, b1.w, acc[1], 0, 0, 0); acc[2] = __builtin_amdgcn_mfma_f32_16x16x4f32(a4.w, b2.w, acc[2], 0, 0, 0);
    }
    lds_wave_sync();
#pragma unroll
    for (int et = 0; et < 3; ++et)
#pragma unroll
      for (int i = 0; i < 4; ++i) lg[(4 * kk + i) * 48 + 16 * et + t] = acc[et][i];
    lds_wave_sync();
    if (lane < 16) {
      const int tok = tok0 + lane;
      const float* sp = (const float*)(P.ws + WS_SSQ1P) + (size_t)tok * 8;
      const float4 s0 = *(const float4*)sp, s1 = *(const float4*)(sp + 4);
      const float rstd = rsqrtf((s0.x + s0.y + s0.z + s0.w + s1.x + s1.y + s1.z + s1.w) * (1.0f / 1024.0f) + EPS);
      ((float*)(P.ws + WS_RSTD1))[tok] = rstd;
      const LAS float* L = lg + lane * 48;
      int gi = 0; float gm = L[0];
#pragma unroll
      for (int i = 1; i < 4; ++i) { const float v = L[i]; if (v > gm) { gm = v; gi = i; } }
      float gs = 0.f;
#pragma unroll
      for (int i = 0; i < 4; ++i) gs += expf((L[i] - gm) * rstd);
      const float gate = 1.0f / gs;
      const LAS float* el = L + 4 + 8 * gi;
      int e1 = 0; float m1 = el[0];
#pragma unroll
      for (int i = 1; i < 8; ++i) { const float v = el[i]; if (v > m1) { m1 = v; e1 = i; } }
      int e2 = 0; float m2v = -3.0e38f;
#pragma unroll
      for (int i = 0; i < 8; ++i) { const float v = el[i]; if (i != e1 && v > m2v) { m2v = v; e2 = i; } }
      const float p2 = expf((m2v - m1) * rstd);
      const float wa = gate / (1.0f + p2), wb = gate * p2 / (1.0f + p2);
      int* cnt = (int*)(P.ws + WS_CNT); int* tokl = (int*)(P.ws + WS_TOKL); float* wl = (float*)(P.ws + WS_WL);
      const int ea = gi * 8 + e1, eb = gi * 8 + e2;
      if (!DRY) {
        const int pa = atomicAdd(&cnt[ea * CNT_STRIDE], 1); tokl[ea * 16384 + pa] = tok * 2; wl[ea * 16384 + pa] = wa;
        const int pb = atomicAdd(&cnt[eb * CNT_STRIDE], 1); tokl[eb * 16384 + pb] = tok * 2 + 1; wl[eb * 16384 + pb] = wb;
      } else { ((float*)(P.ws + WS_RSTD1))[tok] = rstd + 0.0f * (wa + wb + (float)(ea + eb)); }
    }
  }
}

DI void ph4_router(const Ptrs& P, ldsp lds, int bid, int G) {
#if PROBE_ROUTER
  ph4_router_t<true>(P, lds, bid, G);
  __syncthreads();
#endif
  ph4_router_t<false>(P, lds, bid, G);
}

DI int moe_plan(const Ptrs& P, ldsp lds) {
  LAS int* smb = (LAS int*)(lds + LDS_EXTRA + 1024);
  if (threadIdx.x == 0) {
    const int* cnt = (const int*)(P.ws + WS_CNT);
    int a = 0;
    for (int e = 0; e < 32; ++e) { smb[e] = a; a += (cnt[e * CNT_STRIDE] + 127) >> 7; }
    smb[32] = a;
  }
  __syncthreads();
  return smb[32];
}
DI void ph5_up(const Ptrs& P, ldsp lds, int bid, int G) {
  const int tid = threadIdx.x, lane = tid & 63, wave = tid >> 6;
  LAS float* ct = (LAS float*)lds;
  LAS float* rsl = (LAS float*)(lds + LDS_EXTRA);
  LAS int* smb = (LAS int*)(lds + LDS_EXTRA + 1024);
  const int MB = moe_plan(P, lds);
  const int* cnt = (const int*)(P.ws + WS_CNT); const int* tokl = (const int*)(P.ws + WS_TOKL);
  const u16* h1b = (const u16*)(P.ws + A_H1B); const u16* W13T = (const u16*)(P.ws + WS_W13);
  const float* rstd1 = (const float*)(P.ws + WS_RSTD1);
  u16* hid = (u16*)(P.ws + A_HID);
  for (int it = bid; it < MB * 8; it += G) {
    const int nb = it & 7, gmb = it >> 3;
    int e = 0; while (gmb >= smb[e + 1]) ++e;
    const int mb = gmb - smb[e], ce = cnt[e * CNT_STRIDE];
    {
      const u16 *arow[4], *brow[4];
#pragma unroll
      for (int qq = 0; qq < 4; ++qq) {
        const int r = 32 * wave + 8 * qq + (lane >> 3), i = mb * 128 + r;
        const int tok = (i < ce) ? (tokl[e * 16384 + i] >> 1) : 0;
        arow[qq] = h1b + (size_t)tok * 1024; brow[qq] = W13T + ((size_t)e * 1024 + nb * 128 + r) * 1024;
      }
      f32x16 acc[2][2]; zero_acc(acc);
      gemm_core(arow, brow, 16, acc, lds);
      acc_to_lds(acc, lds);
    }
    if (tid < 128) { const int i = mb * 128 + tid; rsl[tid] = (i < ce) ? rstd1[tokl[e * 16384 + i] >> 1] : 0.0f; }
    __syncthreads();
    const int jc = tid & 7, hfc = jc >> 2, c = jc & 3;
#pragma unroll 2
    for (int p = 0; p < 4; ++p) {
      const int row = 32 * p + (tid >> 3);
      const LAS float* src = ct + row * CT_LD + 64 * hfc + 8 * c;
      const float rs = rsl[row];
      f32x4 u0 = *(const LAS f32x4*)src, u1 = *(const LAS f32x4*)(src + 4);
      const f32x4 v0 = *(const LAS f32x4*)(src + 32), v1 = *(const LAS f32x4*)(src + 36);
#pragma unroll
      for (int k = 0; k < 4; ++k) {
        const float a = u0[k] * rs, bq = u1[k] * rs;
        u0[k] = a / (1.0f + __expf(-a)) * (v0[k] * rs); u1[k] = bq / (1.0f + __expf(-bq)) * (v1[k] * rs);
      }
      *(uint4*)(hid + (size_t)(gmb * 128 + row) * 512 + 64 * nb + 8 * jc) = pk8(u0, u1);
    }
    __syncthreads();
  }
}
DI void ph6_down(const Ptrs& P, ldsp lds, int bid, int G) {
  const int tid = threadIdx.x, lane = tid & 63, wave = tid >> 6;
  LAS float* ct = (LAS float*)lds;
  LAS float* wsl = (LAS float*)(lds + LDS_EXTRA);
  LAS int* tkl = (LAS int*)(lds + LDS_EXTRA + 512);
  LAS int* smb = (LAS int*)(lds + LDS_EXTRA + 1024);
  const int MB = moe_plan(P, lds);
  const int* cnt = (const int*)(P.ws + WS_CNT); const int* tokl = (const int*)(P.ws + WS_TOKL); const float* wl = (const float*)(P.ws + WS_WL);
  const u16* hid = (const u16*)(P.ws + A_HID); const u16* W2T = (const u16*)(P.ws + WS_W2);
  for (int it = bid; it < MB * 8; it += G) {
    const int nb = it & 7, gmb = it >> 3;
    int e = 0; while (gmb >= smb[e + 1]) ++e;
    const int mb = gmb - smb[e], ce = cnt[e * CNT_STRIDE];
    {
      const u16 *arow[4], *brow[4];
#pragma unroll
      for (int qq = 0; qq < 4; ++qq) {
        const int r = 32 * wave + 8 * qq + (lane >> 3);
        arow[qq] = hid + (size_t)(gmb * 128 + r) * 512; brow[qq] = W2T + ((size_t)e * 1024 + nb * 128 + r) * 512;
      }
      f32x16 acc[2][2]; zero_acc(acc);
      gemm_core(arow, brow, 8, acc, lds);
      acc_to_lds(acc, lds);
    }
    if (tid < 128) { const int i = mb * 128 + tid; const bool v = i < ce; tkl[tid] = v ? tokl[e * 16384 + i] : -1; wsl[tid] = v ? wl[e * 16384 + i] : 0.0f; }
    __syncthreads();
    const int cc = tid & 15;
#pragma unroll 2
    for (int p = 0; p < 8; ++p) {
      const int row = 16 * p + (tid >> 4);
      const int tk = tkl[row];
      if (tk >= 0) {
        const float w = wsl[row];
        const LAS float* src = ct + row * CT_LD + 8 * cc;
        f32x4 a = *(const LAS f32x4*)src, c4 = *(const LAS f32x4*)(src + 4);
#pragma unroll
        for (int k = 0; k < 4; ++k) { a[k] *= w; c4[k] *= w; }
        *(uint4*)((u16*)(P.ws + ((tk & 1) ? A_Y1 : A_Y0)) + (size_t)(tk >> 1) * 1024 + nb * 128 + 8 * cc) = pk8(a, c4);
      }
    }
    __syncthreads();
  }
}

DI void ph7_combine(const Ptrs& P, ldsp lds, int bid, int G) {
  const int lane = threadIdx.x & 63, wave = threadIdx.x >> 6;
  for (int tok = bid * 4 + wave; tok < T; tok += G * 4) {
    const float4* hr = (const float4*)(P.out + (size_t)tok * 1024) + lane;
    const uint2* y0 = (const uint2*)((const u16*)(P.ws + A_Y0) + (size_t)tok * 1024) + lane;
    const uint2* y1 = (const uint2*)((const u16*)(P.ws + A_Y1) + (size_t)tok * 1024) + lane;
    uint2* o = (uint2*)((u16*)(P.ws + A_H2B) + (size_t)tok * 1024) + lane;
    float ss = 0.f;
#pragma unroll
    for (int j = 0; j < 4; ++j) {
      const float4 hv = hr[64 * j]; const uint2 a = y0[64 * j], c = y1[64 * j];
      const float v0 = hv.x + __uint_as_float(a.x << 16) + __uint_as_float(c.x << 16);
      const float v1 = hv.y + __uint_as_float(a.x & 0xffff0000u) + __uint_as_float(c.x & 0xffff0000u);
      const float v2 = hv.z + __uint_as_float(a.y << 16) + __uint_as_float(c.y << 16);
      const float v3 = hv.w + __uint_as_float(a.y & 0xffff0000u) + __uint_as_float(c.y & 0xffff0000u);
      ss += v0 * v0 + v1 * v1 + v2 * v2 + v3 * v3;
      o[64 * j] = make_uint2(pk2(v0, v1), pk2(v2, v3));
    }
    ss = wave_sum(ss);
    float se = (lane < 8) ? ((const float*)(P.ws + WS_SSQEP))[(size_t)tok * 8 + lane] : 0.f;
    se = wave_sum(se);
    if (lane == 0) {
      ((float*)(P.ws + WS_RSTD2))[tok] = rsqrtf(ss * (1.0f / 1024.0f) + EPS);
      ((float*)(P.ws + WS_RSTDE))[tok] = rsqrtf(se * (1.0f / 1024.0f) + EPS);
    }
  }
}

template <bool DRY>
DI void ph8_final_t(const Ptrs& P, ldsp lds, int bid, int G) {
  const int tid = threadIdx.x, lane = tid & 63, wave = tid >> 6;
  LAS float* ct = (LAS float*)lds;
  const u16* h2b = (const u16*)(P.ws + A_H2B); const u16* WplgT = (const u16*)(P.ws + WS_WPLG);
  for (int it = bid; it < 1024; it += G) {
    int mt, nt; tile_map_1024(it, mt, nt);
    const int m0 = mt * 128, n0 = nt * 128;
    {
      const u16 *arow[4], *brow[4];
#pragma unroll
      for (int qq = 0; qq < 4; ++qq) { const int r = 32 * wave + 8 * qq + (lane >> 3); arow[qq] = h2b + (size_t)(m0 + r) * 1024; brow[qq] = WplgT + (size_t)(n0 + r) * 1024; }
      f32x16 acc[2][2]; zero_acc(acc);
      gemm_core(arow, brow, 16, acc, lds);
      acc_to_lds(acc, lds);
    }
    __syncthreads();
    const int cc = tid & 15;
    const float4 ga = *(const float4*)(P.g_ple + n0 + 8 * cc), gb = *(const float4*)(P.g_ple + n0 + 8 * cc + 4);
    const float gv[8] = {ga.x, ga.y, ga.z, ga.w, gb.x, gb.y, gb.z, gb.w};
#pragma unroll 2
    for (int p = 0; p < 8; ++p) {
      const int row = 16 * p + (tid >> 4);
      const LAS float* src = ct + row * CT_LD + 8 * cc;
      const size_t go = (size_t)(m0 + row) * 1024 + n0 + 8 * cc;
      const float rs2 = ((const float*)(P.ws + WS_RSTD2))[m0 + row], rE = ((const float*)(P.ws + WS_RSTDE))[m0 + row];
      const f32x4 a = *(const LAS f32x4*)src, c4 = *(const LAS f32x4*)(src + 4);
      const float4 ha = *(const float4*)(P.out + go), hb = *(const float4*)(P.out + go + 4);
      const uint4 ya = *(const uint4*)((const u16*)(P.ws + A_Y0) + go), yb = *(const uint4*)((const u16*)(P.ws + A_Y1) + go), ee = *(const uint4*)((const u16*)(P.ws + A_EBF) + go);
      float hv[8] = {ha.x, ha.y, ha.z, ha.w, hb.x, hb.y, hb.z, hb.w};
      const float av[8] = {a[0], a[1], a[2], a[3], c4[0], c4[1], c4[2], c4[3]};
      const unsigned yau[4] = {ya.x, ya.y, ya.z, ya.w}, ybu[4] = {yb.x, yb.y, yb.z, yb.w}, eeu[4] = {ee.x, ee.y, ee.z, ee.w};
#pragma unroll
      for (int k = 0; k < 8; ++k) {
        const unsigned sh = (k & 1) ? 0u : 16u;
        const float yv = __uint_as_float((yau[k >> 1] << sh) & 0xffff0000u) + __uint_as_float((ybu[k >> 1] << sh) & 0xffff0000u);
        const float ev = __uint_as_float((eeu[k >> 1] << sh) & 0xffff0000u);
        const float sg = 1.0f / (1.0f + __expf(-av[k] * rs2));
        hv[k] = hv[k] + yv + ev * rE * gv[k] * sg;
      }
      float* wr = DRY ? ((float*)(P.ws + WS_W13) + go) : (P.out + go);
      *(float4*)wr = make_float4(hv[0], hv[1], hv[2], hv[3]); *(float4*)(wr + 4) = make_float4(hv[4], hv[5], hv[6], hv[7]);
    }
    __syncthreads();
  }
}

DI void ph8_final(const Ptrs& P, ldsp lds, int bid, int G) {
#if PROBE_ROUTER == 2
  ph8_final_t<true>(P, lds, bid, G);
  __syncthreads();
#endif
  ph8_final_t<false>(P, lds, bid, G);
}
__global__ void __launch_bounds__(256, 2) mega(Ptrs P, int ph_lo, int ph_hi) {
  extern __shared__ __attribute__((aligned(16))) unsigned char smem[];
  ldsp lds = (ldsp)smem;
  const int bid = blockIdx.x, G = gridDim.x;
  volatile LAS unsigned* st = (volatile LAS unsigned*)(lds + LDS_EXTRA + 1280);
  XcdBarrier xb; xb.bar = (unsigned*)(P.ws + WS_CTL); xb.x = 0; xb.st = st;
  if (ph_hi - ph_lo > 1) {
    if (threadIdx.x == 0) { st[0] = 0u; st[1] = 0u; }
    __syncthreads();
    xb = xcd_barrier_post((unsigned*)(P.ws + WS_CTL), st);
  }
#define RUN_PHASE(k, call) if (ph_lo <= k && k < ph_hi) { if ((REPEAT_MASK >> k) & 1) { call; xcd_barrier(xb); } call; if (k + 1 < ph_hi) xcd_barrier(xb); }
  RUN_PHASE(0, ph0_prep(P, lds, bid, G))
  RUN_PHASE(1, ph1_inproj(P, lds, bid, G))
  RUN_PHASE(2, ph2_attn(P, lds, bid, G))
  RUN_PHASE(3, ph3_outproj(P, lds, bid, G))
  RUN_PHASE(4, ph4_router(P, lds, bid, G))
  RUN_PHASE(5, ph5_up(P, lds, bid, G))
  RUN_PHASE(6, ph6_down(P, lds, bid, G))
  RUN_PHASE(7, ph7_combine(P, lds, bid, G))
  RUN_PHASE(8, ph8_final(P, lds, bid, G))
}

extern "C" void kernel_launch(void* const* d_in, const int* in_sizes, int n_in, void* d_out, int out_size, void* d_ws, size_t ws_size,
                              hipStream_t stream) {
  static int grid = 0;
  if (grid == 0) {
    if (n_in != 25 || ws_size < WS_END || out_size != T * DM) { fprintf(stderr, "kernel_launch: unexpected n_in %d / out %d / ws_size %zu (need %zu)\n", n_in, out_size, ws_size, (size_t)WS_END); grid = -1; return; }
    int dev = 0, cus = 0, per_cu = 0;
    (void)hipGetDevice(&dev);
    (void)hipDeviceGetAttribute(&cus, hipDeviceAttributeMultiprocessorCount, dev);
    (void)hipFuncSetAttribute((const void*)mega, hipFuncAttributeMaxDynamicSharedMemorySize, LDS_BYTES);
    (void)hipOccupancyMaxActiveBlocksPerMultiprocessor(&per_cu, (const void*)mega, 256, LDS_BYTES);
    if (per_cu < 1) { fprintf(stderr, "kernel_launch: occupancy query returned %d\n", per_cu); grid = -1; return; }
    if (per_cu > 2) per_cu = 2;
    grid = cus * per_cu;
    fprintf(stderr, "kernel_launch: cus %d per_cu %d grid %d\n", cus, per_cu, grid);
  }
  if (grid < 0) return;
  Ptrs P{};
  const float** pp = (const float**)&P;
  for (int i = 0; i < 25; ++i) pp[i] = (const float*)d_in[i];
  P.out = (float*)d_out; P.ws = (unsigned char*)d_ws;
  (void)hipMemsetAsync((unsigned char*)d_ws + WS_CTL, 0, XCD_BAR_WORDS * 4, stream);
#if ONE_LAUNCH
  mega<<<grid, 256, LDS_BYTES, stream>>>(P, 0, 9);
#elif WITH_NAIVE
  for (int ph = 0; ph < 9; ++ph) {
    if (OPT_MASK & (1 << ph)) { mega<<<grid, 256, LDS_BYTES, stream>>>(P, ph, ph + 1); continue; }
    switch (ph) {
      case 0: nv_scal<<<1, 64, 0, stream>>>(P); nv_rope<<<S * 32 / 256, 256, 0, stream>>>(P); break;
      case 1: nv_inproj<<<T / 4, 256, 0, stream>>>(P); break;
      case 2: nv_da<<<16 * 512, 256, 0, stream>>>(P); nv_na<<<NB * HB * S / 256, 256, 0, stream>>>(P); break;
      case 3: nv_outproj<<<T / 4, 256, 0, stream>>>(P); nv_ple<<<T / 4, 256, 0, stream>>>(P); break;
      case 4: nv_router<<<T, 64, 0, stream>>>(P); nv_plan<<<1, 64, 0, stream>>>(P); break;
      case 5: nv_up<<<(32768 + 32 * 128) / 4, 256, 0, stream>>>(P); break;
      case 6: nv_down<<<(32768 + 32 * 128) / 4, 256, 0, stream>>>(P); break;
      case 7: nv_combine<<<T, 256, 0, stream>>>(P); break;
      case 8: nv_final<<<T / 4, 256, 0, stream>>>(P); break;
    }
  }
#else
  for (int ph = 0; ph < 9; ++ph) mega<<<grid, 256, LDS_BYTES, stream>>>(P, ph, ph + 1);
#endif
}
```

```cpp
#define ONE_LAUNCH 1
#define OPT_MASK 0x1ff
#define REPEAT_MASK 0x0
#define PROBE_ROUTER 0
#define WITH_NAIVE 0
#include <hip/hip_runtime.h>
#include <cstdio>
#include <cstdint>

typedef unsigned short u16;
#define DI __device__ __forceinline__

constexpr int T = 16384, S = 4096, DM = 1024, NB = 4;
constexpr int DIN = 3072, DPLE = 256;
constexpr int HA = 4, HB = 16;
constexpr int NE = 32, DE = 512;
constexpr float EPS = 1e-6f;
constexpr float LOG2E = 1.4426950408889634f;
constexpr float LAM_INIT = 0.2f;

constexpr size_t MiB = 1ull << 20;
constexpr size_t WS_WIN = 0, WS_WOUT = 6 * MiB, WS_W13 = 8 * MiB, WS_W2 = 72 * MiB, WS_WPLG = 104 * MiB,
                 WS_WPLE = 106 * MiB, WS_WR = 106 * MiB + 512 * 1024, WS_ROPE = 107 * MiB;
constexpr size_t WS_SMALL = 108 * MiB;
constexpr size_t WS_RSTDX = WS_SMALL;
constexpr size_t WS_SSQ1P = WS_RSTDX + 65536;
constexpr size_t WS_SSQEP = WS_SSQ1P + 524288;
constexpr size_t WS_RSTD1 = WS_SSQEP + 524288;
constexpr size_t WS_RSTD2 = WS_RSTD1 + 65536;
constexpr size_t WS_SCAL  = WS_RSTD2 + 65536;
constexpr size_t WS_CNT   = WS_SCAL + 256;
constexpr int CNT_STRIDE = 64;
constexpr size_t WS_PADST = WS_CNT + 8192;
constexpr size_t WS_CTL   = WS_PADST + 256;
constexpr size_t WS_RSTDE = WS_CTL + 16384;
constexpr size_t WS_TOKL  = WS_SMALL + 2 * MiB;
constexpr size_t WS_WL    = WS_SMALL + 4 * MiB;
constexpr size_t WS_ACT   = 114 * MiB;
constexpr size_t A_XB = WS_ACT, A_AO = WS_ACT, A_HID = WS_ACT, A_H2B = WS_ACT;
constexpr size_t A_PB = WS_ACT + 32 * MiB;
constexpr size_t A_QA = WS_ACT + 40 * MiB, A_KA = WS_ACT + 56 * MiB, A_VAT = WS_ACT + 72 * MiB,
                 A_QB = WS_ACT + 88 * MiB, A_KB = WS_ACT + 104 * MiB, A_VBT = WS_ACT + 120 * MiB;
constexpr size_t A_H1B = WS_ACT + 40 * MiB, A_EBF = WS_ACT + 72 * MiB, A_Y0 = WS_ACT + 104 * MiB, A_Y1 = WS_ACT + 40 * MiB;
constexpr size_t WS_END = WS_ACT + 136 * MiB;

DI float bf2f(u16 u) { return __uint_as_float(((unsigned)u) << 16); }
DI u16 f2bf(float f) { __bf16 b = (__bf16)f; return __builtin_bit_cast(u16, b); }
DI int permpos(int s) { return (s & ~12) | ((s & 8) >> 1) | ((s & 4) << 1); }

struct Ptrs {
  const float *x, *p, *g_mix, *w_in, *g_qa, *g_ka, *lam_q1, *lam_k1, *lam_q2, *lam_k2, *g_sub, *g_qb, *g_kb, *rpb, *w_out,
      *g_ffn, *w_rg, *w_re, *w1, *w3, *w2, *g_plg, *w_plg, *w_ple, *g_ple;
  float* out;
  unsigned char* ws;
};

#define GAS __attribute__((address_space(1)))
#define LAS __attribute__((address_space(3)))
typedef LAS unsigned char* ldsp;
typedef __attribute__((ext_vector_type(8))) short bf16x8;
typedef __attribute__((ext_vector_type(16))) float f32x16;
typedef __attribute__((ext_vector_type(4))) float f32x4;
typedef __attribute__((ext_vector_type(2))) float f32x2v;
typedef __attribute__((ext_vector_type(2))) __bf16 bf16x2v;
constexpr int CT_LD = 132;
constexpr int LDS_EXTRA = 128 * CT_LD * 4;
constexpr int LDS_BYTES = LDS_EXTRA + 2048;

DI unsigned pk2(float a, float b) { bf16x2v v = __builtin_convertvector((f32x2v){a, b}, bf16x2v); return __builtin_bit_cast(unsigned, v); }
DI float wave_sum(float v) {
#pragma unroll
  for (int o = 1; o < 64; o <<= 1) v += __shfl_xor(v, o);
  return v;
}
DI float half_sum32(float v) {
#pragma unroll
  for (int o = 1; o < 32; o <<= 1) v += __shfl_xor(v, o);
  return v;
}
DI int crow(int e, int h) { return (e & 3) + 8 * (e >> 2) + 4 * h; }
DI void glds16(const void* g, ldsp l) { __builtin_amdgcn_global_load_lds((const GAS unsigned*)g, (LAS unsigned*)l, 16, 0, 0); }
DI void lds_wave_sync() { asm volatile("s_waitcnt lgkmcnt(0)" ::: "memory"); }

#define XB_TMO      128
#define XB_XCNT(j)  (256  + 64 * (j))
#define XB_XSUB(j)  (1280 + 64 * (j))
#define XB_XGEN(j)  (2304 + 64 * (j))
#define XB_TOP      3328
#define XB_TOPGEN   3392
#define XCD_BAR_WORDS 3456
#define XB_SPIN_CAP (1u << 22)
DI unsigned xb_ld(unsigned* p) { return __hip_atomic_load(p, __ATOMIC_RELAXED, __HIP_MEMORY_SCOPE_AGENT); }
DI unsigned xb_add(unsigned* p, unsigned v) { return __hip_atomic_fetch_add(p, v, __ATOMIC_RELAXED, __HIP_MEMORY_SCOPE_AGENT); }
DI unsigned xb_xcc_id() { return (unsigned)__builtin_amdgcn_s_getreg((3 << 11) | 20) & 0xFu; }
#define XB_SPIN(cond, bar) do { unsigned _sp = 0; while (cond) { __builtin_amdgcn_s_sleep(1); \
    if ((++_sp & 255u) == 0u) { if (xb_ld(&(bar)[XB_TMO])) break; if (_sp > XB_SPIN_CAP) { atomicAdd(&(bar)[XB_TMO], 1u); break; } } } } while (0)
struct XcdBarrier { unsigned* bar; unsigned x; volatile LAS unsigned* st; };
DI XcdBarrier xcd_barrier_post(unsigned* bar, volatile LAS unsigned* st) {
  XcdBarrier b; b.bar = bar; b.x = xb_xcc_id(); b.st = st;
  if (threadIdx.x == 0) (void)xb_add(&bar[XB_XCNT(b.x)], 1u);
  return b;
}
DI void xcd_barrier_complete(unsigned* bar, unsigned x, unsigned& nloc, unsigned& nx) {
  const unsigned G = gridDim.x;
  unsigned sum, cnt, mine, sp = 0u;
  for (;;) {
    sum = 0u; cnt = 0u; mine = 0u;
#pragma unroll
    for (unsigned j = 0; j < 16; ++j) { const unsigned c = xb_ld(&bar[XB_XCNT(j)]); sum += c; cnt += (c > 0u) ? 1u : 0u; mine = (j == x) ? c : mine; }
    if (sum == G) break;
    __builtin_amdgcn_s_sleep(1);
    if ((++sp & 255u) == 0u) { if (xb_ld(&bar[XB_TMO])) break; if (sp > XB_SPIN_CAP) { atomicAdd(&bar[XB_TMO], 1u); break; } }
  }
  nloc = mine > 0u ? mine : 1u; nx = cnt > 0u ? cnt : 1u;
}
DI void xcd_barrier(const XcdBarrier& b) {
  asm volatile("s_waitcnt vmcnt(0)" ::: "memory");
  __syncthreads();
  if (threadIdx.x == 0) {
    unsigned* bar = b.bar;
    __builtin_amdgcn_s_waitcnt(0);
    unsigned nloc = b.st[0], nx = b.st[1];
    if (nloc == 0u) { xcd_barrier_complete(bar, b.x, nloc, nx); b.st[0] = nloc; b.st[1] = nx; }
    const unsigned old = xb_add(&bar[XB_XSUB(b.x)], 1u);
    const unsigned gen = old / nloc;
    if (old + 1u == (gen + 1u) * nloc) {
      __builtin_amdgcn_fence(__ATOMIC_RELEASE, "agent");
      asm volatile("s_waitcnt vmcnt(0)" ::: "memory");
      const unsigned og = xb_add(&bar[XB_TOP], 1u);
      const unsigned tg = og / nx;
      if (og + 1u == (tg + 1u) * nx) xb_add(&bar[XB_TOPGEN], 1u);
      else XB_SPIN(xb_ld(&bar[XB_TOPGEN]) == tg, bar);
      __builtin_amdgcn_fence(__ATOMIC_ACQUIRE, "agent");
      xb_add(&bar[XB_XGEN(b.x)], 1u);
      asm volatile("s_waitcnt vmcnt(0)" ::: "memory");
    } else {
      XB_SPIN(xb_ld(&bar[XB_XGEN(b.x)]) == gen, bar);
      __builtin_amdgcn_fence(__ATOMIC_ACQUIRE, "agent");
      asm volatile("s_waitcnt vmcnt(0)" ::: "memory");
    }
  }
  __syncthreads();
}

DI void gemm_core(const u16* const (&arow)[4], const u16* const (&brow)[4], int nk, f32x16 (&acc)[2][2], ldsp lds) {
  const int tid = threadIdx.x, lane = tid & 63, wave = __builtin_amdgcn_readfirstlane(tid >> 6);
  const int wm = wave >> 1, wn = wave & 1;
  auto stage = [&](int buf, int kt) {
    ldsp la = lds + buf * 32768 + wave * 4096;
    ldsp lb = la + 16384;
#pragma unroll
    for (int qq = 0; qq < 4; ++qq) {
      const int r = 32 * wave + 8 * qq + (lane >> 3);
      const int c = (lane & 7) ^ ((r >> 1) & 7);
      glds16(arow[qq] + kt * 64 + c * 8, la + qq * 1024);
      glds16(brow[qq] + kt * 64 + c * 8, lb + qq * 1024);
    }
  };
  stage(0, 0);
  asm volatile("s_waitcnt vmcnt(0)" ::: "memory");
  __syncthreads();
  const int r31 = lane & 31, h = lane >> 5;
  for (int kt = 0; kt < nk; ++kt) {
    const int buf = kt & 1;
    if (kt + 1 < nk) stage(buf ^ 1, kt + 1);
    ldsp la = lds + buf * 32768;
    ldsp lb = la + 16384;
#pragma unroll
    for (int s = 0; s < 4; ++s) {
      bf16x8 a[2], b[2];
#pragma unroll
      for (int i = 0; i < 2; ++i) {
        const int ra = 64 * wm + 32 * i + r31, rb = 64 * wn + 32 * i + r31;
        a[i] = *(LAS bf16x8*)(la + ra * 128 + (((2 * s + h) ^ ((ra >> 1) & 7)) << 4));
        b[i] = *(LAS bf16x8*)(lb + rb * 128 + (((2 * s + h) ^ ((rb >> 1) & 7)) << 4));
      }
#pragma unroll
      for (int i = 0; i < 2; ++i)
#pragma unroll
        for (int j = 0; j < 2; ++j) acc[i][j] = __builtin_amdgcn_mfma_f32_32x32x16_bf16(a[i], b[j], acc[i][j], 0, 0, 0);
    }
    asm volatile("s_waitcnt vmcnt(0)" ::: "memory");
    __syncthreads();
  }
}
DI void zero_acc(f32x16 (&acc)[2][2]) {
#pragma unroll
  for (int i = 0; i < 2; ++i)
#pragma unroll
    for (int j = 0; j < 2; ++j)
#pragma unroll
      for (int e = 0; e < 16; ++e) acc[i][j][e] = 0.0f;
}

DI void tr_item(const float* W, int ldw, int k0, int n0, const float* gk, u16* dst0, u16* dst1, int ldd, LAS float* scr, int lane) {
  float4 v[16];
  const float* src = W + (size_t)(k0 + (lane >> 4)) * ldw + n0 + 4 * (lane & 15);
#pragma unroll
  for (int j = 0; j < 16; ++j) v[j] = *(const float4*)(src + (size_t)(4 * j) * ldw);
  if (gk) {
#pragma unroll
    for (int j = 0; j < 16; ++j) { const float g = gk[k0 + 4 * j + (lane >> 4)]; v[j].x *= g; v[j].y *= g; v[j].z *= g; v[j].w *= g; }
  }
  LAS float* w = scr + (lane >> 4) * 65 + 4 * (lane & 15);
#pragma unroll
  for (int j = 0; j < 16; ++j) { w[(4 * j) * 65] = v[j].x; w[(4 * j) * 65 + 1] = v[j].y; w[(4 * j) * 65 + 2] = v[j].z; w[(4 * j) * 65 + 3] = v[j].w; }
  lds_wave_sync();
  const int c = lane & 7;
#pragma unroll
  for (int j = 0; j < 8; ++j) {
    const int n = (lane >> 3) + 8 * j;
    const LAS float* s = scr + (8 * c) * 65 + n;
    uint4 o;
    o.x = pk2(s[0 * 65], s[1 * 65]); o.y = pk2(s[2 * 65], s[3 * 65]); o.z = pk2(s[4 * 65], s[5 * 65]); o.w = pk2(s[6 * 65], s[7 * 65]);
    u16* d = (j < 4) ? (dst0 + (size_t)n * ldd) : (dst1 + (size_t)(n - 32) * ldd);
    *(uint4*)(d + k0 + 8 * c) = o;
  }
  lds_wave_sync();
}

DI void ph0_prep(const Ptrs& P, ldsp lds, int bid, int G) {
  const int tid = threadIdx.x, lane = tid & 63, wave = tid >> 6;
  LAS float* scr = (LAS float*)(lds + wave * 16640);
  const int gw = bid * 4 + wave, NGW = G * 4;
  constexpr int I_W1 = 4096, I_W3 = 4096, I_W2 = 4096, I_X = 8192, I_WIN = 768, I_P = 2048, I_WOUT = 256, I_PLG = 256, I_PLE = 64,
                I_WR = 768, I_ROPE = 2048, I_SC = 1;
  constexpr int TOTAL = I_W1 + I_W3 + I_W2 + I_X + I_WIN + I_P + I_WOUT + I_PLG + I_PLE + I_WR + I_ROPE + I_SC;
  u16* W13T = (u16*)(P.ws + WS_W13); u16* W2T = (u16*)(P.ws + WS_W2);
  for (int it = gw; it < TOTAL; it += NGW) {
    int r = it;
    if (r < I_W1 + I_W3) {
      const int isw3 = r >= I_W1; if (isw3) r -= I_W1;
      const int e = r >> 7, q = r & 127, kb = q >> 3, nb = q & 7;
      u16* d0 = W13T + ((size_t)e * 1024 + nb * 128 + isw3 * 32) * 1024;
      tr_item((isw3 ? P.w3 : P.w1) + (size_t)e * 1024 * 512, 512, kb * 64, nb * 64, P.g_ffn, d0, d0 + 64 * 1024, 1024, scr, lane);
      continue;
    }
    r -= I_W1 + I_W3;
    if (r < I_W2) {
      const int e = r >> 7, q = r & 127, kb = q >> 4, nb = q & 15;
      u16* d0 = W2T + ((size_t)e * 1024 + nb * 64) * 512;
      tr_item(P.w2 + (size_t)e * 512 * 1024, 1024, kb * 64, nb * 64, nullptr, d0, d0 + 32 * 512, 512, scr, lane);
      continue;
    }
    r -= I_W2;
    if (r < I_X) {
      const float4* xr = (const float4*)(P.x + (size_t)r * 2048) + lane;
      float4 v[8];
#pragma unroll
      for (int j = 0; j < 8; ++j) v[j] = xr[64 * j];
      float s0 = 0.f, s1 = 0.f;
#pragma unroll
      for (int j = 0; j < 4; ++j) { s0 += v[j].x * v[j].x + v[j].y * v[j].y + v[j].z * v[j].z + v[j].w * v[j].w; s1 += v[j + 4].x * v[j + 4].x + v[j + 4].y * v[j + 4].y + v[j + 4].z * v[j + 4].z + v[j + 4].w * v[j + 4].w; }
      s0 = wave_sum(s0); s1 = wave_sum(s1);
      if (lane == 0) { float* rx = (float*)(P.ws + WS_RSTDX); rx[2 * r] = rsqrtf(s0 * (1.0f / 1024.0f) + EPS); rx[2 * r + 1] = rsqrtf(s1 * (1.0f / 1024.0f) + EPS); }
      uint2* o = (uint2*)((u16*)(P.ws + A_XB) + (size_t)r * 2048) + lane;
#pragma unroll
      for (int j = 0; j < 8; ++j) o[64 * j] = make_uint2(pk2(v[j].x, v[j].y), pk2(v[j].z, v[j].w));
      continue;
    }
    r -= I_X;
    if (r < I_WIN) {
      const int kb = r / 48, nb = r % 48;
      u16* d0 = (u16*)(P.ws + WS_WIN) + (size_t)(nb * 64) * 1024;
      tr_item(P.w_in, DIN, kb * 64, nb * 64, P.g_mix, d0, d0 + 32 * 1024, 1024, scr, lane);
      continue;
    }
    r -= I_WIN;
    if (r < I_P) {
      const float4* pr = (const float4*)P.p + (size_t)r * 512 + lane;
      uint2* o = (uint2*)(P.ws + A_PB) + (size_t)r * 512 + lane;
      float4 v[8];
#pragma unroll
      for (int j = 0; j < 8; ++j) v[j] = pr[64 * j];
#pragma unroll
      for (int j = 0; j < 8; ++j) o[64 * j] = make_uint2(pk2(v[j].x, v[j].y), pk2(v[j].z, v[j].w));
      continue;
    }
    r -= I_P;
    if (r < I_WOUT) {
      const int kb = r >> 4, nb = r & 15;
      u16* d0 = (u16*)(P.ws + WS_WOUT) + (size_t)(nb * 64) * 1024;
      tr_item(P.w_out, 1024, kb * 64, nb * 64, nullptr, d0, d0 + 32 * 1024, 1024, scr, lane);
      continue;
    }
    r -= I_WOUT;
    if (r < I_PLG) {
      const int kb = r >> 4, nb = r & 15;
      u16* d0 = (u16*)(P.ws + WS_WPLG) + (size_t)(nb * 64) * 1024;
      tr_item(P.w_plg, 1024, kb * 64, nb * 64, P.g_plg, d0, d0 + 32 * 1024, 1024, scr, lane);
      continue;
    }
    r -= I_PLG;
    if (r < I_PLE) {
      const int kb = r >> 4, nb = r & 15;
      u16* d0 = (u16*)(P.ws + WS_WPLE) + (size_t)(nb * 64) * 256;
      tr_item(P.w_ple, 1024, kb * 64, nb * 64, nullptr, d0, d0 + 32 * 256, 256, scr, lane);
      continue;
    }
    r -= I_PLE;
    if (r < I_WR) {
      const int idx = r * 64 + lane, rr = idx >> 10, k = idx & 1023;
      float v = 0.f;
      if (rr < 4) v = P.w_rg[k * 4 + rr]; else if (rr < 36) v = P.w_re[k * 32 + (rr - 4)];
      ((float*)(P.ws + WS_WR))[idx] = v * P.g_ffn[k];
      continue;
    }
    r -= I_WR;
    if (r < I_ROPE) {
      const int idx = r * 64 + lane, s = idx >> 5, i = idx & 31;
      const float inv = powf(10000.0f, -(float)(2 * i) / 64.0f);
      const float ang = (float)s * inv;
      float sn, cs; sincosf(ang, &sn, &cs);
      ((float2*)(P.ws + WS_ROPE))[idx] = make_float2(cs, sn);
      continue;
    }
    if (lane == 0) {
      float s1 = 0, s2 = 0, mq = 0, mk = 0;
      for (int i = 0; i < 64; ++i) {
        s1 += P.lam_q1[i] * P.lam_k1[i]; s2 += P.lam_q2[i] * P.lam_k2[i];
        mq = fmaxf(mq, fabsf(P.g_qa[i])); mk = fmaxf(mk, fabsf(P.g_ka[i]));
      }
      float* sc = (float*)(P.ws + WS_SCAL);
      sc[0] = expf(s1) - expf(s2) + LAM_INIT;
      sc[1] = 8.0f * mq * mk * LOG2E;
      int* cnt = (int*)(P.ws + WS_CNT);
      for (int i = 0; i < 32; ++i) cnt[i * CNT_STRIDE] = 0;
    }
  }
}

DI void acc_to_lds(const f32x16 (&acc)[2][2], ldsp lds) {
  const int tid = threadIdx.x, lane = tid & 63, wave = tid >> 6, wm = wave >> 1, wn = wave & 1, h = lane >> 5, i31 = lane & 31;
  LAS float* ct = (LAS float*)lds;
#pragma unroll
  for (int mi = 0; mi < 2; ++mi)
#pragma unroll
    for (int ni = 0; ni < 2; ++ni)
#pragma unroll
      for (int e = 0; e < 16; ++e) ct[(64 * wm + 32 * mi + crow(e, h)) * CT_LD + 64 * wn + 32 * ni + i31] = acc[mi][ni][e];
}
DI void acc_to_lds_T(const f32x16 (&acc)[2][2], ldsp lds) {
  const int tid = threadIdx.x, lane = tid & 63, wave = tid >> 6, wm = wave >> 1, wn = wave & 1, h = lane >> 5, i31 = lane & 31;
  LAS float* ct = (LAS float*)lds;
#pragma unroll
  for (int mi = 0; mi < 2; ++mi)
#pragma unroll
    for (int ni = 0; ni < 2; ++ni)
#pragma unroll
      for (int g = 0; g < 4; ++g) {
        f32x4 v = {acc[mi][ni][4 * g], acc[mi][ni][4 * g + 1], acc[mi][ni][4 * g + 2], acc[mi][ni][4 * g + 3]};
        *(LAS f32x4*)(ct + (64 * wn + 32 * ni + i31) * CT_LD + 64 * wm + 32 * mi + 8 * g + 4 * h) = v;
      }
}
DI uint4 pk8(const f32x4 a, const f32x4 b) { return make_uint4(pk2(a[0], a[1]), pk2(a[2], a[3]), pk2(b[0], b[1]), pk2(b[2], b[3])); }
DI void ph1_inproj(const Ptrs& P, ldsp lds, int bid, int G) {
  const int tid = threadIdx.x, lane = tid & 63, wave = tid >> 6;
  const u16* xb = (const u16*)(P.ws + A_XB); const u16* WinT = (const u16*)(P.ws + WS_WIN);
  const float* rstdx = (const float*)(P.ws + WS_RSTDX);
  const float2* rope = (const float2*)(P.ws + WS_ROPE);
  u16* qA = (u16*)(P.ws + A_QA); u16* kA = (u16*)(P.ws + A_KA); u16* vAt = (u16*)(P.ws + A_VAT);
  u16* qB = (u16*)(P.ws + A_QB); u16* kB = (u16*)(P.ws + A_KB); u16* vBt = (u16*)(P.ws + A_VBT);
  const float qsA = 0.125f * LOG2E, qsB = 0.17677669529663687f * LOG2E;
  LAS float* ct = (LAS float*)lds;
  LAS float* rsl = (LAS float*)(lds + LDS_EXTRA);
  for (int it = bid; it < 3072; it += G) {
    const int xcd = it & 7, loc = it >> 3, grp = loc >> 6, w = loc & 63, mh = grp / 3, ng = grp % 3;
    const int mt = 16 * xcd + 8 * mh + (w & 7), nt = 8 * ng + (w >> 3);
    const int m0 = mt * 128, n0 = nt * 128;
    {
      const u16 *arow[4], *brow[4];
#pragma unroll
      for (int qq = 0; qq < 4; ++qq) { const int r = 32 * wave + 8 * qq + (lane >> 3); arow[qq] = xb + (size_t)(m0 + r) * 1024; brow[qq] = WinT + (size_t)(n0 + r) * 1024; }
      f32x16 acc[2][2]; zero_acc(acc);
      gemm_core(arow, brow, 16, acc, lds);
      if ((n0 >= 1024 && n0 < 1536) || n0 >= 2560) acc_to_lds_T(acc, lds); else acc_to_lds(acc, lds);
    }
    if (tid < 128) rsl[tid] = rstdx[m0 + tid];
    __syncthreads();
    const int b = m0 >> 12, sb = m0 & 4095;
    if (n0 < 1024) {
      const int isk = n0 >= 512, hh = (n0 & 511) >> 7, c4 = tid & 3, comp = (tid >> 2) & 1;
      const float* gg = isk ? P.g_ka : P.g_qa;
      const float4 g1a = *(const float4*)(gg + 8 * c4), g1b = *(const float4*)(gg + 8 * c4 + 4), g2a = *(const float4*)(gg + 32 + 8 * c4), g2b = *(const float4*)(gg + 36 + 8 * c4);
      u16* dstb = (isk ? kA : qA) + (size_t)(b * 4 + hh) * 4096 * 128 + comp * 64 + 8 * c4;
#pragma unroll 2
      for (int p = 0; p < 4; ++p) {
        const int row = 32 * p + (tid >> 3), s = sb + row;
        const LAS float* src = ct + row * CT_LD + comp * 64 + 8 * c4;
        const f32x4 x1a = *(const LAS f32x4*)src, x1b = *(const LAS f32x4*)(src + 4), x2a = *(const LAS f32x4*)(src + 32), x2b = *(const LAS f32x4*)(src + 36);
        float ss = 0.f;
#pragma unroll
        for (int k = 0; k < 4; ++k) ss += x1a[k] * x1a[k] + x1b[k] * x1b[k] + x2a[k] * x2a[k] + x2b[k] * x2b[k];
        ss += __shfl_xor(ss, 1); ss += __shfl_xor(ss, 2);
        const float rs = rsl[row];
        const float rn = rsqrtf(ss * rs * rs * (1.0f / 64.0f) + EPS) * rs * (isk ? 1.0f : qsA);
        const float4* rp = (const float4*)(rope + (size_t)s * 32 + 8 * c4);
        const float4 csA = rp[0], csB = rp[1], csC = rp[2], csD = rp[3];
        f32x4 o1a, o1b, o2a, o2b;
        { const float y = x1a[0] * rn * g1a.x, z = x2a[0] * rn * g2a.x; o1a[0] = y * csA.x - z * csA.y; o2a[0] = z * csA.x + y * csA.y; }
        { const float y = x1a[1] * rn * g1a.y, z = x2a[1] * rn * g2a.y; o1a[1] = y * csA.z - z * csA.w; o2a[1] = z * csA.z + y * csA.w; }
        { const float y = x1a[2] * rn * g1a.z, z = x2a[2] * rn * g2a.z; o1a[2] = y * csB.x - z * csB.y; o2a[2] = z * csB.x + y * csB.y; }
        { const float y = x1a[3] * rn * g1a.w, z = x2a[3] * rn * g2a.w; o1a[3] = y * csB.z - z * csB.w; o2a[3] = z * csB.z + y * csB.w; }
        { const float y = x1b[0] * rn * g1b.x, z = x2b[0] * rn * g2b.x; o1b[0] = y * csC.x - z * csC.y; o2b[0] = z * csC.x + y * csC.y; }
        { const float y = x1b[1] * rn * g1b.y, z = x2b[1] * rn * g2b.y; o1b[1] = y * csC.z - z * csC.w; o2b[1] = z * csC.z + y * csC.w; }
        { const float y = x1b[2] * rn * g1b.z, z = x2b[2] * rn * g2b.z; o1b[2] = y * csD.x - z * csD.y; o2b[2] = z * csD.x + y * csD.y; }
        { const float y = x1b[3] * rn * g1b.w, z = x2b[3] * rn * g2b.w; o1b[3] = y * csD.z - z * csD.w; o2b[3] = z * csD.z + y * csD.w; }
        u16* dst = dstb + (size_t)s * 128;
        *(uint4*)dst = pk8(o1a, o1b);
        *(uint4*)(dst + 32) = pk8(o2a, o2b);
      }
    } else if (n0 < 1536 || n0 >= 2560) {
      const int isA = n0 < 1536, cc = tid & 15;
      const int t0 = isA ? (16 * (cc >> 1) + 4 * (cc & 1)) : 8 * cc, t1 = isA ? t0 + 8 : t0 + 4;
      const f32x4 ra = *(const LAS f32x4*)(rsl + t0), rb = *(const LAS f32x4*)(rsl + t1);
#pragma unroll 2
      for (int p = 0; p < 8; ++p) {
        const int col = 16 * p + (tid >> 4);
        u16* dst;
        if (isA) dst = vAt + ((size_t)(b * 4 + ((n0 - 1024) >> 7)) * 128 + col) * 4096 + sb;
        else dst = vBt + ((size_t)(b * 16 + ((n0 - 2560) >> 5) + (col >> 5)) * 32 + (col & 31)) * 4096 + sb;
        f32x4 a = *(const LAS f32x4*)(ct + col * CT_LD + t0), c4v = *(const LAS f32x4*)(ct + col * CT_LD + t1);
#pragma unroll
        for (int k = 0; k < 4; ++k) { a[k] *= ra[k]; c4v[k] *= rb[k]; }
        *(uint4*)(dst + 8 * cc) = pk8(a, c4v);
      }
    } else {
      const int isk = n0 >= 2048, c4 = tid & 3, hq = (tid >> 2) & 3;
      const float* gg = isk ? P.g_kb : P.g_qb;
      const float4 ga = *(const float4*)(gg + 8 * c4), gb = *(const float4*)(gg + 8 * c4 + 4);
      const int hd = (((n0 - 1536) & 511) >> 5) + hq;
      u16* dstb = (isk ? kB : qB) + (size_t)(b * 16 + hd) * 4096 * 32 + 8 * c4;
#pragma unroll 2
      for (int p = 0; p < 8; ++p) {
        const int row = 16 * p + (tid >> 4), s = sb + row;
        const LAS float* src = ct + row * CT_LD + hq * 32 + 8 * c4;
        f32x4 a = *(const LAS f32x4*)src, c4v = *(const LAS f32x4*)(src + 4);
        float ss = 0.f;
#pragma unroll
        for (int k = 0; k < 4; ++k) ss += a[k] * a[k] + c4v[k] * c4v[k];
        ss += __shfl_xor(ss, 1); ss += __shfl_xor(ss, 2);
        const float rs = rsl[row];
        const float rn = rsqrtf(ss * rs * rs * (1.0f / 32.0f) + EPS) * rs * (isk ? 1.0f : qsB);
        a[0] *= rn * ga.x; a[1] *= rn * ga.y; a[2] *= rn * ga.z; a[3] *= rn * ga.w;
        c4v[0] *= rn * gb.x; c4v[1] *= rn * gb.y; c4v[2] *= rn * gb.z; c4v[3] *= rn * gb.w;
        *(uint4*)(dstb + (size_t)s * 32) = pk8(a, c4v);
      }
    }
    __syncthreads();
  }
}
typedef __attribute__((ext_vector_type(4))) unsigned u32x4;
DI bf16x8 packp(const f32x16& x, int s) {
  u32x4 p;
  p[0] = pk2(x[8 * s + 0], x[8 * s + 1]); p[1] = pk2(x[8 * s + 2], x[8 * s + 3]);
  p[2] = pk2(x[8 * s + 4], x[8 * s + 5]); p[3] = pk2(x[8 * s + 6], x[8 * s + 7]);
  return __builtin_bit_cast(bf16x8, p);
}
template <bool SHIFT>
DI void da_item(const Ptrs& P, ldsp lds, int item, float lam, float m2) {
  const int tid = threadIdx.x, lane = tid & 63, wave = __builtin_amdgcn_readfirstlane(tid >> 6), h = lane >> 5, i31 = lane & 31;
  const int xcd = item & 7, loc = item >> 3, bh = 2 * xcd + (loc >> 5), qblk = loc & 31;
  const u16* qA = (const u16*)(P.ws + A_QA) + (size_t)bh * 4096 * 128;
  const u16* kA = (const u16*)(P.ws + A_KA) + (size_t)bh * 4096 * 128;
  const u16* vAt = (const u16*)(P.ws + A_VAT) + (size_t)bh * 128 * 4096;
  const int q = qblk * 128 + 32 * wave + i31;
  bf16x8 qf[2][4];
#pragma unroll
  for (int c = 0; c < 2; ++c)
#pragma unroll
    for (int s = 0; s < 4; ++s) qf[c][s] = *(const bf16x8*)(qA + (size_t)q * 128 + c * 64 + 16 * s + 8 * h);
  auto stage = [&](int buf, int tile) {
    int ln = lane; asm volatile("" : "+v"(ln));
    ldsp lk = lds + buf * 32768 + wave * 4096;
    ldsp lv = lk + 16384;
    const u16* kt = kA + (size_t)tile * 64 * 128;
    const u16* vt = vAt + tile * 64;
#pragma unroll
    for (int qq = 0; qq < 4; ++qq) {
      const int q4 = 4 * wave + qq;
      const int krow = 4 * q4 + (ln >> 4), kc = (ln & 15) ^ (krow & 15);
      const int vrow = 8 * q4 + (ln >> 3), vc = (ln & 7) ^ ((vrow >> 1) & 7);
      glds16(kt + krow * 128 + kc * 8, lk + qq * 1024);
      glds16(vt + vrow * 4096 + vc * 8, lv + qq * 1024);
    }
  };
  f32x16 O1[4], O2[4];
#pragma unroll
  for (int dt = 0; dt < 4; ++dt)
#pragma unroll
    for (int e = 0; e < 16; ++e) { O1[dt][e] = 0.f; O2[dt][e] = 0.f; }
  float l1 = 0.f, l2 = 0.f;
  stage(0, 0);
  asm volatile("s_waitcnt vmcnt(0)" ::: "memory");
  __syncthreads();
  for (int tile = 0; tile < 64; ++tile) {
    const int buf = tile & 1;
    if (tile + 1 < 64) stage(buf ^ 1, tile + 1);
    ldsp lk = lds + buf * 32768;
    ldsp lv = lk + 16384;
#pragma unroll 1
    for (int kt2 = 0; kt2 < 2; ++kt2) {
      bf16x8 pf[2][2];
      const int key = 32 * kt2 + i31;
#pragma unroll
      for (int c = 0; c < 2; ++c) {
        f32x16 sa;
#pragma unroll
        for (int e = 0; e < 16; ++e) sa[e] = 0.f;
#pragma unroll
        for (int s = 0; s < 4; ++s) {
          const bf16x8 kf = *(LAS bf16x8*)(lk + key * 256 + (((c * 8 + 2 * s + h) ^ (key & 15)) << 4));
          sa = __builtin_amdgcn_mfma_f32_32x32x16_bf16(kf, qf[c][s], sa, 0, 0, 0);
        }
        float ls = 0.f;
#pragma unroll
        for (int e = 0; e < 16; ++e) { sa[e] = __builtin_amdgcn_exp2f(SHIFT ? sa[e] - m2 : sa[e]); ls += sa[e]; }
        if (c == 0) l1 += ls; else l2 += ls;
        pf[c][0] = packp(sa, 0); pf[c][1] = packp(sa, 1);
      }
      __builtin_amdgcn_sched_barrier(0);
#pragma unroll
      for (int s2 = 0; s2 < 2; ++s2)
#pragma unroll
        for (int dt = 0; dt < 4; ++dt) {
          const int d = 32 * dt + i31, ks = 2 * kt2 + s2;
          const bf16x8 vf = *(LAS bf16x8*)(lv + d * 128 + (((2 * ks + h) ^ ((d >> 1) & 7)) << 4));
          O1[dt] = __builtin_amdgcn_mfma_f32_32x32x16_bf16(vf, pf[0][s2], O1[dt], 0, 0, 0);
          O2[dt] = __builtin_amdgcn_mfma_f32_32x32x16_bf16(vf, pf[1][s2], O2[dt], 0, 0, 0);
        }
    }
    asm volatile("s_waitcnt vmcnt(0)" ::: "memory");
    __syncthreads();
  }
  l1 += __shfl_xor(l1, 32); l2 += __shfl_xor(l2, 32);
  const float i1 = 1.0f / l1, i2 = lam / l2;
  float ss = 0.f;
#pragma unroll
  for (int dt = 0; dt < 4; ++dt)
#pragma unroll
    for (int e = 0; e < 16; ++e) { const float o = O1[dt][e] * i1 - O2[dt][e] * i2; O1[dt][e] = o; ss += o * o; }
  ss += __shfl_xor(ss, 32);
  const float rn = rsqrtf(ss * (1.0f / 128.0f) + EPS) * (1.0f - LAM_INIT);
  const int b = bh >> 2, hh = bh & 3;
  u16* dst = (u16*)(P.ws + A_AO) + ((size_t)b * 4096 + q) * 1024 + hh * 128;
#pragma unroll
  for (int dt = 0; dt < 4; ++dt)
#pragma unroll
    for (int g = 0; g < 4; ++g) {
      const int d0 = 32 * dt + 8 * g + 4 * h;
      const float4 gs = *(const float4*)(P.g_sub + d0);
      *(uint2*)(dst + d0) = make_uint2(pk2(O1[dt][4 * g] * rn * gs.x, O1[dt][4 * g + 1] * rn * gs.y), pk2(O1[dt][4 * g + 2] * rn * gs.z, O1[dt][4 * g + 3] * rn * gs.w));
    }
}

typedef __attribute__((ext_vector_type(4))) short s16x4;
DI void na_item(const Ptrs& P, ldsp lds, int item, int wave, int lane) {
  const int r = item & 63, hd = (item >> 6) & 15, b = item >> 10;
  const int qi = lane & 15, g = lane >> 4;
  const u16* qB = (const u16*)(P.ws + A_QB) + (size_t)(b * 16 + hd) * 4096 * 32;
  const u16* kB = (const u16*)(P.ws + A_KB) + (size_t)(b * 16 + hd) * 4096 * 32;
  const u16* vBt = (const u16*)(P.ws + A_VBT) + (size_t)(b * 16 + hd) * 32 * 4096;
  LAS float* rpl = (LAS float*)(lds + wave * 2048);
  lds_wave_sync();
  for (int i = lane; i < 465; i += 64) rpl[i] = P.rpb[hd * 465 + i] * LOG2E;
  lds_wave_sync();
  const int rs = min(max(r - 4, 0), 56);
  const int rb0 = rs - r + 7;
  u16* aob = (u16*)(P.ws + A_AO) + ((size_t)b * 4096 + r * 64) * 1024 + 512 + hd * 32;
#pragma unroll 1
  for (int j = 0; j < 4; ++j) {
    const int c = 16 * j + qi, cs = min(max(c - 8, 0), 48);
    const int kb = min(min(max(16 * j - 8, 0), 48), 32);
    const bf16x8 qf = *(const bf16x8*)(qB + (size_t)(r * 64 + c) * 32 + 8 * g);
    f32x4 sa[8][2];
    float mx = -1e30f;
#pragma unroll
    for (int ri = 0; ri < 8; ++ri)
#pragma unroll
      for (int t = 0; t < 2; ++t) {
        const bf16x8 kf = *(const bf16x8*)(kB + (size_t)((rs + ri) * 64 + kb + 16 * t + qi) * 32 + 8 * g);
        f32x4 z = {0.f, 0.f, 0.f, 0.f};
        z = __builtin_amdgcn_mfma_f32_16x16x32_bf16(kf, qf, z, 0, 0, 0);
#pragma unroll
        for (int i = 0; i < 4; ++i) {
          const int kc = kb + 16 * t + 4 * g + i;
          const bool valid = (kc >= cs) && (kc < cs + 16);
          const int co = min(max(kc - c + 15, 0), 30);
          const float sv = valid ? z[i] + rpl[(rb0 + ri) * 31 + co] : -1e30f;
          z[i] = sv; mx = fmaxf(mx, sv);
        }
        sa[ri][t] = z;
      }
    mx = fmaxf(mx, __shfl_xor(mx, 16)); mx = fmaxf(mx, __shfl_xor(mx, 32));
    float l = 0.f;
    f32x4 oa[2] = {{0.f, 0.f, 0.f, 0.f}, {0.f, 0.f, 0.f, 0.f}};
#pragma unroll
    for (int ri = 0; ri < 8; ++ri) {
      float p[8];
#pragma unroll
      for (int t = 0; t < 2; ++t)
#pragma unroll
        for (int i = 0; i < 4; ++i) { const float e = __builtin_amdgcn_exp2f(sa[ri][t][i] - mx); p[4 * t + i] = e; l += e; }
      u32x4 pp; pp[0] = pk2(p[0], p[1]); pp[1] = pk2(p[2], p[3]); pp[2] = pk2(p[4], p[5]); pp[3] = pk2(p[6], p[7]);
      const bf16x8 pfr = __builtin_bit_cast(bf16x8, pp);
#pragma unroll
      for (int dtl = 0; dtl < 2; ++dtl) {
        const u16* vp = vBt + (size_t)(16 * dtl + qi) * 4096 + (rs + ri) * 64 + kb + 4 * g;
        const s16x4 lo = *(const s16x4*)vp, hi = *(const s16x4*)(vp + 16);
        const bf16x8 vf = __builtin_shufflevector(lo, hi, 0, 1, 2, 3, 4, 5, 6, 7);
        oa[dtl] = __builtin_amdgcn_mfma_f32_16x16x32_bf16(vf, pfr, oa[dtl], 0, 0, 0);
      }
    }
    l += __shfl_xor(l, 16); l += __shfl_xor(l, 32);
    const float il = 1.0f / l;
    u16* dst = aob + (size_t)c * 1024;
#pragma unroll
    for (int dtl = 0; dtl < 2; ++dtl)
      *(uint2*)(dst + 16 * dtl + 4 * g) = make_uint2(pk2(oa[dtl][0] * il, oa[dtl][1] * il), pk2(oa[dtl][2] * il, oa[dtl][3] * il));
  }
}

DI void ph2_attn(const Ptrs& P, ldsp lds, int bid, int G) {
  {
    const float* sc = (const float*)(P.ws + WS_SCAL);
    const float lam = sc[0], m2 = sc[1];
    if (m2 < 64.0f) { for (int it = bid; it < 512; it += G) da_item<false>(P, lds, it, lam, m2); }
  }
  const int wave = threadIdx.x >> 6, lane = threadIdx.x & 63;
  for (int wi = bid * 4 + wave; wi < 4096; wi += G * 4) na_item(P, lds, wi, wave, lane);
}

DI void tile_map_1024(int t2, int& mt, int& nt) {
  const int xcd = t2 & 7, loc = t2 >> 3, grp = loc >> 6, w = loc & 63;
  mt = 16 * xcd + 8 * grp + (w & 7); nt = w >> 3;
}
DI void ph3_outproj(const Ptrs& P, ldsp lds, int bid, int G) {
  const int tid = threadIdx.x, lane = tid & 63, wave = tid >> 6;
  LAS float* ct = (LAS float*)lds;
  for (int it = bid; it < 2048; it += G) {
    const int isple = it >= 1024;
    int mt, nt; tile_map_1024(it & 1023, mt, nt);
    const int m0 = mt * 128, n0 = nt * 128;
    {
      const u16* A = isple ? (const u16*)(P.ws + A_PB) : (const u16*)(P.ws + A_AO);
      const u16* B = isple ? (const u16*)(P.ws + WS_WPLE) : (const u16*)(P.ws + WS_WOUT);
      const int ld = isple ? 256 : 1024;
      const u16 *arow[4], *brow[4];
#pragma unroll
      for (int qq = 0; qq < 4; ++qq) { const int r = 32 * wave + 8 * qq + (lane >> 3); arow[qq] = A + (size_t)(m0 + r) * ld; brow[qq] = B + (size_t)(n0 + r) * ld; }
      f32x16 acc[2][2]; zero_acc(acc);
      gemm_core(arow, brow, isple ? 4 : 16, acc, lds);
      acc_to_lds(acc, lds);
    }
    __syncthreads();
    const int cc = tid & 15;
    float* ssqp = (float*)(P.ws + (isple ? WS_SSQEP : WS_SSQ1P));
#pragma unroll 2
    for (int p = 0; p < 8; ++p) {
      const int row = 16 * p + (tid >> 4);
      const LAS float* src = ct + row * CT_LD + 8 * cc;
      const size_t go = (size_t)(m0 + row) * 1024 + n0 + 8 * cc;
      f32x4 a = *(const LAS f32x4*)src, c4 = *(const LAS f32x4*)(src + 4);
      if (!isple) {
        const float4 xa = *(const float4*)(P.x + go), xb4 = *(const float4*)(P.x + go + 4);
        a[0] += xa.x; a[1] += xa.y; a[2] += xa.z; a[3] += xa.w; c4[0] += xb4.x; c4[1] += xb4.y; c4[2] += xb4.z; c4[3] += xb4.w;
        *(float4*)(P.out + go) = make_float4(a[0], a[1], a[2], a[3]); *(float4*)(P.out + go + 4) = make_float4(c4[0], c4[1], c4[2], c4[3]);
        *(uint4*)((u16*)(P.ws + A_H1B) + go) = pk8(a, c4);
      } else {
        *(uint4*)((u16*)(P.ws + A_EBF) + go) = pk8(a, c4);
      }
      float ss = a[0] * a[0] + a[1] * a[1] + a[2] * a[2] + a[3] * a[3] + c4[0] * c4[0] + c4[1] * c4[1] + c4[2] * c4[2] + c4[3] * c4[3];
      ss += __shfl_xor(ss, 1); ss += __shfl_xor(ss, 2); ss += __shfl_xor(ss, 4); ss += __shfl_xor(ss, 8);
      if (cc == 0) ssqp[(size_t)(m0 + row) * 8 + nt] = ss;
    }
    __syncthreads();
  }
}

template <bool DRY>
DI void ph4_router_t(const Ptrs& P, ldsp lds, int bid, int G) {
  const int tid = threadIdx.x, lane = tid & 63, wave = tid >> 6, t = lane & 15, kk = lane >> 4;
  LAS float* lg = (LAS float*)(lds + wave * 3072);
  const float* h1 = P.out; const float* WrT = (const float*)(P.ws + WS_WR);
  for (int item = bid * 4 + wave; item < 1024; item += G * 4) {
    const int tok0 = item * 16;
    f32x4 acc[3] = {{0.f, 0.f, 0.f, 0.f}, {0.f, 0.f, 0.f, 0.f}, {0.f, 0.f, 0.f, 0.f}};
    const float* ap = h1 + (size_t)(tok0 + t) * 1024 + 4 * kk;
    const float* bp = WrT + (size_t)t * 1024 + 4 * kk;
#pragma unroll 4
    for (int s = 0; s < 64; ++s) {
      const float4 a4 = *(const float4*)(ap + 16 * s);
      const float4 b0 = *(const float4*)(bp + 16 * s), b1 = *(const float4*)(bp + 16 * 1024 + 16 * s), b2 = *(const float4*)(bp + 32 * 1024 + 16 * s);
      acc[0] = __builtin_amdgcn_mfma_f32_16x16x4f32(a4.x, b0.x, acc[0], 0, 0, 0); acc[1] = __builtin_amdgcn_mfma_f32_16x16x4f32(a4.x, b1.x, acc[1], 0, 0, 0); acc[2] = __builtin_amdgcn_mfma_f32_16x16x4f32(a4.x, b2.x, acc[2], 0, 0, 0);
      acc[0] = __builtin_amdgcn_mfma_f32_16x16x4f32(a4.y, b0.y, acc[0], 0, 0, 0); acc[1] = __builtin_amdgcn_mfma_f32_16x16x4f32(a4.y, b1.y, acc[1], 0, 0, 0); acc[2] = __builtin_amdgcn_mfma_f32_16x16x4f32(a4.y, b2.y, acc[2], 0, 0, 0);
      acc[0] = __builtin_amdgcn_mfma_f32_16x16x4f32(a4.z, b0.z, acc[0], 0, 0, 0); acc[1] = __builtin_amdgcn_mfma_f32_16x16x4f32(a4.z, b1.z, acc[1], 0, 0, 0); acc[2] = __builtin_amdgcn_mfma_f32_16x16x4f32(a4.z, b2.z, acc[2], 0, 0, 0);
      acc[0] = __builtin_amdgcn_mfma_f32_16x16x4f32(a4.w, b0.w, acc[0], 0, 0, 0); acc[1] = __builtin_amdgcn_mfma_f32_16x16x4f32(a4.w, b1.w, acc[1], 0, 0, 0); acc[2] = __builtin_amdgcn_mfma_f32_16x16x4f32(a4.w, b2.w, acc[2], 0, 0, 0);
    }
    lds_wave_sync();
#pragma unroll
    for (int et = 0; et < 3; ++et)
#pragma unroll
      for (int i = 0; i < 4; ++i) lg[(4 * kk + i) * 48 + 16 * et + t] = acc[et][i];
    lds_wave_sync();
    if (lane < 16) {
      const int tok = tok0 + lane;
      const float* sp = (const float*)(P.ws + WS_SSQ1P) + (size_t)tok * 8;
      const float4 s0 = *(const float4*)sp, s1 = *(const float4*)(sp + 4);
      const float rstd = rsqrtf((s0.x + s0.y + s0.z + s0.w + s1.x + s1.y + s1.z + s1.w) * (1.0f / 1024.0f) + EPS);
      ((float*)(P.ws + WS_RSTD1))[tok] = rstd;
      const LAS float* L = lg + lane * 48;
      int gi = 0; float gm = L[0];
#pragma unroll
      for (int i = 1; i < 4; ++i) { const float v = L[i]; if (v > gm) { gm = v; gi = i; } }
      float gs = 0.f;
#pragma unroll
      for (int i = 0; i < 4; ++i) gs += expf((L[i] - gm) * rstd);
      const float gate = 1.0f / gs;
      const LAS float* el = L + 4 + 8 * gi;
      int e1 = 0; float m1 = el[0];
#pragma unroll
      for (int i = 1; i < 8; ++i) { const float v = el[i]; if (v > m1) { m1 = v; e1 = i; } }
      int e2 = 0; float m2v = -3.0e38f;
#pragma unroll
      for (int i = 0; i < 8; ++i) { const float v = el[i]; if (i != e1 && v > m2v) { m2v = v; e2 = i; } }
      const float p2 = expf((m2v - m1) * rstd);
      const float wa = gate / (1.0f + p2), wb = gate * p2 / (1.0f + p2);
      int* cnt = (int*)(P.ws + WS_CNT); int* tokl = (int*)(P.ws + WS_TOKL); float* wl = (float*)(P.ws + WS_WL);
      const int ea = gi * 8 + e1, eb = gi * 8 + e2;
      if (!DRY) {
        const int pa = atomicAdd(&cnt[ea * CNT_STRIDE], 1); tokl[ea * 16384 + pa] = tok * 2; wl[ea * 16384 + pa] = wa;
        const int pb = atomicAdd(&cnt[eb * CNT_STRIDE], 1); tokl[eb * 16384 + pb] = tok * 2 + 1; wl[eb * 16384 + pb] = wb;
      } else { ((float*)(P.ws + WS_RSTD1))[tok] = rstd + 0.0f * (wa + wb + (float)(ea + eb)); }
    }
  }
}

DI void ph4_router(const Ptrs& P, ldsp lds, int bid, int G) {
#if PROBE_ROUTER
  ph4_router_t<true>(P, lds, bid, G);
  __syncthreads();
#endif
  ph4_router_t<false>(P, lds, bid, G);
}

DI int moe_plan(const Ptrs& P, ldsp lds) {
  LAS int* smb = (LAS int*)(lds + LDS_EXTRA + 1024);
  if (threadIdx.x == 0) {
    const int* cnt = (const int*)(P.ws + WS_CNT);
    int a = 0;
    for (int e = 0; e < 32; ++e) { smb[e] = a; a += (cnt[e * CNT_STRIDE] + 127) >> 7; }
    smb[32] = a;
  }
  __syncthreads();
  return smb[32];
}
DI void ph5_up(const Ptrs& P, ldsp lds, int bid, int G) {
  const int tid = threadIdx.x, lane = tid & 63, wave = tid >> 6;
  LAS float* ct = (LAS float*)lds;
  LAS float* rsl = (LAS float*)(lds + LDS_EXTRA);
  LAS int* smb = (LAS int*)(lds + LDS_EXTRA + 1024);
  const int MB = moe_plan(P, lds);
  const int* cnt = (const int*)(P.ws + WS_CNT); const int* tokl = (const int*)(P.ws + WS_TOKL);
  const u16* h1b = (const u16*)(P.ws + A_H1B); const u16* W13T = (const u16*)(P.ws + WS_W13);
  const float* rstd1 = (const float*)(P.ws + WS_RSTD1);
  u16* hid = (u16*)(P.ws + A_HID);
  for (int it = bid; it < MB * 8; it += G) {
    const int nb = it & 7, gmb = it >> 3;
    int e = 0; while (gmb >= smb[e + 1]) ++e;
    const int mb = gmb - smb[e], ce = cnt[e * CNT_STRIDE];
    {
      const u16 *arow[4], *brow[4];
#pragma unroll
      for (int qq = 0; qq < 4; ++qq) {
        const int r = 32 * wave + 8 * qq + (lane >> 3), i = mb * 128 + r;
        const int tok = (i < ce) ? (tokl[e * 16384 + i] >> 1) : 0;
        arow[qq] = h1b + (size_t)tok * 1024; brow[qq] = W13T + ((size_t)e * 1024 + nb * 128 + r) * 1024;
      }
      f32x16 acc[2][2]; zero_acc(acc);
      gemm_core(arow, brow, 16, acc, lds);
      acc_to_lds(acc, lds);
    }
    if (tid < 128) { const int i = mb * 128 + tid; rsl[tid] = (i < ce) ? rstd1[tokl[e * 16384 + i] >> 1] : 0.0f; }
    __syncthreads();
    const int jc = tid & 7, hfc = jc >> 2, c = jc & 3;
#pragma unroll 2
    for (int p = 0; p < 4; ++p) {
      const int row = 32 * p + (tid >> 3);
      const LAS float* src = ct + row * CT_LD + 64 * hfc + 8 * c;
      const float rs = rsl[row];
      f32x4 u0 = *(const LAS f32x4*)src, u1 = *(const LAS f32x4*)(src + 4);
      const f32x4 v0 = *(const LAS f32x4*)(src + 32), v1 = *(const LAS f32x4*)(src + 36);
#pragma unroll
      for (int k = 0; k < 4; ++k) {
        const float a = u0[k] * rs, bq = u1[k] * rs;
        u0[k] = a / (1.0f + __expf(-a)) * (v0[k] * rs); u1[k] = bq / (1.0f + __expf(-bq)) * (v1[k] * rs);
      }
      *(uint4*)(hid + (size_t)(gmb * 128 + row) * 512 + 64 * nb + 8 * jc) = pk8(u0, u1);
    }
    __syncthreads();
  }
}
DI void ph6_down(const Ptrs& P, ldsp lds, int bid, int G) {
  const int tid = threadIdx.x, lane = tid & 63, wave = tid >> 6;
  LAS float* ct = (LAS float*)lds;
  LAS float* wsl = (LAS float*)(lds + LDS_EXTRA);
  LAS int* tkl = (LAS int*)(lds + LDS_EXTRA + 512);
  LAS int* smb = (LAS int*)(lds + LDS_EXTRA + 1024);
  const int MB = moe_plan(P, lds);
  const int* cnt = (const int*)(P.ws + WS_CNT); const int* tokl = (const int*)(P.ws + WS_TOKL); const float* wl = (const float*)(P.ws + WS_WL);
  const u16* hid = (const u16*)(P.ws + A_HID); const u16* W2T = (const u16*)(P.ws + WS_W2);
  for (int it = bid; it < MB * 8; it += G) {
    const int nb = it & 7, gmb = it >> 3;
    int e = 0; while (gmb >= smb[e + 1]) ++e;
    const int mb = gmb - smb[e], ce = cnt[e * CNT_STRIDE];
    {
      const u16 *arow[4], *brow[4];
#pragma unroll
      for (int qq = 0; qq < 4; ++qq) {
        const int r = 32 * wave + 8 * qq + (lane >> 3);
        arow[qq] = hid + (size_t)(gmb * 128 + r) * 512; brow[qq] = W2T + ((size_t)e * 1024 + nb * 128 + r) * 512;
      }
      f32x16 acc[2][2]; zero_acc(acc);
      gemm_core(arow, brow, 8, acc, lds);
      acc_to_lds(acc, lds);
    }
    if (tid < 128) { const int i = mb * 128 + tid; const bool v = i < ce; tkl[tid] = v ? tokl[e * 16384 + i] : -1; wsl[tid] = v ? wl[e * 16384 + i] : 0.0f; }
    __syncthreads();
    const int cc = tid & 15;
#pragma unroll 2
    for (int p = 0; p < 8; ++p) {
      const int row = 16 * p + (tid >> 4);
      const int tk = tkl[row];
      if (tk >= 0) {
        const float w = wsl[row];
        const LAS float* src = ct + row * CT_LD + 8 * cc;
        f32x4 a = *(const LAS f32x4*)src, c4 = *(const LAS f32x4*)(src + 4);
#pragma unroll
        for (int k = 0; k < 4; ++k) { a[k] *= w; c4[k] *= w; }
        *(uint4*)((u16*)(P.ws + ((tk & 1) ? A_Y1 : A_Y0)) + (size_t)(tk >> 1) * 1024 + nb * 128 + 8 * cc) = pk8(a, c4);
      }
    }
    __syncthreads();
  }
}

DI void ph7_combine(const Ptrs& P, ldsp lds, int bid, int G) {
  const int lane = threadIdx.x & 63, wave = threadIdx.x >> 6;
  for (int tok = bid * 4 + wave; tok < T; tok += G * 4) {
    const float4* hr = (const float4*)(P.out + (size_t)tok * 1024) + lane;
    const uint2* y0 = (const uint2*)((const u16*)(P.ws + A_Y0) + (size_t)tok * 1024) + lane;
    const uint2* y1 = (const uint2*)((const u16*)(P.ws + A_Y1) + (size_t)tok * 1024) + lane;
    uint2* o = (uint2*)((u16*)(P.ws + A_H2B) + (size_t)tok * 1024) + lane;
    float ss = 0.f;
#pragma unroll
    for (int j = 0; j < 4; ++j) {
      const float4 hv = hr[64 * j]; const uint2 a = y0[64 * j], c = y1[64 * j];
      const float v0 = hv.x + __uint_as_float(a.x << 16) + __uint_as_float(c.x << 16);
      const float v1 = hv.y + __uint_as_float(a.x & 0xffff0000u) + __uint_as_float(c.x & 0xffff0000u);
      const float v2 = hv.z + __uint_as_float(a.y << 16) + __uint_as_float(c.y << 16);
      const float v3 = hv.w + __uint_as_float(a.y & 0xffff0000u) + __uint_as_float(c.y & 0xffff0000u);
      ss += v0 * v0 + v1 * v1 + v2 * v2 + v3 * v3;
      o[64 * j] = make_uint2(pk2(v0, v1), pk2(v2, v3));
    }
    ss = wave_sum(ss);
    float se = (lane < 8) ? ((const float*)(P.ws + WS_SSQEP))[(size_t)tok * 8 + lane] : 0.f;
    se = wave_sum(se);
    if (lane == 0) {
      ((float*)(P.ws + WS_RSTD2))[tok] = rsqrtf(ss * (1.0f / 1024.0f) + EPS);
      ((float*)(P.ws + WS_RSTDE))[tok] = rsqrtf(se * (1.0f / 1024.0f) + EPS);
    }
  }
}

template <bool DRY>
DI void ph8_final_t(const Ptrs& P, ldsp lds, int bid, int G) {
  const int tid = threadIdx.x, lane = tid & 63, wave = tid >> 6;
  LAS float* ct = (LAS float*)lds;
  const u16* h2b = (const u16*)(P.ws + A_H2B); const u16* WplgT = (const u16*)(P.ws + WS_WPLG);
  for (int it = bid; it < 1024; it += G) {
    int mt, nt; tile_map_1024(it, mt, nt);
    const int m0 = mt * 128, n0 = nt * 128;
    {
      const u16 *arow[4], *brow[4];
#pragma unroll
      for (int qq = 0; qq < 4; ++qq) { const int r = 32 * wave + 8 * qq + (lane >> 3); arow[qq] = h2b + (size_t)(m0 + r) * 1024; brow[qq] = WplgT + (size_t)(n0 + r) * 1024; }
      f32x16 acc[2][2]; zero_acc(acc);
      gemm_core(arow, brow, 16, acc, lds);
      acc_to_lds(acc, lds);
    }
    __syncthreads();
    const int cc = tid & 15;
    const float4 ga = *(const float4*)(P.g_ple + n0 + 8 * cc), gb = *(const float4*)(P.g_ple + n0 + 8 * cc + 4);
    const float gv[8] = {ga.x, ga.y, ga.z, ga.w, gb.x, gb.y, gb.z, gb.w};
#pragma unroll 2
    for (int p = 0; p < 8; ++p) {
      const int row = 16 * p + (tid >> 4);
      const LAS float* src = ct + row * CT_LD + 8 * cc;
      const size_t go = (size_t)(m0 + row) * 1024 + n0 + 8 * cc;
      const float rs2 = ((const float*)(P.ws + WS_RSTD2))[m0 + row], rE = ((const float*)(P.ws + WS_RSTDE))[m0 + row];
      const f32x4 a = *(const LAS f32x4*)src, c4 = *(const LAS f32x4*)(src + 4);
      const float4 ha = *(const float4*)(P.out + go), hb = *(const float4*)(P.out + go + 4);
      const uint4 ya = *(const uint4*)((const u16*)(P.ws + A_Y0) + go), yb = *(const uint4*)((const u16*)(P.ws + A_Y1) + go), ee = *(const uint4*)((const u16*)(P.ws + A_EBF) + go);
      float hv[8] = {ha.x, ha.y, ha.z, ha.w, hb.x, hb.y, hb.z, hb.w};
      const float av[8] = {a[0], a[1], a[2], a[3], c4[0], c4[1], c4[2], c4[3]};
      const unsigned yau[4] = {ya.x, ya.y, ya.z, ya.w}, ybu[4] = {yb.x, yb.y, yb.z, yb.w}, eeu[4] = {ee.x, ee.y, ee.z, ee.w};
#pragma unroll
      for (int k = 0; k < 8; ++k) {
        const unsigned sh = (k & 1) ? 0u : 16u;
        const float yv = __uint_as_float((yau[k >> 1] << sh) & 0xffff0000u) + __uint_as_float((ybu[k >> 1] << sh) & 0xffff0000u);
        const float ev = __uint_as_float((eeu[k >> 1] << sh) & 0xffff0000u);
        const float sg = 1.0f / (1.0f + __expf(-av[k] * rs2));
        hv[k] = hv[k] + yv + ev * rE * gv[k] * sg;
      }
      float* wr = DRY ? ((float*)(P.ws + WS_W13) + go) : (P.out + go);
      *(float4*)wr = make_float4(hv[0], hv[1], hv[2], hv[3]); *(float4*)(wr + 4) = make_float4(hv[4], hv[5], hv[6], hv[7]);
    }
    __syncthreads();
  }
}

DI void ph8_final(const Ptrs& P, ldsp lds, int bid, int G) {
#if PROBE_ROUTER == 2
  ph8_final_t<true>(P, lds, bid, G);
  __syncthreads();
#endif
  ph8_final_t<false>(P, lds, bid, G);
}
__global__ void __launch_bounds__(256, 2) mega(Ptrs P, int ph_lo, int ph_hi) {
  extern __shared__ __attribute__((aligned(16))) unsigned char smem[];
  ldsp lds = (ldsp)smem;
  const int bid = blockIdx.x, G = gridDim.x;
  volatile LAS unsigned* st = (volatile LAS unsigned*)(lds + LDS_EXTRA + 1280);
  XcdBarrier xb; xb.bar = (unsigned*)(P.ws + WS_CTL); xb.x = 0; xb.st = st;
  if (ph_hi - ph_lo > 1) {
    if (threadIdx.x == 0) { st[0] = 0u; st[1] = 0u; }
    __syncthreads();
    xb = xcd_barrier_post((unsigned*)(P.ws + WS_CTL), st);
  }
#define RUN_PHASE(k, call) if (ph_lo <= k && k < ph_hi) { if ((REPEAT_MASK >> k) & 1) { call; xcd_barrier(xb); } call; if (k + 1 < ph_hi) xcd_barrier(xb); }
  RUN_PHASE(0, ph0_prep(P, lds, bid, G))
  RUN_PHASE(1, ph1_inproj(P, lds, bid, G))
  RUN_PHASE(2, ph2_attn(P, lds, bid, G))
  RUN_PHASE(3, ph3_outproj(P, lds, bid, G))
  RUN_PHASE(4, ph4_router(P, lds, bid, G))
  RUN_PHASE(5, ph5_up(P, lds, bid, G))
  RUN_PHASE(6, ph6_down(P, lds, bid, G))
  RUN_PHASE(7, ph7_combine(P, lds, bid, G))
  RUN_PHASE(8, ph8_final(P, lds, bid, G))
}

extern "C" void kernel_launch(void* const* d_in, const int* in_sizes, int n_in, void* d_out, int out_size, void* d_ws, size_t ws_size,
                              hipStream_t stream) {
  static int grid = 0;
  if (grid == 0) {
    if (n_in != 25 || ws_size < WS_END || out_size != T * DM) { fprintf(stderr, "kernel_launch: unexpected n_in %d / out %d / ws_size %zu (need %zu)\n", n_in, out_size, ws_size, (size_t)WS_END); grid = -1; return; }
    int dev = 0, cus = 0, per_cu = 0;
    (void)hipGetDevice(&dev);
    (void)hipDeviceGetAttribute(&cus, hipDeviceAttributeMultiprocessorCount, dev);
    (void)hipFuncSetAttribute((const void*)mega, hipFuncAttributeMaxDynamicSharedMemorySize, LDS_BYTES);
    (void)hipOccupancyMaxActiveBlocksPerMultiprocessor(&per_cu, (const void*)mega, 256, LDS_BYTES);
    if (per_cu < 1) { fprintf(stderr, "kernel_launch: occupancy query returned %d\n", per_cu); grid = -1; return; }
    if (per_cu > 2) per_cu = 2;
    grid = cus * per_cu;
    fprintf(stderr, "kernel_launch: cus %d per_cu %d grid %d\n", cus, per_cu, grid);
  }
  if (grid < 0) return;
  Ptrs P{};
  const float** pp = (const float**)&P;
  for (int i = 0; i < 25; ++i) pp[i] = (const float*)d_in[i];
  P.out = (float*)d_out; P.ws = (unsigned char*)d_ws;
  (void)hipMemsetAsync((unsigned char*)d_ws + WS_CTL, 0, XCD_BAR_WORDS * 4, stream);
#if ONE_LAUNCH
  mega<<<grid, 256, LDS_BYTES, stream>>>(P, 0, 9);
#elif WITH_NAIVE
  for (int ph = 0; ph < 9; ++ph) {
    if (OPT_MASK & (1 << ph)) { mega<<<grid, 256, LDS_BYTES, stream>>>(P, ph, ph + 1); continue; }
    switch (ph) {
      case 0: nv_scal<<<1, 64, 0, stream>>>(P); nv_rope<<<S * 32 / 256, 256, 0, stream>>>(P); break;
      case 1: nv_inproj<<<T / 4, 256, 0, stream>>>(P); break;
      case 2: nv_da<<<16 * 512, 256, 0, stream>>>(P); nv_na<<<NB * HB * S / 256, 256, 0, stream>>>(P); break;
      case 3: nv_outproj<<<T / 4, 256, 0, stream>>>(P); nv_ple<<<T / 4, 256, 0, stream>>>(P); break;
      case 4: nv_router<<<T, 64, 0, stream>>>(P); nv_plan<<<1, 64, 0, stream>>>(P); break;
      case 5: nv_up<<<(32768 + 32 * 128) / 4, 256, 0, stream>>>(P); break;
      case 6: nv_down<<<(32768 + 32 * 128) / 4, 256, 0, stream>>>(P); break;
      case 7: nv_combine<<<T, 256, 0, stream>>>(P); break;
      case 8: nv_final<<<T / 4, 256, 0, stream>>>(P); break;
    }
  }
#else
  for (int ph = 0; ph < 9; ++ph) mega<<<grid, 256, LDS_BYTES, stream>>>(P, ph, ph + 1);
#endif
}
```

```cpp
#define ONE_LAUNCH 1
#define OPT_MASK 0x1ff
#define REPEAT_MASK 0x0
#define PROBE_ROUTER 0
#define WITH_NAIVE 0
#include <hip/hip_runtime.h>
#include <cstdio>
#include <cstdint>

typedef unsigned short u16;
#define DI __device__ __forceinline__

constexpr int T = 16384, S = 4096, DM = 1024, NB = 4;
constexpr int DIN = 3072, DPLE = 256;
constexpr int HA = 4, HB = 16;
constexpr int NE = 32, DE = 512;
constexpr float EPS = 1e-6f;
constexpr float LOG2E = 1.4426950408889634f;
constexpr float LAM_INIT = 0.2f;

constexpr size_t MiB = 1ull << 20;
constexpr size_t WS_WIN = 0, WS_WOUT = 6 * MiB, WS_W13 = 8 * MiB, WS_W2 = 72 * MiB, WS_WPLG = 104 * MiB,
                 WS_WPLE = 106 * MiB, WS_WR = 106 * MiB + 512 * 1024, WS_ROPE = 107 * MiB;
constexpr size_t WS_SMALL = 108 * MiB;
constexpr size_t WS_RSTDX = WS_SMALL;
constexpr size_t WS_SSQ1P = WS_RSTDX + 65536;
constexpr size_t WS_SSQEP = WS_SSQ1P + 524288;
constexpr size_t WS_RSTD1 = WS_SSQEP + 524288;
constexpr size_t WS_RSTD2 = WS_RSTD1 + 65536;
constexpr size_t WS_SCAL  = WS_RSTD2 + 65536;
constexpr size_t WS_CNT   = WS_SCAL + 256;
constexpr int CNT_STRIDE = 64;
constexpr size_t WS_PADST = WS_CNT + 8192;
constexpr size_t WS_CTL   = WS_PADST + 256;
constexpr size_t WS_RSTDE = WS_CTL + 16384;
constexpr size_t WS_TOKL  = WS_SMALL + 2 * MiB;
constexpr size_t WS_WL    = WS_SMALL + 4 * MiB;
constexpr size_t WS_ACT   = 114 * MiB;
constexpr size_t A_XB = WS_ACT, A_AO = WS_ACT, A_HID = WS_ACT, A_H2B = WS_ACT;
constexpr size_t A_PB = WS_ACT + 32 * MiB;
constexpr size_t A_QA = WS_ACT + 40 * MiB, A_KA = WS_ACT + 56 * MiB, A_VAT = WS_ACT + 72 * MiB,
                 A_QB = WS_ACT + 88 * MiB, A_KB = WS_ACT + 104 * MiB, A_VBT = WS_ACT + 120 * MiB;
constexpr size_t A_H1B = WS_ACT + 40 * MiB, A_EBF = WS_ACT + 72 * MiB, A_Y0 = WS_ACT + 104 * MiB, A_Y1 = WS_ACT + 40 * MiB;
constexpr size_t WS_END = WS_ACT + 136 * MiB;

DI float bf2f(u16 u) { return __uint_as_float(((unsigned)u) << 16); }
DI u16 f2bf(float f) { __bf16 b = (__bf16)f; return __builtin_bit_cast(u16, b); }
DI int permpos(int s) { return (s & ~12) | ((s & 8) >> 1) | ((s & 4) << 1); }

struct Ptrs {
  const float *x, *p, *g_mix, *w_in, *g_qa, *g_ka, *lam_q1, *lam_k1, *lam_q2, *lam_k2, *g_sub, *g_qb, *g_kb, *rpb, *w_out,
      *g_ffn, *w_rg, *w_re, *w1, *w3, *w2, *g_plg, *w_plg, *w_ple, *g_ple;
  float* out;
  unsigned char* ws;
};

#define GAS __attribute__((address_space(1)))
#define LAS __attribute__((address_space(3)))
typedef LAS unsigned char* ldsp;
typedef __attribute__((ext_vector_type(8))) short bf16x8;
typedef __attribute__((ext_vector_type(16))) float f32x16;
typedef __attribute__((ext_vector_type(4))) float f32x4;
typedef __attribute__((ext_vector_type(2))) float f32x2v;
typedef __attribute__((ext_vector_type(2))) __bf16 bf16x2v;
constexpr int CT_LD = 132;
constexpr int LDS_EXTRA = 128 * CT_LD * 4;
constexpr int LDS_BYTES = LDS_EXTRA + 2048;

DI unsigned pk2(float a, float b) { bf16x2v v = __builtin_convertvector((f32x2v){a, b}, bf16x2v); return __builtin_bit_cast(unsigned, v); }
DI float wave_sum(float v) {
#pragma unroll
  for (int o = 1; o < 64; o <<= 1) v += __shfl_xor(v, o);
  return v;
}
DI float half_sum32(float v) {
#pragma unroll
  for (int o = 1; o < 32; o <<= 1) v += __shfl_xor(v, o);
  return v;
}
DI int crow(int e, int h) { return (e & 3) + 8 * (e >> 2) + 4 * h; }
DI void glds16(const void* g, ldsp l) { __builtin_amdgcn_global_load_lds((const GAS unsigned*)g, (LAS unsigned*)l, 16, 0, 0); }
DI void lds_wave_sync() { asm volatile("s_waitcnt lgkmcnt(0)" ::: "memory"); }

#define XB_TMO      128
#define XB_XCNT(j)  (256  + 64 * (j))
#define XB_XSUB(j)  (1280 + 64 * (j))
#define XB_XGEN(j)  (2304 + 64 * (j))
#define XB_TOP      3328
#define XB_TOPGEN   3392
#define XCD_BAR_WORDS 3456
#define XB_SPIN_CAP (1u << 22)
DI unsigned xb_ld(unsigned* p) { return __hip_atomic_load(p, __ATOMIC_RELAXED, __HIP_MEMORY_SCOPE_AGENT); }
DI unsigned xb_add(unsigned* p, unsigned v) { return __hip_atomic_fetch_add(p, v, __ATOMIC_RELAXED, __HIP_MEMORY_SCOPE_AGENT); }
DI unsigned xb_xcc_id() { return (unsigned)__builtin_amdgcn_s_getreg((3 << 11) | 20) & 0xFu; }
#define XB_SPIN(cond, bar) do { unsigned _sp = 0; while (cond) { __builtin_amdgcn_s_sleep(1); \
    if ((++_sp & 255u) == 0u) { if (xb_ld(&(bar)[XB_TMO])) break; if (_sp > XB_SPIN_CAP) { atomicAdd(&(bar)[XB_TMO], 1u); break; } } } } while (0)
struct XcdBarrier { unsigned* bar; unsigned x; volatile LAS unsigned* st; };
DI XcdBarrier xcd_barrier_post(unsigned* bar, volatile LAS unsigned* st) {
  XcdBarrier b; b.bar = bar; b.x = xb_xcc_id(); b.st = st;
  if (threadIdx.x == 0) (void)xb_add(&bar[XB_XCNT(b.x)], 1u);
  return b;
}
DI void xcd_barrier_complete(unsigned* bar, unsigned x, unsigned& nloc, unsigned& nx) {
  const unsigned G = gridDim.x;
  unsigned sum, cnt, mine, sp = 0u;
  for (;;) {
    sum = 0u; cnt = 0u; mine = 0u;
#pragma unroll
    for (unsigned j = 0; j < 16; ++j) { const unsigned c = xb_ld(&bar[XB_XCNT(j)]); sum += c; cnt += (c > 0u) ? 1u : 0u; mine = (j == x) ? c : mine; }
    if (sum == G) break;
    __builtin_amdgcn_s_sleep(1);
    if ((++sp & 255u) == 0u) { if (xb_ld(&bar[XB_TMO])) break; if (sp > XB_SPIN_CAP) { atomicAdd(&bar[XB_TMO], 1u); break; } }
  }
  nloc = mine > 0u ? mine : 1u; nx = cnt > 0u ? cnt : 1u;
}
DI void xcd_barrier(const XcdBarrier& b) {
  asm volatile("s_waitcnt vmcnt(0)" ::: "memory");
  __syncthreads();
  if (threadIdx.x == 0) {
    unsigned* bar = b.bar;
    __builtin_amdgcn_s_waitcnt(0);
    unsigned nloc = b.st[0], nx = b.st[1];
    if (nloc == 0u) { xcd_barrier_complete(bar, b.x, nloc, nx); b.st[0] = nloc; b.st[1] = nx; }
    const unsigned old = xb_add(&bar[XB_XSUB(b.x)], 1u);
    const unsigned gen = old / nloc;
    if (old + 1u == (gen + 1u) * nloc) {
      __builtin_amdgcn_fence(__ATOMIC_RELEASE, "agent");
      asm volatile("s_waitcnt vmcnt(0)" ::: "memory");
      const unsigned og = xb_add(&bar[XB_TOP], 1u);
      const unsigned tg = og / nx;
      if (og + 1u == (tg + 1u) * nx) xb_add(&bar[XB_TOPGEN], 1u);
      else XB_SPIN(xb_ld(&bar[XB_TOPGEN]) == tg, bar);
      __builtin_amdgcn_fence(__ATOMIC_ACQUIRE, "agent");
      xb_add(&bar[XB_XGEN(b.x)], 1u);
      asm volatile("s_waitcnt vmcnt(0)" ::: "memory");
    } else {
      XB_SPIN(xb_ld(&bar[XB_XGEN(b.x)]) == gen, bar);
      __builtin_amdgcn_fence(__ATOMIC_ACQUIRE, "agent");
      asm volatile("s_waitcnt vmcnt(0)" ::: "memory");
    }
  }
  __syncthreads();
}

DI void gemm_core(const u16* const (&arow)[4], const u16* const (&brow)[4], int nk, f32x16 (&acc)[2][2], ldsp lds) {
  const int tid = threadIdx.x, lane = tid & 63, wave = __builtin_amdgcn_readfirstlane(tid >> 6);
  const int wm = wave >> 1, wn = wave & 1;
  auto stage = [&](int buf, int kt) {
    ldsp la = lds + buf * 32768 + wave * 4096;
    ldsp lb = la + 16384;
#pragma unroll
    for (int qq = 0; qq < 4; ++qq) {
      const int r = 32 * wave + 8 * qq + (lane >> 3);
      const int c = (lane & 7) ^ ((r >> 1) & 7);
      glds16(arow[qq] + kt * 64 + c * 8, la + qq * 1024);
      glds16(brow[qq] + kt * 64 + c * 8, lb + qq * 1024);
    }
  };
  stage(0, 0);
  asm volatile("s_waitcnt vmcnt(0)" ::: "memory");
  __syncthreads();
  const int r31 = lane & 31, h = lane >> 5;
  for (int kt = 0; kt < nk; ++kt) {
    const int buf = kt & 1;
    if (kt + 1 < nk) stage(buf ^ 1, kt + 1);
    ldsp la = lds + buf * 32768;
    ldsp lb = la + 16384;
#pragma unroll
    for (int s = 0; s < 4; ++s) {
      bf16x8 a[2], b[2];
#pragma unroll
      for (int i = 0; i < 2; ++i) {
        const int ra = 64 * wm + 32 * i + r31, rb = 64 * wn + 32 * i + r31;
        a[i] = *(LAS bf16x8*)(la + ra * 128 + (((2 * s + h) ^ ((ra >> 1) & 7)) << 4));
        b[i] = *(LAS bf16x8*)(lb + rb * 128 + (((2 * s + h) ^ ((rb >> 1) & 7)) << 4));
      }
#pragma unroll
      for (int i = 0; i < 2; ++i)
#pragma unroll
        for (int j = 0; j < 2; ++j) acc[i][j] = __builtin_amdgcn_mfma_f32_32x32x16_bf16(a[i], b[j], acc[i][j], 0, 0, 0);
    }
    asm volatile("s_waitcnt vmcnt(0)" ::: "memory");
    __syncthreads();
  }
}
DI void zero_acc(f32x16 (&acc)[2][2]) {
#pragma unroll
  for (int i = 0; i < 2; ++i)
#pragma unroll
    for (int j = 0; j < 2; ++j)
#pragma unroll
      for (int e = 0; e < 16; ++e) acc[i][j][e] = 0.0f;
}

DI void tr_item(const float* W, int ldw, int k0, int n0, const float* gk, u16* dst0, u16* dst1, int ldd, LAS float* scr, int lane) {
  float4 v[16];
  const float* src = W + (size_t)(k0 + (lane >> 4)) * ldw + n0 + 4 * (lane & 15);
#pragma unroll
  for (int j = 0; j < 16; ++j) v[j] = *(const float4*)(src + (size_t)(4 * j) * ldw);
  if (gk) {
#pragma unroll
    for (int j = 0; j < 16; ++j) { const float g = gk[k0 + 4 * j + (lane >> 4)]; v[j].x *= g; v[j].y *= g; v[j].z *= g; v[j].w *= g; }
  }
  LAS float* w = scr + (lane >> 4) * 65 + 4 * (lane & 15);
#pragma unroll
  for (int j = 0; j < 16; ++j) { w[(4 * j) * 65] = v[j].x; w[(4 * j) * 65 + 1] = v[j].y; w[(4 * j) * 65 + 2] = v[j].z; w[(4 * j) * 65 + 3] = v[j].w; }
  lds_wave_sync();
  const int c = lane & 7;
#pragma unroll
  for (int j = 0; j < 8; ++j) {
    const int n = (lane >> 3) + 8 * j;
    const LAS float* s = scr + (8 * c) * 65 + n;
    uint4 o;
    o.x = pk2(s[0 * 65], s[1 * 65]); o.y = pk2(s[2 * 65], s[3 * 65]); o.z = pk2(s[4 * 65], s[5 * 65]); o.w = pk2(s[6 * 65], s[7 * 65]);
    u16* d = (j < 4) ? (dst0 + (size_t)n * ldd) : (dst1 + (size_t)(n - 32) * ldd);
    *(uint4*)(d + k0 + 8 * c) = o;
  }
  lds_wave_sync();
}

DI void ph0_prep(const Ptrs& P, ldsp lds, int bid, int G) {
  const int tid = threadIdx.x, lane = tid & 63, wave = tid >> 6;
  LAS float* scr = (LAS float*)(lds + wave * 16640);
  const int gw = bid * 4 + wave, NGW = G * 4;
  constexpr int I_W1 = 4096, I_W3 = 4096, I_W2 = 4096, I_X = 8192, I_WIN = 768, I_P = 2048, I_WOUT = 256, I_PLG = 256, I_PLE = 64,
                I_WR = 768, I_ROPE = 2048, I_SC = 1;
  constexpr int TOTAL = I_W1 + I_W3 + I_W2 + I_X + I_WIN + I_P + I_WOUT + I_PLG + I_PLE + I_WR + I_ROPE + I_SC;
  u16* W13T = (u16*)(P.ws + WS_W13); u16* W2T = (u16*)(P.ws + WS_W2);
  for (int it = gw; it < TOTAL; it += NGW) {
    int r = it;
    if (r < I_W1 + I_W3) {
      const int isw3 = r >= I_W1; if (isw3) r -= I_W1;
      const int e = r >> 7, q = r & 127, kb = q >> 3, nb = q & 7;
      u16* d0 = W13T + ((size_t)e * 1024 + nb * 128 + isw3 * 32) * 1024;
      tr_item((isw3 ? P.w3 : P.w1) + (size_t)e * 1024 * 512, 512, kb * 64, nb * 64, P.g_ffn, d0, d0 + 64 * 1024, 1024, scr, lane);
      continue;
    }
    r -= I_W1 + I_W3;
    if (r < I_W2) {
      const int e = r >> 7, q = r & 127, kb = q >> 4, nb = q & 15;
      u16* d0 = W2T + ((size_t)e * 1024 + nb * 64) * 512;
      tr_item(P.w2 + (size_t)e * 512 * 1024, 1024, kb * 64, nb * 64, nullptr, d0, d0 + 32 * 512, 512, scr, lane);
      continue;
    }
    r -= I_W2;
    if (r < I_X) {
      const float4* xr = (const float4*)(P.x + (size_t)r * 2048) + lane;
      float4 v[8];
#pragma unroll
      for (int j = 0; j < 8; ++j) v[j] = xr[64 * j];
      float s0 = 0.f, s1 = 0.f;
#pragma unroll
      for (int j = 0; j < 4; ++j) { s0 += v[j].x * v[j].x + v[j].y * v[j].y + v[j].z * v[j].z + v[j].w * v[j].w; s1 += v[j + 4].x * v[j + 4].x + v[j + 4].y * v[j + 4].y + v[j + 4].z * v[j + 4].z + v[j + 4].w * v[j + 4].w; }
      s0 = wave_sum(s0); s1 = wave_sum(s1);
      if (lane == 0) { float* rx = (float*)(P.ws + WS_RSTDX); rx[2 * r] = rsqrtf(s0 * (1.0f / 1024.0f) + EPS); rx[2 * r + 1] = rsqrtf(s1 * (1.0f / 1024.0f) + EPS); }
      uint2* o = (uint2*)((u16*)(P.ws + A_XB) + (size_t)r * 2048) + lane;
#pragma unroll
      for (int j = 0; j < 8; ++j) o[64 * j] = make_uint2(pk2(v[j].x, v[j].y), pk2(v[j].z, v[j].w));
      continue;
    }
    r -= I_X;
    if (r < I_WIN) {
      const int kb = r / 48, nb = r % 48;
      u16* d0 = (u16*)(P.ws + WS_WIN) + (size_t)(nb * 64) * 1024;
      tr_item(P.w_in, DIN, kb * 64, nb * 64, P.g_mix, d0, d0 + 32 * 1024, 1024, scr, lane);
      continue;
    }
    r -= I_WIN;
    if (r < I_P) {
      const float4* pr = (const float4*)P.p + (size_t)r * 512 + lane;
      uint2* o = (uint2*)(P.ws + A_PB) + (size_t)r * 512 + lane;
      float4 v[8];
#pragma unroll
      for (int j = 0; j < 8; ++j) v[j] = pr[64 * j];
#pragma unroll
      for (int j = 0; j < 8; ++j) o[64 * j] = make_uint2(pk2(v[j].x, v[j].y), pk2(v[j].z, v[j].w));
      continue;
    }
    r -= I_P;
    if (r < I_WOUT) {
      const int kb = r >> 4, nb = r & 15;
      u16* d0 = (u16*)(P.ws + WS_WOUT) + (size_t)(nb * 64) * 1024;
      tr_item(P.w_out, 1024, kb * 64, nb * 64, nullptr, d0, d0 + 32 * 1024, 1024, scr, lane);
      continue;
    }
    r -= I_WOUT;
    if (r < I_PLG) {
      const int kb = r >> 4, nb = r & 15;
      u16* d0 = (u16*)(P.ws + WS_WPLG) + (size_t)(nb * 64) * 1024;
      tr_item(P.w_plg, 1024, kb * 64, nb * 64, P.g_plg, d0, d0 + 32 * 1024, 1024, scr, lane);
      continue;
    }
    r -= I_PLG;
    if (r < I_PLE) {
      const int kb = r >> 4, nb = r & 15;
      u16* d0 = (u16*)(P.ws + WS_WPLE) + (size_t)(nb * 64) * 256;
      tr_item(P.w_ple, 1024, kb * 64, nb * 64, nullptr, d0, d0 + 32 * 256, 256, scr, lane);
      continue;
    }
    r -= I_PLE;
    if (r < I_WR) {
      const int idx = r * 64 + lane, rr = idx >> 10, k = idx & 1023;
      float v = 0.f;
      if (rr < 4) v = P.w_rg[k * 4 + rr]; else if (rr < 36) v = P.w_re[k * 32 + (rr - 4)];
      ((float*)(P.ws + WS_WR))[idx] = v * P.g_ffn[k];
      continue;
    }
    r -= I_WR;
    if (r < I_ROPE) {
      const int idx = r * 64 + lane, s = idx >> 5, i = idx & 31;
      const float inv = powf(10000.0f, -(float)(2 * i) / 64.0f);
      const float ang = (float)s * inv;
      float sn, cs; sincosf(ang, &sn, &cs);
      ((float2*)(P.ws + WS_ROPE))[idx] = make_float2(cs, sn);
      continue;
    }
    if (lane == 0) {
      float s1 = 0, s2 = 0, mq = 0, mk = 0;
      for (int i = 0; i < 64; ++i) {
        s1 += P.lam_q1[i] * P.lam_k1[i]; s2 += P.lam_q2[i] * P.lam_k2[i];
        mq = fmaxf(mq, fabsf(P.g_qa[i])); mk = fmaxf(mk, fabsf(P.g_ka[i]));
      }
      float* sc = (float*)(P.ws + WS_SCAL);
      sc[0] = expf(s1) - expf(s2) + LAM_INIT;
      sc[1] = 8.0f * mq * mk * LOG2E;
      float mqb = 0, mkb = 0;
      for (int i = 0; i < 32; ++i) { mqb = fmaxf(mqb, fabsf(P.g_qb[i])); mkb = fmaxf(mkb, fabsf(P.g_kb[i])); }
      sc[2] = 5.656854249f * mqb * mkb;
      int* cnt = (int*)(P.ws + WS_CNT);
      for (int i = 0; i < 32; ++i) cnt[i * CNT_STRIDE] = 0;
    }
  }
}

DI void acc_to_lds(const f32x16 (&acc)[2][2], ldsp lds) {
  const int tid = threadIdx.x, lane = tid & 63, wave = tid >> 6, wm = wave >> 1, wn = wave & 1, h = lane >> 5, i31 = lane & 31;
  LAS float* ct = (LAS float*)lds;
#pragma unroll
  for (int mi = 0; mi < 2; ++mi)
#pragma unroll
    for (int ni = 0; ni < 2; ++ni)
#pragma unroll
      for (int e = 0; e < 16; ++e) ct[(64 * wm + 32 * mi + crow(e, h)) * CT_LD + 64 * wn + 32 * ni + i31] = acc[mi][ni][e];
}
DI void acc_to_lds_T(const f32x16 (&acc)[2][2], ldsp lds) {
  const int tid = threadIdx.x, lane = tid & 63, wave = tid >> 6, wm = wave >> 1, wn = wave & 1, h = lane >> 5, i31 = lane & 31;
  LAS float* ct = (LAS float*)lds;
#pragma unroll
  for (int mi = 0; mi < 2; ++mi)
#pragma unroll
    for (int ni = 0; ni < 2; ++ni)
#pragma unroll
      for (int g = 0; g < 4; ++g) {
        f32x4 v = {acc[mi][ni][4 * g], acc[mi][ni][4 * g + 1], acc[mi][ni][4 * g + 2], acc[mi][ni][4 * g + 3]};
        *(LAS f32x4*)(ct + (64 * wn + 32 * ni + i31) * CT_LD + 64 * wm + 32 * mi + 8 * g + 4 * h) = v;
      }
}
DI uint4 pk8(const f32x4 a, const f32x4 b) { return make_uint4(pk2(a[0], a[1]), pk2(a[2], a[3]), pk2(b[0], b[1]), pk2(b[2], b[3])); }
DI void ph1_inproj(const Ptrs& P, ldsp lds, int bid, int G) {
  const int tid = threadIdx.x, lane = tid & 63, wave = tid >> 6;
  const u16* xb = (const u16*)(P.ws + A_XB); const u16* WinT = (const u16*)(P.ws + WS_WIN);
  const float* rstdx = (const float*)(P.ws + WS_RSTDX);
  const float2* rope = (const float2*)(P.ws + WS_ROPE);
  u16* qA = (u16*)(P.ws + A_QA); u16* kA = (u16*)(P.ws + A_KA); u16* vAt = (u16*)(P.ws + A_VAT);
  u16* qB = (u16*)(P.ws + A_QB); u16* kB = (u16*)(P.ws + A_KB); u16* vBt = (u16*)(P.ws + A_VBT);
  const float qsA = 0.125f * LOG2E, qsB = 0.17677669529663687f * LOG2E;
  LAS float* ct = (LAS float*)lds;
  LAS float* rsl = (LAS float*)(lds + LDS_EXTRA);
  for (int it = bid; it < 3072; it += G) {
    const int xcd = it & 7, loc = it >> 3, grp = loc >> 6, w = loc & 63, mh = grp / 3, ng = grp % 3;
    const int mt = 16 * xcd + 8 * mh + (w & 7), nt = 8 * ng + (w >> 3);
    const int m0 = mt * 128, n0 = nt * 128;
    {
      const u16 *arow[4], *brow[4];
#pragma unroll
      for (int qq = 0; qq < 4; ++qq) { const int r = 32 * wave + 8 * qq + (lane >> 3); arow[qq] = xb + (size_t)(m0 + r) * 1024; brow[qq] = WinT + (size_t)(n0 + r) * 1024; }
      f32x16 acc[2][2]; zero_acc(acc);
      gemm_core(arow, brow, 16, acc, lds);
      if ((n0 >= 1024 && n0 < 1536) || n0 >= 2560) acc_to_lds_T(acc, lds); else acc_to_lds(acc, lds);
    }
    if (tid < 128) rsl[tid] = rstdx[m0 + tid];
    __syncthreads();
    const int b = m0 >> 12, sb = m0 & 4095;
    if (n0 < 1024) {
      const int isk = n0 >= 512, hh = (n0 & 511) >> 7, c4 = tid & 3, comp = (tid >> 2) & 1;
      const float* gg = isk ? P.g_ka : P.g_qa;
      const float4 g1a = *(const float4*)(gg + 8 * c4), g1b = *(const float4*)(gg + 8 * c4 + 4), g2a = *(const float4*)(gg + 32 + 8 * c4), g2b = *(const float4*)(gg + 36 + 8 * c4);
      u16* dstb = (isk ? kA : qA) + (size_t)(b * 4 + hh) * 4096 * 128 + comp * 64 + 8 * c4;
#pragma unroll 2
      for (int p = 0; p < 4; ++p) {
        const int row = 32 * p + (tid >> 3), s = sb + row;
        const LAS float* src = ct + row * CT_LD + comp * 64 + 8 * c4;
        const f32x4 x1a = *(const LAS f32x4*)src, x1b = *(const LAS f32x4*)(src + 4), x2a = *(const LAS f32x4*)(src + 32), x2b = *(const LAS f32x4*)(src + 36);
        float ss = 0.f;
#pragma unroll
        for (int k = 0; k < 4; ++k) ss += x1a[k] * x1a[k] + x1b[k] * x1b[k] + x2a[k] * x2a[k] + x2b[k] * x2b[k];
        ss += __shfl_xor(ss, 1); ss += __shfl_xor(ss, 2);
        const float rs = rsl[row];
        const float rn = rsqrtf(ss * rs * rs * (1.0f / 64.0f) + EPS) * rs * (isk ? 1.0f : qsA);
        const float4* rp = (const float4*)(rope + (size_t)s * 32 + 8 * c4);
        const float4 csA = rp[0], csB = rp[1], csC = rp[2], csD = rp[3];
        f32x4 o1a, o1b, o2a, o2b;
        { const float y = x1a[0] * rn * g1a.x, z = x2a[0] * rn * g2a.x; o1a[0] = y * csA.x - z * csA.y; o2a[0] = z * csA.x + y * csA.y; }
        { const float y = x1a[1] * rn * g1a.y, z = x2a[1] * rn * g2a.y; o1a[1] = y * csA.z - z * csA.w; o2a[1] = z * csA.z + y * csA.w; }
        { const float y = x1a[2] * rn * g1a.z, z = x2a[2] * rn * g2a.z; o1a[2] = y * csB.x - z * csB.y; o2a[2] = z * csB.x + y * csB.y; }
        { const float y = x1a[3] * rn * g1a.w, z = x2a[3] * rn * g2a.w; o1a[3] = y * csB.z - z * csB.w; o2a[3] = z * csB.z + y * csB.w; }
        { const float y = x1b[0] * rn * g1b.x, z = x2b[0] * rn * g2b.x; o1b[0] = y * csC.x - z * csC.y; o2b[0] = z * csC.x + y * csC.y; }
        { const float y = x1b[1] * rn * g1b.y, z = x2b[1] * rn * g2b.y; o1b[1] = y * csC.z - z * csC.w; o2b[1] = z * csC.z + y * csC.w; }
        { const float y = x1b[2] * rn * g1b.z, z = x2b[2] * rn * g2b.z; o1b[2] = y * csD.x - z * csD.y; o2b[2] = z * csD.x + y * csD.y; }
        { const float y = x1b[3] * rn * g1b.w, z = x2b[3] * rn * g2b.w; o1b[3] = y * csD.z - z * csD.w; o2b[3] = z * csD.z + y * csD.w; }
        u16* dst = dstb + (size_t)s * 128;
        *(uint4*)dst = pk8(o1a, o1b);
        *(uint4*)(dst + 32) = pk8(o2a, o2b);
      }
    } else if (n0 < 1536 || n0 >= 2560) {
      const int isA = n0 < 1536, cc = tid & 15;
      const int t0 = isA ? (16 * (cc >> 1) + 4 * (cc & 1)) : 8 * cc, t1 = isA ? t0 + 8 : t0 + 4;
      const f32x4 ra = *(const LAS f32x4*)(rsl + t0), rb = *(const LAS f32x4*)(rsl + t1);
#pragma unroll 2
      for (int p = 0; p < 8; ++p) {
        const int col = 16 * p + (tid >> 4);
        u16* dst;
        if (isA) dst = vAt + ((size_t)(b * 4 + ((n0 - 1024) >> 7)) * 128 + col) * 4096 + sb;
        else dst = vBt + ((size_t)(b * 16 + ((n0 - 2560) >> 5) + (col >> 5)) * 32 + (col & 31)) * 4096 + sb;
        f32x4 a = *(const LAS f32x4*)(ct + col * CT_LD + t0), c4v = *(const LAS f32x4*)(ct + col * CT_LD + t1);
#pragma unroll
        for (int k = 0; k < 4; ++k) { a[k] *= ra[k]; c4v[k] *= rb[k]; }
        *(uint4*)(dst + 8 * cc) = pk8(a, c4v);
      }
    } else {
      const int isk = n0 >= 2048, c4 = tid & 3, hq = (tid >> 2) & 3;
      const float* gg = isk ? P.g_kb : P.g_qb;
      const float4 ga = *(const float4*)(gg + 8 * c4), gb = *(const float4*)(gg + 8 * c4 + 4);
      const int hd = (((n0 - 1536) & 511) >> 5) + hq;
      u16* dstb = (isk ? kB : qB) + (size_t)(b * 16 + hd) * 4096 * 32 + 8 * c4;
#pragma unroll 2
      for (int p = 0; p < 8; ++p) {
        const int row = 16 * p + (tid >> 4), s = sb + row;
        const LAS float* src = ct + row * CT_LD + hq * 32 + 8 * c4;
        f32x4 a = *(const LAS f32x4*)src, c4v = *(const LAS f32x4*)(src + 4);
        float ss = 0.f;
#pragma unroll
        for (int k = 0; k < 4; ++k) ss += a[k] * a[k] + c4v[k] * c4v[k];
        ss += __shfl_xor(ss, 1); ss += __shfl_xor(ss, 2);
        const float rs = rsl[row];
        const float rn = rsqrtf(ss * rs * rs * (1.0f / 32.0f) + EPS) * rs * (isk ? 1.0f : qsB);
        a[0] *= rn * ga.x; a[1] *= rn * ga.y; a[2] *= rn * ga.z; a[3] *= rn * ga.w;
        c4v[0] *= rn * gb.x; c4v[1] *= rn * gb.y; c4v[2] *= rn * gb.z; c4v[3] *= rn * gb.w;
        *(uint4*)(dstb + (size_t)s * 32) = pk8(a, c4v);
      }
    }
    __syncthreads();
  }
}
typedef __attribute__((ext_vector_type(4))) unsigned u32x4;
DI bf16x8 packp(const f32x16& x, int s) {
  u32x4 p;
  p[0] = pk2(x[8 * s + 0], x[8 * s + 1]); p[1] = pk2(x[8 * s + 2], x[8 * s + 3]);
  p[2] = pk2(x[8 * s + 4], x[8 * s + 5]); p[3] = pk2(x[8 * s + 6], x[8 * s + 7]);
  return __builtin_bit_cast(bf16x8, p);
}
template <bool SHIFT>
DI void da_item(const Ptrs& P, ldsp lds, int item, float lam, float m2) {
  const int tid = threadIdx.x, lane = tid & 63, wave = __builtin_amdgcn_readfirstlane(tid >> 6), h = lane >> 5, i31 = lane & 31;
  const int xcd = item & 7, loc = item >> 3, bh = 2 * xcd + (loc >> 5), qblk = loc & 31;
  const u16* qA = (const u16*)(P.ws + A_QA) + (size_t)bh * 4096 * 128;
  const u16* kA = (const u16*)(P.ws + A_KA) + (size_t)bh * 4096 * 128;
  const u16* vAt = (const u16*)(P.ws + A_VAT) + (size_t)bh * 128 * 4096;
  const int q = qblk * 128 + 32 * wave + i31;
  bf16x8 qf[2][4];
#pragma unroll
  for (int c = 0; c < 2; ++c)
#pragma unroll
    for (int s = 0; s < 4; ++s) qf[c][s] = *(const bf16x8*)(qA + (size_t)q * 128 + c * 64 + 16 * s + 8 * h);
  auto stage = [&](int buf, int tile) {
    int ln = lane; asm volatile("" : "+v"(ln));
    ldsp lk = lds + buf * 32768 + wave * 4096;
    ldsp lv = lk + 16384;
    const u16* kt = kA + (size_t)tile * 64 * 128;
    const u16* vt = vAt + tile * 64;
#pragma unroll
    for (int qq = 0; qq < 4; ++qq) {
      const int q4 = 4 * wave + qq;
      const int krow = 4 * q4 + (ln >> 4), kc = (ln & 15) ^ (krow & 15);
      const int vrow = 8 * q4 + (ln >> 3), vc = (ln & 7) ^ ((vrow >> 1) & 7);
      glds16(kt + krow * 128 + kc * 8, lk + qq * 1024);
      glds16(vt + vrow * 4096 + vc * 8, lv + qq * 1024);
    }
  };
  f32x16 O1[4], O2[4];
#pragma unroll
  for (int dt = 0; dt < 4; ++dt)
#pragma unroll
    for (int e = 0; e < 16; ++e) { O1[dt][e] = 0.f; O2[dt][e] = 0.f; }
  float l1 = 0.f, l2 = 0.f;
  stage(0, 0);
  asm volatile("s_waitcnt vmcnt(0)" ::: "memory");
  __syncthreads();
  for (int tile = 0; tile < 64; ++tile) {
    const int buf = tile & 1;
    if (tile + 1 < 64) stage(buf ^ 1, tile + 1);
    ldsp lk = lds + buf * 32768;
    ldsp lv = lk + 16384;
#pragma unroll 1
    for (int kt2 = 0; kt2 < 2; ++kt2) {
      bf16x8 pf[2][2];
      const int key = 32 * kt2 + i31;
#pragma unroll
      for (int c = 0; c < 2; ++c) {
        f32x16 sa;
#pragma unroll
        for (int e = 0; e < 16; ++e) sa[e] = 0.f;
#pragma unroll
        for (int s = 0; s < 4; ++s) {
          const bf16x8 kf = *(LAS bf16x8*)(lk + key * 256 + (((c * 8 + 2 * s + h) ^ (key & 15)) << 4));
          sa = __builtin_amdgcn_mfma_f32_32x32x16_bf16(kf, qf[c][s], sa, 0, 0, 0);
        }
        float ls = 0.f;
#pragma unroll
        for (int e = 0; e < 16; ++e) { sa[e] = __builtin_amdgcn_exp2f(SHIFT ? sa[e] - m2 : sa[e]); ls += sa[e]; }
        if (c == 0) l1 += ls; else l2 += ls;
        pf[c][0] = packp(sa, 0); pf[c][1] = packp(sa, 1);
      }
      __builtin_amdgcn_sched_barrier(0);
#pragma unroll
      for (int s2 = 0; s2 < 2; ++s2)
#pragma unroll
        for (int dt = 0; dt < 4; ++dt) {
          const int d = 32 * dt + i31, ks = 2 * kt2 + s2;
          const bf16x8 vf = *(LAS bf16x8*)(lv + d * 128 + (((2 * ks + h) ^ ((d >> 1) & 7)) << 4));
          O1[dt] = __builtin_amdgcn_mfma_f32_32x32x16_bf16(vf, pf[0][s2], O1[dt], 0, 0, 0);
          O2[dt] = __builtin_amdgcn_mfma_f32_32x32x16_bf16(vf, pf[1][s2], O2[dt], 0, 0, 0);
        }
    }
    asm volatile("s_waitcnt vmcnt(0)" ::: "memory");
    __syncthreads();
  }
  l1 += __shfl_xor(l1, 32); l2 += __shfl_xor(l2, 32);
  const float i1 = 1.0f / l1, i2 = lam / l2;
  float ss = 0.f;
#pragma unroll
  for (int dt = 0; dt < 4; ++dt)
#pragma unroll
    for (int e = 0; e < 16; ++e) { const float o = O1[dt][e] * i1 - O2[dt][e] * i2; O1[dt][e] = o; ss += o * o; }
  ss += __shfl_xor(ss, 32);
  const float rn = rsqrtf(ss * (1.0f / 128.0f) + EPS) * (1.0f - LAM_INIT);
  const int b = bh >> 2, hh = bh & 3;
  u16* dst = (u16*)(P.ws + A_AO) + ((size_t)b * 4096 + q) * 1024 + hh * 128;
#pragma unroll
  for (int dt = 0; dt < 4; ++dt)
#pragma unroll
    for (int g = 0; g < 4; ++g) {
      const int d0 = 32 * dt + 8 * g + 4 * h;
      const float4 gs = *(const float4*)(P.g_sub + d0);
      *(uint2*)(dst + d0) = make_uint2(pk2(O1[dt][4 * g] * rn * gs.x, O1[dt][4 * g + 1] * rn * gs.y), pk2(O1[dt][4 * g + 2] * rn * gs.z, O1[dt][4 * g + 3] * rn * gs.w));
    }
}

typedef __attribute__((ext_vector_type(4))) short s16x4;
constexpr int NA_VSTRIDE = 1424;
constexpr int NA_TAB = 32 * NA_VSTRIDE;
DI void na_block(const Ptrs& P, ldsp lds, int item, float qkbound) {
  const int tid = threadIdx.x, lane = tid & 63, wave = tid >> 6;
  const int r0 = (item & 15) * 4, hd = (item >> 4) & 15, b = item >> 8;
  const int qi = lane & 15, g = lane >> 4;
  LAS float* EB = (LAS float*)(lds + NA_TAB);
  LAS float* RW = EB + 960;
  const int R0 = min(max(r0 - 4, 0), 56), NR = min(11, 64 - R0);
  const u16* vB = (const u16*)(P.ws + A_VBT) + (size_t)(b * 16 + hd) * 32 * 4096;
  __syncthreads();
  {
    u32x4 vv[11];
#pragma unroll
    for (int k = 0; k < 11; ++k) {
      const int sg = (tid >> 3) + 32 * k, d = sg / NR, kr = sg - d * NR;
      vv[k] = *(const u32x4*)(vB + (size_t)min(d, 31) * 4096 + (R0 + min(kr, NR - 1)) * 64 + 8 * (tid & 7));
    }
    float mxa = 0.f;
    const float r0v = (tid < 465) ? P.rpb[hd * 465 + tid] : 0.f, r1v = (tid + 256 < 465) ? P.rpb[hd * 465 + tid + 256] : 0.f;
    mxa = fmaxf(fabsf(r0v), fabsf(r1v));
#pragma unroll
    for (int o = 1; o < 64; o <<= 1) mxa = fmaxf(mxa, __shfl_xor(mxa, o));
    LAS float* red = (LAS float*)(lds + NA_TAB + 7680);
    if (lane == 0) red[wave] = mxa;
#pragma unroll
    for (int k = 0; k < 11; ++k) {
      const int sg = (tid >> 3) + 32 * k, d = sg / NR, kr = sg - d * NR;
      if (sg < 32 * NR) *(LAS u32x4*)(lds + d * NA_VSTRIDE + kr * 128 + 16 * (tid & 7)) = vv[k];
    }
    __syncthreads();
    const float m2 = (qkbound + fmaxf(fmaxf(red[0], red[1]), fmaxf(red[2], red[3]))) * LOG2E;
    for (int e = tid; e < 960; e += 256) {
      const int br = e >> 6, co = (e & 63) - 16;
      const float v = (co >= 0 && co <= 30) ? P.rpb[hd * 465 + br * 31 + co] * LOG2E - m2 : -1e30f;
      RW[e] = v;
      EB[e] = (co >= 7 && co <= 22) ? v : -1e30f;
    }
    __syncthreads();
  }
  const int r = r0 + wave;
  const int rs = min(max(r - 4, 0), 56), rb0 = rs - r + 7;
  const u16* qB = (const u16*)(P.ws + A_QB) + (size_t)(b * 16 + hd) * 4096 * 32;
  const u16* kBp = (const u16*)(P.ws + A_KB) + (size_t)(b * 16 + hd) * 4096 * 32;
  bf16x8 kf[16], qf;
  auto issue_kq = [&](int jq) {
    const int kb = min(min(max(16 * jq - 8, 0), 48), 32);
    const u16* kp = kBp + (size_t)(rs * 64 + kb + qi) * 32 + 8 * g;
    qf = *(const bf16x8*)(qB + (size_t)(r * 64 + 16 * jq + qi) * 32 + 8 * g);
#pragma unroll
    for (int ri = 0; ri < 8; ++ri)
#pragma unroll
      for (int t = 0; t < 2; ++t) kf[2 * ri + t] = *(const bf16x8*)(kp + (ri * 64 + 16 * t) * 32);
  };
  issue_kq(0);
#pragma unroll 1
  for (int jq = 0; jq < 4; ++jq) {
    const int kb = min(min(max(16 * jq - 8, 0), 48), 32);
    const LAS float* tb[2];
    {
      const int cobase = (jq == 0) ? 15 : ((jq == 3) ? -1 : 7);
#pragma unroll
      for (int t = 0; t < 2; ++t) {
        const int off = rb0 * 64 + cobase + 16 * t + 4 * g - qi + 16;
        const LAS float* pe = EB + off; const LAS float* pr = RW + off; const LAS float* pn = RW + 48;
        const LAS float* sel = pe;
        if (jq == 0 && qi < 8) sel = (t == 0) ? pr : pn;
        if (jq == 3 && qi > 8) sel = (t == 1) ? pr : pn;
        tb[t] = sel;
      }
    }
    f32x4 sa[8][2];
#pragma unroll
    for (int ri = 0; ri < 8; ++ri)
#pragma unroll
      for (int t = 0; t < 2; ++t) {
        const LAS float* tp = tb[t] + ri * 64;
        const f32x4 ci = {tp[0], tp[1], tp[2], tp[3]};
        sa[ri][t] = __builtin_amdgcn_mfma_f32_16x16x32_bf16(kf[2 * ri + t], qf, ci, 0, 0, 0);
      }
    __builtin_amdgcn_sched_barrier(0);
    if (jq + 1 < 4) issue_kq(jq + 1);
    __builtin_amdgcn_sched_barrier(0);
    float l = 0.f;
    f32x4 oa[2] = {{0.f, 0.f, 0.f, 0.f}, {0.f, 0.f, 0.f, 0.f}};
    ldsp vl = lds + qi * NA_VSTRIDE + (rs - R0) * 128 + (kb + 4 * g) * 2;
#pragma unroll
    for (int ri = 0; ri < 8; ++ri) {
      float p[8];
#pragma unroll
      for (int t = 0; t < 2; ++t)
#pragma unroll
        for (int i = 0; i < 4; ++i) { const float e = __builtin_amdgcn_exp2f(sa[ri][t][i]); p[4 * t + i] = e; l += e; }
      u32x4 pp; pp[0] = pk2(p[0], p[1]); pp[1] = pk2(p[2], p[3]); pp[2] = pk2(p[4], p[5]); pp[3] = pk2(p[6], p[7]);
      const bf16x8 pfr = __builtin_bit_cast(bf16x8, pp);
#pragma unroll
      for (int dtl = 0; dtl < 2; ++dtl) {
        const s16x4 lo = *(LAS s16x4*)(vl + dtl * 16 * NA_VSTRIDE + ri * 128), hi = *(LAS s16x4*)(vl + dtl * 16 * NA_VSTRIDE + ri * 128 + 32);
        const bf16x8 vf = __builtin_shufflevector(lo, hi, 0, 1, 2, 3, 4, 5, 6, 7);
        oa[dtl] = __builtin_amdgcn_mfma_f32_16x16x32_bf16(vf, pfr, oa[dtl], 0, 0, 0);
      }
    }
    l += __shfl_xor(l, 16); l += __shfl_xor(l, 32);
    const float il = 1.0f / l;
    u16* dst = (u16*)(P.ws + A_AO) + ((size_t)b * 4096 + r * 64 + 16 * jq + qi) * 1024 + 512 + hd * 32;
#pragma unroll
    for (int dtl = 0; dtl < 2; ++dtl)
      *(uint2*)(dst + 16 * dtl + 4 * g) = make_uint2(pk2(oa[dtl][0] * il, oa[dtl][1] * il), pk2(oa[dtl][2] * il, oa[dtl][3] * il));
  }
}

DI void ph2_attn(const Ptrs& P, ldsp lds, int bid, int G) {
  {
    const float* sc = (const float*)(P.ws + WS_SCAL);
    const float lam = sc[0], m2 = sc[1];
    if (m2 < 64.0f) { for (int it = bid; it < 512; it += G) da_item<false>(P, lds, it, lam, m2); }
  }
  const float qkb = ((const float*)(P.ws + WS_SCAL))[2];
#if PROBE_ROUTER == 3
#pragma unroll 1
  for (int rep = 0; rep < 2; ++rep)
#endif
  for (int it = bid; it < 1024; it += G) na_block(P, lds, it, qkb);
}

DI void tile_map_1024(int t2, int& mt, int& nt) {
  const int xcd = t2 & 7, loc = t2 >> 3, grp = loc >> 6, w = loc & 63;
  mt = 16 * xcd + 8 * grp + (w & 7); nt = w >> 3;
}
DI void ph3_outproj(const Ptrs& P, ldsp lds, int bid, int G) {
  const int tid = threadIdx.x, lane = tid & 63, wave = tid >> 6;
  LAS float* ct = (LAS float*)lds;
  for (int it = bid; it < 2048; it += G) {
    const int isple = it >= 1024;
    int mt, nt; tile_map_1024(it & 1023, mt, nt);
    const int m0 = mt * 128, n0 = nt * 128;
    {
      const u16* A = isple ? (const u16*)(P.ws + A_PB) : (const u16*)(P.ws + A_AO);
      const u16* B = isple ? (const u16*)(P.ws + WS_WPLE) : (const u16*)(P.ws + WS_WOUT);
      const int ld = isple ? 256 : 1024;
      const u16 *arow[4], *brow[4];
#pragma unroll
      for (int qq = 0; qq < 4; ++qq) { const int r = 32 * wave + 8 * qq + (lane >> 3); arow[qq] = A + (size_t)(m0 + r) * ld; brow[qq] = B + (size_t)(n0 + r) * ld; }
      f32x16 acc[2][2]; zero_acc(acc);
      gemm_core(arow, brow, isple ? 4 : 16, acc, lds);
      acc_to_lds(acc, lds);
    }
    __syncthreads();
    const int cc = tid & 15;
    float* ssqp = (float*)(P.ws + (isple ? WS_SSQEP : WS_SSQ1P));
#pragma unroll 2
    for (int p = 0; p < 8; ++p) {
      const int row = 16 * p + (tid >> 4);
      const LAS float* src = ct + row * CT_LD + 8 * cc;
      const size_t go = (size_t)(m0 + row) * 1024 + n0 + 8 * cc;
      f32x4 a = *(const LAS f32x4*)src, c4 = *(const LAS f32x4*)(src + 4);
      if (!isple) {
        const float4 xa = *(const float4*)(P.x + go), xb4 = *(const float4*)(P.x + go + 4);
        a[0] += xa.x; a[1] += xa.y; a[2] += xa.z; a[3] += xa.w; c4[0] += xb4.x; c4[1] += xb4.y; c4[2] += xb4.z; c4[3] += xb4.w;
        *(float4*)(P.out + go) = make_float4(a[0], a[1], a[2], a[3]); *(float4*)(P.out + go + 4) = make_float4(c4[0], c4[1], c4[2], c4[3]);
        *(uint4*)((u16*)(P.ws + A_H1B) + go) = pk8(a, c4);
      } else {
        *(uint4*)((u16*)(P.ws + A_EBF) + go) = pk8(a, c4);
      }
      float ss = a[0] * a[0] + a[1] * a[1] + a[2] * a[2] + a[3] * a[3] + c4[0] * c4[0] + c4[1] * c4[1] + c4[2] * c4[2] + c4[3] * c4[3];
      ss += __shfl_xor(ss, 1); ss += __shfl_xor(ss, 2); ss += __shfl_xor(ss, 4); ss += __shfl_xor(ss, 8);
      if (cc == 0) ssqp[(size_t)(m0 + row) * 8 + nt] = ss;
    }
    __syncthreads();
  }
}

template <bool DRY>
DI void ph4_router_t(const Ptrs& P, ldsp lds, int bid, int G) {
  const int tid = threadIdx.x, lane = tid & 63, wave = tid >> 6, t = lane & 15, kk = lane >> 4;
  LAS float* lg = (LAS float*)(lds + wave * 3072);
  const float* h1 = P.out; const float* WrT = (const float*)(P.ws + WS_WR);
  for (int item = bid * 4 + wave; item < 1024; item += G * 4) {
    const int tok0 = item * 16;
    f32x4 acc[3] = {{0.f, 0.f, 0.f, 0.f}, {0.f, 0.f, 0.f, 0.f}, {0.f, 0.f, 0.f, 0.f}};
    const float* ap = h1 + (size_t)(tok0 + t) * 1024 + 4 * kk;
    const float* bp = WrT + (size_t)t * 1024 + 4 * kk;
#pragma unroll 4
    for (int s = 0; s < 64; ++s) {
      const float4 a4 = *(const float4*)(ap + 16 * s);
      const float4 b0 = *(const float4*)(bp + 16 * s), b1 = *(const float4*)(bp + 16 * 1024 + 16 * s), b2 = *(const float4*)(bp + 32 * 1024 + 16 * s);
      acc[0] = __builtin_amdgcn_mfma_f32_16x16x4f32(a4.x, b0.x, acc[0], 0, 0, 0); acc[1] = __builtin_amdgcn_mfma_f32_16x16x4f32(a4.x, b1.x, acc[1], 0, 0, 0); acc[2] = __builtin_amdgcn_mfma_f32_16x16x4f32(a4.x, b2.x, acc[2], 0, 0, 0);
      acc[0] = __builtin_amdgcn_mfma_f32_16x16x4f32(a4.y, b0.y, acc[0], 0, 0, 0); acc[1] = __builtin_amdgcn_mfma_f32_16x16x4f32(a4.y, b1.y, acc[1], 0, 0, 0); acc[2] = __builtin_amdgcn_mfma_f32_16x16x4f32(a4.y, b2.y, acc[2], 0, 0, 0);
      acc[0] = __builtin_amdgcn_mfma_f32_16x16x4f32(a4.z, b0.z, acc[0], 0, 0, 0); acc[1] = __builtin_amdgcn_mfma_f32_16x16x4f32(a4.z, b1.z, acc[1], 0, 0, 0); acc[2] = __builtin_amdgcn_mfma_f32_16x16x4f32(a4.z, b2.z, acc[2], 0, 0, 0);
      acc[0] = __builtin_amdgcn_mfma_f32_16x16x4f32(a4.w, b0.w, acc[0], 0, 0, 0); acc[1] = __builtin_amdgcn_mfma_f32_16x16x4f32(a4.w, b1.w, acc[1], 0, 0, 0); acc[2] = __builtin_amdgcn_mfma_f32_16x16x4f32(a4.w, b2.w, acc[2], 0, 0, 0);
    }
    lds_wave_sync();
#pragma unroll
    for (int et = 0; et < 3; ++et)
#pragma unroll
      for (int i = 0; i < 4; ++i) lg[(4 * kk + i) * 48 + 16 * et + t] = acc[et][i];
    lds_wave_sync();
    if (lane < 16) {
      const int tok = tok0 + lane;
      const float* sp = (const float*)(P.ws + WS_SSQ1P) + (size_t)tok * 8;
      const float4 s0 = *(const float4*)sp, s1 = *(const float4*)(sp + 4);
      const float rstd = rsqrtf((s0.x + s0.y + s0.z + s0.w + s1.x + s1.y + s1.z + s1.w) * (1.0f / 1024.0f) + EPS);
      ((float*)(P.ws + WS_RSTD1))[tok] = rstd;
      const LAS float* L = lg + lane * 48;
      int gi = 0; float gm = L[0];
#pragma unroll
      for (int i = 1; i < 4; ++i) { const float v = L[i]; if (v > gm) { gm = v; gi = i; } }
      float gs = 0.f;
#pragma unroll
      for (int i = 0; i < 4; ++i) gs += expf((L[i] - gm) * rstd);
      const float gate = 1.0f / gs;
      const LAS float* el = L + 4 + 8 * gi;
      int e1 = 0; float m1 = el[0];
#pragma unroll
      for (int i = 1; i < 8; ++i) { const float v = el[i]; if (v > m1) { m1 = v; e1 = i; } }
      int e2 = 0; float m2v = -3.0e38f;
#pragma unroll
      for (int i = 0; i < 8; ++i) { const float v = el[i]; if (i != e1 && v > m2v) { m2v = v; e2 = i; } }
      const float p2 = expf((m2v - m1) * rstd);
      const float wa = gate / (1.0f + p2), wb = gate * p2 / (1.0f + p2);
      int* cnt = (int*)(P.ws + WS_CNT); int* tokl = (int*)(P.ws + WS_TOKL); float* wl = (float*)(P.ws + WS_WL);
      const int ea = gi * 8 + e1, eb = gi * 8 + e2;
      if (!DRY) {
        const int pa = atomicAdd(&cnt[ea * CNT_STRIDE], 1); tokl[ea * 16384 + pa] = tok * 2; wl[ea * 16384 + pa] = wa;
        const int pb = atomicAdd(&cnt[eb * CNT_STRIDE], 1); tokl[eb * 16384 + pb] = tok * 2 + 1; wl[eb * 16384 + pb] = wb;
      } else { ((float*)(P.ws + WS_RSTD1))[tok] = rstd + 0.0f * (wa + wb + (float)(ea + eb)); }
    }
  }
}

DI void ph4_router(const Ptrs& P, ldsp lds, int bid, int G) {
#if PROBE_ROUTER
  ph4_router_t<true>(P, lds, bid, G);
  __syncthreads();
#endif
  ph4_router_t<false>(P, lds, bid, G);
}

DI int moe_plan(const Ptrs& P, ldsp lds) {
  LAS int* smb = (LAS int*)(lds + LDS_EXTRA + 1024);
  if (threadIdx.x == 0) {
    const int* cnt = (const int*)(P.ws + WS_CNT);
    int a = 0;
    for (int e = 0; e < 32; ++e) { smb[e] = a; a += (cnt[e * CNT_STRIDE] + 127) >> 7; }
    smb[32] = a;
  }
  __syncthreads();
  return smb[32];
}
DI void ph5_up(const Ptrs& P, ldsp lds, int bid, int G) {
  const int tid = threadIdx.x, lane = tid & 63, wave = tid >> 6;
  LAS float* ct = (LAS float*)lds;
  LAS float* rsl = (LAS float*)(lds + LDS_EXTRA);
  LAS int* smb = (LAS int*)(lds + LDS_EXTRA + 1024);
  const int MB = moe_plan(P, lds);
  const int* cnt = (const int*)(P.ws + WS_CNT); const int* tokl = (const int*)(P.ws + WS_TOKL);
  const u16* h1b = (const u16*)(P.ws + A_H1B); const u16* W13T = (const u16*)(P.ws + WS_W13);
  const float* rstd1 = (const float*)(P.ws + WS_RSTD1);
  u16* hid = (u16*)(P.ws + A_HID);
  for (int it = bid; it < MB * 8; it += G) {
    const int nb = it & 7, gmb = it >> 3;
    int e = 0; while (gmb >= smb[e + 1]) ++e;
    const int mb = gmb - smb[e], ce = cnt[e * CNT_STRIDE];
    {
      const u16 *arow[4], *brow[4];
#pragma unroll
      for (int qq = 0; qq < 4; ++qq) {
        const int r = 32 * wave + 8 * qq + (lane >> 3), i = mb * 128 + r;
        const int tok = (i < ce) ? (tokl[e * 16384 + i] >> 1) : 0;
        arow[qq] = h1b + (size_t)tok * 1024; brow[qq] = W13T + ((size_t)e * 1024 + nb * 128 + r) * 1024;
      }
      f32x16 acc[2][2]; zero_acc(acc);
      gemm_core(arow, brow, 16, acc, lds);
      acc_to_lds(acc, lds);
    }
    if (tid < 128) { const int i = mb * 128 + tid; rsl[tid] = (i < ce) ? rstd1[tokl[e * 16384 + i] >> 1] : 0.0f; }
    __syncthreads();
    const int jc = tid & 7, hfc = jc >> 2, c = jc & 3;
#pragma unroll 2
    for (int p = 0; p < 4; ++p) {
      const int row = 32 * p + (tid >> 3);
      const LAS float* src = ct + row * CT_LD + 64 * hfc + 8 * c;
      const float rs = rsl[row];
      f32x4 u0 = *(const LAS f32x4*)src, u1 = *(const LAS f32x4*)(src + 4);
      const f32x4 v0 = *(const LAS f32x4*)(src + 32), v1 = *(const LAS f32x4*)(src + 36);
#pragma unroll
      for (int k = 0; k < 4; ++k) {
        const float a = u0[k] * rs, bq = u1[k] * rs;
        u0[k] = a / (1.0f + __expf(-a)) * (v0[k] * rs); u1[k] = bq / (1.0f + __expf(-bq)) * (v1[k] * rs);
      }
      *(uint4*)(hid + (size_t)(gmb * 128 + row) * 512 + 64 * nb + 8 * jc) = pk8(u0, u1);
    }
    __syncthreads();
  }
}
DI void ph6_down(const Ptrs& P, ldsp lds, int bid, int G) {
  const int tid = threadIdx.x, lane = tid & 63, wave = tid >> 6;
  LAS float* ct = (LAS float*)lds;
  LAS float* wsl = (LAS float*)(lds + LDS_EXTRA);
  LAS int* tkl = (LAS int*)(lds + LDS_EXTRA + 512);
  LAS int* smb = (LAS int*)(lds + LDS_EXTRA + 1024);
  const int MB = moe_plan(P, lds);
  const int* cnt = (const int*)(P.ws + WS_CNT); const int* tokl = (const int*)(P.ws + WS_TOKL); const float* wl = (const float*)(P.ws + WS_WL);
  const u16* hid = (const u16*)(P.ws + A_HID); const u16* W2T = (const u16*)(P.ws + WS_W2);
  for (int it = bid; it < MB * 8; it += G) {
    const int nb = it & 7, gmb = it >> 3;
    int e = 0; while (gmb >= smb[e + 1]) ++e;
    const int mb = gmb - smb[e], ce = cnt[e * CNT_STRIDE];
    {
      const u16 *arow[4], *brow[4];
#pragma unroll
      for (int qq = 0; qq < 4; ++qq) {
        const int r = 32 * wave + 8 * qq + (lane >> 3);
        arow[qq] = hid + (size_t)(gmb * 128 + r) * 512; brow[qq] = W2T + ((size_t)e * 1024 + nb * 128 + r) * 512;
      }
      f32x16 acc[2][2]; zero_acc(acc);
      gemm_core(arow, brow, 8, acc, lds);
      acc_to_lds(acc, lds);
    }
    if (tid < 128) { const int i = mb * 128 + tid; const bool v = i < ce; tkl[tid] = v ? tokl[e * 16384 + i] : -1; wsl[tid] = v ? wl[e * 16384 + i] : 0.0f; }
    __syncthreads();
    const int cc = tid & 15;
#pragma unroll 2
    for (int p = 0; p < 8; ++p) {
      const int row = 16 * p + (tid >> 4);
      const int tk = tkl[row];
      if (tk >= 0) {
        const float w = wsl[row];
        const LAS float* src = ct + row * CT_LD + 8 * cc;
        f32x4 a = *(const LAS f32x4*)src, c4 = *(const LAS f32x4*)(src + 4);
#pragma unroll
        for (int k = 0; k < 4; ++k) { a[k] *= w; c4[k] *= w; }
        *(uint4*)((u16*)(P.ws + ((tk & 1) ? A_Y1 : A_Y0)) + (size_t)(tk >> 1) * 1024 + nb * 128 + 8 * cc) = pk8(a, c4);
      }
    }
    __syncthreads();
  }
}

DI void ph7_combine(const Ptrs& P, ldsp lds, int bid, int G) {
  const int lane = threadIdx.x & 63, wave = threadIdx.x >> 6;
  for (int tok = bid * 4 + wave; tok < T; tok += G * 4) {
    const float4* hr = (const float4*)(P.out + (size_t)tok * 1024) + lane;
    const uint2* y0 = (const uint2*)((const u16*)(P.ws + A_Y0) + (size_t)tok * 1024) + lane;
    const uint2* y1 = (const uint2*)((const u16*)(P.ws + A_Y1) + (size_t)tok * 1024) + lane;
    uint2* o = (uint2*)((u16*)(P.ws + A_H2B) + (size_t)tok * 1024) + lane;
    float ss = 0.f;
#pragma unroll
    for (int j = 0; j < 4; ++j) {
      const float4 hv = hr[64 * j]; const uint2 a = y0[64 * j], c = y1[64 * j];
      const float v0 = hv.x + __uint_as_float(a.x << 16) + __uint_as_float(c.x << 16);
      const float v1 = hv.y + __uint_as_float(a.x & 0xffff0000u) + __uint_as_float(c.x & 0xffff0000u);
      const float v2 = hv.z + __uint_as_float(a.y << 16) + __uint_as_float(c.y << 16);
      const float v3 = hv.w + __uint_as_float(a.y & 0xffff0000u) + __uint_as_float(c.y & 0xffff0000u);
      ss += v0 * v0 + v1 * v1 + v2 * v2 + v3 * v3;
      o[64 * j] = make_uint2(pk2(v0, v1), pk2(v2, v3));
    }
    ss = wave_sum(ss);
    float se = (lane < 8) ? ((const float*)(P.ws + WS_SSQEP))[(size_t)tok * 8 + lane] : 0.f;
    se = wave_sum(se);
    if (lane == 0) {
      ((float*)(P.ws + WS_RSTD2))[tok] = rsqrtf(ss * (1.0f / 1024.0f) + EPS);
      ((float*)(P.ws + WS_RSTDE))[tok] = rsqrtf(se * (1.0f / 1024.0f) + EPS);
    }
  }
}

template <bool DRY>
DI void ph8_final_t(const Ptrs& P, ldsp lds, int bid, int G) {
  const int tid = threadIdx.x, lane = tid & 63, wave = tid >> 6;
  LAS float* ct = (LAS float*)lds;
  const u16* h2b = (const u16*)(P.ws + A_H2B); const u16* WplgT = (const u16*)(P.ws + WS_WPLG);
  for (int it = bid; it < 1024; it += G) {
    int mt, nt; tile_map_1024(it, mt, nt);
    const int m0 = mt * 128, n0 = nt * 128;
    {
      const u16 *arow[4], *brow[4];
#pragma unroll
      for (int qq = 0; qq < 4; ++qq) { const int r = 32 * wave + 8 * qq + (lane >> 3); arow[qq] = h2b + (size_t)(m0 + r) * 1024; brow[qq] = WplgT + (size_t)(n0 + r) * 1024; }
      f32x16 acc[2][2]; zero_acc(acc);
      gemm_core(arow, brow, 16, acc, lds);
      acc_to_lds(acc, lds);
    }
    __syncthreads();
    const int cc = tid & 15;
    const float4 ga = *(const float4*)(P.g_ple + n0 + 8 * cc), gb = *(const float4*)(P.g_ple + n0 + 8 * cc + 4);
    const float gv[8] = {ga.x, ga.y, ga.z, ga.w, gb.x, gb.y, gb.z, gb.w};
#pragma unroll 2
    for (int p = 0; p < 8; ++p) {
      const int row = 16 * p + (tid >> 4);
      const LAS float* src = ct + row * CT_LD + 8 * cc;
      const size_t go = (size_t)(m0 + row) * 1024 + n0 + 8 * cc;
      const float rs2 = ((const float*)(P.ws + WS_RSTD2))[m0 + row], rE = ((const float*)(P.ws + WS_RSTDE))[m0 + row];
      const f32x4 a = *(const LAS f32x4*)src, c4 = *(const LAS f32x4*)(src + 4);
      const float4 ha = *(const float4*)(P.out + go), hb = *(const float4*)(P.out + go + 4);
      const uint4 ya = *(const uint4*)((const u16*)(P.ws + A_Y0) + go), yb = *(const uint4*)((const u16*)(P.ws + A_Y1) + go), ee = *(const uint4*)((const u16*)(P.ws + A_EBF) + go);
      float hv[8] = {ha.x, ha.y, ha.z, ha.w, hb.x, hb.y, hb.z, hb.w};
      const float av[8] = {a[0], a[1], a[2], a[3], c4[0], c4[1], c4[2], c4[3]};
      const unsigned yau[4] = {ya.x, ya.y, ya.z, ya.w}, ybu[4] = {yb.x, yb.y, yb.z, yb.w}, eeu[4] = {ee.x, ee.y, ee.z, ee.w};
#pragma unroll
      for (int k = 0; k < 8; ++k) {
        const unsigned sh = (k & 1) ? 0u : 16u;
        const float yv = __uint_as_float((yau[k >> 1] << sh) & 0xffff0000u) + __uint_as_float((ybu[k >> 1] << sh) & 0xffff0000u);
        const float ev = __uint_as_float((eeu[k >> 1] << sh) & 0xffff0000u);
        const float sg = 1.0f / (1.0f + __expf(-av[k] * rs2));
        hv[k] = hv[k] + yv + ev * rE * gv[k] * sg;
      }
      float* wr = DRY ? ((float*)(P.ws + WS_W13) + go) : (P.out + go);
      *(float4*)wr = make_float4(hv[0], hv[1], hv[2], hv[3]); *(float4*)(wr + 4) = make_float4(hv[4], hv[5], hv[6], hv[7]);
    }
    __syncthreads();
  }
}

DI void ph8_final(const Ptrs& P, ldsp lds, int bid, int G) {
#if PROBE_ROUTER == 2
  ph8_final_t<true>(P, lds, bid, G);
  __syncthreads();
#endif
  ph8_final_t<false>(P, lds, bid, G);
}
__global__ void __launch_bounds__(256, 2) mega(Ptrs P, int ph_lo, int ph_hi) {
  extern __shared__ __attribute__((aligned(16))) unsigned char smem[];
  ldsp lds = (ldsp)smem;
  const int bid = blockIdx.x, G = gridDim.x;
  volatile LAS unsigned* st = (volatile LAS unsigned*)(lds + LDS_EXTRA + 1280);
  XcdBarrier xb; xb.bar = (unsigned*)(P.ws + WS_CTL); xb.x = 0; xb.st = st;
  if (ph_hi - ph_lo > 1) {
    if (threadIdx.x == 0) { st[0] = 0u; st[1] = 0u; }
    __syncthreads();
    xb = xcd_barrier_post((unsigned*)(P.ws + WS_CTL), st);
  }
#define RUN_PHASE(k, call) if (ph_lo <= k && k < ph_hi) { if ((REPEAT_MASK >> k) & 1) { call; xcd_barrier(xb); } call; if (k + 1 < ph_hi) xcd_barrier(xb); }
  RUN_PHASE(0, ph0_prep(P, lds, bid, G))
  RUN_PHASE(1, ph1_inproj(P, lds, bid, G))
  RUN_PHASE(2, ph2_attn(P, lds, bid, G))
  RUN_PHASE(3, ph3_outproj(P, lds, bid, G))
  RUN_PHASE(4, ph4_router(P, lds, bid, G))
  RUN_PHASE(5, ph5_up(P, lds, bid, G))
  RUN_PHASE(6, ph6_down(P, lds, bid, G))
  RUN_PHASE(7, ph7_combine(P, lds, bid, G))
  RUN_PHASE(8, ph8_final(P, lds, bid, G))
}

extern "C" void kernel_launch(void* const* d_in, const int* in_sizes, int n_in, void* d_out, int out_size, void* d_ws, size_t ws_size,
                              hipStream_t stream) {
  static int grid = 0;
  if (grid == 0) {
    if (n_in != 25 || ws_size < WS_END || out_size != T * DM) { fprintf(stderr, "kernel_launch: unexpected n_in %d / out %d / ws_size %zu (need %zu)\n", n_in, out_size, ws_size, (size_t)WS_END); grid = -1; return; }
    int dev = 0, cus = 0, per_cu = 0;
    (void)hipGetDevice(&dev);
    (void)hipDeviceGetAttribute(&cus, hipDeviceAttributeMultiprocessorCount, dev);
    (void)hipFuncSetAttribute((const void*)mega, hipFuncAttributeMaxDynamicSharedMemorySize, LDS_BYTES);
    (void)hipOccupancyMaxActiveBlocksPerMultiprocessor(&per_cu, (const void*)mega, 256, LDS_BYTES);
    if (per_cu < 1) { fprintf(stderr, "kernel_launch: occupancy query returned %d\n", per_cu); grid = -1; return; }
    if (per_cu > 2) per_cu = 2;
    grid = cus * per_cu;
    fprintf(stderr, "kernel_launch: cus %d per_cu %d grid %d\n", cus, per_cu, grid);
  }
  if (grid < 0) return;
  Ptrs P{};
  const float** pp = (const float**)&P;
  for (int i = 0; i < 25; ++i) pp[i] = (const float*)d_in[i];
  P.out = (float*)d_out; P.ws = (unsigned char*)d_ws;
  (void)hipMemsetAsync((unsigned char*)d_ws + WS_CTL, 0, XCD_BAR_WORDS * 4, stream);
#if ONE_LAUNCH
  mega<<<grid, 256, LDS_BYTES, stream>>>(P, 0, 9);
#elif WITH_NAIVE
  for (int ph = 0; ph < 9; ++ph) {
    if (OPT_MASK & (1 << ph)) { mega<<<grid, 256, LDS_BYTES, stream>>>(P, ph, ph + 1); continue; }
    switch (ph) {
      case 0: nv_scal<<<1, 64, 0, stream>>>(P); nv_rope<<<S * 32 / 256, 256, 0, stream>>>(P); break;
      case 1: nv_inproj<<<T / 4, 256, 0, stream>>>(P); break;
      case 2: nv_da<<<16 * 512, 256, 0, stream>>>(P); nv_na<<<NB * HB * S / 256, 256, 0, stream>>>(P); break;
      case 3: nv_outproj<<<T / 4, 256, 0, stream>>>(P); nv_ple<<<T / 4, 256, 0, stream>>>(P); break;
      case 4: nv_router<<<T, 64, 0, stream>>>(P); nv_plan<<<1, 64, 0, stream>>>(P); break;
      case 5: nv_up<<<(32768 + 32 * 128) / 4, 256, 0, stream>>>(P); break;
      case 6: nv_down<<<(32768 + 32 * 128) / 4, 256, 0, stream>>>(P); break;
      case 7: nv_combine<<<T, 256, 0, stream>>>(P); break;
      case 8: nv_final<<<T / 4, 256, 0, stream>>>(P); break;
    }
  }
#else
  for (int ph = 0; ph < 9; ++ph) mega<<<grid, 256, LDS_BYTES, stream>>>(P, ph, ph + 1);
#endif
}
```

```cpp
#define ONE_LAUNCH 1
#define OPT_MASK 0x1ff
#define REPEAT_MASK 0x0
#define PROBE_ROUTER 0
#define WITH_NAIVE 0
#include <hip/hip_runtime.h>
#include <cstdio>
#include <cstdint>

typedef unsigned short u16;
#define DI __device__ __forceinline__

constexpr int T = 16384, S = 4096, DM = 1024, NB = 4;
constexpr int DIN = 3072, DPLE = 256;
constexpr int HA = 4, HB = 16;
constexpr int NE = 32, DE = 512;
constexpr float EPS = 1e-6f;
constexpr float LOG2E = 1.4426950408889634f;
constexpr float LAM_INIT = 0.2f;

constexpr size_t MiB = 1ull << 20;
constexpr size_t WS_WIN = 0, WS_WOUT = 6 * MiB, WS_W13 = 8 * MiB, WS_W2 = 72 * MiB, WS_WPLG = 104 * MiB,
                 WS_WPLE = 106 * MiB, WS_WR = 106 * MiB + 512 * 1024, WS_ROPE = 107 * MiB;
constexpr size_t WS_SMALL = 108 * MiB;
constexpr size_t WS_RSTDX = WS_SMALL;
constexpr size_t WS_SSQ1P = WS_RSTDX + 65536;
constexpr size_t WS_SSQEP = WS_SSQ1P + 524288;
constexpr size_t WS_RSTD1 = WS_SSQEP + 524288;
constexpr size_t WS_RSTD2 = WS_RSTD1 + 65536;
constexpr size_t WS_SCAL  = WS_RSTD2 + 65536;
constexpr size_t WS_CNT   = WS_SCAL + 256;
constexpr int CNT_STRIDE = 64;
constexpr size_t WS_PADST = WS_CNT + 8192;
constexpr size_t WS_CTL   = WS_PADST + 256;
constexpr size_t WS_RSTDE = WS_CTL + 16384;
constexpr size_t WS_TOKL  = WS_SMALL + 2 * MiB;
constexpr size_t WS_WL    = WS_SMALL + 4 * MiB;
constexpr size_t WS_ACT   = 114 * MiB;
constexpr size_t A_XB = WS_ACT, A_AO = WS_ACT, A_HID = WS_ACT, A_H2B = WS_ACT;
constexpr size_t A_PB = WS_ACT + 32 * MiB;
constexpr size_t A_QA = WS_ACT + 40 * MiB, A_KA = WS_ACT + 56 * MiB, A_VAT = WS_ACT + 72 * MiB,
                 A_QB = WS_ACT + 88 * MiB, A_KB = WS_ACT + 104 * MiB, A_VBT = WS_ACT + 120 * MiB;
constexpr size_t A_H1B = WS_ACT + 40 * MiB, A_EBF = WS_ACT + 72 * MiB, A_Y0 = WS_ACT + 104 * MiB, A_Y1 = WS_ACT + 40 * MiB;
constexpr size_t WS_END = WS_ACT + 136 * MiB;

DI float bf2f(u16 u) { return __uint_as_float(((unsigned)u) << 16); }
DI u16 f2bf(float f) { __bf16 b = (__bf16)f; return __builtin_bit_cast(u16, b); }
DI int permpos(int s) { return (s & ~12) | ((s & 8) >> 1) | ((s & 4) << 1); }

struct Ptrs {
  const float *x, *p, *g_mix, *w_in, *g_qa, *g_ka, *lam_q1, *lam_k1, *lam_q2, *lam_k2, *g_sub, *g_qb, *g_kb, *rpb, *w_out,
      *g_ffn, *w_rg, *w_re, *w1, *w3, *w2, *g_plg, *w_plg, *w_ple, *g_ple;
  float* out;
  unsigned char* ws;
};

#define GAS __attribute__((address_space(1)))
#define LAS __attribute__((address_space(3)))
typedef LAS unsigned char* ldsp;
typedef __attribute__((ext_vector_type(8))) short bf16x8;
typedef __attribute__((ext_vector_type(16))) float f32x16;
typedef __attribute__((ext_vector_type(4))) float f32x4;
typedef __attribute__((ext_vector_type(2))) float f32x2v;
typedef __attribute__((ext_vector_type(2))) __bf16 bf16x2v;
constexpr int CT_LD = 132;
constexpr int LDS_EXTRA = 128 * CT_LD * 4;
constexpr int LDS_BYTES = LDS_EXTRA + 2048;

DI unsigned pk2(float a, float b) { bf16x2v v = __builtin_convertvector((f32x2v){a, b}, bf16x2v); return __builtin_bit_cast(unsigned, v); }
DI float wave_sum(float v) {
#pragma unroll
  for (int o = 1; o < 64; o <<= 1) v += __shfl_xor(v, o);
  return v;
}
DI float half_sum32(float v) {
#pragma unroll
  for (int o = 1; o < 32; o <<= 1) v += __shfl_xor(v, o);
  return v;
}
DI int crow(int e, int h) { return (e & 3) + 8 * (e >> 2) + 4 * h; }
DI void glds16(const void* g, ldsp l) { __builtin_amdgcn_global_load_lds((const GAS unsigned*)g, (LAS unsigned*)l, 16, 0, 0); }
DI void lds_wave_sync() { asm volatile("s_waitcnt lgkmcnt(0)" ::: "memory"); }

#define XB_TMO      128
#define XB_XCNT(j)  (256  + 64 * (j))
#define XB_XSUB(j)  (1280 + 64 * (j))
#define XB_XGEN(j)  (2304 + 64 * (j))
#define XB_TOP      3328
#define XB_TOPGEN   3392
#define XCD_BAR_WORDS 3456
#define XB_SPIN_CAP (1u << 22)
DI unsigned xb_ld(unsigned* p) { return __hip_atomic_load(p, __ATOMIC_RELAXED, __HIP_MEMORY_SCOPE_AGENT); }
DI unsigned xb_add(unsigned* p, unsigned v) { return __hip_atomic_fetch_add(p, v, __ATOMIC_RELAXED, __HIP_MEMORY_SCOPE_AGENT); }
DI unsigned xb_xcc_id() { return (unsigned)__builtin_amdgcn_s_getreg((3 << 11) | 20) & 0xFu; }
#define XB_SPIN(cond, bar) do { unsigned _sp = 0; while (cond) { __builtin_amdgcn_s_sleep(1); \
    if ((++_sp & 255u) == 0u) { if (xb_ld(&(bar)[XB_TMO])) break; if (_sp > XB_SPIN_CAP) { atomicAdd(&(bar)[XB_TMO], 1u); break; } } } } while (0)
struct XcdBarrier { unsigned* bar; unsigned x; volatile LAS unsigned* st; };
DI XcdBarrier xcd_barrier_post(unsigned* bar, volatile LAS unsigned* st) {
  XcdBarrier b; b.bar = bar; b.x = xb_xcc_id(); b.st = st;
  if (threadIdx.x == 0) (void)xb_add(&bar[XB_XCNT(b.x)], 1u);
  return b;
}
DI void xcd_barrier_complete(unsigned* bar, unsigned x, unsigned& nloc, unsigned& nx) {
  const unsigned G = gridDim.x;
  unsigned sum, cnt, mine, sp = 0u;
  for (;;) {
    sum = 0u; cnt = 0u; mine = 0u;
#pragma unroll
    for (unsigned j = 0; j < 16; ++j) { const unsigned c = xb_ld(&bar[XB_XCNT(j)]); sum += c; cnt += (c > 0u) ? 1u : 0u; mine = (j == x) ? c : mine; }
    if (sum == G) break;
    __builtin_amdgcn_s_sleep(1);
    if ((++sp & 255u) == 0u) { if (xb_ld(&bar[XB_TMO])) break; if (sp > XB_SPIN_CAP) { atomicAdd(&bar[XB_TMO], 1u); break; } }
  }
  nloc = mine > 0u ? mine : 1u; nx = cnt > 0u ? cnt : 1u;
}
DI void xcd_barrier(const XcdBarrier& b) {
  asm volatile("s_waitcnt vmcnt(0)" ::: "memory");
  __syncthreads();
  if (threadIdx.x == 0) {
    unsigned* bar = b.bar;
    __builtin_amdgcn_s_waitcnt(0);
    unsigned nloc = b.st[0], nx = b.st[1];
    if (nloc == 0u) { xcd_barrier_complete(bar, b.x, nloc, nx); b.st[0] = nloc; b.st[1] = nx; }
    const unsigned old = xb_add(&bar[XB_XSUB(b.x)], 1u);
    const unsigned gen = old / nloc;
    if (old + 1u == (gen + 1u) * nloc) {
      __builtin_amdgcn_fence(__ATOMIC_RELEASE, "agent");
      asm volatile("s_waitcnt vmcnt(0)" ::: "memory");
      const unsigned og = xb_add(&bar[XB_TOP], 1u);
      const unsigned tg = og / nx;
      if (og + 1u == (tg + 1u) * nx) xb_add(&bar[XB_TOPGEN], 1u);
      else XB_SPIN(xb_ld(&bar[XB_TOPGEN]) == tg, bar);
      __builtin_amdgcn_fence(__ATOMIC_ACQUIRE, "agent");
      xb_add(&bar[XB_XGEN(b.x)], 1u);
      asm volatile("s_waitcnt vmcnt(0)" ::: "memory");
    } else {
      XB_SPIN(xb_ld(&bar[XB_XGEN(b.x)]) == gen, bar);
      __builtin_amdgcn_fence(__ATOMIC_ACQUIRE, "agent");
      asm volatile("s_waitcnt vmcnt(0)" ::: "memory");
    }
  }
  __syncthreads();
}

DI void gemm_core(const u16* const (&arow)[4], const u16* const (&brow)[4], int nk, f32x16 (&acc)[2][2], ldsp lds) {
  const int tid = threadIdx.x, lane = tid & 63, wave = __builtin_amdgcn_readfirstlane(tid >> 6);
  const int wm = wave >> 1, wn = wave & 1;
  auto stage = [&](int buf, int kt) {
    ldsp la = lds + buf * 32768 + wave * 4096;
    ldsp lb = la + 16384;
#pragma unroll
    for (int qq = 0; qq < 4; ++qq) {
      const int r = 32 * wave + 8 * qq + (lane >> 3);
      const int c = (lane & 7) ^ ((r >> 1) & 7);
      glds16(arow[qq] + kt * 64 + c * 8, la + qq * 1024);
      glds16(brow[qq] + kt * 64 + c * 8, lb + qq * 1024);
    }
  };
  stage(0, 0);
  asm volatile("s_waitcnt vmcnt(0)" ::: "memory");
  __syncthreads();
  const int r31 = lane & 31, h = lane >> 5;
  for (int kt = 0; kt < nk; ++kt) {
    const int buf = kt & 1;
    if (kt + 1 < nk) stage(buf ^ 1, kt + 1);
    ldsp la = lds + buf * 32768;
    ldsp lb = la + 16384;
#pragma unroll
    for (int s = 0; s < 4; ++s) {
      bf16x8 a[2], b[2];
#pragma unroll
      for (int i = 0; i < 2; ++i) {
        const int ra = 64 * wm + 32 * i + r31, rb = 64 * wn + 32 * i + r31;
        a[i] = *(LAS bf16x8*)(la + ra * 128 + (((2 * s + h) ^ ((ra >> 1) & 7)) << 4));
        b[i] = *(LAS bf16x8*)(lb + rb * 128 + (((2 * s + h) ^ ((rb >> 1) & 7)) << 4));
      }
#pragma unroll
      for (int i = 0; i < 2; ++i)
#pragma unroll
        for (int j = 0; j < 2; ++j) acc[i][j] = __builtin_amdgcn_mfma_f32_32x32x16_bf16(a[i], b[j], acc[i][j], 0, 0, 0);
    }
    asm volatile("s_waitcnt vmcnt(0)" ::: "memory");
    __syncthreads();
  }
}
DI void zero_acc(f32x16 (&acc)[2][2]) {
#pragma unroll
  for (int i = 0; i < 2; ++i)
#pragma unroll
    for (int j = 0; j < 2; ++j)
#pragma unroll
      for (int e = 0; e < 16; ++e) acc[i][j][e] = 0.0f;
}

DI void tr_item(const float* W, int ldw, int k0, int n0, const float* gk, u16* dst0, u16* dst1, int ldd, LAS float* scr, int lane) {
  float4 v[16];
  const float* src = W + (size_t)(k0 + (lane >> 4)) * ldw + n0 + 4 * (lane & 15);
#pragma unroll
  for (int j = 0; j < 16; ++j) v[j] = *(const float4*)(src + (size_t)(4 * j) * ldw);
  if (gk) {
#pragma unroll
    for (int j = 0; j < 16; ++j) { const float g = gk[k0 + 4 * j + (lane >> 4)]; v[j].x *= g; v[j].y *= g; v[j].z *= g; v[j].w *= g; }
  }
  LAS float* w = scr + (lane >> 4) * 65 + 4 * (lane & 15);
#pragma unroll
  for (int j = 0; j < 16; ++j) { w[(4 * j) * 65] = v[j].x; w[(4 * j) * 65 + 1] = v[j].y; w[(4 * j) * 65 + 2] = v[j].z; w[(4 * j) * 65 + 3] = v[j].w; }
  lds_wave_sync();
  const int c = lane & 7;
#pragma unroll
  for (int j = 0; j < 8; ++j) {
    const int n = (lane >> 3) + 8 * j;
    const LAS float* s = scr + (8 * c) * 65 + n;
    uint4 o;
    o.x = pk2(s[0 * 65], s[1 * 65]); o.y = pk2(s[2 * 65], s[3 * 65]); o.z = pk2(s[4 * 65], s[5 * 65]); o.w = pk2(s[6 * 65], s[7 * 65]);
    u16* d = (j < 4) ? (dst0 + (size_t)n * ldd) : (dst1 + (size_t)(n - 32) * ldd);
    *(uint4*)(d + k0 + 8 * c) = o;
  }
  lds_wave_sync();
}

DI void ph0_prep(const Ptrs& P, ldsp lds, int bid, int G) {
  const int tid = threadIdx.x, lane = tid & 63, wave = tid >> 6;
  LAS float* scr = (LAS float*)(lds + wave * 16640);
  const int gw = bid * 4 + wave, NGW = G * 4;
  constexpr int I_W1 = 4096, I_W3 = 4096, I_W2 = 4096, I_X = 8192, I_WIN = 768, I_P = 2048, I_WOUT = 256, I_PLG = 256, I_PLE = 64,
                I_WR = 768, I_ROPE = 2048, I_SC = 1;
  constexpr int TOTAL = I_W1 + I_W3 + I_W2 + I_X + I_WIN + I_P + I_WOUT + I_PLG + I_PLE + I_WR + I_ROPE + I_SC;
  u16* W13T = (u16*)(P.ws + WS_W13); u16* W2T = (u16*)(P.ws + WS_W2);
  for (int it = gw; it < TOTAL; it += NGW) {
    int r = it;
    if (r < I_W1 + I_W3) {
      const int isw3 = r >= I_W1; if (isw3) r -= I_W1;
      const int e = r >> 7, q = r & 127, kb = q >> 3, nb = q & 7;
      u16* d0 = W13T + ((size_t)e * 1024 + nb * 128 + isw3 * 32) * 1024;
      tr_item((isw3 ? P.w3 : P.w1) + (size_t)e * 1024 * 512, 512, kb * 64, nb * 64, P.g_ffn, d0, d0 + 64 * 1024, 1024, scr, lane);
      continue;
    }
    r -= I_W1 + I_W3;
    if (r < I_W2) {
      const int e = r >> 7, q = r & 127, kb = q >> 4, nb = q & 15;
      u16* d0 = W2T + ((size_t)e * 1024 + nb * 64) * 512;
      tr_item(P.w2 + (size_t)e * 512 * 1024, 1024, kb * 64, nb * 64, nullptr, d0, d0 + 32 * 512, 512, scr, lane);
      continue;
    }
    r -= I_W2;
    if (r < I_X) {
      const float4* xr = (const float4*)(P.x + (size_t)r * 2048) + lane;
      float4 v[8];
#pragma unroll
      for (int j = 0; j < 8; ++j) v[j] = xr[64 * j];
      float s0 = 0.f, s1 = 0.f;
#pragma unroll
      for (int j = 0; j < 4; ++j) { s0 += v[j].x * v[j].x + v[j].y * v[j].y + v[j].z * v[j].z + v[j].w * v[j].w; s1 += v[j + 4].x * v[j + 4].x + v[j + 4].y * v[j + 4].y + v[j + 4].z * v[j + 4].z + v[j + 4].w * v[j + 4].w; }
      s0 = wave_sum(s0); s1 = wave_sum(s1);
      if (lane == 0) { float* rx = (float*)(P.ws + WS_RSTDX); rx[2 * r] = rsqrtf(s0 * (1.0f / 1024.0f) + EPS); rx[2 * r + 1] = rsqrtf(s1 * (1.0f / 1024.0f) + EPS); }
      uint2* o = (uint2*)((u16*)(P.ws + A_XB) + (size_t)r * 2048) + lane;
#pragma unroll
      for (int j = 0; j < 8; ++j) o[64 * j] = make_uint2(pk2(v[j].x, v[j].y), pk2(v[j].z, v[j].w));
      continue;
    }
    r -= I_X;
    if (r < I_WIN) {
      const int kb = r / 48, nb = r % 48;
      u16* d0 = (u16*)(P.ws + WS_WIN) + (size_t)(nb * 64) * 1024;
      tr_item(P.w_in, DIN, kb * 64, nb * 64, P.g_mix, d0, d0 + 32 * 1024, 1024, scr, lane);
      continue;
    }
    r -= I_WIN;
    if (r < I_P) {
      const float4* pr = (const float4*)P.p + (size_t)r * 512 + lane;
      uint2* o = (uint2*)(P.ws + A_PB) + (size_t)r * 512 + lane;
      float4 v[8];
#pragma unroll
      for (int j = 0; j < 8; ++j) v[j] = pr[64 * j];
#pragma unroll
      for (int j = 0; j < 8; ++j) o[64 * j] = make_uint2(pk2(v[j].x, v[j].y), pk2(v[j].z, v[j].w));
      continue;
    }
    r -= I_P;
    if (r < I_WOUT) {
      const int kb = r >> 4, nb = r & 15;
      u16* d0 = (u16*)(P.ws + WS_WOUT) + (size_t)(nb * 64) * 1024;
      tr_item(P.w_out, 1024, kb * 64, nb * 64, nullptr, d0, d0 + 32 * 1024, 1024, scr, lane);
      continue;
    }
    r -= I_WOUT;
    if (r < I_PLG) {
      const int kb = r >> 4, nb = r & 15;
      u16* d0 = (u16*)(P.ws + WS_WPLG) + (size_t)(nb * 64) * 1024;
      tr_item(P.w_plg, 1024, kb * 64, nb * 64, P.g_plg, d0, d0 + 32 * 1024, 1024, scr, lane);
      continue;
    }
    r -= I_PLG;
    if (r < I_PLE) {
      const int kb = r >> 4, nb = r & 15;
      u16* d0 = (u16*)(P.ws + WS_WPLE) + (size_t)(nb * 64) * 256;
      tr_item(P.w_ple, 1024, kb * 64, nb * 64, nullptr, d0, d0 + 32 * 256, 256, scr, lane);
      continue;
    }
    r -= I_PLE;
    if (r < I_WR) {
      const int idx = r * 64 + lane, rr = idx >> 10, k = idx & 1023;
      float v = 0.f;
      if (rr < 4) v = P.w_rg[k * 4 + rr]; else if (rr < 36) v = P.w_re[k * 32 + (rr - 4)];
      ((float*)(P.ws + WS_WR))[idx] = v * P.g_ffn[k];
      continue;
    }
    r -= I_WR;
    if (r < I_ROPE) {
      const int idx = r * 64 + lane, s = idx >> 5, i = idx & 31;
      const float inv = powf(10000.0f, -(float)(2 * i) / 64.0f);
      const float ang = (float)s * inv;
      float sn, cs; sincosf(ang, &sn, &cs);
      ((float2*)(P.ws + WS_ROPE))[idx] = make_float2(cs, sn);
      continue;
    }
    if (lane == 0) {
      float s1 = 0, s2 = 0, mq = 0, mk = 0;
      for (int i = 0; i < 64; ++i) {
        s1 += P.lam_q1[i] * P.lam_k1[i]; s2 += P.lam_q2[i] * P.lam_k2[i];
        mq = fmaxf(mq, fabsf(P.g_qa[i])); mk = fmaxf(mk, fabsf(P.g_ka[i]));
      }
      float* sc = (float*)(P.ws + WS_SCAL);
      sc[0] = expf(s1) - expf(s2) + LAM_INIT;
      sc[1] = 8.0f * mq * mk * LOG2E;
      float mqb = 0, mkb = 0;
      for (int i = 0; i < 32; ++i) { mqb = fmaxf(mqb, fabsf(P.g_qb[i])); mkb = fmaxf(mkb, fabsf(P.g_kb[i])); }
      sc[2] = 5.656854249f * mqb * mkb;
      int* cnt = (int*)(P.ws + WS_CNT);
      for (int i = 0; i < 32; ++i) cnt[i * CNT_STRIDE] = 0;
    }
  }
}

DI void acc_to_lds(const f32x16 (&acc)[2][2], ldsp lds) {
  const int tid = threadIdx.x, lane = tid & 63, wave = tid >> 6, wm = wave >> 1, wn = wave & 1, h = lane >> 5, i31 = lane & 31;
  LAS float* ct = (LAS float*)lds;
#pragma unroll
  for (int mi = 0; mi < 2; ++mi)
#pragma unroll
    for (int ni = 0; ni < 2; ++ni)
#pragma unroll
      for (int e = 0; e < 16; ++e) ct[(64 * wm + 32 * mi + crow(e, h)) * CT_LD + 64 * wn + 32 * ni + i31] = acc[mi][ni][e];
}
DI void acc_to_lds_T(const f32x16 (&acc)[2][2], ldsp lds) {
  const int tid = threadIdx.x, lane = tid & 63, wave = tid >> 6, wm = wave >> 1, wn = wave & 1, h = lane >> 5, i31 = lane & 31;
  LAS float* ct = (LAS float*)lds;
#pragma unroll
  for (int mi = 0; mi < 2; ++mi)
#pragma unroll
    for (int ni = 0; ni < 2; ++ni)
#pragma unroll
      for (int g = 0; g < 4; ++g) {
        f32x4 v = {acc[mi][ni][4 * g], acc[mi][ni][4 * g + 1], acc[mi][ni][4 * g + 2], acc[mi][ni][4 * g + 3]};
        *(LAS f32x4*)(ct + (64 * wn + 32 * ni + i31) * CT_LD + 64 * wm + 32 * mi + 8 * g + 4 * h) = v;
      }
}
DI uint4 pk8(const f32x4 a, const f32x4 b) { return make_uint4(pk2(a[0], a[1]), pk2(a[2], a[3]), pk2(b[0], b[1]), pk2(b[2], b[3])); }
DI void ph1_inproj(const Ptrs& P, ldsp lds, int bid, int G) {
  const int tid = threadIdx.x, lane = tid & 63, wave = tid >> 6;
  const u16* xb = (const u16*)(P.ws + A_XB); const u16* WinT = (const u16*)(P.ws + WS_WIN);
  const float* rstdx = (const float*)(P.ws + WS_RSTDX);
  const float2* rope = (const float2*)(P.ws + WS_ROPE);
  u16* qA = (u16*)(P.ws + A_QA); u16* kA = (u16*)(P.ws + A_KA); u16* vAt = (u16*)(P.ws + A_VAT);
  u16* qB = (u16*)(P.ws + A_QB); u16* kB = (u16*)(P.ws + A_KB); u16* vBt = (u16*)(P.ws + A_VBT);
  const float qsA = 0.125f * LOG2E, qsB = 0.17677669529663687f * LOG2E;
  LAS float* ct = (LAS float*)lds;
  LAS float* rsl = (LAS float*)(lds + LDS_EXTRA);
  for (int it = bid; it < 3072; it += G) {
    const int xcd = it & 7, loc = it >> 3, grp = loc >> 6, w = loc & 63, mh = grp / 3, ng = grp % 3;
    const int mt = 16 * xcd + 8 * mh + (w & 7), nt = 8 * ng + (w >> 3);
    const int m0 = mt * 128, n0 = nt * 128;
    {
      const u16 *arow[4], *brow[4];
#pragma unroll
      for (int qq = 0; qq < 4; ++qq) { const int r = 32 * wave + 8 * qq + (lane >> 3); arow[qq] = xb + (size_t)(m0 + r) * 1024; brow[qq] = WinT + (size_t)(n0 + r) * 1024; }
      f32x16 acc[2][2]; zero_acc(acc);
      gemm_core(arow, brow, 16, acc, lds);
      if ((n0 >= 1024 && n0 < 1536) || n0 >= 2560) acc_to_lds_T(acc, lds); else acc_to_lds(acc, lds);
    }
    if (tid < 128) rsl[tid] = rstdx[m0 + tid];
    __syncthreads();
    const int b = m0 >> 12, sb = m0 & 4095;
    if (n0 < 1024) {
      const int isk = n0 >= 512, hh = (n0 & 511) >> 7, c4 = tid & 3, comp = (tid >> 2) & 1;
      const float* gg = isk ? P.g_ka : P.g_qa;
      const float4 g1a = *(const float4*)(gg + 8 * c4), g1b = *(const float4*)(gg + 8 * c4 + 4), g2a = *(const float4*)(gg + 32 + 8 * c4), g2b = *(const float4*)(gg + 36 + 8 * c4);
      u16* dstb = (isk ? kA : qA) + (size_t)(b * 4 + hh) * 4096 * 128 + comp * 64 + 8 * c4;
#pragma unroll 2
      for (int p = 0; p < 4; ++p) {
        const int row = 32 * p + (tid >> 3), s = sb + row;
        const LAS float* src = ct + row * CT_LD + comp * 64 + 8 * c4;
        const f32x4 x1a = *(const LAS f32x4*)src, x1b = *(const LAS f32x4*)(src + 4), x2a = *(const LAS f32x4*)(src + 32), x2b = *(const LAS f32x4*)(src + 36);
        float ss = 0.f;
#pragma unroll
        for (int k = 0; k < 4; ++k) ss += x1a[k] * x1a[k] + x1b[k] * x1b[k] + x2a[k] * x2a[k] + x2b[k] * x2b[k];
        ss += __shfl_xor(ss, 1); ss += __shfl_xor(ss, 2);
        const float rs = rsl[row];
        const float rn = rsqrtf(ss * rs * rs * (1.0f / 64.0f) + EPS) * rs * (isk ? 1.0f : qsA);
        const float4* rp = (const float4*)(rope + (size_t)s * 32 + 8 * c4);
        const float4 csA = rp[0], csB = rp[1], csC = rp[2], csD = rp[3];
        f32x4 o1a, o1b, o2a, o2b;
        { const float y = x1a[0] * rn * g1a.x, z = x2a[0] * rn * g2a.x; o1a[0] = y * csA.x - z * csA.y; o2a[0] = z * csA.x + y * csA.y; }
        { const float y = x1a[1] * rn * g1a.y, z = x2a[1] * rn * g2a.y; o1a[1] = y * csA.z - z * csA.w; o2a[1] = z * csA.z + y * csA.w; }
        { const float y = x1a[2] * rn * g1a.z, z = x2a[2] * rn * g2a.z; o1a[2] = y * csB.x - z * csB.y; o2a[2] = z * csB.x + y * csB.y; }
        { const float y = x1a[3] * rn * g1a.w, z = x2a[3] * rn * g2a.w; o1a[3] = y * csB.z - z * csB.w; o2a[3] = z * csB.z + y * csB.w; }
        { const float y = x1b[0] * rn * g1b.x, z = x2b[0] * rn * g2b.x; o1b[0] = y * csC.x - z * csC.y; o2b[0] = z * csC.x + y * csC.y; }
        { const float y = x1b[1] * rn * g1b.y, z = x2b[1] * rn * g2b.y; o1b[1] = y * csC.z - z * csC.w; o2b[1] = z * csC.z + y * csC.w; }
        { const float y = x1b[2] * rn * g1b.z, z = x2b[2] * rn * g2b.z; o1b[2] = y * csD.x - z * csD.y; o2b[2] = z * csD.x + y * csD.y; }
        { const float y = x1b[3] * rn * g1b.w, z = x2b[3] * rn * g2b.w; o1b[3] = y * csD.z - z * csD.w; o2b[3] = z * csD.z + y * csD.w; }
        u16* dst = dstb + (size_t)s * 128;
        *(uint4*)dst = pk8(o1a, o1b);
        *(uint4*)(dst + 32) = pk8(o2a, o2b);
      }
    } else if (n0 < 1536 || n0 >= 2560) {
      const int isA = n0 < 1536, cc = tid & 15;
      const int t0 = isA ? (16 * (cc >> 1) + 4 * (cc & 1)) : 8 * cc, t1 = isA ? t0 + 8 : t0 + 4;
      const f32x4 ra = *(const LAS f32x4*)(rsl + t0), rb = *(const LAS f32x4*)(rsl + t1);
#pragma unroll 2
      for (int p = 0; p < 8; ++p) {
        const int col = 16 * p + (tid >> 4);
        u16* dst;
        if (isA) dst = vAt + ((size_t)(b * 4 + ((n0 - 1024) >> 7)) * 128 + col) * 4096 + sb;
        else dst = vBt + ((size_t)(b * 16 + ((n0 - 2560) >> 5) + (col >> 5)) * 32 + (col & 31)) * 4096 + sb;
        f32x4 a = *(const LAS f32x4*)(ct + col * CT_LD + t0), c4v = *(const LAS f32x4*)(ct + col * CT_LD + t1);
#pragma unroll
        for (int k = 0; k < 4; ++k) { a[k] *= ra[k]; c4v[k] *= rb[k]; }
        *(uint4*)(dst + 8 * cc) = pk8(a, c4v);
      }
    } else {
      const int isk = n0 >= 2048, c4 = tid & 3, hq = (tid >> 2) & 3;
      const float* gg = isk ? P.g_kb : P.g_qb;
      const float4 ga = *(const float4*)(gg + 8 * c4), gb = *(const float4*)(gg + 8 * c4 + 4);
      const int hd = (((n0 - 1536) & 511) >> 5) + hq;
      u16* dstb = (isk ? kB : qB) + (size_t)(b * 16 + hd) * 4096 * 32 + 8 * c4;
#pragma unroll 2
      for (int p = 0; p < 8; ++p) {
        const int row = 16 * p + (tid >> 4), s = sb + row;
        const LAS float* src = ct + row * CT_LD + hq * 32 + 8 * c4;
        f32x4 a = *(const LAS f32x4*)src, c4v = *(const LAS f32x4*)(src + 4);
        float ss = 0.f;
#pragma unroll
        for (int k = 0; k < 4; ++k) ss += a[k] * a[k] + c4v[k] * c4v[k];
        ss += __shfl_xor(ss, 1); ss += __shfl_xor(ss, 2);
        const float rs = rsl[row];
        const float rn = rsqrtf(ss * rs * rs * (1.0f / 32.0f) + EPS) * rs * (isk ? 1.0f : qsB);
        a[0] *= rn * ga.x; a[1] *= rn * ga.y; a[2] *= rn * ga.z; a[3] *= rn * ga.w;
        c4v[0] *= rn * gb.x; c4v[1] *= rn * gb.y; c4v[2] *= rn * gb.z; c4v[3] *= rn * gb.w;
        *(uint4*)(dstb + (size_t)s * 32) = pk8(a, c4v);
      }
    }
    __syncthreads();
  }
}
typedef __attribute__((ext_vector_type(4))) unsigned u32x4;
DI bf16x8 packp(const f32x16& x, int s) {
  u32x4 p;
  p[0] = pk2(x[8 * s + 0], x[8 * s + 1]); p[1] = pk2(x[8 * s + 2], x[8 * s + 3]);
  p[2] = pk2(x[8 * s + 4], x[8 * s + 5]); p[3] = pk2(x[8 * s + 6], x[8 * s + 7]);
  return __builtin_bit_cast(bf16x8, p);
}
DI int grp_of(int kk) { return ((kk >> 2) == 1 || (kk >> 2) == 2 || (kk >> 2) == 4 || (kk >> 2) == 7) ? 1 : 0; }
DI int rank_of(int kk) { const int q = kk >> 2; return kk - ((q == 0) ? 0 : (q <= 2) ? 4 : (q == 3 || q == 4) ? 8 : (q <= 6) ? 12 : 16); }
DI int key_of(int grp, int jj) { return grp ? (jj < 8 ? jj + 4 : (jj < 12 ? jj + 8 : jj + 16)) : (jj < 4 ? jj : (jj < 8 ? jj + 8 : jj + 12)); }
constexpr int DA_STAGE = 33280, DA_VOFF = 16640;
template <bool SHIFT>
DI void da_item(const Ptrs& P, ldsp lds, int item, float lam, float m2) {
  const int tid = threadIdx.x, lane = tid & 63, wave = __builtin_amdgcn_readfirstlane(tid >> 6), h = lane >> 5, i31 = lane & 31;
  const int xcd = item & 7, loc = item >> 3, bh = 2 * xcd + (loc >> 5), qblk = loc & 31;
  const u16* qA = (const u16*)(P.ws + A_QA) + (size_t)bh * 4096 * 128;
  const u16* kA = (const u16*)(P.ws + A_KA) + (size_t)bh * 4096 * 128;
  const u16* vAt = (const u16*)(P.ws + A_VAT) + (size_t)bh * 128 * 4096;
  const int q = qblk * 128 + 32 * wave + i31;
  bf16x8 qf[2][4];
#pragma unroll
  for (int c = 0; c < 2; ++c)
#pragma unroll
    for (int s = 0; s < 4; ++s) qf[c][s] = *(const bf16x8*)(qA + (size_t)q * 128 + c * 64 + 16 * s + 8 * h);
  auto stage = [&](int buf, int tile) {
    int ln = lane; asm volatile("" : "+v"(ln));
    ldsp lk = lds + buf * DA_STAGE;
    const u16* kt = kA + (size_t)tile * 64 * 128;
    const u16* vt = vAt + tile * 64;
#pragma unroll
    for (int qq = 0; qq < 4; ++qq) {
      const int jj = 4 * wave + qq;
      const int ra = key_of(0, jj), rb = key_of(1, jj);
      const int ku = ln >> 4, key = 32 * (ku >> 1) + ((ku & 1) ? rb : ra);
      glds16(kt + key * 128 + (ln & 15) * 8, lk + jj * 1040);
      const int vu = ln >> 3, d = 32 * (vu >> 1) + ((vu & 1) ? rb : ra);
      glds16(vt + d * 4096 + (ln & 7) * 8, lk + DA_VOFF + jj * 1040);
    }
  };
  const int rk = rank_of(i31), gr = grp_of(i31);
  const int kbase = rk * 1040 + gr * 256 + h * 16;
  const int vbase = DA_VOFF + rk * 1040 + gr * 128 + h * 16;
  f32x16 O1[4], O2[4];
#pragma unroll
  for (int dt = 0; dt < 4; ++dt)
#pragma unroll
    for (int e = 0; e < 16; ++e) { O1[dt][e] = 0.f; O2[dt][e] = 0.f; }
  float l1 = 0.f, l2 = 0.f;
  __syncthreads();
  stage(0, 0);
  asm volatile("s_waitcnt vmcnt(0)" ::: "memory");
  __syncthreads();
  for (int tile = 0; tile < 64; ++tile) {
    const int buf = tile & 1;
    if (tile + 1 < 64) stage(buf ^ 1, tile + 1);
    ldsp lb = lds + buf * DA_STAGE;
#pragma unroll 1
    for (int kt2 = 0; kt2 < 2; ++kt2) {
      bf16x8 pf[2][2];
      ldsp lk = lb + kbase + kt2 * 512;
      ldsp lv = lb + vbase + kt2 * 64;
#pragma unroll
      for (int c = 0; c < 2; ++c) {
        f32x16 sa;
#pragma unroll
        for (int e = 0; e < 16; ++e) sa[e] = 0.f;
#pragma unroll
        for (int s = 0; s < 4; ++s) {
          const bf16x8 kf = *(LAS bf16x8*)(lk + c * 128 + s * 32);
          sa = __builtin_amdgcn_mfma_f32_32x32x16_bf16(kf, qf[c][s], sa, 0, 0, 0);
        }
        float ls = 0.f;
#pragma unroll
        for (int e = 0; e < 16; ++e) { sa[e] = __builtin_amdgcn_exp2f(SHIFT ? sa[e] - m2 : sa[e]); ls += sa[e]; }
        if (c == 0) l1 += ls; else l2 += ls;
        pf[c][0] = packp(sa, 0); pf[c][1] = packp(sa, 1);
      }
      __builtin_amdgcn_sched_barrier(0);
      bf16x8 va = *(LAS bf16x8*)(lv), vb = *(LAS bf16x8*)(lv + 256);
#pragma unroll
      for (int st = 0; st < 4; ++st) {
        const int s2 = st >> 1, dtp = st & 1;
        bf16x8 na = va, nb = vb;
        if (st < 3) { const int s2n = (st + 1) >> 1, dn = (st + 1) & 1; na = *(LAS bf16x8*)(lv + s2n * 32 + dn * 512); nb = *(LAS bf16x8*)(lv + s2n * 32 + dn * 512 + 256); }
        __builtin_amdgcn_sched_barrier(0);
        O1[2 * dtp] = __builtin_amdgcn_mfma_f32_32x32x16_bf16(va, pf[0][s2], O1[2 * dtp], 0, 0, 0);
        O2[2 * dtp] = __builtin_amdgcn_mfma_f32_32x32x16_bf16(va, pf[1][s2], O2[2 * dtp], 0, 0, 0);
        O1[2 * dtp + 1] = __builtin_amdgcn_mfma_f32_32x32x16_bf16(vb, pf[0][s2], O1[2 * dtp + 1], 0, 0, 0);
        O2[2 * dtp + 1] = __builtin_amdgcn_mfma_f32_32x32x16_bf16(vb, pf[1][s2], O2[2 * dtp + 1], 0, 0, 0);
        __builtin_amdgcn_sched_barrier(0);
        va = na; vb = nb;
      }
    }
    asm volatile("s_waitcnt vmcnt(0)" ::: "memory");
    __syncthreads();
  }
  l1 += __shfl_xor(l1, 32); l2 += __shfl_xor(l2, 32);
  const float i1 = 1.0f / l1, i2 = lam / l2;
  float ss = 0.f;
#pragma unroll
  for (int dt = 0; dt < 4; ++dt)
#pragma unroll
    for (int e = 0; e < 16; ++e) { const float o = O1[dt][e] * i1 - O2[dt][e] * i2; O1[dt][e] = o; ss += o * o; }
  ss += __shfl_xor(ss, 32);
  const float rn = rsqrtf(ss * (1.0f / 128.0f) + EPS) * (1.0f - LAM_INIT);
  const int b = bh >> 2, hh = bh & 3;
  u16* dst = (u16*)(P.ws + A_AO) + ((size_t)b * 4096 + q) * 1024 + hh * 128;
#pragma unroll
  for (int dt = 0; dt < 4; ++dt)
#pragma unroll
    for (int g = 0; g < 4; ++g) {
      const int d0 = 32 * dt + 8 * g + 4 * h;
      const float4 gs = *(const float4*)(P.g_sub + d0);
      *(uint2*)(dst + d0) = make_uint2(pk2(O1[dt][4 * g] * rn * gs.x, O1[dt][4 * g + 1] * rn * gs.y), pk2(O1[dt][4 * g + 2] * rn * gs.z, O1[dt][4 * g + 3] * rn * gs.w));
    }
}

typedef __attribute__((ext_vector_type(4))) short s16x4;
constexpr int NA_VSTRIDE = 1424;
constexpr int NA_TAB = 32 * NA_VSTRIDE;
DI void na_block(const Ptrs& P, ldsp lds, int item, float qkbound) {
  const int tid = threadIdx.x, lane = tid & 63, wave = tid >> 6;
  const int r0 = (item & 15) * 4, hd = (item >> 4) & 15, b = item >> 8;
  const int qi = lane & 15, g = lane >> 4;
  LAS float* EB = (LAS float*)(lds + NA_TAB);
  LAS float* RW = EB + 960;
  const int R0 = min(max(r0 - 4, 0), 56), NR = min(11, 64 - R0);
  const u16* vB = (const u16*)(P.ws + A_VBT) + (size_t)(b * 16 + hd) * 32 * 4096;
  __syncthreads();
  {
    u32x4 vv[11];
#pragma unroll
    for (int k = 0; k < 11; ++k) {
      const int sg = (tid >> 3) + 32 * k, d = sg / NR, kr = sg - d * NR;
      vv[k] = *(const u32x4*)(vB + (size_t)min(d, 31) * 4096 + (R0 + min(kr, NR - 1)) * 64 + 8 * (tid & 7));
    }
    float mxa = 0.f;
    const float r0v = (tid < 465) ? P.rpb[hd * 465 + tid] : 0.f, r1v = (tid + 256 < 465) ? P.rpb[hd * 465 + tid + 256] : 0.f;
    mxa = fmaxf(fabsf(r0v), fabsf(r1v));
#pragma unroll
    for (int o = 1; o < 64; o <<= 1) mxa = fmaxf(mxa, __shfl_xor(mxa, o));
    LAS float* red = (LAS float*)(lds + NA_TAB + 7680);
    if (lane == 0) red[wave] = mxa;
#pragma unroll
    for (int k = 0; k < 11; ++k) {
      const int sg = (tid >> 3) + 32 * k, d = sg / NR, kr = sg - d * NR;
      if (sg < 32 * NR) *(LAS u32x4*)(lds + d * NA_VSTRIDE + kr * 128 + 16 * (tid & 7)) = vv[k];
    }
    __syncthreads();
    const float m2 = (qkbound + fmaxf(fmaxf(red[0], red[1]), fmaxf(red[2], red[3]))) * LOG2E;
    for (int e = tid; e < 960; e += 256) {
      const int br = e >> 6, co = (e & 63) - 16;
      const float v = (co >= 0 && co <= 30) ? P.rpb[hd * 465 + br * 31 + co] * LOG2E - m2 : -1e30f;
      RW[e] = v;
      EB[e] = (co >= 7 && co <= 22) ? v : -1e30f;
    }
    __syncthreads();
  }
  const int r = r0 + wave;
  const int rs = min(max(r - 4, 0), 56), rb0 = rs - r + 7;
  const u16* qB = (const u16*)(P.ws + A_QB) + (size_t)(b * 16 + hd) * 4096 * 32;
  const u16* kBp = (const u16*)(P.ws + A_KB) + (size_t)(b * 16 + hd) * 4096 * 32;
  bf16x8 kf[16], qf;
  auto issue_kq = [&](int jq) {
    const int kb = min(min(max(16 * jq - 8, 0), 48), 32);
    const u16* kp = kBp + (size_t)(rs * 64 + kb + qi) * 32 + 8 * g;
    qf = *(const bf16x8*)(qB + (size_t)(r * 64 + 16 * jq + qi) * 32 + 8 * g);
#pragma unroll
    for (int ri = 0; ri < 8; ++ri)
#pragma unroll
      for (int t = 0; t < 2; ++t) kf[2 * ri + t] = *(const bf16x8*)(kp + (ri * 64 + 16 * t) * 32);
  };
  issue_kq(0);
#pragma unroll 1
  for (int jq = 0; jq < 4; ++jq) {
    const int kb = min(min(max(16 * jq - 8, 0), 48), 32);
    const LAS float* tb[2];
    {
      const int cobase = (jq == 0) ? 15 : ((jq == 3) ? -1 : 7);
#pragma unroll
      for (int t = 0; t < 2; ++t) {
        const int off = rb0 * 64 + cobase + 16 * t + 4 * g - qi + 16;
        const LAS float* pe = EB + off; const LAS float* pr = RW + off; const LAS float* pn = RW + 48;
        const LAS float* sel = pe;
        if (jq == 0 && qi < 8) sel = (t == 0) ? pr : pn;
        if (jq == 3 && qi > 8) sel = (t == 1) ? pr : pn;
        tb[t] = sel;
      }
    }
    f32x4 sa[8][2];
#pragma unroll
    for (int ri = 0; ri < 8; ++ri)
#pragma unroll
      for (int t = 0; t < 2; ++t) {
        const LAS float* tp = tb[t] + ri * 64;
        const f32x4 ci = {tp[0], tp[1], tp[2], tp[3]};
        sa[ri][t] = __builtin_amdgcn_mfma_f32_16x16x32_bf16(kf[2 * ri + t], qf, ci, 0, 0, 0);
      }
    __builtin_amdgcn_sched_barrier(0);
    if (jq + 1 < 4) issue_kq(jq + 1);
    __builtin_amdgcn_sched_barrier(0);
    float l = 0.f;
    f32x4 oa[2] = {{0.f, 0.f, 0.f, 0.f}, {0.f, 0.f, 0.f, 0.f}};
    ldsp vl = lds + qi * NA_VSTRIDE + (rs - R0) * 128 + (kb + 4 * g) * 2;
#pragma unroll
    for (int ri = 0; ri < 8; ++ri) {
      float p[8];
#pragma unroll
      for (int t = 0; t < 2; ++t)
#pragma unroll
        for (int i = 0; i < 4; ++i) { const float e = __builtin_amdgcn_exp2f(sa[ri][t][i]); p[4 * t + i] = e; l += e; }
      u32x4 pp; pp[0] = pk2(p[0], p[1]); pp[1] = pk2(p[2], p[3]); pp[2] = pk2(p[4], p[5]); pp[3] = pk2(p[6], p[7]);
      const bf16x8 pfr = __builtin_bit_cast(bf16x8, pp);
#pragma unroll
      for (int dtl = 0; dtl < 2; ++dtl) {
        const s16x4 lo = *(LAS s16x4*)(vl + dtl * 16 * NA_VSTRIDE + ri * 128), hi = *(LAS s16x4*)(vl + dtl * 16 * NA_VSTRIDE + ri * 128 + 32);
        const bf16x8 vf = __builtin_shufflevector(lo, hi, 0, 1, 2, 3, 4, 5, 6, 7);
        oa[dtl] = __builtin_amdgcn_mfma_f32_16x16x32_bf16(vf, pfr, oa[dtl], 0, 0, 0);
      }
    }
    l += __shfl_xor(l, 16); l += __shfl_xor(l, 32);
    const float il = 1.0f / l;
    u16* dst = (u16*)(P.ws + A_AO) + ((size_t)b * 4096 + r * 64 + 16 * jq + qi) * 1024 + 512 + hd * 32;
#pragma unroll
    for (int dtl = 0; dtl < 2; ++dtl)
      *(uint2*)(dst + 16 * dtl + 4 * g) = make_uint2(pk2(oa[dtl][0] * il, oa[dtl][1] * il), pk2(oa[dtl][2] * il, oa[dtl][3] * il));
  }
}

DI void ph2_attn(const Ptrs& P, ldsp lds, int bid, int G) {
  const float* sc = (const float*)(P.ws + WS_SCAL);
  const float lam = sc[0], m2 = sc[1], qkb = sc[2];
  const bool na_first = bid >= (G >> 1);
  if (!na_first) {
    if (m2 < 64.0f) { for (int it = bid; it < 512; it += G) da_item<false>(P, lds, it, lam, m2); }
  }
#if PROBE_ROUTER == 3
#pragma unroll 1
  for (int rep = 0; rep < 2; ++rep)
#endif
  for (int it = bid; it < 1024; it += G) na_block(P, lds, it, qkb);
  if (na_first) {
    if (m2 < 64.0f) { for (int it = bid; it < 512; it += G) da_item<false>(P, lds, it, lam, m2); }
  }
}

DI void tile_map_1024(int t2, int& mt, int& nt) {
  const int xcd = t2 & 7, loc = t2 >> 3, grp = loc >> 6, w = loc & 63;
  mt = 16 * xcd + 8 * grp + (w & 7); nt = w >> 3;
}
DI void ph3_outproj(const Ptrs& P, ldsp lds, int bid, int G) {
  const int tid = threadIdx.x, lane = tid & 63, wave = tid >> 6;
  LAS float* ct = (LAS float*)lds;
  for (int it = bid; it < 2048; it += G) {
    const int isple = it >= 1024;
    int mt, nt; tile_map_1024(it & 1023, mt, nt);
    const int m0 = mt * 128, n0 = nt * 128;
    {
      const u16* A = isple ? (const u16*)(P.ws + A_PB) : (const u16*)(P.ws + A_AO);
      const u16* B = isple ? (const u16*)(P.ws + WS_WPLE) : (const u16*)(P.ws + WS_WOUT);
      const int ld = isple ? 256 : 1024;
      const u16 *arow[4], *brow[4];
#pragma unroll
      for (int qq = 0; qq < 4; ++qq) { const int r = 32 * wave + 8 * qq + (lane >> 3); arow[qq] = A + (size_t)(m0 + r) * ld; brow[qq] = B + (size_t)(n0 + r) * ld; }
      f32x16 acc[2][2]; zero_acc(acc);
      gemm_core(arow, brow, isple ? 4 : 16, acc, lds);
      acc_to_lds(acc, lds);
    }
    __syncthreads();
    const int cc = tid & 15;
    float* ssqp = (float*)(P.ws + (isple ? WS_SSQEP : WS_SSQ1P));
#pragma unroll 2
    for (int p = 0; p < 8; ++p) {
      const int row = 16 * p + (tid >> 4);
      const LAS float* src = ct + row * CT_LD + 8 * cc;
      const size_t go = (size_t)(m0 + row) * 1024 + n0 + 8 * cc;
      f32x4 a = *(const LAS f32x4*)src, c4 = *(const LAS f32x4*)(src + 4);
      if (!isple) {
        const float4 xa = *(const float4*)(P.x + go), xb4 = *(const float4*)(P.x + go + 4);
        a[0] += xa.x; a[1] += xa.y; a[2] += xa.z; a[3] += xa.w; c4[0] += xb4.x; c4[1] += xb4.y; c4[2] += xb4.z; c4[3] += xb4.w;
        *(float4*)(P.out + go) = make_float4(a[0], a[1], a[2], a[3]); *(float4*)(P.out + go + 4) = make_float4(c4[0], c4[1], c4[2], c4[3]);
        *(uint4*)((u16*)(P.ws + A_H1B) + go) = pk8(a, c4);
      } else {
        *(uint4*)((u16*)(P.ws + A_EBF) + go) = pk8(a, c4);
      }
      float ss = a[0] * a[0] + a[1] * a[1] + a[2] * a[2] + a[3] * a[3] + c4[0] * c4[0] + c4[1] * c4[1] + c4[2] * c4[2] + c4[3] * c4[3];
      ss += __shfl_xor(ss, 1); ss += __shfl_xor(ss, 2); ss += __shfl_xor(ss, 4); ss += __shfl_xor(ss, 8);
      if (cc == 0) ssqp[(size_t)(m0 + row) * 8 + nt] = ss;
    }
    __syncthreads();
  }
}

template <bool DRY>
DI void ph4_router_t(const Ptrs& P, ldsp lds, int bid, int G) {
  const int tid = threadIdx.x, lane = tid & 63, wave = tid >> 6, t = lane & 15, kk = lane >> 4;
  LAS float* lg = (LAS float*)(lds + wave * 3072);
  const float* h1 = P.out; const float* WrT = (const float*)(P.ws + WS_WR);
  for (int item = bid * 4 + wave; item < 1024; item += G * 4) {
    const int tok0 = item * 16;
    f32x4 acc[3] = {{0.f, 0.f, 0.f, 0.f}, {0.f, 0.f, 0.f, 0.f}, {0.f, 0.f, 0.f, 0.f}};
    const float* ap = h1 + (size_t)(tok0 + t) * 1024 + 4 * kk;
    const float* bp = WrT + (size_t)t * 1024 + 4 * kk;
#pragma unroll 4
    for (int s = 0; s < 64; ++s) {
      const float4 a4 = *(const float4*)(ap + 16 * s);
      const float4 b0 = *(const float4*)(bp + 16 * s), b1 = *(const float4*)(bp + 16 * 1024 + 16 * s), b2 = *(const float4*)(bp + 32 * 1024 + 16 * s);
      acc[0] = __builtin_amdgcn_mfma_f32_16x16x4f32(a4.x, b0.x, acc[0], 0, 0, 0); acc[1] = __builtin_amdgcn_mfma_f32_16x16x4f32(a4.x, b1.x, acc[1], 0, 0, 0); acc[2] = __builtin_amdgcn_mfma_f32_16x16x4f32(a4.x, b2.x, acc[2], 0, 0, 0);
      acc[0] = __builtin_amdgcn_mfma_f32_16x16x4f32(a4.y, b0.y, acc[0], 0, 0, 0); acc[1] = __builtin_amdgcn_mfma_f32_16x16x4f32(a4.y, b1.y, acc[1], 0, 0, 0); acc[2] = __builtin_amdgcn_mfma_f32_16x16x4f32(a4.y, b2.y, acc[2], 0, 0, 0);
      acc[0] = __builtin_amdgcn_mfma_f32_16x16x4f32(a4.z, b0.z, acc[0], 0, 0, 0); acc[1] = __builtin_amdgcn_mfma_f32_16x16x4f32(a4.z, b1.z, acc[1], 0, 0, 0); acc[2] = __builtin_amdgcn_mfma_f32_16x16x4f32(a4.z, b2.z, acc[2], 0, 0, 0);
      acc[0] = __builtin_amdgcn_mfma_f32_16x16x4f32(a4.w, b0.w, acc[0], 0, 0, 0); acc[1] = __builtin_amdgcn_mfma_f32_16x16x4f32(a4.w, b1.w, acc[1], 0, 0, 0); acc[2] = __builtin_amdgcn_mfma_f32_16x16x4f32(a4.w, b2.w, acc[2], 0, 0, 0);
    }
    lds_wave_sync();
#pragma unroll
    for (int et = 0; et < 3; ++et)
#pragma unroll
      for (int i = 0; i < 4; ++i) lg[(4 * kk + i) * 48 + 16 * et + t] = acc[et][i];
    lds_wave_sync();
    if (lane < 16) {
      const int tok = tok0 + lane;
      const float* sp = (const float*)(P.ws + WS_SSQ1P) + (size_t)tok * 8;
      const float4 s0 = *(const float4*)sp, s1 = *(const float4*)(sp + 4);
      const float rstd = rsqrtf((s0.x + s0.y + s0.z + s0.w + s1.x + s1.y + s1.z + s1.w) * (1.0f / 1024.0f) + EPS);
      ((float*)(P.ws + WS_RSTD1))[tok] = rstd;
      const LAS float* L = lg + lane * 48;
      int gi = 0; float gm = L[0];
#pragma unroll
      for (int i = 1; i < 4; ++i) { const float v = L[i]; if (v > gm) { gm = v; gi = i; } }
      float gs = 0.f;
#pragma unroll
      for (int i = 0; i < 4; ++i) gs += expf((L[i] - gm) * rstd);
      const float gate = 1.0f / gs;
      const LAS float* el = L + 4 + 8 * gi;
      int e1 = 0; float m1 = el[0];
#pragma unroll
      for (int i = 1; i < 8; ++i) { const float v = el[i]; if (v > m1) { m1 = v; e1 = i; } }
      int e2 = 0; float m2v = -3.0e38f;
#pragma unroll
      for (int i = 0; i < 8; ++i) { const float v = el[i]; if (i != e1 && v > m2v) { m2v = v; e2 = i; } }
      const float p2 = expf((m2v - m1) * rstd);
      const float wa = gate / (1.0f + p2), wb = gate * p2 / (1.0f + p2);
      int* cnt = (int*)(P.ws + WS_CNT); int* tokl = (int*)(P.ws + WS_TOKL); float* wl = (float*)(P.ws + WS_WL);
      const int ea = gi * 8 + e1, eb = gi * 8 + e2;
      if (!DRY) {
        const int pa = atomicAdd(&cnt[ea * CNT_STRIDE], 1); tokl[ea * 16384 + pa] = tok * 2; wl[ea * 16384 + pa] = wa;
        const int pb = atomicAdd(&cnt[eb * CNT_STRIDE], 1); tokl[eb * 16384 + pb] = tok * 2 + 1; wl[eb * 16384 + pb] = wb;
      } else { ((float*)(P.ws + WS_RSTD1))[tok] = rstd + 0.0f * (wa + wb + (float)(ea + eb)); }
    }
  }
}

DI void ph4_router(const Ptrs& P, ldsp lds, int bid, int G) {
#if PROBE_ROUTER
  ph4_router_t<true>(P, lds, bid, G);
  __syncthreads();
#endif
  ph4_router_t<false>(P, lds, bid, G);
}

DI int moe_plan(const Ptrs& P, ldsp lds) {
  LAS int* smb = (LAS int*)(lds + LDS_EXTRA + 1024);
  if (threadIdx.x == 0) {
    const int* cnt = (const int*)(P.ws + WS_CNT);
    int a = 0;
    for (int e = 0; e < 32; ++e) { smb[e] = a; a += (cnt[e * CNT_STRIDE] + 127) >> 7; }
    smb[32] = a;
  }
  __syncthreads();
  return smb[32];
}
DI void ph5_up(const Ptrs& P, ldsp lds, int bid, int G) {
  const int tid = threadIdx.x, lane = tid & 63, wave = tid >> 6;
  LAS float* ct = (LAS float*)lds;
  LAS float* rsl = (LAS float*)(lds + LDS_EXTRA);
  LAS int* smb = (LAS int*)(lds + LDS_EXTRA + 1024);
  const int MB = moe_plan(P, lds);
  const int* cnt = (const int*)(P.ws + WS_CNT); const int* tokl = (const int*)(P.ws + WS_TOKL);
  const u16* h1b = (const u16*)(P.ws + A_H1B); const u16* W13T = (const u16*)(P.ws + WS_W13);
  const float* rstd1 = (const float*)(P.ws + WS_RSTD1);
  u16* hid = (u16*)(P.ws + A_HID);
  for (int it = bid; it < MB * 8; it += G) {
    const int nb = it & 7, gmb = it >> 3;
    int e = 0; while (gmb >= smb[e + 1]) ++e;
    const int mb = gmb - smb[e], ce = cnt[e * CNT_STRIDE];
    {
      const u16 *arow[4], *brow[4];
#pragma unroll
      for (int qq = 0; qq < 4; ++qq) {
        const int r = 32 * wave + 8 * qq + (lane >> 3), i = mb * 128 + r;
        const int tok = (i < ce) ? (tokl[e * 16384 + i] >> 1) : 0;
        arow[qq] = h1b + (size_t)tok * 1024; brow[qq] = W13T + ((size_t)e * 1024 + nb * 128 + r) * 1024;
      }
      f32x16 acc[2][2]; zero_acc(acc);
      gemm_core(arow, brow, 16, acc, lds);
      acc_to_lds(acc, lds);
    }
    if (tid < 128) { const int i = mb * 128 + tid; rsl[tid] = (i < ce) ? rstd1[tokl[e * 16384 + i] >> 1] : 0.0f; }
    __syncthreads();
    const int jc = tid & 7, hfc = jc >> 2, c = jc & 3;
#pragma unroll 2
    for (int p = 0; p < 4; ++p) {
      const int row = 32 * p + (tid >> 3);
      const LAS float* src = ct + row * CT_LD + 64 * hfc + 8 * c;
      const float rs = rsl[row];
      f32x4 u0 = *(const LAS f32x4*)src, u1 = *(const LAS f32x4*)(src + 4);
      const f32x4 v0 = *(const LAS f32x4*)(src + 32), v1 = *(const LAS f32x4*)(src + 36);
#pragma unroll
      for (int k = 0; k < 4; ++k) {
        const float a = u0[k] * rs, bq = u1[k] * rs;
        u0[k] = a / (1.0f + __expf(-a)) * (v0[k] * rs); u1[k] = bq / (1.0f + __expf(-bq)) * (v1[k] * rs);
      }
      *(uint4*)(hid + (size_t)(gmb * 128 + row) * 512 + 64 * nb + 8 * jc) = pk8(u0, u1);
    }
    __syncthreads();
  }
}
DI void ph6_down(const Ptrs& P, ldsp lds, int bid, int G) {
  const int tid = threadIdx.x, lane = tid & 63, wave = tid >> 6;
  LAS float* ct = (LAS float*)lds;
  LAS float* wsl = (LAS float*)(lds + LDS_EXTRA);
  LAS int* tkl = (LAS int*)(lds + LDS_EXTRA + 512);
  LAS int* smb = (LAS int*)(lds + LDS_EXTRA + 1024);
  const int MB = moe_plan(P, lds);
  const int* cnt = (const int*)(P.ws + WS_CNT); const int* tokl = (const int*)(P.ws + WS_TOKL); const float* wl = (const float*)(P.ws + WS_WL);
  const u16* hid = (const u16*)(P.ws + A_HID); const u16* W2T = (const u16*)(P.ws + WS_W2);
  for (int it = bid; it < MB * 8; it += G) {
    const int nb = it & 7, gmb = it >> 3;
    int e = 0; while (gmb >= smb[e + 1]) ++e;
    const int mb = gmb - smb[e], ce = cnt[e * CNT_STRIDE];
    {
      const u16 *arow[4], *brow[4];
#pragma unroll
      for (int qq = 0; qq < 4; ++qq) {
        const int r = 32 * wave + 8 * qq + (lane >> 3);
        arow[qq] = hid + (size_t)(gmb * 128 + r) * 512; brow[qq] = W2T + ((size_t)e * 1024 + nb * 128 + r) * 512;
      }
      f32x16 acc[2][2]; zero_acc(acc);
      gemm_core(arow, brow, 8, acc, lds);
      acc_to_lds(acc, lds);
    }
    if (tid < 128) { const int i = mb * 128 + tid; const bool v = i < ce; tkl[tid] = v ? tokl[e * 16384 + i] : -1; wsl[tid] = v ? wl[e * 16384 + i] : 0.0f; }
    __syncthreads();
    const int cc = tid & 15;
#pragma unroll 2
    for (int p = 0; p < 8; ++p) {
      const int row = 16 * p + (tid >> 4);
      const int tk = tkl[row];
      if (tk >= 0) {
        const float w = wsl[row];
        const LAS float* src = ct + row * CT_LD + 8 * cc;
        f32x4 a = *(const LAS f32x4*)src, c4 = *(const LAS f32x4*)(src + 4);
#pragma unroll
        for (int k = 0; k < 4; ++k) { a[k] *= w; c4[k] *= w; }
        *(uint4*)((u16*)(P.ws + ((tk & 1) ? A_Y1 : A_Y0)) + (size_t)(tk >> 1) * 1024 + nb * 128 + 8 * cc) = pk8(a, c4);
      }
    }
    __syncthreads();
  }
}

DI void ph7_combine(const Ptrs& P, ldsp lds, int bid, int G) {
  const int lane = threadIdx.x & 63, wave = threadIdx.x >> 6;
  for (int tok = bid * 4 + wave; tok < T; tok += G * 4) {
    const float4* hr = (const float4*)(P.out + (size_t)tok * 1024) + lane;
    const uint2* y0 = (const uint2*)((const u16*)(P.ws + A_Y0) + (size_t)tok * 1024) + lane;
    const uint2* y1 = (const uint2*)((const u16*)(P.ws + A_Y1) + (size_t)tok * 1024) + lane;
    uint2* o = (uint2*)((u16*)(P.ws + A_H2B) + (size_t)tok * 1024) + lane;
    float ss = 0.f;
#pragma unroll
    for (int j = 0; j < 4; ++j) {
      const float4 hv = hr[64 * j]; const uint2 a = y0[64 * j], c = y1[64 * j];
      const float v0 = hv.x + __uint_as_float(a.x << 16) + __uint_as_float(c.x << 16);
      const float v1 = hv.y + __uint_as_float(a.x & 0xffff0000u) + __uint_as_float(c.x & 0xffff0000u);
      const float v2 = hv.z + __uint_as_float(a.y << 16) + __uint_as_float(c.y << 16);
      const float v3 = hv.w + __uint_as_float(a.y & 0xffff0000u) + __uint_as_float(c.y & 0xffff0000u);
      ss += v0 * v0 + v1 * v1 + v2 * v2 + v3 * v3;
      o[64 * j] = make_uint2(pk2(v0, v1), pk2(v2, v3));
    }
    ss = wave_sum(ss);
    float se = (lane < 8) ? ((const float*)(P.ws + WS_SSQEP))[(size_t)tok * 8 + lane] : 0.f;
    se = wave_sum(se);
    if (lane == 0) {
      ((float*)(P.ws + WS_RSTD2))[tok] = rsqrtf(ss * (1.0f / 1024.0f) + EPS);
      ((float*)(P.ws + WS_RSTDE))[tok] = rsqrtf(se * (1.0f / 1024.0f) + EPS);
    }
  }
}

template <bool DRY>
DI void ph8_final_t(const Ptrs& P, ldsp lds, int bid, int G) {
  const int tid = threadIdx.x, lane = tid & 63, wave = tid >> 6;
  LAS float* ct = (LAS float*)lds;
  const u16* h2b = (const u16*)(P.ws + A_H2B); const u16* WplgT = (const u16*)(P.ws + WS_WPLG);
  for (int it = bid; it < 1024; it += G) {
    int mt, nt; tile_map_1024(it, mt, nt);
    const int m0 = mt * 128, n0 = nt * 128;
    {
      const u16 *arow[4], *brow[4];
#pragma unroll
      for (int qq = 0; qq < 4; ++qq) { const int r = 32 * wave + 8 * qq + (lane >> 3); arow[qq] = h2b + (size_t)(m0 + r) * 1024; brow[qq] = WplgT + (size_t)(n0 + r) * 1024; }
      f32x16 acc[2][2]; zero_acc(acc);
      gemm_core(arow, brow, 16, acc, lds);
      acc_to_lds(acc, lds);
    }
    __syncthreads();
    const int cc = tid & 15;
    const float4 ga = *(const float4*)(P.g_ple + n0 + 8 * cc), gb = *(const float4*)(P.g_ple + n0 + 8 * cc + 4);
    const float gv[8] = {ga.x, ga.y, ga.z, ga.w, gb.x, gb.y, gb.z, gb.w};
#pragma unroll 2
    for (int p = 0; p < 8; ++p) {
      const int row = 16 * p + (tid >> 4);
      const LAS float* src = ct + row * CT_LD + 8 * cc;
      const size_t go = (size_t)(m0 + row) * 1024 + n0 + 8 * cc;
      const float rs2 = ((const float*)(P.ws + WS_RSTD2))[m0 + row], rE = ((const float*)(P.ws + WS_RSTDE))[m0 + row];
      const f32x4 a = *(const LAS f32x4*)src, c4 = *(const LAS f32x4*)(src + 4);
      const float4 ha = *(const float4*)(P.out + go), hb = *(const float4*)(P.out + go + 4);
      const uint4 ya = *(const uint4*)((const u16*)(P.ws + A_Y0) + go), yb = *(const uint4*)((const u16*)(P.ws + A_Y1) + go), ee = *(const uint4*)((const u16*)(P.ws + A_EBF) + go);
      float hv[8] = {ha.x, ha.y, ha.z, ha.w, hb.x, hb.y, hb.z, hb.w};
      const float av[8] = {a[0], a[1], a[2], a[3], c4[0], c4[1], c4[2], c4[3]};
      const unsigned yau[4] = {ya.x, ya.y, ya.z, ya.w}, ybu[4] = {yb.x, yb.y, yb.z, yb.w}, eeu[4] = {ee.x, ee.y, ee.z, ee.w};
#pragma unroll
      for (int k = 0; k < 8; ++k) {
        const unsigned sh = (k & 1) ? 0u : 16u;
        const float yv = __uint_as_float((yau[k >> 1] << sh) & 0xffff0000u) + __uint_as_float((ybu[k >> 1] << sh) & 0xffff0000u);
        const float ev = __uint_as_float((eeu[k >> 1] << sh) & 0xffff0000u);
        const float sg = 1.0f / (1.0f + __expf(-av[k] * rs2));
        hv[k] = hv[k] + yv + ev * rE * gv[k] * sg;
      }
      float* wr = DRY ? ((float*)(P.ws + WS_W13) + go) : (P.out + go);
      *(float4*)wr = make_float4(hv[0], hv[1], hv[2], hv[3]); *(float4*)(wr + 4) = make_float4(hv[4], hv[5], hv[6], hv[7]);
    }
    __syncthreads();
  }
}

DI void ph8_final(const Ptrs& P, ldsp lds, int bid, int G) {
#if PROBE_ROUTER == 2
  ph8_final_t<true>(P, lds, bid, G);
  __syncthreads();
#endif
  ph8_final_t<false>(P, lds, bid, G);
}
__global__ void __launch_bounds__(256, 2) mega(Ptrs P, int ph_lo, int ph_hi) {
  extern __shared__ __attribute__((aligned(16))) unsigned char smem[];
  ldsp lds = (ldsp)smem;
  const int bid = blockIdx.x, G = gridDim.x;
  volatile LAS unsigned* st = (volatile LAS unsigned*)(lds + LDS_EXTRA + 1280);
  XcdBarrier xb; xb.bar = (unsigned*)(P.ws + WS_CTL); xb.x = 0; xb.st = st;
  if (ph_hi - ph_lo > 1) {
    if (threadIdx.x == 0) { st[0] = 0u; st[1] = 0u; }
    __syncthreads();
    xb = xcd_barrier_post((unsigned*)(P.ws + WS_CTL), st);
  }
#define RUN_PHASE(k, call) if (ph_lo <= k && k < ph_hi) { if ((REPEAT_MASK >> k) & 1) { call; xcd_barrier(xb); } call; if (k + 1 < ph_hi) xcd_barrier(xb); }
  RUN_PHASE(0, ph0_prep(P, lds, bid, G))
  RUN_PHASE(1, ph1_inproj(P, lds, bid, G))
  RUN_PHASE(2, ph2_attn(P, lds, bid, G))
  RUN_PHASE(3, ph3_outproj(P, lds, bid, G))
  RUN_PHASE(4, ph4_router(P, lds, bid, G))
  RUN_PHASE(5, ph5_up(P, lds, bid, G))
  RUN_PHASE(6, ph6_down(P, lds, bid, G))
  RUN_PHASE(7, ph7_combine(P, lds, bid, G))
  RUN_PHASE(8, ph8_final(P, lds, bid, G))
}

extern "C" void kernel_launch(void* const* d_in, const int* in_sizes, int n_in, void* d_out, int out_size, void* d_ws, size_t ws_size,
                              hipStream_t stream) {
  static int grid = 0;
  if (grid == 0) {
    if (n_in != 25 || ws_size < WS_END || out_size != T * DM) { fprintf(stderr, "kernel_launch: unexpected n_in %d / out %d / ws_size %zu (need %zu)\n", n_in, out_size, ws_size, (size_t)WS_END); grid = -1; return; }
    int dev = 0, cus = 0, per_cu = 0;
    (void)hipGetDevice(&dev);
    (void)hipDeviceGetAttribute(&cus, hipDeviceAttributeMultiprocessorCount, dev);
    (void)hipFuncSetAttribute((const void*)mega, hipFuncAttributeMaxDynamicSharedMemorySize, LDS_BYTES);
    (void)hipOccupancyMaxActiveBlocksPerMultiprocessor(&per_cu, (const void*)mega, 256, LDS_BYTES);
    if (per_cu < 1) { fprintf(stderr, "kernel_launch: occupancy query returned %d\n", per_cu); grid = -1; return; }
    if (per_cu > 2) per_cu = 2;
    grid = cus * per_cu;
    fprintf(stderr, "kernel_launch: cus %d per_cu %d grid %d\n", cus, per_cu, grid);
  }
  if (grid < 0) return;
  Ptrs P{};
  const float** pp = (const float**)&P;
  for (int i = 0; i < 25; ++i) pp[i] = (const float*)d_in[i];
  P.out = (float*)d_out; P.ws = (unsigned char*)d_ws;
  (void)hipMemsetAsync((unsigned char*)d_ws + WS_CTL, 0, XCD_BAR_WORDS * 4, stream);
#if ONE_LAUNCH
  mega<<<grid, 256, LDS_BYTES, stream>>>(P, 0, 9);
#elif WITH_NAIVE
  for (int ph = 0; ph < 9; ++ph) {
    if (OPT_MASK & (1 << ph)) { mega<<<grid, 256, LDS_BYTES, stream>>>(P, ph, ph + 1); continue; }
    switch (ph) {
      case 0: nv_scal<<<1, 64, 0, stream>>>(P); nv_rope<<<S * 32 / 256, 256, 0, stream>>>(P); break;
      case 1: nv_inproj<<<T / 4, 256, 0, stream>>>(P); break;
      case 2: nv_da<<<16 * 512, 256, 0, stream>>>(P); nv_na<<<NB * HB * S / 256, 256, 0, stream>>>(P); break;
      case 3: nv_outproj<<<T / 4, 256, 0, stream>>>(P); nv_ple<<<T / 4, 256, 0, stream>>>(P); break;
      case 4: nv_router<<<T, 64, 0, stream>>>(P); nv_plan<<<1, 64, 0, stream>>>(P); break;
      case 5: nv_up<<<(32768 + 32 * 128) / 4, 256, 0, stream>>>(P); break;
      case 6: nv_down<<<(32768 + 32 * 128) / 4, 256, 0, stream>>>(P); break;
      case 7: nv_combine<<<T, 256, 0, stream>>>(P); break;
      case 8: nv_final<<<T / 4, 256, 0, stream>>>(P); break;
    }
  }
#else
  for (int ph = 0; ph < 9; ++ph) mega<<<grid, 256, LDS_BYTES, stream>>>(P, ph, ph + 1);
#endif
}
```

```cpp
#define ONE_LAUNCH 2
#define NEW_MASK 0x1ff
#include <hip/hip_runtime.h>
#include <cstdio>
#include <cstdint>

typedef unsigned short u16;
#define DI __device__ __forceinline__

constexpr int T = 16384, S = 4096, DM = 1024, NB = 4;
constexpr int DIN = 3072, DPLE = 256;
constexpr int HA = 4, HB = 16;
constexpr int NE = 32, DE = 512;
constexpr float EPS = 1e-6f;
constexpr float LOG2E = 1.4426950408889634f;
constexpr float LAM_INIT = 0.2f;

constexpr size_t MiB = 1ull << 20;
constexpr size_t WS_WIN = 0, WS_WOUT = 6 * MiB, WS_W13 = 8 * MiB, WS_W2 = 72 * MiB, WS_WPLG = 104 * MiB,
                 WS_WPLE = 106 * MiB, WS_WR = 106 * MiB + 512 * 1024, WS_ROPE = 107 * MiB;
constexpr size_t WS_SMALL = 108 * MiB;
constexpr size_t WS_RSTDX = WS_SMALL;
constexpr size_t WS_SSQ1P = 250 * MiB;
constexpr size_t WS_SSQEP = 251 * MiB;
constexpr int SSQ_PARTS = 16;
constexpr size_t WS_RSTD1 = WS_RSTDX + 65536;
constexpr size_t WS_RSTD2 = WS_RSTD1 + 65536;
constexpr size_t WS_SCAL  = WS_RSTD2 + 65536;
constexpr size_t WS_CNT   = WS_SCAL + 256;
constexpr int CNT_STRIDE = 64;
constexpr size_t WS_PADST = WS_CNT + 8192;
constexpr size_t WS_CTL   = WS_PADST + 256;
constexpr size_t WS_RSTDE = WS_CTL + 16384;
constexpr size_t WS_PAR   = WS_SMALL + 1 * MiB;
constexpr int PAR_GQA = 0, PAR_GKA = 64, PAR_GSUB = 128, PAR_GQB = 256, PAR_GKB = 288, PAR_GPLE = 320, PAR_RPB = 1344, PAR_TOTAL = 1344 + 7440;
constexpr size_t WS_TOKL  = WS_SMALL + 2 * MiB;
constexpr size_t WS_WL    = WS_SMALL + 4 * MiB;
constexpr size_t WS_ACT   = 114 * MiB;
constexpr size_t A_XB = WS_ACT, A_AO = 260 * MiB, A_HID = WS_ACT, A_H2B = WS_ACT;
constexpr size_t A_PB = 252 * MiB;
constexpr size_t A_QA = WS_ACT + 40 * MiB, A_KA = WS_ACT + 56 * MiB, A_VAT = WS_ACT + 72 * MiB,
                 A_QB = WS_ACT + 88 * MiB, A_KB = WS_ACT + 104 * MiB, A_VBT = WS_ACT + 120 * MiB;
constexpr size_t A_H1B = WS_ACT + 40 * MiB, A_EBF = WS_ACT + 72 * MiB, A_Y0 = WS_ACT + 104 * MiB, A_Y1 = 260 * MiB;
constexpr size_t WS_END = 292 * MiB;

DI float bf2f(u16 u) { return __uint_as_float(((unsigned)u) << 16); }
DI u16 f2bf(float f) { __bf16 b = (__bf16)f; return __builtin_bit_cast(u16, b); }
DI int permpos(int s) { return (s & ~12) | ((s & 8) >> 1) | ((s & 4) << 1); }

struct Ptrs {
  const float *x, *p, *g_mix, *w_in, *g_qa, *g_ka, *lam_q1, *lam_k1, *lam_q2, *lam_k2, *g_sub, *g_qb, *g_kb, *rpb, *w_out,
      *g_ffn, *w_rg, *w_re, *w1, *w3, *w2, *g_plg, *w_plg, *w_ple, *g_ple;
  float* out;
  unsigned char* ws;
};

#define GAS __attribute__((address_space(1)))
#define LAS __attribute__((address_space(3)))
typedef LAS unsigned char* ldsp;
typedef __attribute__((ext_vector_type(8))) short bf16x8;
typedef __attribute__((ext_vector_type(16))) float f32x16;
typedef __attribute__((ext_vector_type(4))) float f32x4;
typedef __attribute__((ext_vector_type(2))) float f32x2v;
typedef __attribute__((ext_vector_type(2))) __bf16 bf16x2v;
DI unsigned pk2(float a, float b) { bf16x2v v = __builtin_convertvector((f32x2v){a, b}, bf16x2v); return __builtin_bit_cast(unsigned, v); }
DI float wave_sum(float v) {
#pragma unroll
  for (int o = 1; o < 64; o <<= 1) v += __shfl_xor(v, o);
  return v;
}
DI void glds16(const void* g, ldsp l) { __builtin_amdgcn_global_load_lds((const GAS unsigned*)g, (LAS unsigned*)l, 16, 0, 0); }
DI void lds_wave_sync() { asm volatile("s_waitcnt lgkmcnt(0)" ::: "memory"); }

#define XB_TMO      128
#define XB_XCNT(j)  (256  + 64 * (j))
#define XB_XSUB(j)  (1280 + 64 * (j))
#define XB_XGEN(j)  (2304 + 64 * (j))
#define XB_TOP      3328
#define XB_TOPGEN   3392
#define XCD_BAR_WORDS 3456
#define XB_SPIN_CAP (1u << 22)
DI unsigned xb_ld(unsigned* p) { return __hip_atomic_load(p, __ATOMIC_RELAXED, __HIP_MEMORY_SCOPE_AGENT); }
DI unsigned xb_add(unsigned* p, unsigned v) { return __hip_atomic_fetch_add(p, v, __ATOMIC_RELAXED, __HIP_MEMORY_SCOPE_AGENT); }
DI unsigned xb_xcc_id() { return (unsigned)__builtin_amdgcn_s_getreg((3 << 11) | 20) & 0xFu; }
#define XB_SPIN(cond, bar) do { unsigned _sp = 0; while (cond) { __builtin_amdgcn_s_sleep(1); \
    if ((++_sp & 255u) == 0u) { if (xb_ld(&(bar)[XB_TMO])) break; if (_sp > XB_SPIN_CAP) { atomicAdd(&(bar)[XB_TMO], 1u); break; } } } } while (0)
struct XcdBarrier { unsigned* bar; unsigned x; volatile LAS unsigned* st; };
DI XcdBarrier xcd_barrier_post(unsigned* bar, volatile LAS unsigned* st) {
  XcdBarrier b; b.bar = bar; b.x = xb_xcc_id(); b.st = st;
  if (threadIdx.x == 0) (void)xb_add(&bar[XB_XCNT(b.x)], 1u);
  return b;
}
DI void xcd_barrier_complete(unsigned* bar, unsigned x, unsigned& nloc, unsigned& nx) {
  const unsigned G = gridDim.x;
  unsigned sum, cnt, mine, sp = 0u;
  for (;;) {
    sum = 0u; cnt = 0u; mine = 0u;
#pragma unroll
    for (unsigned j = 0; j < 16; ++j) { const unsigned c = xb_ld(&bar[XB_XCNT(j)]); sum += c; cnt += (c > 0u) ? 1u : 0u; mine = (j == x) ? c : mine; }
    if (sum == G) break;
    __builtin_amdgcn_s_sleep(1);
    if ((++sp & 255u) == 0u) { if (xb_ld(&bar[XB_TMO])) break; if (sp > XB_SPIN_CAP) { atomicAdd(&bar[XB_TMO], 1u); break; } }
  }
  nloc = mine > 0u ? mine : 1u; nx = cnt > 0u ? cnt : 1u;
}
DI void xcd_barrier(const XcdBarrier& b) {
  asm volatile("s_waitcnt vmcnt(0)" ::: "memory");
  __syncthreads();
  if (threadIdx.x == 0) {
    unsigned* bar = b.bar;
    __builtin_amdgcn_s_waitcnt(0);
    unsigned nloc = b.st[0], nx = b.st[1];
    if (nloc == 0u) { xcd_barrier_complete(bar, b.x, nloc, nx); b.st[0] = nloc; b.st[1] = nx; }
    const unsigned old = xb_add(&bar[XB_XSUB(b.x)], 1u);
    const unsigned gen = old / nloc;
    if (old + 1u == (gen + 1u) * nloc) {
      __builtin_amdgcn_fence(__ATOMIC_RELEASE, "agent");
      asm volatile("s_waitcnt vmcnt(0)" ::: "memory");
      const unsigned og = xb_add(&bar[XB_TOP], 1u);
      const unsigned tg = og / nx;
      if (og + 1u == (tg + 1u) * nx) xb_add(&bar[XB_TOPGEN], 1u);
      else XB_SPIN(xb_ld(&bar[XB_TOPGEN]) == tg, bar);
      __builtin_amdgcn_fence(__ATOMIC_ACQUIRE, "agent");
      xb_add(&bar[XB_XGEN(b.x)], 1u);
      asm volatile("s_waitcnt vmcnt(0)" ::: "memory");
    } else {
      XB_SPIN(xb_ld(&bar[XB_XGEN(b.x)]) == gen, bar);
      __builtin_amdgcn_fence(__ATOMIC_ACQUIRE, "agent");
      asm volatile("s_waitcnt vmcnt(0)" ::: "memory");
    }
  }
  __syncthreads();
}

DI int win8_row(int f);
DI int perm256(int f);
DI int w13_row_w1(int f);
DI int w13_row_w3(int f);
typedef int (*rowmap_t)(int);
template <rowmap_t rowmap = (rowmap_t) nullptr>
DI void tr_item(const float* W, int ldw, int k0, int n0, const float* gk, u16* dst0, u16* dst1, int ldd, LAS float* scr, int lane) {
  float4 v[16];
  const float* src = W + (size_t)(k0 + (lane >> 4)) * ldw + n0 + 4 * (lane & 15);
#pragma unroll
  for (int j = 0; j < 16; ++j) { const f32x4 t = __builtin_nontemporal_load((const f32x4*)(src + (size_t)(4 * j) * ldw)); v[j] = make_float4(t[0], t[1], t[2], t[3]); }
  if (gk) {
#pragma unroll
    for (int j = 0; j < 16; ++j) { const float g = gk[k0 + 4 * j + (lane >> 4)]; v[j].x *= g; v[j].y *= g; v[j].z *= g; v[j].w *= g; }
  }
  LAS float* w = scr + (lane >> 4) * 65 + 4 * (lane & 15);
#pragma unroll
  for (int j = 0; j < 16; ++j) { w[(4 * j) * 65] = v[j].x; w[(4 * j) * 65 + 1] = v[j].y; w[(4 * j) * 65 + 2] = v[j].z; w[(4 * j) * 65 + 3] = v[j].w; }
  lds_wave_sync();
  const int c = lane & 7;
#pragma unroll
  for (int j = 0; j < 8; ++j) {
    const int n = (lane >> 3) + 8 * j;
    const LAS float* s = scr + (8 * c) * 65 + n;
    uint4 o;
    o.x = pk2(s[0 * 65], s[1 * 65]); o.y = pk2(s[2 * 65], s[3 * 65]); o.z = pk2(s[4 * 65], s[5 * 65]); o.w = pk2(s[6 * 65], s[7 * 65]);
    u16* d = rowmap ? (dst0 + (size_t)rowmap(n0 + n) * ldd) : ((j < 4) ? (dst0 + (size_t)n * ldd) : (dst1 + (size_t)(n - 32) * ldd));
    *(uint4*)(d + k0 + 8 * c) = o;
  }
  lds_wave_sync();
}

typedef const __attribute__((address_space(4))) Ptrs* kargp_t;
DI kargp_t kargs_now() {
#if defined(__HIP_DEVICE_COMPILE__)
  kargp_t kp = (kargp_t)__builtin_amdgcn_kernarg_segment_ptr(); asm volatile("" : "+s"(kp)); return kp;
#else
  return nullptr;
#endif
}
DI Ptrs load_args() {
#if defined(__HIP_DEVICE_COMPILE__)
  kargp_t kp = kargs_now(); Ptrs r; __builtin_memcpy(&r, (const void*)kp, sizeof(Ptrs)); return r;
#else
  return Ptrs{};
#endif
}
DI void late_weight_item(int r, LAS float* scr, int lane) {
  unsigned char* const wsb = kargs_now()->ws;
  if (r < 4096) {
    u16* W2T = (u16*)(wsb + WS_W2);
    const int e = r >> 7, q = r & 127, kb = q >> 4, nb = q & 15;
    tr_item<perm256>(kargs_now()->w2 + (size_t)e * 512 * 1024, 1024, kb * 64, nb * 64, nullptr, W2T + (size_t)e * 1024 * 512, nullptr, 512, scr, lane);
  } else {
    r -= 4096;
    const int kb = r >> 4, nb = r & 15;
    tr_item<perm256>(kargs_now()->w_plg, 1024, kb * 64, nb * 64, kargs_now()->g_plg, (u16*)(wsb + WS_WPLG), nullptr, 1024, scr, lane);
  }
}
DI void ph0_prep(const Ptrs& Punused, ldsp lds, int bid, int G) {
  unsigned char* const wsb = kargs_now()->ws;
  const int tid = threadIdx.x, lane = tid & 63, wave = tid >> 6;
  LAS float* scr = (LAS float*)(lds + wave * 16640);
  const int nwv = blockDim.x >> 6, gw = bid * nwv + wave, NGW = G * nwv;
  constexpr int I_W1 = 4096, I_W3 = 4096, I_W2 = 4096, I_X = 8192, I_WIN = 768, I_P = 2048, I_WOUT = 256, I_PLG = 256, I_PLE = 64,
                I_WR = 768, I_ROPE = 2048, I_PAR = (PAR_TOTAL + 63) / 64, I_SC = 1;
  constexpr int TOTAL = I_W1 + I_W3 + I_W2 + I_X + I_WIN + I_P + I_WOUT + I_PLG + I_PLE + I_WR + I_ROPE + I_PAR + I_SC;
  u16* W13T = (u16*)(wsb + WS_W13); u16* W2T = (u16*)(wsb + WS_W2);
  for (int r0_ = gw; r0_ < I_W1 + I_W3; r0_ += NGW) {
    int r = r0_;
      const int isw3 = r >= I_W1; if (isw3) r -= I_W1;
      const int e = r >> 7, q = r & 127, kb = q >> 3, nb = q & 7;
      u16* d0 = W13T + ((size_t)e * 1024 + nb * 128 + isw3 * 32) * 1024;
#if NEW_MASK & 0x20
      if (isw3) tr_item<w13_row_w3>(kargs_now()->w3 + (size_t)e * 1024 * 512, 512, kb * 64, nb * 64, kargs_now()->g_ffn, W13T + (size_t)e * 1024 * 1024, nullptr, 1024, scr, lane);
      else tr_item<w13_row_w1>(kargs_now()->w1 + (size_t)e * 1024 * 512, 512, kb * 64, nb * 64, kargs_now()->g_ffn, W13T + (size_t)e * 1024 * 1024, nullptr, 1024, scr, lane);
#else
      tr_item((isw3 ? kargs_now()->w3 : kargs_now()->w1) + (size_t)e * 1024 * 512, 512, kb * 64, nb * 64, kargs_now()->g_ffn, d0, d0 + 64 * 1024, 1024, scr, lane);
#endif
  }
  for (int r0_ = gw; r0_ < I_X; r0_ += NGW) {
    int r = r0_;
      const float4* xr = (const float4*)(kargs_now()->x + (size_t)r * 2048) + lane;
      float4 v[8];
#pragma unroll
      for (int j = 0; j < 8; ++j) { const f32x4 t = __builtin_nontemporal_load((const f32x4*)(xr + 64 * j)); v[j] = make_float4(t[0], t[1], t[2], t[3]); }
      float s0 = 0.f, s1 = 0.f;
#pragma unroll
      for (int j = 0; j < 4; ++j) { s0 += v[j].x * v[j].x + v[j].y * v[j].y + v[j].z * v[j].z + v[j].w * v[j].w; s1 += v[j + 4].x * v[j + 4].x + v[j + 4].y * v[j + 4].y + v[j + 4].z * v[j + 4].z + v[j + 4].w * v[j + 4].w; }
      s0 = wave_sum(s0); s1 = wave_sum(s1);
      if (lane == 0) { float* rx = (float*)(wsb + WS_RSTDX); rx[2 * r] = rsqrtf(s0 * (1.0f / 1024.0f) + EPS); rx[2 * r + 1] = rsqrtf(s1 * (1.0f / 1024.0f) + EPS); }
      uint2* o = (uint2*)((u16*)(wsb + A_XB) + (size_t)r * 2048) + lane;
#pragma unroll
      for (int j = 0; j < 8; ++j) o[64 * j] = make_uint2(pk2(v[j].x, v[j].y), pk2(v[j].z, v[j].w));
  }
  for (int r0_ = gw; r0_ < I_WIN; r0_ += NGW) {
    int r = r0_;
      const int kb = r / 48, nb = r % 48;
      u16* d0 = (u16*)(wsb + WS_WIN) + (size_t)(nb * 64) * 1024;
      tr_item<win8_row>(kargs_now()->w_in, DIN, kb * 64, nb * 64, kargs_now()->g_mix, (u16*)(wsb + WS_WIN), nullptr, 1024, scr, lane);
  }
  for (int r0_ = gw; r0_ < I_P; r0_ += NGW) {
    int r = r0_;
      const float4* pr = (const float4*)kargs_now()->p + (size_t)r * 512 + lane;
      uint2* o = (uint2*)(wsb + A_PB) + (size_t)r * 512 + lane;
      float4 v[8];
#pragma unroll
      for (int j = 0; j < 8; ++j) { const f32x4 t = __builtin_nontemporal_load((const f32x4*)(pr + 64 * j)); v[j] = make_float4(t[0], t[1], t[2], t[3]); }
#pragma unroll
      for (int j = 0; j < 8; ++j) o[64 * j] = make_uint2(pk2(v[j].x, v[j].y), pk2(v[j].z, v[j].w));
  }
  for (int r0_ = gw; r0_ < I_WOUT; r0_ += NGW) {
    int r = r0_;
      const int kb = r >> 4, nb = r & 15;
      u16* d0 = (u16*)(wsb + WS_WOUT) + (size_t)(nb * 64) * 1024;
#if NEW_MASK & 0x8
      tr_item<perm256>(kargs_now()->w_out, 1024, kb * 64, nb * 64, nullptr, (u16*)(wsb + WS_WOUT), nullptr, 1024, scr, lane);
#else
      tr_item(kargs_now()->w_out, 1024, kb * 64, nb * 64, nullptr, d0, d0 + 32 * 1024, 1024, scr, lane);
#endif
  }
  for (int r0_ = gw; r0_ < I_PLE; r0_ += NGW) {
    int r = r0_;
      const int kb = r >> 4, nb = r & 15;
      u16* d0 = (u16*)(wsb + WS_WPLE) + (size_t)(nb * 64) * 256;
#if NEW_MASK & 0x8
      tr_item<perm256>(kargs_now()->w_ple, 1024, kb * 64, nb * 64, nullptr, (u16*)(wsb + WS_WPLE), nullptr, 256, scr, lane);
#else
      tr_item(kargs_now()->w_ple, 1024, kb * 64, nb * 64, nullptr, d0, d0 + 32 * 256, 256, scr, lane);
#endif
  }
  for (int r0_ = gw; r0_ < I_WR; r0_ += NGW) {
    int r = r0_;
      const int idx = r * 64 + lane, rr = idx >> 10, k = idx & 1023;
      float v = 0.f;
      if (rr < 4) v = kargs_now()->w_rg[k * 4 + rr]; else if (rr < 36) v = kargs_now()->w_re[k * 32 + (rr - 4)];
      ((float*)(wsb + WS_WR))[idx] = v * kargs_now()->g_ffn[k];
  }
  for (int r0_ = gw; r0_ < I_ROPE; r0_ += NGW) {
    int r = r0_;
      const int idx = r * 64 + lane, s = idx >> 5, i = idx & 31;
      const float inv = powf(10000.0f, -(float)(2 * i) / 64.0f);
      const float ang = (float)s * inv;
      float sn, cs; sincosf(ang, &sn, &cs);
      ((float2*)(wsb + WS_ROPE))[idx] = make_float2(cs, sn);
  }
  for (int r0_ = gw; r0_ < I_PAR; r0_ += NGW) {
    int r = r0_;
      const int idx = r * 64 + lane;
      if (idx < PAR_TOTAL) {
        float v;
        if (idx < PAR_GKA) v = kargs_now()->g_qa[idx]; else if (idx < PAR_GSUB) v = kargs_now()->g_ka[idx - PAR_GKA]; else if (idx < PAR_GQB) v = kargs_now()->g_sub[idx - PAR_GSUB];
        else if (idx < PAR_GKB) v = kargs_now()->g_qb[idx - PAR_GQB]; else if (idx < PAR_GPLE) v = kargs_now()->g_kb[idx - PAR_GKB]; else if (idx < PAR_RPB) v = kargs_now()->g_ple[idx - PAR_GPLE];
        else v = kargs_now()->rpb[idx - PAR_RPB];
        ((float*)(wsb + WS_PAR))[idx] = v;
      }
  }
  if (gw == 0) {
    if (lane == 0) {
      float s1 = 0, s2 = 0, mq = 0, mk = 0;
      for (int i = 0; i < 64; ++i) {
        s1 += kargs_now()->lam_q1[i] * kargs_now()->lam_k1[i]; s2 += kargs_now()->lam_q2[i] * kargs_now()->lam_k2[i];
        mq = fmaxf(mq, fabsf(kargs_now()->g_qa[i])); mk = fmaxf(mk, fabsf(kargs_now()->g_ka[i]));
      }
      float* sc = (float*)(wsb + WS_SCAL);
      sc[0] = expf(s1) - expf(s2) + LAM_INIT;
      sc[1] = 8.0f * mq * mk * LOG2E;
      float mqb = 0, mkb = 0;
      for (int i = 0; i < 32; ++i) { mqb = fmaxf(mqb, fabsf(kargs_now()->g_qb[i])); mkb = fmaxf(mkb, fabsf(kargs_now()->g_kb[i])); }
      sc[2] = 5.656854249f * mqb * mkb;
      int* cnt = (int*)(wsb + WS_CNT);
      for (int i = 0; i < 32; ++i) cnt[i * CNT_STRIDE] = 0;
    }
  }
}

DI uint4 pk8(const f32x4 a, const f32x4 b) { return make_uint4(pk2(a[0], a[1]), pk2(a[2], a[3]), pk2(b[0], b[1]), pk2(b[2], b[3])); }

typedef __attribute__((ext_vector_type(4))) unsigned u32x4;
DI bf16x8 packp(const f32x16& x, int s) {
  u32x4 p;
  p[0] = pk2(x[8 * s + 0], x[8 * s + 1]); p[1] = pk2(x[8 * s + 2], x[8 * s + 3]);
  p[2] = pk2(x[8 * s + 4], x[8 * s + 5]); p[3] = pk2(x[8 * s + 6], x[8 * s + 7]);
  return __builtin_bit_cast(bf16x8, p);
}
DI int grp_of(int kk) { return ((kk >> 2) == 1 || (kk >> 2) == 2 || (kk >> 2) == 4 || (kk >> 2) == 7) ? 1 : 0; }
DI int rank_of(int kk) { const int q = kk >> 2; return kk - ((q == 0) ? 0 : (q <= 2) ? 4 : (q == 3 || q == 4) ? 8 : (q <= 6) ? 12 : 16); }
DI int key_of(int grp, int jj) { return grp ? (jj < 8 ? jj + 4 : (jj < 12 ? jj + 8 : jj + 16)) : (jj < 4 ? jj : (jj < 8 ? jj + 8 : jj + 12)); }
constexpr int DA_STAGE = 33280, DA_VOFF = 16640;
typedef __attribute__((ext_vector_type(4))) short s16x4;
DI void ph4_router_t(const Ptrs& P, ldsp lds, int bid, int G) {
  const int tid = threadIdx.x, lane = tid & 63, wave = tid >> 6, t = lane & 15, kk = lane >> 4, kh = wave & 1;
  LAS float* lg = (LAS float*)(lds + wave * 3072);
  const u16* h1 = (const u16*)(P.ws + A_H1B); const float* WrT = (const float*)(P.ws + WS_WR);
  const int np = blockDim.x >> 7, trips = (1024 + G * np - 1) / (G * np);
  for (int it = 0; it < trips; ++it) {
    const int item = (it * G + bid) * np + (wave >> 1);
    const bool valid = item < 1024;
    const int tok0 = valid ? item * 16 : 0;
    f32x4 acc[3] = {{0.f, 0.f, 0.f, 0.f}, {0.f, 0.f, 0.f, 0.f}, {0.f, 0.f, 0.f, 0.f}};
    const u16* ap = h1 + (size_t)(tok0 + t) * 1024 + 4 * kk + 512 * kh;
    const float* bp = WrT + (size_t)t * 1024 + 4 * kk + 512 * kh;
#pragma unroll 4
    for (int s = 0; s < 32; ++s) {
      const uint2 ab = *(const uint2*)(ap + 16 * s);
      const float4 a4 = make_float4(__uint_as_float(ab.x << 16), __uint_as_float(ab.x & 0xffff0000u), __uint_as_float(ab.y << 16), __uint_as_float(ab.y & 0xffff0000u));
      const float4 b0 = *(const float4*)(bp + 16 * s), b1 = *(const float4*)(bp + 16 * 1024 + 16 * s), b2 = *(const float4*)(bp + 32 * 1024 + 16 * s);
      acc[0] = __builtin_amdgcn_mfma_f32_16x16x4f32(a4.x, b0.x, acc[0], 0, 0, 0); acc[1] = __builtin_amdgcn_mfma_f32_16x16x4f32(a4.x, b1.x, acc[1], 0, 0, 0); acc[2] = __builtin_amdgcn_mfma_f32_16x16x4f32(a4.x, b2.x, acc[2], 0, 0, 0);
      acc[0] = __builtin_amdgcn_mfma_f32_16x16x4f32(a4.y, b0.y, acc[0], 0, 0, 0); acc[1] = __builtin_amdgcn_mfma_f32_16x16x4f32(a4.y, b1.y, acc[1], 0, 0, 0); acc[2] = __builtin_amdgcn_mfma_f32_16x16x4f32(a4.y, b2.y, acc[2], 0, 0, 0);
      acc[0] = __builtin_amdgcn_mfma_f32_16x16x4f32(a4.z, b0.z, acc[0], 0, 0, 0); acc[1] = __builtin_amdgcn_mfma_f32_16x16x4f32(a4.z, b1.z, acc[1], 0, 0, 0); acc[2] = __builtin_amdgcn_mfma_f32_16x16x4f32(a4.z, b2.z, acc[2], 0, 0, 0);
      acc[0] = __builtin_amdgcn_mfma_f32_16x16x4f32(a4.w, b0.w, acc[0], 0, 0, 0); acc[1] = __builtin_amdgcn_mfma_f32_16x16x4f32(a4.w, b1.w, acc[1], 0, 0, 0); acc[2] = __builtin_amdgcn_mfma_f32_16x16x4f32(a4.w, b2.w, acc[2], 0, 0, 0);
    }
    __syncthreads();
#pragma unroll
    for (int et = 0; et < 3; ++et)
#pragma unroll
      for (int i = 0; i < 4; ++i) lg[(4 * kk + i) * 48 + 16 * et + t] = acc[et][i];
    __syncthreads();
    if (valid && kh == 0 && lane < 16) {
      const int tok = tok0 + lane;
      const float* sp = (const float*)(P.ws + WS_SSQ1P) + (size_t)tok * SSQ_PARTS;
      const float4 s0 = *(const float4*)sp, s1 = *(const float4*)(sp + 4), s2 = *(const float4*)(sp + 8), s3 = *(const float4*)(sp + 12);
      const float rstd = rsqrtf(((s0.x + s0.y + s0.z + s0.w) + (s1.x + s1.y + s1.z + s1.w) + (s2.x + s2.y + s2.z + s2.w) + (s3.x + s3.y + s3.z + s3.w)) * (1.0f / 1024.0f) + EPS);
      const LAS float* L = lg + lane * 48;
      const LAS float* L2 = L + 768;
      float gl[4];
#pragma unroll
      for (int i = 0; i < 4; ++i) gl[i] = L[i] + L2[i];
      int gi = 0; float gm = gl[0];
#pragma unroll
      for (int i = 1; i < 4; ++i) { if (gl[i] > gm) { gm = gl[i]; gi = i; } }
      float gs = 0.f;
#pragma unroll
      for (int i = 0; i < 4; ++i) gs += expf((gl[i] - gm) * rstd);
      const float gate = 1.0f / gs;
      const LAS float* el = L + 4 + 8 * gi; const LAS float* el2 = L2 + 4 + 8 * gi;
      float ev[8];
#pragma unroll
      for (int i = 0; i < 8; ++i) ev[i] = el[i] + el2[i];
      int e1 = 0; float m1 = ev[0];
#pragma unroll
      for (int i = 1; i < 8; ++i) { if (ev[i] > m1) { m1 = ev[i]; e1 = i; } }
      int e2 = 0; float m2v = -3.0e38f;
#pragma unroll
      for (int i = 0; i < 8; ++i) { if (i != e1 && ev[i] > m2v) { m2v = ev[i]; e2 = i; } }
      const float p2 = expf((m2v - m1) * rstd);
      const float wa = gate / (1.0f + p2), wb = gate * p2 / (1.0f + p2);
      int* cnt = (int*)(P.ws + WS_CNT); int* tokl = (int*)(P.ws + WS_TOKL); float* wl = (float*)(P.ws + WS_WL);
      const int ea = gi * 8 + e1, eb = gi * 8 + e2;
      {
        ((float*)(P.ws + WS_RSTD1))[tok] = rstd;
        const int pa = atomicAdd(&cnt[ea * CNT_STRIDE], 1); tokl[ea * 16384 + pa] = tok * 2; wl[ea * 16384 + pa] = wa;
        const int pb = atomicAdd(&cnt[eb * CNT_STRIDE], 1); tokl[eb * 16384 + pb] = tok * 2 + 1; wl[eb * 16384 + pb] = wb;
      }
    }
  }
}

DI void ph4_router(const Ptrs& P, ldsp lds, int bid, int G) {
  ph4_router_t(P, lds, bid, G);
}

DI void ph7_combine(const Ptrs& P, ldsp lds, int bid, int G) {
  const int lane = threadIdx.x & 63, wave = threadIdx.x >> 6;
  const int nwv = blockDim.x >> 6;
  for (int tok = bid * nwv + wave; tok < T; tok += G * nwv) {
    const uint2* hr = (const uint2*)((const u16*)(P.ws + A_H1B) + (size_t)tok * 1024) + lane;
    const uint2* y0 = (const uint2*)((const u16*)(P.ws + A_Y0) + (size_t)tok * 1024) + lane;
    const uint2* y1 = (const uint2*)((const u16*)(P.ws + A_Y1) + (size_t)tok * 1024) + lane;
    uint2* o = (uint2*)((u16*)(P.ws + A_H2B) + (size_t)tok * 1024) + lane;
    float ss = 0.f;
#pragma unroll
    for (int j = 0; j < 4; ++j) {
      const uint2 hv = hr[64 * j], a = y0[64 * j], c = y1[64 * j];
      const float v0 = __uint_as_float(hv.x << 16) + __uint_as_float(a.x << 16) + __uint_as_float(c.x << 16);
      const float v1 = __uint_as_float(hv.x & 0xffff0000u) + __uint_as_float(a.x & 0xffff0000u) + __uint_as_float(c.x & 0xffff0000u);
      const float v2 = __uint_as_float(hv.y << 16) + __uint_as_float(a.y << 16) + __uint_as_float(c.y << 16);
      const float v3 = __uint_as_float(hv.y & 0xffff0000u) + __uint_as_float(a.y & 0xffff0000u) + __uint_as_float(c.y & 0xffff0000u);
      ss += v0 * v0 + v1 * v1 + v2 * v2 + v3 * v3;
      o[64 * j] = make_uint2(pk2(v0, v1), pk2(v2, v3));
    }
    ss = wave_sum(ss);
    float se = (lane < SSQ_PARTS) ? ((const float*)(P.ws + WS_SSQEP))[(size_t)tok * SSQ_PARTS + lane] : 0.f;
    se = wave_sum(se);
    if (lane == 0) {
      ((float*)(P.ws + WS_RSTD2))[tok] = rsqrtf(ss * (1.0f / 1024.0f) + EPS);
      ((float*)(P.ws + WS_RSTDE))[tok] = rsqrtf(se * (1.0f / 1024.0f) + EPS);
    }
  }
}

namespace g8 {
constexpr int BM = 256, BK = 64, HALF = 128, HTB = HALF * BK * 2, STAGE_BYTES = 8 * HTB, NXCD = 8, WGM = 8;
constexpr int LDS_EXTRA8 = STAGE_BYTES;
constexpr int LDS_BYTES8 = STAGE_BYTES + 4096;
DI int lds_byte(int r, int c) { const int st = (r >> 4) * 2 + (c >> 5), rr = r & 15, cc = c & 31, ob = rr * 64 + cc * 2; return st * 1024 + (ob ^ (((ob >> 9) & 1) << 5)); }
DI void stage_rc(int b, int& R, int& C) { const int st = b / 1024, sb = b % 1024, swz = sb ^ (((sb >> 9) & 1) << 5); R = (st >> 1) * 16 + swz / 64; C = (st & 1) * 32 + (swz % 64) / 2; }

struct Unit { int pm, pn, e, ce; };
struct GridOrder {
  int nM, nN, nwg, G, c; unsigned pnmap;
  DI void init(int nM_, int nN_, int G_, int c_, unsigned pnmap_ = 0u) { nM = nM_; nN = nN_; nwg = nM * nN; G = G_; c = c_; pnmap = pnmap_; }
  DI bool next(int i, Unit& u) const {
    const int L = i * G + c; if (L >= nwg) return false;
    int wgid = L; { const int q = nwg / NXCD, r = nwg % NXCD, xcd = wgid % NXCD, off = wgid / NXCD; wgid = (xcd < r ? xcd * (q + 1) : r * (q + 1) + (xcd - r) * q) + off; }
    const int nig = WGM * nN, gid = wgid / nig, fm = gid * WGM, gsz = (nM - fm) < WGM ? (nM - fm) : WGM;
    u.pm = fm + ((wgid % nig) % gsz); u.pn = (wgid % nig) / gsz; if (pnmap) u.pn = (int)((pnmap >> (4 * u.pn)) & 15u); u.e = 0; u.ce = 0; return true;
  }
};

template <class Epi, class Sched, bool SWAP, bool GATHER>
DI void gemm_phase(ldsp lds, const unsigned char* Abase, const unsigned char* Bbase, int K, const Sched& S, const Epi& E, int pA = 0, int pB = 0) {
  if (pA == 0) pA = K; if (pB == 0) pB = K;
  int tid = threadIdx.x; asm volatile("" : "+v"(tid));
  const int wid = __builtin_amdgcn_readfirstlane(tid >> 6), lane = tid & 63, wr = wid >> 2, wc = wid & 3, fr = lane & 15, fq = lane >> 4;
  const int nt = K / BK;
  int sR[2], sC[2];
  unsigned voffB[2], voffA[2];
#pragma unroll
  for (int i = 0; i < 2; ++i) { stage_rc(tid * 16 + i * 8192, sR[i], sC[i]); voffB[i] = (unsigned)(sR[i] * pB + sC[i]) * 2u; voffA[i] = (unsigned)(sR[i] * pA + sC[i]) * 2u; }
  const size_t tstepA = (size_t)BM * pA * 2;
  const size_t kstep = (size_t)(BK * 2);
  const size_t hstep = (size_t)HALF * pB * 2, hstepA = (size_t)HALF * pA * 2;
  const unsigned ldsw = (unsigned)wid * 1024u;
  const int aoff = lds_byte(wr * 64 + fr, fq * 8), boff = lds_byte(wc * 32 + fr, fq * 8);
#define G8_SA(b, h) (((b) * 2 + (h)) * HTB)
#define G8_SB(b, h) ((4 + (b) * 2 + (h)) * HTB)
#define G8_STAGE_B(bufoff, gbase) do { _Pragma("unroll") for (int _i = 0; _i < 2; ++_i) \
    __builtin_amdgcn_global_load_lds((const GAS unsigned*)((const unsigned char*)(gbase) + voffB[_i]), (LAS unsigned*)(lds + (bufoff) + ldsw + _i * 8192), 16, 0, 0); } while (0)
#define G8_STAGE_A(bufoff, hsel, nx, koff) do { _Pragma("unroll") for (int _i = 0; _i < 2; ++_i) { \
    const unsigned char* _p; \
    if (GATHER) _p = Abase + (size_t)((nx) ? ((hsel) ? nv1[_i] : nv0[_i]) : ((hsel) ? cv1[_i] : cv0[_i])) + (koff); \
    else _p = ((nx) ? nA : cA) + ((hsel) ? hstepA : (size_t)0) + voffA[_i] + (koff); \
    __builtin_amdgcn_global_load_lds((const GAS unsigned*)_p, (LAS unsigned*)(lds + (bufoff) + ldsw + _i * 8192), 16, 0, 0); } } while (0)
#define G8_LDA(dst, b, h) do { _Pragma("unroll") for (int m = 0; m < 4; ++m) _Pragma("unroll") for (int k = 0; k < 2; ++k) dst[m][k] = *(const LAS bf16x8*)(lds + G8_SA(b, h) + aoff + m * 2048 + k * 1024); } while (0)
#define G8_LDB(dst, b, h) do { _Pragma("unroll") for (int n = 0; n < 2; ++n) _Pragma("unroll") for (int k = 0; k < 2; ++k) dst[n][k] = *(const LAS bf16x8*)(lds + G8_SB(b, h) + boff + n * 2048 + k * 1024); } while (0)
#define G8_MMA(ai, bj, At, Bt) do { __builtin_amdgcn_s_setprio(1); \
    _Pragma("unroll") for (int m = 0; m < 4; ++m) _Pragma("unroll") for (int n = 0; n < 2; ++n) _Pragma("unroll") for (int k = 0; k < 2; ++k) \
        acc[ai][bj][m][n] = SWAP ? __builtin_amdgcn_mfma_f32_16x16x32_bf16(At[m][k], Bt[n][k], acc[ai][bj][m][n], 0, 0, 0) \
                                 : __builtin_amdgcn_mfma_f32_16x16x32_bf16(Bt[n][k], At[m][k], acc[ai][bj][m][n], 0, 0, 0); \
    __builtin_amdgcn_s_setprio(0); } while (0)
#define G8_WAIT_V(n) asm volatile("s_waitcnt vmcnt(" #n ")" ::: "memory")
#define G8_WAIT_L(n) asm volatile("s_waitcnt lgkmcnt(" #n ")" ::: "memory")
#define G8_BAR __builtin_amdgcn_s_barrier()
#define G8_SCHED __builtin_amdgcn_sched_barrier(0)
  Unit cur, nxt; int ui = 0;
  if (!S.next(0, cur)) return;
  f32x4 acc[2][2][4][2];
#pragma unroll
  for (int a = 0; a < 2; ++a)
#pragma unroll
    for (int b = 0; b < 2; ++b)
#pragma unroll
      for (int m = 0; m < 4; ++m)
#pragma unroll
        for (int n = 0; n < 2; ++n) acc[a][b][m][n] = (f32x4){0.f, 0.f, 0.f, 0.f};
  bf16x8 At[4][2], B0[2][2], B1[2][2];
  unsigned cv0[2] = {0u, 0u}, cv1[2] = {0u, 0u}, nv0[2] = {0u, 0u}, nv1[2] = {0u, 0u};
  const unsigned char* cA = Abase; const unsigned char* nA = Abase;
  if (GATHER) E.a_off(cur, sR, sC, cv0, cv1); else cA = Abase + (size_t)cur.pm * tstepA;
  const unsigned char* cB = Bbase + E.b_off(cur);
  G8_STAGE_B(G8_SB(0, 0), cB); G8_STAGE_A(G8_SA(0, 0), 0, false, 0); G8_STAGE_B(G8_SB(0, 1), cB + hstep); G8_STAGE_A(G8_SA(0, 1), 1, false, 0);
  if (wr == 1) G8_BAR;
  G8_WAIT_V(4); G8_BAR;
  G8_STAGE_B(G8_SB(1, 0), cB + kstep); G8_STAGE_A(G8_SA(1, 0), 0, false, kstep); G8_STAGE_B(G8_SB(1, 1), cB + hstep + kstep);
  G8_WAIT_V(6); G8_BAR;
  for (;;) {
    const bool has_next = S.next(ui + 1, nxt);
    if (GATHER) { if (has_next) E.a_off(nxt, sR, sC, nv0, nv1); else { nv0[0] = cv0[0]; nv0[1] = cv0[1]; nv1[0] = cv1[0]; nv1[1] = cv1[1]; } }
    else nA = has_next ? Abase + (size_t)nxt.pm * tstepA : cA;
    const unsigned char* nB = has_next ? Bbase + E.b_off(nxt) : cB;
#pragma unroll 1
    for (int t = 0; t < nt; t += 2) {
      const bool last = (t == nt - 2);
      const size_t k1 = (size_t)(t + 1) * kstep;
      const size_t k2 = last ? 0 : (size_t)(t + 2) * kstep, k3 = k2 + kstep;
      const unsigned char* b2 = last ? nB : cB + (size_t)(t + 2) * kstep; const unsigned char* b3 = b2 + kstep;
      G8_LDB(B0, 0, 0); G8_SCHED; G8_LDA(At, 0, 0); G8_STAGE_A(G8_SA(1, 1), 1, false, k1);
      G8_WAIT_L(8); G8_BAR; G8_WAIT_L(0); G8_MMA(0, 0, At, B0); G8_BAR; G8_SCHED;
      G8_LDB(B1, 0, 1); G8_STAGE_B(G8_SB(0, 0), b2);
      G8_BAR; G8_WAIT_L(0); G8_MMA(0, 1, At, B1); G8_BAR;
      G8_LDA(At, 0, 1); G8_STAGE_A(G8_SA(0, 0), 0, last, k2);
      G8_BAR; G8_WAIT_L(0); G8_MMA(1, 0, At, B0); G8_BAR; G8_SCHED;
      G8_STAGE_B(G8_SB(0, 1), b2 + hstep);
      G8_WAIT_V(6); G8_BAR; G8_MMA(1, 1, At, B1); G8_BAR;
      G8_LDB(B0, 1, 0); G8_SCHED; G8_LDA(At, 1, 0); G8_STAGE_A(G8_SA(0, 1), 1, last, k2);
      G8_WAIT_L(8); G8_BAR; G8_WAIT_L(0); G8_MMA(0, 0, At, B0); G8_BAR; G8_SCHED;
      G8_LDB(B1, 1, 1); G8_STAGE_B(G8_SB(1, 0), b3);
      G8_BAR; G8_WAIT_L(0); G8_MMA(0, 1, At, B1); G8_BAR;
      G8_LDA(At, 1, 1); G8_STAGE_A(G8_SA(1, 0), 0, last, k3);
      G8_BAR; G8_WAIT_L(0); G8_MMA(1, 0, At, B0); G8_BAR; G8_SCHED;
      G8_STAGE_B(G8_SB(1, 1), b3 + hstep);
      G8_WAIT_V(6); G8_BAR; G8_MMA(1, 1, At, B1); G8_BAR;
    }
    E(acc, cur, wr, wc, fr, fq);
    if (!has_next) break;
#pragma unroll
    for (int a = 0; a < 2; ++a)
#pragma unroll
      for (int b = 0; b < 2; ++b)
#pragma unroll
        for (int m = 0; m < 4; ++m)
#pragma unroll
          for (int n = 0; n < 2; ++n) acc[a][b][m][n] = (f32x4){0.f, 0.f, 0.f, 0.f};
    cur = nxt; cB = nB; cA = nA; ++ui;
    if (GATHER) { cv0[0] = nv0[0]; cv0[1] = nv0[1]; cv1[0] = nv1[0]; cv1[1] = nv1[1]; }
  }
  G8_WAIT_V(0);
  if (wr == 0) G8_BAR;
  G8_BAR;
#undef G8_SA
#undef G8_SB
#undef G8_STAGE_A
#undef G8_STAGE_B
#undef G8_LDA
#undef G8_LDB
#undef G8_MMA
#undef G8_WAIT_V
#undef G8_WAIT_L
#undef G8_BAR
#undef G8_SCHED
}
DI void dense_a_off(int pm, int K, const int (&sR)[2], const int (&sC)[2], unsigned (&v0)[2], unsigned (&v1)[2]) {
#pragma unroll
  for (int i = 0; i < 2; ++i) { v0[i] = (unsigned)((pm * BM + sR[i]) * K + sC[i]) * 2u; v1[i] = v0[i] + (unsigned)(HALF * K * 2); }
}
}

DI int win8_row(int f) {
  if (f < 1024) {
    const int rel = f & 511, pn = (f >> 9) * 2 + (rel >> 8), hl = (rel >> 7) & 1, comp = (rel >> 6) & 1, i = rel & 63;
    const int bj = i >> 5, ip = i & 31, fq = ip >> 3, n = (ip >> 2) & 1, j = ip & 3;
    return pn * 256 + 128 * bj + 32 * (2 * hl + comp) + 16 * n + 4 * fq + j;
  }
  if (f < 1536 || f >= 2560) return f;
  const int rel = (f - 1536) & 511, pn = 6 + ((f - 1536) >> 9) * 2 + (rel >> 8), hl = (rel >> 5) & 7, ip = rel & 31;
  const int bj = hl >> 2, wc = hl & 3, fq = ip >> 3, n = (ip >> 2) & 1, j = ip & 3;
  return pn * 256 + 128 * bj + 32 * wc + 16 * n + 4 * fq + j;
}
struct EpiInproj {
  const Ptrs* Pp;
  DI void a_off(const g8::Unit& u, const int (&sR)[2], const int (&sC)[2], unsigned (&v0)[2], unsigned (&v1)[2]) const { g8::dense_a_off(u.pm, 1024, sR, sC, v0, v1); }
  DI size_t b_off(const g8::Unit& u) const { return (size_t)u.pn * 256 * 1024 * 2; }
  DI void operator()(const f32x4 (&acc)[2][2][4][2], const g8::Unit& u, int wr, int wc, int fr, int fq) const {
    const Ptrs& P = *Pp;
    const float* rstdx = (const float*)(P.ws + WS_RSTDX);
    asm volatile("" : "+v"(rstdx));
    const int pn = u.pn, row00 = u.pm * 256 + wr * 64, b = row00 >> 12;
    float rsr[8];
#pragma unroll
    for (int k = 0; k < 8; ++k) rsr[k] = rstdx[row00 + 128 * (k >> 2) + 16 * (k & 3) + fr];
    const float qsA = 0.125f * LOG2E, qsB = 0.17677669529663687f * LOG2E;
    if (pn < 4) {
      const int isk = pn >= 2, head = 2 * (pn & 1) + (wc >> 1), comp = wc & 1;
      const float* gg = ((const float*)(P.ws + WS_PAR)) + (isk ? PAR_GKA : PAR_GQA);
      asm volatile("" : "+v"(gg));
      const float4 g1a = *(const float4*)(gg + 8 * fq), g1b = *(const float4*)(gg + 8 * fq + 4), g2a = *(const float4*)(gg + 32 + 8 * fq), g2b = *(const float4*)(gg + 36 + 8 * fq);
      const float ga[8] = {g1a.x, g1a.y, g1a.z, g1a.w, g1b.x, g1b.y, g1b.z, g1b.w}, gb[8] = {g2a.x, g2a.y, g2a.z, g2a.w, g2b.x, g2b.y, g2b.z, g2b.w};
      u16* dstb = (u16*)(P.ws + (isk ? A_KA : A_QA)) + (size_t)(b * 4 + head) * 4096 * 128 + comp * 64 + 8 * fq;
      const float2* rope = (const float2*)(P.ws + WS_ROPE);
      struct Rp { f32x4 c0, c1, c2, c3; };
      auto ldrope = [&](int k) { const int s = (row00 + 128 * (k >> 2) + 16 * (k & 3) + fr) & 4095; const f32x4* rp = (const f32x4*)(rope + (size_t)s * 32 + 8 * fq);
        Rp r; r.c0 = rp[0]; r.c1 = rp[1]; r.c2 = rp[2]; r.c3 = rp[3]; return r; };
      Rp cur = ldrope(0);
#pragma unroll
      for (int k = 0; k < 8; ++k) {
        const int ai = k >> 2, m = k & 3;
        Rp nxt = cur;
        if (k < 7) nxt = ldrope(k + 1);
        const int row = row00 + 128 * ai + 16 * m + fr, s = row & 4095;
        const float rs = rsr[k];
        float x1[8], x2[8]; float ss = 0.f;
#pragma unroll
        for (int n = 0; n < 2; ++n)
#pragma unroll
          for (int j = 0; j < 4; ++j) { x1[4 * n + j] = acc[ai][0][m][n][j] * rs; x2[4 * n + j] = acc[ai][1][m][n][j] * rs; ss += x1[4 * n + j] * x1[4 * n + j] + x2[4 * n + j] * x2[4 * n + j]; }
        ss += __shfl_xor(ss, 16); ss += __shfl_xor(ss, 32);
        const float rn = rsqrtf(ss * (1.0f / 64.0f) + EPS) * (isk ? 1.0f : qsA);
        const float cs[8] = {cur.c0[0], cur.c0[2], cur.c1[0], cur.c1[2], cur.c2[0], cur.c2[2], cur.c3[0], cur.c3[2]}, sn[8] = {cur.c0[1], cur.c0[3], cur.c1[1], cur.c1[3], cur.c2[1], cur.c2[3], cur.c3[1], cur.c3[3]};
        f32x4 o1a, o1b, o2a, o2b;
#pragma unroll
        for (int e = 0; e < 8; ++e) {
          const float y = x1[e] * rn * ga[e], z = x2[e] * rn * gb[e];
          const float p1 = y * cs[e] - z * sn[e], p2 = z * cs[e] + y * sn[e];
          if (e < 4) { o1a[e] = p1; o2a[e] = p2; } else { o1b[e - 4] = p1; o2b[e - 4] = p2; }
        }
        u16* d = dstb + (size_t)s * 128;
        *(uint4*)d = pk8(o1a, o1b);
        *(uint4*)(d + 32) = pk8(o2a, o2b);
        asm volatile("" ::: "memory");
        cur = nxt;
      }
    } else if (pn >= 6 && pn < 10) {
      const int isk = pn >= 8;
      const float* gg = ((const float*)(P.ws + WS_PAR)) + (isk ? PAR_GKB : PAR_GQB);
      asm volatile("" : "+v"(gg));
      const float4 g1a = *(const float4*)(gg + 8 * fq), g1b = *(const float4*)(gg + 8 * fq + 4);
      const float ga[8] = {g1a.x, g1a.y, g1a.z, g1a.w, g1b.x, g1b.y, g1b.z, g1b.w};
#pragma unroll
      for (int bj = 0; bj < 2; ++bj) {
        const int hd = 8 * (pn & 1) + 4 * bj + wc;
        u16* dstb = (u16*)(P.ws + (isk ? A_KB : A_QB)) + (size_t)(b * 16 + hd) * 4096 * 32 + 8 * fq;
#pragma unroll
        for (int ai = 0; ai < 2; ++ai)
#pragma unroll
          for (int m = 0; m < 4; ++m) {
            const int row = row00 + 128 * ai + 16 * m + fr, s = row & 4095;
            const float rs = rsr[4 * ai + m];
            float x[8]; float ss = 0.f;
#pragma unroll
            for (int n = 0; n < 2; ++n)
#pragma unroll
              for (int j = 0; j < 4; ++j) { x[4 * n + j] = acc[ai][bj][m][n][j] * rs; ss += x[4 * n + j] * x[4 * n + j]; }
            ss += __shfl_xor(ss, 16); ss += __shfl_xor(ss, 32);
            const float rn = rsqrtf(ss * (1.0f / 32.0f) + EPS) * (isk ? 1.0f : qsB);
            f32x4 oa, ob;
#pragma unroll
            for (int e = 0; e < 4; ++e) { oa[e] = x[e] * rn * ga[e]; ob[e] = x[4 + e] * rn * ga[4 + e]; }
            *(uint4*)(dstb + (size_t)s * 32) = pk8(oa, ob);
          }
      }
    } else {
      const int isA = pn < 6;
#pragma unroll
      for (int ai = 0; ai < 2; ++ai)
#pragma unroll
        for (int m = 0; m < 4; ++m) {
          const int row0 = row00 + 128 * ai + 16 * m + 4 * fq, s0 = row0 & 4095;
          const float4 rs = *(const float4*)(rstdx + row0);
          const int sp = isA ? permpos(s0) : s0;
#pragma unroll
          for (int bj = 0; bj < 2; ++bj)
#pragma unroll
            for (int n = 0; n < 2; ++n) {
              const int c = 128 * bj + 32 * wc + 16 * n + fr;
              u16* dst;
              if (isA) dst = (u16*)(P.ws + A_VAT) + ((size_t)(b * 4 + 2 * (pn - 4) + (c >> 7)) * 128 + (c & 127)) * 4096;
              else dst = (u16*)(P.ws + A_VBT) + ((size_t)(b * 16 + 8 * (pn - 10) + (c >> 5)) * 32 + (c & 31)) * 4096;
              const f32x4 v = acc[ai][bj][m][n];
              *(uint2*)(dst + sp) = make_uint2(pk2(v[0] * rs.x, v[1] * rs.y), pk2(v[2] * rs.z, v[3] * rs.w));
            }
        }
    }
  }
};
DI void ph1_inproj8(const Ptrs& P, ldsp lds, int bid, int G) {
  EpiInproj E; E.Pp = &P;
  {
    g8::GridOrder S; S.init(64, 8, G, bid, 0x98763210u);
    g8::gemm_phase<EpiInproj, g8::GridOrder, false, false>(lds, (const unsigned char*)(P.ws + A_XB), (const unsigned char*)(P.ws + WS_WIN), 1024, S, E);
  }
  {
    g8::GridOrder S; S.init(64, 4, G, bid, 0xBA54u);
    g8::gemm_phase<EpiInproj, g8::GridOrder, true, false>(lds, (const unsigned char*)(P.ws + A_XB), (const unsigned char*)(P.ws + WS_WIN), 1024, S, E);
  }
}

DI int p32(int ip) { return 16 * ((ip >> 2) & 1) + 4 * (ip >> 3) + (ip & 3); }
DI int perm256(int f) { return (f & ~31) | p32(f & 31); }
DI int w13_row_w1(int f) { return ((f >> 7) << 8) | (f & 96) | p32(f & 31); }
DI int w13_row_w3(int f) { return (((f >> 7) << 8) | (f & 96) | p32(f & 31)) + 128; }

template <bool PLE>
struct EpiOut {
  const Ptrs* Pp;
  DI void a_off(const g8::Unit&, const int (&)[2], const int (&)[2], unsigned (&)[2], unsigned (&)[2]) const {}
  DI size_t b_off(const g8::Unit& u) const { return (size_t)u.pn * 256 * (PLE ? 256 : 1024) * 2; }
  struct Ld { float4 a0, a1, b0, b1; };
  DI void operator()(const f32x4 (&acc)[2][2][4][2], const g8::Unit& u, int wr, int wc, int fr, int fq) const {
    const Ptrs& P = *Pp;
    float* ssqp = (float*)(P.ws + (PLE ? WS_SSQEP : WS_SSQ1P));
    const int row0 = u.pm * 256 + 64 * wr + fr, col0 = u.pn * 256 + 32 * wc + 8 * fq;
    auto load = [&](int gidx) { const int ai = gidx >> 2, m = gidx & 3; const size_t go = (size_t)(row0 + 128 * ai + 16 * m) * 1024 + col0;
      Ld l; if (!PLE) { const u16* xbp = (const u16*)(P.ws + A_XB) + go; const uint4 ua = *(const uint4*)xbp, ub = *(const uint4*)(xbp + 128);
        l.a0 = make_float4(__uint_as_float(ua.x << 16), __uint_as_float(ua.x & 0xffff0000u), __uint_as_float(ua.y << 16), __uint_as_float(ua.y & 0xffff0000u));
        l.a1 = make_float4(__uint_as_float(ua.z << 16), __uint_as_float(ua.z & 0xffff0000u), __uint_as_float(ua.w << 16), __uint_as_float(ua.w & 0xffff0000u));
        l.b0 = make_float4(__uint_as_float(ub.x << 16), __uint_as_float(ub.x & 0xffff0000u), __uint_as_float(ub.y << 16), __uint_as_float(ub.y & 0xffff0000u));
        l.b1 = make_float4(__uint_as_float(ub.z << 16), __uint_as_float(ub.z & 0xffff0000u), __uint_as_float(ub.w << 16), __uint_as_float(ub.w & 0xffff0000u)); }
      else { l.a0 = l.a1 = l.b0 = l.b1 = make_float4(0.f, 0.f, 0.f, 0.f); } return l; };
    Ld cur = load(0);
#pragma unroll
    for (int gidx = 0; gidx < 8; ++gidx) {
      const int ai = gidx >> 2, m = gidx & 3;
      Ld nxt = cur;
      if (gidx < 7) nxt = load(gidx + 1);
      const int row = row0 + 128 * ai + 16 * m;
      float ss = 0.f;
#pragma unroll
      for (int bj = 0; bj < 2; ++bj) {
        const size_t go = (size_t)row * 1024 + col0 + 128 * bj;
        f32x4 a = acc[ai][bj][m][0], c4 = acc[ai][bj][m][1];
        if (!PLE) {
          const float4 xa = bj ? cur.b0 : cur.a0, xb4 = bj ? cur.b1 : cur.a1;
          a[0] += xa.x; a[1] += xa.y; a[2] += xa.z; a[3] += xa.w; c4[0] += xb4.x; c4[1] += xb4.y; c4[2] += xb4.z; c4[3] += xb4.w;
          *(uint4*)((u16*)(P.ws + A_H1B) + go) = pk8(a, c4);
        } else {
          *(uint4*)((u16*)(P.ws + A_EBF) + go) = pk8(a, c4);
        }
        ss += a[0] * a[0] + a[1] * a[1] + a[2] * a[2] + a[3] * a[3] + c4[0] * c4[0] + c4[1] * c4[1] + c4[2] * c4[2] + c4[3] * c4[3];
      }
      ss += __shfl_xor(ss, 16); ss += __shfl_xor(ss, 32);
      if (fq == 0) ssqp[(size_t)row * 16 + u.pn * 4 + wc] = ss;
      asm volatile("" ::: "memory");
      cur = nxt;
    }
  }
};
DI void ph3_outproj8(const Ptrs& P, ldsp lds, int bid, int G) {
  { EpiOut<false> E; E.Pp = &P; g8::GridOrder S; S.init(64, 4, G, bid);
    g8::gemm_phase<EpiOut<false>, g8::GridOrder, false, false>(lds, (const unsigned char*)(P.ws + A_AO), (const unsigned char*)(P.ws + WS_WOUT), 1024, S, E); }
}

DI int moe_plan8(const Ptrs& P, ldsp lds) {
  LAS int* smb = (LAS int*)(lds + g8::LDS_EXTRA8);
  __syncthreads();
  if (threadIdx.x == 0) {
    const int* cnt = (const int*)(P.ws + WS_CNT);
    int a = 0;
    for (int e = 0; e < 32; ++e) { smb[e] = a; a += (cnt[e * CNT_STRIDE] + 255) >> 8; smb[64 + e] = cnt[e * CNT_STRIDE]; }
    smb[32] = a;
  }
  __syncthreads();
  return smb[32];
}
struct MoeOrder {
  int MB, G, c; const LAS int* smb;
  DI bool next(int i, g8::Unit& u) const {
    const int L = i * G + c;
    if (L >= ((MB + 7) >> 3) * 32) return false;
    const int gmb = (L >> 5) * 8 + (L & 7);
    u.pn = (L >> 3) & 3;
    if (gmb >= MB) return false;
    int e = 0; while (gmb >= smb[e + 1]) ++e;
    u.pm = gmb; u.e = e; u.ce = smb[64 + e] - (gmb - smb[e]) * 256;
    return true;
  }
};
struct EpiUp {
  const Ptrs* Pp; const LAS int* smb;
  DI void a_off(const g8::Unit& u, const int (&sR)[2], const int (&sC)[2], unsigned (&v0)[2], unsigned (&v1)[2]) const {
    const int* tokl = (const int*)(Pp->ws + WS_TOKL) + u.e * 16384 + (u.pm - smb[u.e]) * 256;
#pragma unroll
    for (int i = 0; i < 2; ++i) {
      const int r0 = sR[i], r1 = 128 + sR[i];
      const int t0 = (r0 < u.ce) ? (tokl[r0] >> 1) : 0, t1 = (r1 < u.ce) ? (tokl[r1] >> 1) : 0;
      v0[i] = (unsigned)(t0 * 1024 + sC[i]) * 2u; v1[i] = (unsigned)(t1 * 1024 + sC[i]) * 2u;
    }
  }
  DI size_t b_off(const g8::Unit& u) const { return ((size_t)u.e * 1024 + u.pn * 256) * 1024 * 2; }
  DI void operator()(const f32x4 (&acc)[2][2][4][2], const g8::Unit& u, int wr, int wc, int fr, int fq) const {
    const Ptrs& P = *Pp;
    if (u.ce <= 0) return;
    const int* tokl = (const int*)(P.ws + WS_TOKL) + u.e * 16384 + (u.pm - smb[u.e]) * 256;
    const float* rstd1 = (const float*)(P.ws + WS_RSTD1);
    u16* hid = (u16*)(P.ws + A_HID);
    float rsv[8];
    {
      int tk[8];
#pragma unroll
      for (int k = 0; k < 8; ++k) { const int rl = 128 * (k >> 2) + 64 * wr + 16 * (k & 3) + fr; tk[k] = (rl < u.ce) ? (tokl[rl] >> 1) : -1; }
#pragma unroll
      for (int k = 0; k < 8; ++k) rsv[k] = (tk[k] >= 0) ? rstd1[tk[k]] : 0.0f;
    }
#pragma unroll
    for (int ai = 0; ai < 2; ++ai)
#pragma unroll
      for (int m = 0; m < 4; ++m) {
        const int rl = 128 * ai + 64 * wr + 16 * m + fr;
        const float rs = rsv[4 * ai + m];
        f32x4 h0, h1;
#pragma unroll
        for (int j = 0; j < 4; ++j) {
          const float a = acc[ai][0][m][0][j] * rs, b = acc[ai][0][m][1][j] * rs;
          h0[j] = a / (1.0f + __expf(-a)) * (acc[ai][1][m][0][j] * rs); h1[j] = b / (1.0f + __expf(-b)) * (acc[ai][1][m][1][j] * rs);
        }
        *(uint4*)(hid + (size_t)(u.pm * 256 + rl) * 512 + u.pn * 128 + 32 * wc + 8 * fq) = pk8(h0, h1);
      }
  }
};
DI void ph5_up8(const Ptrs& P, ldsp lds, int bid, int G) {
  const int MB = moe_plan8(P, lds);
  const LAS int* smb = (const LAS int*)(lds + g8::LDS_EXTRA8);
  MoeOrder S; S.MB = MB; S.G = G; S.c = bid; S.smb = smb;
  EpiUp E; E.Pp = &P; E.smb = smb;
  g8::gemm_phase<EpiUp, MoeOrder, false, true>(lds, (const unsigned char*)(P.ws + A_H1B), (const unsigned char*)(P.ws + WS_W13), 1024, S, E);
  {
    const int NU = ((MB + 7) >> 3) * 32, rem = NU % G, nl = rem ? G - rem : G, li = rem ? bid - rem : bid;
    EpiOut<true> E2; E2.Pp = &P; g8::GridOrder S2; S2.init(64, 4, nl, li < 0 ? 0 : li);
    if (li < 0) S2.nwg = 0;
    g8::gemm_phase<EpiOut<true>, g8::GridOrder, false, false>(lds, (const unsigned char*)(P.ws + A_PB), (const unsigned char*)(P.ws + WS_WPLE), 256, S2, E2);
    if (li >= 0) {
      const int lane = threadIdx.x & 63, wave = threadIdx.x >> 6, nwv = blockDim.x >> 6;
      LAS float* scr = (LAS float*)(lds + wave * 16640);
      for (int r = li * nwv + wave; r < 4096 + 256; r += nl * nwv) late_weight_item(r, scr, lane);
    }
  }
}
struct EpiDown {
  const Ptrs* Pp; const LAS int* smb;
  DI void a_off(const g8::Unit&, const int (&)[2], const int (&)[2], unsigned (&)[2], unsigned (&)[2]) const {}
  DI size_t b_off(const g8::Unit& u) const { return ((size_t)u.e * 1024 + u.pn * 256) * 512 * 2; }
  DI void operator()(const f32x4 (&acc)[2][2][4][2], const g8::Unit& u, int wr, int wc, int fr, int fq) const {
    const Ptrs& P = *Pp;
    if (u.ce <= 0) return;
    const int base = u.e * 16384 + (u.pm - smb[u.e]) * 256;
    const int* tokl = (const int*)(P.ws + WS_TOKL) + base; const float* wl = (const float*)(P.ws + WS_WL) + base;
    int tkv[8]; float wv[8];
#pragma unroll
    for (int k = 0; k < 8; ++k) { const int rl = 128 * (k >> 2) + 64 * wr + 16 * (k & 3) + fr; const bool v = rl < u.ce; tkv[k] = v ? tokl[rl] : -1; wv[k] = v ? wl[rl] : 0.0f; }
#pragma unroll
    for (int ai = 0; ai < 2; ++ai)
#pragma unroll
      for (int m = 0; m < 4; ++m) {
        const int tk = tkv[4 * ai + m];
        if (tk >= 0) {
          const float w = wv[4 * ai + m];
          u16* y = (u16*)(P.ws + ((tk & 1) ? A_Y1 : A_Y0)) + (size_t)(tk >> 1) * 1024 + u.pn * 256 + 32 * wc + 8 * fq;
#pragma unroll
          for (int bj = 0; bj < 2; ++bj) {
            f32x4 a = acc[ai][bj][m][0], c4 = acc[ai][bj][m][1];
#pragma unroll
            for (int j = 0; j < 4; ++j) { a[j] *= w; c4[j] *= w; }
            *(uint4*)(y + 128 * bj) = pk8(a, c4);
          }
        }
      }
  }
};
DI void ph6_down8(const Ptrs& P, ldsp lds, int bid, int G) {
  const int MB = moe_plan8(P, lds);
  const LAS int* smb = (const LAS int*)(lds + g8::LDS_EXTRA8);
  MoeOrder S; S.MB = MB; S.G = G; S.c = bid; S.smb = smb;
  EpiDown E; E.Pp = &P; E.smb = smb;
  g8::gemm_phase<EpiDown, MoeOrder, false, false>(lds, (const unsigned char*)(P.ws + A_HID), (const unsigned char*)(P.ws + WS_W2), 512, S, E);
}

struct EpiFinal {
  const Ptrs* Pp;
  DI void a_off(const g8::Unit&, const int (&)[2], const int (&)[2], unsigned (&)[2], unsigned (&)[2]) const {}
  DI size_t b_off(const g8::Unit& u) const { return (size_t)u.pn * 256 * 1024 * 2; }
  struct Ld { u32x4 hh; u32x4 ee; };
  DI void operator()(const f32x4 (&acc)[2][2][4][2], const g8::Unit& u, int wr, int wc, int fr, int fq) const {
    const Ptrs& P = *Pp;
    const float* rstd2 = (const float*)(P.ws + WS_RSTD2); const float* rstdE = (const float*)(P.ws + WS_RSTDE);
    const int row0 = u.pm * 256 + 64 * wr + fr, col0 = u.pn * 256 + 32 * wc + 8 * fq;
    auto load = [&](int gidx) { const int bj = gidx >> 3, ai = (gidx >> 2) & 1, m = gidx & 3; const int row = row0 + 128 * ai + 16 * m; const size_t go = (size_t)row * 1024 + col0 + 128 * bj;
      Ld l;
      l.hh = *(const u32x4*)((const u16*)(P.ws + A_H2B) + go); l.ee = *(const u32x4*)((const u16*)(P.ws + A_EBF) + go); return l; };
    Ld cur = load(0);
    float gv[8];
#pragma unroll
    for (int gidx = 0; gidx < 16; ++gidx) {
      const int bj = gidx >> 3, ai = (gidx >> 2) & 1, m = gidx & 3;
      if ((gidx & 7) == 0) { const float4 ga = *(const float4*)(P.g_ple + col0 + 128 * bj), gb = *(const float4*)(P.g_ple + col0 + 128 * bj + 4);
        gv[0] = ga.x; gv[1] = ga.y; gv[2] = ga.z; gv[3] = ga.w; gv[4] = gb.x; gv[5] = gb.y; gv[6] = gb.z; gv[7] = gb.w; }
      Ld nxt = cur;
      if (gidx < 15) nxt = load(gidx + 1);
      const size_t go = (size_t)(row0 + 128 * ai + 16 * m) * 1024 + col0 + 128 * bj;
      const int row = row0 + 128 * ai + 16 * m;
      const float rs2 = rstd2[row], rE = rstdE[row];
      float hv[8];
#pragma unroll
      for (int k = 0; k < 8; ++k) hv[k] = __uint_as_float((cur.hh[k >> 1] << ((k & 1) ? 0u : 16u)) & 0xffff0000u);
      const f32x4 a = acc[ai][bj][m][0], c4 = acc[ai][bj][m][1];
      const float av[8] = {a[0], a[1], a[2], a[3], c4[0], c4[1], c4[2], c4[3]};
      const unsigned eeu[4] = {cur.ee[0], cur.ee[1], cur.ee[2], cur.ee[3]};
#pragma unroll
      for (int k = 0; k < 8; ++k) {
        const unsigned sh = (k & 1) ? 0u : 16u;
        const float ev = __uint_as_float((eeu[k >> 1] << sh) & 0xffff0000u);
        const float sg = 1.0f / (1.0f + __expf(-av[k] * rs2));
        hv[k] = hv[k] + ev * rE * gv[k] * sg;
      }
      float* wr_ = P.out + go;
      __builtin_nontemporal_store((f32x4){hv[0], hv[1], hv[2], hv[3]}, (f32x4*)wr_); __builtin_nontemporal_store((f32x4){hv[4], hv[5], hv[6], hv[7]}, (f32x4*)(wr_ + 4));
      asm volatile("" ::: "memory");
      cur = nxt;
    }
  }
};
DI void ph8_final8(const Ptrs& P, ldsp lds, int bid, int G) {
  EpiFinal E; E.Pp = &P; g8::GridOrder S; S.init(64, 4, G, bid);
  g8::gemm_phase<EpiFinal, g8::GridOrder, false, false>(lds, (const unsigned char*)(P.ws + A_H2B), (const unsigned char*)(P.ws + WS_WPLG), 1024, S, E);
}

template <bool SHIFT>
DI void da_item8(const Ptrs& P, ldsp lds, int item, float lam, float m2) {
  const int tid = threadIdx.x, lane = tid & 63, wave = __builtin_amdgcn_readfirstlane(tid >> 6), h = lane >> 5, i31 = lane & 31;
  const int xcd = item & 7, loc = item >> 3, bh = 2 * xcd + (loc >> 4), qblk = loc & 15;
  const u16* qA = (const u16*)(P.ws + A_QA) + (size_t)bh * 4096 * 128;
  const u16* kA = (const u16*)(P.ws + A_KA) + (size_t)bh * 4096 * 128;
  const u16* vAt = (const u16*)(P.ws + A_VAT) + (size_t)bh * 128 * 4096;
  const int q = qblk * 256 + 32 * wave + i31;
  bf16x8 qf[2][4];
#pragma unroll
  for (int c = 0; c < 2; ++c)
#pragma unroll
    for (int s = 0; s < 4; ++s) qf[c][s] = *(const bf16x8*)(qA + (size_t)q * 128 + c * 64 + 16 * s + 8 * h);
  auto stage = [&](int buf, int tile) {
    int ln = lane; asm volatile("" : "+v"(ln));
    ldsp lk = lds + buf * DA_STAGE;
    const u16* kt = kA + (size_t)tile * 64 * 128;
    const u16* vt = vAt + tile * 64;
#pragma unroll
    for (int qq = 0; qq < 2; ++qq) {
      const int jj = 2 * wave + qq;
      const int ra = key_of(0, jj), rb = key_of(1, jj);
      const int ku = ln >> 4, key = 32 * (ku >> 1) + ((ku & 1) ? rb : ra);
      glds16(kt + key * 128 + (ln & 15) * 8, lk + jj * 1040);
      const int vu = ln >> 3, d = 32 * (vu >> 1) + ((vu & 1) ? rb : ra);
      glds16(vt + d * 4096 + (ln & 7) * 8, lk + DA_VOFF + jj * 1040);
    }
  };
  const int rk = rank_of(i31), gr = grp_of(i31);
  const int kbase = rk * 1040 + gr * 256 + h * 16;
  const int vbase = DA_VOFF + rk * 1040 + gr * 128 + h * 16;
  f32x16 O1[4], O2[4];
#pragma unroll
  for (int dt = 0; dt < 4; ++dt)
#pragma unroll
    for (int e = 0; e < 16; ++e) { O1[dt][e] = 0.f; O2[dt][e] = 0.f; }
  float l1 = 0.f, l2 = 0.f;
  __syncthreads();
  stage(0, 0);
  stage(1, 1);
  asm volatile("s_waitcnt vmcnt(4)" ::: "memory");
  __builtin_amdgcn_s_barrier();
  int buf = 0;
  for (int tile = 0; tile < 64; ++tile) {
    if (tile + 2 < 64) stage(buf >= 1 ? buf - 1 : 2, tile + 2);
    ldsp lb = lds + buf * DA_STAGE;
#pragma unroll 1
    for (int kt2 = 0; kt2 < 2; ++kt2) {
      bf16x8 pf[2][2];
      ldsp lk = lb + kbase + kt2 * 512;
      ldsp lv = lb + vbase + kt2 * 64;
#pragma unroll
      for (int c = 0; c < 2; ++c) {
        f32x16 sa;
#pragma unroll
        for (int e = 0; e < 16; ++e) sa[e] = 0.f;
#pragma unroll
        for (int s = 0; s < 4; ++s) {
          const bf16x8 kf = *(LAS bf16x8*)(lk + c * 128 + s * 32);
          sa = __builtin_amdgcn_mfma_f32_32x32x16_bf16(kf, qf[c][s], sa, 0, 0, 0);
        }
        float ls = 0.f;
#pragma unroll
        for (int e = 0; e < 16; ++e) { sa[e] = __builtin_amdgcn_exp2f(SHIFT ? sa[e] - m2 : sa[e]); ls += sa[e]; }
        if (c == 0) l1 += ls; else l2 += ls;
        pf[c][0] = packp(sa, 0); pf[c][1] = packp(sa, 1);
      }
      __builtin_amdgcn_sched_barrier(0);
      bf16x8 va = *(LAS bf16x8*)(lv), vb = *(LAS bf16x8*)(lv + 256);
#pragma unroll
      for (int st = 0; st < 4; ++st) {
        const int s2 = st >> 1, dtp = st & 1;
        bf16x8 na = va, nb = vb;
        if (st < 3) { const int s2n = (st + 1) >> 1, dn = (st + 1) & 1; na = *(LAS bf16x8*)(lv + s2n * 32 + dn * 512); nb = *(LAS bf16x8*)(lv + s2n * 32 + dn * 512 + 256); }
        __builtin_amdgcn_sched_barrier(0);
        __builtin_amdgcn_s_setprio(1);
        O1[2 * dtp] = __builtin_amdgcn_mfma_f32_32x32x16_bf16(va, pf[0][s2], O1[2 * dtp], 0, 0, 0);
        O2[2 * dtp] = __builtin_amdgcn_mfma_f32_32x32x16_bf16(va, pf[1][s2], O2[2 * dtp], 0, 0, 0);
        O1[2 * dtp + 1] = __builtin_amdgcn_mfma_f32_32x32x16_bf16(vb, pf[0][s2], O1[2 * dtp + 1], 0, 0, 0);
        O2[2 * dtp + 1] = __builtin_amdgcn_mfma_f32_32x32x16_bf16(vb, pf[1][s2], O2[2 * dtp + 1], 0, 0, 0);
        __builtin_amdgcn_s_setprio(0);
        __builtin_amdgcn_sched_barrier(0);
        va = na; vb = nb;
      }
    }
    if (tile + 2 < 64) asm volatile("s_waitcnt vmcnt(4)" ::: "memory"); else asm volatile("s_waitcnt vmcnt(0)" ::: "memory");
    __builtin_amdgcn_s_barrier();
    buf = (buf == 2) ? 0 : buf + 1;
  }
  l1 += __shfl_xor(l1, 32); l2 += __shfl_xor(l2, 32);
  const float i1 = 1.0f / l1, i2 = lam / l2;
  float ss = 0.f;
#pragma unroll
  for (int dt = 0; dt < 4; ++dt)
#pragma unroll
    for (int e = 0; e < 16; ++e) { const float o = O1[dt][e] * i1 - O2[dt][e] * i2; O1[dt][e] = o; ss += o * o; }
  ss += __shfl_xor(ss, 32);
  const float rn = rsqrtf(ss * (1.0f / 128.0f) + EPS) * (1.0f - LAM_INIT);
  const int b = bh >> 2, hh = bh & 3;
  u16* dst = (u16*)(P.ws + A_AO) + ((size_t)b * 4096 + q) * 1024 + hh * 128;
#pragma unroll
  for (int dt = 0; dt < 4; ++dt)
#pragma unroll
    for (int g = 0; g < 4; ++g) {
      const int d0 = 32 * dt + 8 * g + 4 * h;
      const float4 gs = *(const float4*)(P.g_sub + d0);
      *(uint2*)(dst + d0) = make_uint2(pk2(O1[dt][4 * g] * rn * gs.x, O1[dt][4 * g + 1] * rn * gs.y), pk2(O1[dt][4 * g + 2] * rn * gs.z, O1[dt][4 * g + 3] * rn * gs.w));
    }
}

constexpr int NA8_VSTRIDE = 1936;
constexpr int NA8_TAB = 32 * NA8_VSTRIDE;
DI void na_block8(const Ptrs& P, ldsp lds, int item, float qkbound) {
  const int tid = threadIdx.x, lane = tid & 63, wave = tid >> 6;
  const int r0 = (item & 7) * 8, hd = (item >> 3) & 15, b = item >> 7;
  const int qi = lane & 15, g = lane >> 4;
  LAS float* EB = (LAS float*)(lds + NA8_TAB);
  LAS float* RW = EB + 960;
  const int R0 = min(max(r0 - 4, 0), 56), NR = min(15, 64 - R0);
  const u16* vB = (const u16*)(P.ws + A_VBT) + (size_t)(b * 16 + hd) * 32 * 4096;
  __syncthreads();
  {
    u32x4 vv[8];
#pragma unroll
    for (int k = 0; k < 8; ++k) {
      const int sg = (tid >> 3) + 64 * k, d = sg / NR, kr = sg - d * NR;
      vv[k] = *(const u32x4*)(vB + (size_t)min(d, 31) * 4096 + (R0 + min(kr, NR - 1)) * 64 + 8 * (tid & 7));
    }
    float mxa = 0.f;
    const float r0v = (tid < 465) ? P.rpb[hd * 465 + tid] : 0.f;
    mxa = fabsf(r0v);
#pragma unroll
    for (int o = 1; o < 64; o <<= 1) mxa = fmaxf(mxa, __shfl_xor(mxa, o));
    LAS float* red = (LAS float*)(lds + NA8_TAB + 7680);
    if (lane == 0) red[wave] = mxa;
#pragma unroll
    for (int k = 0; k < 8; ++k) {
      const int sg = (tid >> 3) + 64 * k, d = sg / NR, kr = sg - d * NR;
      if (sg < 32 * NR) *(LAS u32x4*)(lds + d * NA8_VSTRIDE + kr * 128 + 16 * (tid & 7)) = vv[k];
    }
    __syncthreads();
    const float m2 = (qkbound + fmaxf(fmaxf(fmaxf(red[0], red[1]), fmaxf(red[2], red[3])), fmaxf(fmaxf(red[4], red[5]), fmaxf(red[6], red[7])))) * LOG2E;
    for (int e = tid; e < 960; e += 512) {
      const int br = e >> 6, co = (e & 63) - 16;
      const float v = (co >= 0 && co <= 30) ? P.rpb[hd * 465 + br * 31 + co] * LOG2E - m2 : -1e30f;
      RW[e] = v;
      EB[e] = (co >= 7 && co <= 22) ? v : -1e30f;
    }
    __syncthreads();
  }
  const int r = r0 + wave;
  const int rs = min(max(r - 4, 0), 56), rb0 = rs - r + 7;
  const u16* qB = (const u16*)(P.ws + A_QB) + (size_t)(b * 16 + hd) * 4096 * 32;
  const u16* kBp = (const u16*)(P.ws + A_KB) + (size_t)(b * 16 + hd) * 4096 * 32;
  bf16x8 kf[16], qf;
  auto issue_kq = [&](int jq) {
    const int kb = min(min(max(16 * jq - 8, 0), 48), 32);
    const u16* kp = kBp + (size_t)(rs * 64 + kb + qi) * 32 + 8 * g;
    qf = *(const bf16x8*)(qB + (size_t)(r * 64 + 16 * jq + qi) * 32 + 8 * g);
#pragma unroll
    for (int ri = 0; ri < 8; ++ri)
#pragma unroll
      for (int t = 0; t < 2; ++t) kf[2 * ri + t] = *(const bf16x8*)(kp + (ri * 64 + 16 * t) * 32);
  };
  issue_kq(0);
#pragma unroll 1
  for (int jq = 0; jq < 4; ++jq) {
    const int kb = min(min(max(16 * jq - 8, 0), 48), 32);
    const LAS float* tb[2];
    {
      const int cobase = (jq == 0) ? 15 : ((jq == 3) ? -1 : 7);
#pragma unroll
      for (int t = 0; t < 2; ++t) {
        const int off = rb0 * 64 + cobase + 16 * t + 4 * g - qi + 16;
        const LAS float* pe = EB + off; const LAS float* pr = RW + off; const LAS float* pn = RW + 48;
        const LAS float* sel = pe;
        if (jq == 0 && qi < 8) sel = (t == 0) ? pr : pn;
        if (jq == 3 && qi > 8) sel = (t == 1) ? pr : pn;
        tb[t] = sel;
      }
    }
    f32x4 sa[8][2];
#pragma unroll
    for (int ri = 0; ri < 8; ++ri)
#pragma unroll
      for (int t = 0; t < 2; ++t) {
        const LAS float* tp = tb[t] + ri * 64;
        const f32x4 ci = {tp[0], tp[1], tp[2], tp[3]};
        sa[ri][t] = __builtin_amdgcn_mfma_f32_16x16x32_bf16(kf[2 * ri + t], qf, ci, 0, 0, 0);
      }
    __builtin_amdgcn_sched_barrier(0);
    if (jq + 1 < 4) issue_kq(jq + 1);
    __builtin_amdgcn_sched_barrier(0);
    float l = 0.f;
    f32x4 oa[2] = {{0.f, 0.f, 0.f, 0.f}, {0.f, 0.f, 0.f, 0.f}};
    ldsp vl = lds + qi * NA8_VSTRIDE + (rs - R0) * 128 + (kb + 4 * g) * 2;
#pragma unroll
    for (int ri = 0; ri < 8; ++ri) {
      float p[8];
#pragma unroll
      for (int t = 0; t < 2; ++t)
#pragma unroll
        for (int i = 0; i < 4; ++i) { const float e = __builtin_amdgcn_exp2f(sa[ri][t][i]); p[4 * t + i] = e; l += e; }
      u32x4 pp; pp[0] = pk2(p[0], p[1]); pp[1] = pk2(p[2], p[3]); pp[2] = pk2(p[4], p[5]); pp[3] = pk2(p[6], p[7]);
      const bf16x8 pfr = __builtin_bit_cast(bf16x8, pp);
#pragma unroll
      for (int dtl = 0; dtl < 2; ++dtl) {
        const s16x4 lo = *(LAS s16x4*)(vl + dtl * 16 * NA8_VSTRIDE + ri * 128), hi = *(LAS s16x4*)(vl + dtl * 16 * NA8_VSTRIDE + ri * 128 + 32);
        const bf16x8 vf = __builtin_shufflevector(lo, hi, 0, 1, 2, 3, 4, 5, 6, 7);
        oa[dtl] = __builtin_amdgcn_mfma_f32_16x16x32_bf16(vf, pfr, oa[dtl], 0, 0, 0);
      }
    }
    l += __shfl_xor(l, 16); l += __shfl_xor(l, 32);
    const float il = 1.0f / l;
    u16* dst = (u16*)(P.ws + A_AO) + ((size_t)b * 4096 + r * 64 + 16 * jq + qi) * 1024 + 512 + hd * 32;
#pragma unroll
    for (int dtl = 0; dtl < 2; ++dtl)
      *(uint2*)(dst + 16 * dtl + 4 * g) = make_uint2(pk2(oa[dtl][0] * il, oa[dtl][1] * il), pk2(oa[dtl][2] * il, oa[dtl][3] * il));
  }
}

DI void ph2_attn8(const Ptrs& P, ldsp lds, int bid, int G) {
  const float* sc = (const float*)(P.ws + WS_SCAL);
  const float lam = sc[0], m2 = sc[1], qkb = sc[2];
  if (m2 < 64.0f) { for (int it = bid; it < 256; it += G) da_item8<false>(P, lds, it, lam, m2); }
  else { for (int it = bid; it < 256; it += G) da_item8<true>(P, lds, it, lam, m2); }
  for (int it = bid; it < 512; it += G) na_block8(P, lds, it, qkb);
}

__global__ void __launch_bounds__(512, 2) mega8(Ptrs Pk, int ph_lo, int ph_hi) {
  extern __shared__ __attribute__((aligned(16))) unsigned char smem[];
  ldsp lds = (ldsp)smem;
  const int bid = blockIdx.x, G = gridDim.x;
  volatile LAS unsigned* st = (volatile LAS unsigned*)(lds + g8::LDS_EXTRA8 + 4080);
  XcdBarrier xb; xb.bar = (unsigned*)(Pk.ws + WS_CTL); xb.x = 0; xb.st = st;
  if (ph_hi - ph_lo > 1) {
    if (threadIdx.x == 0) { st[0] = 0u; st[1] = 0u; }
    __syncthreads();
    xb = xcd_barrier_post((unsigned*)(Pk.ws + WS_CTL), st);
  }
#define RUN_PHASE8(k, call) if (ph_lo <= k && k < ph_hi) { { const Ptrs P = load_args(); call; } if (k + 1 < ph_hi) xcd_barrier(xb); }
  RUN_PHASE8(0, ph0_prep(P, lds, bid, G))
  RUN_PHASE8(1, ph1_inproj8(P, lds, bid, G))
  RUN_PHASE8(2, ph2_attn8(P, lds, bid, G))
  RUN_PHASE8(3, ph3_outproj8(P, lds, bid, G))
  RUN_PHASE8(4, ph4_router(P, lds, bid, G))
  RUN_PHASE8(5, ph5_up8(P, lds, bid, G))
  RUN_PHASE8(6, ph6_down8(P, lds, bid, G))
  RUN_PHASE8(7, ph7_combine(P, lds, bid, G))
  RUN_PHASE8(8, ph8_final8(P, lds, bid, G))
}
extern "C" void kernel_launch(void* const* d_in, const int* in_sizes, int n_in, void* d_out, int out_size, void* d_ws, size_t ws_size,
                              hipStream_t stream) {
  static int grid = 0;
  if (grid == 0) {
    if (n_in != 25 || ws_size < WS_END || out_size != T * DM) { fprintf(stderr, "kernel_launch: unexpected n_in %d / out %d / ws_size %zu (need %zu)\\n", n_in, out_size, ws_size, (size_t)WS_END); grid = -1; return; }
    int dev = 0, cus = 0, per_cu = 0;
    (void)hipGetDevice(&dev);
    (void)hipDeviceGetAttribute(&cus, hipDeviceAttributeMultiprocessorCount, dev);
    (void)hipFuncSetAttribute((const void*)mega8, hipFuncAttributeMaxDynamicSharedMemorySize, g8::LDS_BYTES8);
    (void)hipOccupancyMaxActiveBlocksPerMultiprocessor(&per_cu, (const void*)mega8, 512, g8::LDS_BYTES8);
    if (per_cu < 1) { fprintf(stderr, "kernel_launch: occupancy query returned %d\\n", per_cu); grid = -1; return; }
    grid = cus;
  }
  if (grid < 0) return;
  Ptrs P{};
  const float** pp = (const float**)&P;
  for (int i = 0; i < 25; ++i) pp[i] = (const float*)d_in[i];
  P.out = (float*)d_out; P.ws = (unsigned char*)d_ws;
  (void)hipMemsetAsync((unsigned char*)d_ws + WS_CTL, 0, XCD_BAR_WORDS * 4, stream);
  mega8<<<grid, 512, g8::LDS_BYTES8, stream>>>(P, 0, 9);
}
```

```cpp
#define ONE_LAUNCH 2
#define NEW_MASK 0x1ff
#include <hip/hip_runtime.h>
#include <cstdio>
#include <cstdint>

typedef unsigned short u16;
#define DI __device__ __forceinline__

constexpr int T = 16384, S = 4096, DM = 1024, NB = 4;
constexpr int DIN = 3072, DPLE = 256;
constexpr int HA = 4, HB = 16;
constexpr int NE = 32, DE = 512;
constexpr float EPS = 1e-6f;
constexpr float LOG2E = 1.4426950408889634f;
constexpr float LAM_INIT = 0.2f;

constexpr size_t MiB = 1ull << 20;
constexpr size_t WS_WIN = 0, WS_WOUT = 6 * MiB, WS_W13 = 8 * MiB, WS_W2 = 72 * MiB, WS_WPLG = 104 * MiB,
                 WS_WPLE = 106 * MiB, WS_WR = 106 * MiB + 512 * 1024, WS_ROPE = 107 * MiB;
constexpr size_t WS_SMALL = 108 * MiB;
constexpr size_t WS_RSTDX = WS_SMALL;
constexpr size_t WS_SSQ1P = 250 * MiB;
constexpr size_t WS_SSQEP = 251 * MiB;
constexpr int SSQ_PARTS = 16;
constexpr size_t WS_RSTD1 = WS_RSTDX + 65536;
constexpr size_t WS_RSTD2 = WS_RSTD1 + 65536;
constexpr size_t WS_SCAL  = WS_RSTD2 + 65536;
constexpr size_t WS_CNT   = WS_SCAL + 256;
constexpr int CNT_STRIDE = 64;
constexpr size_t WS_PADST = WS_CNT + 8192;
constexpr size_t WS_CTL   = WS_PADST + 256;
constexpr size_t WS_RSTDE = WS_CTL + 16384;
constexpr size_t WS_PAR   = WS_SMALL + 1 * MiB;
constexpr int PAR_GQA = 0, PAR_GKA = 64, PAR_GSUB = 128, PAR_GQB = 256, PAR_GKB = 288, PAR_GPLE = 320, PAR_RPB = 1344, PAR_TOTAL = 1344 + 7440;
constexpr size_t WS_TOKL  = WS_SMALL + 2 * MiB;
constexpr size_t WS_WL    = WS_SMALL + 4 * MiB;
constexpr size_t WS_ACT   = 114 * MiB;
constexpr size_t A_XB = WS_ACT, A_AO = 260 * MiB, A_HID = WS_ACT, A_H2B = WS_ACT;
constexpr size_t A_PB = 252 * MiB;
constexpr size_t A_QA = WS_ACT + 40 * MiB, A_KA = WS_ACT + 56 * MiB, A_VAT = WS_ACT + 72 * MiB,
                 A_QB = WS_ACT + 88 * MiB, A_KB = WS_ACT + 104 * MiB, A_VBT = WS_ACT + 120 * MiB;
constexpr size_t A_H1B = WS_ACT + 40 * MiB, A_EBF = WS_ACT + 72 * MiB, A_Y0 = WS_ACT + 104 * MiB, A_Y1 = 260 * MiB;
constexpr size_t WS_END = 292 * MiB;

DI float bf2f(u16 u) { return __uint_as_float(((unsigned)u) << 16); }
DI u16 f2bf(float f) { __bf16 b = (__bf16)f; return __builtin_bit_cast(u16, b); }
DI int permpos(int s) { return (s & ~12) | ((s & 8) >> 1) | ((s & 4) << 1); }

struct Ptrs {
  const float *x, *p, *g_mix, *w_in, *g_qa, *g_ka, *lam_q1, *lam_k1, *lam_q2, *lam_k2, *g_sub, *g_qb, *g_kb, *rpb, *w_out,
      *g_ffn, *w_rg, *w_re, *w1, *w3, *w2, *g_plg, *w_plg, *w_ple, *g_ple;
  float* out;
  unsigned char* ws;
};

#define GAS __attribute__((address_space(1)))
#define LAS __attribute__((address_space(3)))
typedef LAS unsigned char* ldsp;
typedef __attribute__((ext_vector_type(8))) short bf16x8;
typedef __attribute__((ext_vector_type(16))) float f32x16;
typedef __attribute__((ext_vector_type(4))) float f32x4;
typedef __attribute__((ext_vector_type(2))) float f32x2v;
typedef __attribute__((ext_vector_type(2))) __bf16 bf16x2v;
DI unsigned pk2(float a, float b) { bf16x2v v = __builtin_convertvector((f32x2v){a, b}, bf16x2v); return __builtin_bit_cast(unsigned, v); }
DI float wave_sum(float v) {
#pragma unroll
  for (int o = 1; o < 64; o <<= 1) v += __shfl_xor(v, o);
  return v;
}
DI void glds16(const void* g, ldsp l) { __builtin_amdgcn_global_load_lds((const GAS unsigned*)g, (LAS unsigned*)l, 16, 0, 0); }
DI void lds_wave_sync() { asm volatile("s_waitcnt lgkmcnt(0)" ::: "memory"); }

#define XB_TMO      128
#define XB_XCNT(j)  (256  + 64 * (j))
#define XB_XSUB(j)  (1280 + 64 * (j))
#define XB_XGEN(j)  (2304 + 64 * (j))
#define XB_TOP      3328
#define XB_TOPGEN   3392
#define XCD_BAR_WORDS 3456
#define XB_SPIN_CAP (1u << 22)
DI unsigned xb_ld(unsigned* p) { return __hip_atomic_load(p, __ATOMIC_RELAXED, __HIP_MEMORY_SCOPE_AGENT); }
DI unsigned xb_add(unsigned* p, unsigned v) { return __hip_atomic_fetch_add(p, v, __ATOMIC_RELAXED, __HIP_MEMORY_SCOPE_AGENT); }
DI unsigned xb_xcc_id() { return (unsigned)__builtin_amdgcn_s_getreg((3 << 11) | 20) & 0xFu; }
#define XB_SPIN(cond, bar) do { unsigned _sp = 0; while (cond) { __builtin_amdgcn_s_sleep(1); \
    if ((++_sp & 255u) == 0u) { if (xb_ld(&(bar)[XB_TMO])) break; if (_sp > XB_SPIN_CAP) { atomicAdd(&(bar)[XB_TMO], 1u); break; } } } } while (0)
struct XcdBarrier { unsigned* bar; unsigned x; volatile LAS unsigned* st; };
DI XcdBarrier xcd_barrier_post(unsigned* bar, volatile LAS unsigned* st) {
  XcdBarrier b; b.bar = bar; b.x = xb_xcc_id(); b.st = st;
  if (threadIdx.x == 0) (void)xb_add(&bar[XB_XCNT(b.x)], 1u);
  return b;
}
DI void xcd_barrier_complete(unsigned* bar, unsigned x, unsigned& nloc, unsigned& nx) {
  const unsigned G = gridDim.x;
  unsigned sum, cnt, mine, sp = 0u;
  for (;;) {
    sum = 0u; cnt = 0u; mine = 0u;
#pragma unroll
    for (unsigned j = 0; j < 16; ++j) { const unsigned c = xb_ld(&bar[XB_XCNT(j)]); sum += c; cnt += (c > 0u) ? 1u : 0u; mine = (j == x) ? c : mine; }
    if (sum == G) break;
    __builtin_amdgcn_s_sleep(1);
    if ((++sp & 255u) == 0u) { if (xb_ld(&bar[XB_TMO])) break; if (sp > XB_SPIN_CAP) { atomicAdd(&bar[XB_TMO], 1u); break; } }
  }
  nloc = mine > 0u ? mine : 1u; nx = cnt > 0u ? cnt : 1u;
}
DI void xcd_barrier(const XcdBarrier& b) {
  asm volatile("s_waitcnt vmcnt(0)" ::: "memory");
  __syncthreads();
  if (threadIdx.x == 0) {
    unsigned* bar = b.bar;
    __builtin_amdgcn_s_waitcnt(0);
    unsigned nloc = b.st[0], nx = b.st[1];
    if (nloc == 0u) { xcd_barrier_complete(bar, b.x, nloc, nx); b.st[0] = nloc; b.st[1] = nx; }
    const unsigned old = xb_add(&bar[XB_XSUB(b.x)], 1u);
    const unsigned gen = old / nloc;
    if (old + 1u == (gen + 1u) * nloc) {
      __builtin_amdgcn_fence(__ATOMIC_RELEASE, "agent");
      asm volatile("s_waitcnt vmcnt(0)" ::: "memory");
      const unsigned og = xb_add(&bar[XB_TOP], 1u);
      const unsigned tg = og / nx;
      if (og + 1u == (tg + 1u) * nx) xb_add(&bar[XB_TOPGEN], 1u);
      else XB_SPIN(xb_ld(&bar[XB_TOPGEN]) == tg, bar);
      __builtin_amdgcn_fence(__ATOMIC_ACQUIRE, "agent");
      xb_add(&bar[XB_XGEN(b.x)], 1u);
      asm volatile("s_waitcnt vmcnt(0)" ::: "memory");
    } else {
      XB_SPIN(xb_ld(&bar[XB_XGEN(b.x)]) == gen, bar);
      __builtin_amdgcn_fence(__ATOMIC_ACQUIRE, "agent");
      asm volatile("s_waitcnt vmcnt(0)" ::: "memory");
    }
  }
  __syncthreads();
}

DI int win8_row(int f);
DI int perm256(int f);
DI int w13_row_w1(int f);
DI int w13_row_w3(int f);
typedef int (*rowmap_t)(int);
template <rowmap_t rowmap = (rowmap_t) nullptr>
DI void tr_item(const float* W, int ldw, int k0, int n0, const float* gk, u16* dst0, u16* dst1, int ldd, LAS float* scr, int lane) {
  float4 v[16];
  const float* src = W + (size_t)(k0 + (lane >> 4)) * ldw + n0 + 4 * (lane & 15);
#pragma unroll
  for (int j = 0; j < 16; ++j) { const f32x4 t = __builtin_nontemporal_load((const f32x4*)(src + (size_t)(4 * j) * ldw)); v[j] = make_float4(t[0], t[1], t[2], t[3]); }
  if (gk) {
#pragma unroll
    for (int j = 0; j < 16; ++j) { const float g = gk[k0 + 4 * j + (lane >> 4)]; v[j].x *= g; v[j].y *= g; v[j].z *= g; v[j].w *= g; }
  }
  LAS float* w = scr + (lane >> 4) * 65 + 4 * (lane & 15);
#pragma unroll
  for (int j = 0; j < 16; ++j) { w[(4 * j) * 65] = v[j].x; w[(4 * j) * 65 + 1] = v[j].y; w[(4 * j) * 65 + 2] = v[j].z; w[(4 * j) * 65 + 3] = v[j].w; }
  lds_wave_sync();
  const int c = lane & 7;
#pragma unroll
  for (int j = 0; j < 8; ++j) {
    const int n = (lane >> 3) + 8 * j;
    const LAS float* s = scr + (8 * c) * 65 + n;
    uint4 o;
    o.x = pk2(s[0 * 65], s[1 * 65]); o.y = pk2(s[2 * 65], s[3 * 65]); o.z = pk2(s[4 * 65], s[5 * 65]); o.w = pk2(s[6 * 65], s[7 * 65]);
    u16* d = rowmap ? (dst0 + (size_t)rowmap(n0 + n) * ldd) : ((j < 4) ? (dst0 + (size_t)n * ldd) : (dst1 + (size_t)(n - 32) * ldd));
    *(uint4*)(d + k0 + 8 * c) = o;
  }
  lds_wave_sync();
}

typedef const __attribute__((address_space(4))) Ptrs* kargp_t;
DI kargp_t kargs_now() {
#if defined(__HIP_DEVICE_COMPILE__)
  kargp_t kp = (kargp_t)__builtin_amdgcn_kernarg_segment_ptr(); asm volatile("" : "+s"(kp)); return kp;
#else
  return nullptr;
#endif
}
DI Ptrs load_args() {
#if defined(__HIP_DEVICE_COMPILE__)
  kargp_t kp = kargs_now(); Ptrs r; __builtin_memcpy(&r, (const void*)kp, sizeof(Ptrs)); return r;
#else
  return Ptrs{};
#endif
}
DI void late_weight_item(int r, LAS float* scr, int lane) {
  unsigned char* const wsb = kargs_now()->ws;
  if (r < 4096) {
    u16* W2T = (u16*)(wsb + WS_W2);
    const int e = r >> 7, q = r & 127, kb = q >> 4, nb = q & 15;
    tr_item<perm256>(kargs_now()->w2 + (size_t)e * 512 * 1024, 1024, kb * 64, nb * 64, nullptr, W2T + (size_t)e * 1024 * 512, nullptr, 512, scr, lane);
  } else {
    r -= 4096;
    const int kb = r >> 4, nb = r & 15;
    tr_item<perm256>(kargs_now()->w_plg, 1024, kb * 64, nb * 64, kargs_now()->g_plg, (u16*)(wsb + WS_WPLG), nullptr, 1024, scr, lane);
  }
}
DI void ph0_prep(const Ptrs& Punused, ldsp lds, int bid, int G) {
  unsigned char* const wsb = kargs_now()->ws;
  const int tid = threadIdx.x, lane = tid & 63, wave = tid >> 6;
  LAS float* scr = (LAS float*)(lds + wave * 16640);
  const int nwv = blockDim.x >> 6, gw = bid * nwv + wave, NGW = G * nwv;
  constexpr int I_W1 = 4096, I_W3 = 4096, I_W2 = 4096, I_X = 8192, I_WIN = 768, I_P = 2048, I_WOUT = 256, I_PLG = 256, I_PLE = 64,
                I_WR = 768, I_ROPE = 2048, I_PAR = (PAR_TOTAL + 63) / 64, I_SC = 1;
  constexpr int TOTAL = I_W1 + I_W3 + I_W2 + I_X + I_WIN + I_P + I_WOUT + I_PLG + I_PLE + I_WR + I_ROPE + I_PAR + I_SC;
  u16* W13T = (u16*)(wsb + WS_W13); u16* W2T = (u16*)(wsb + WS_W2);
  for (int r0_ = gw; r0_ < I_W1 + I_W3; r0_ += NGW) {
    int r = r0_;
      const int isw3 = r >= I_W1; if (isw3) r -= I_W1;
      const int e = r >> 7, q = r & 127, kb = q >> 3, nb = q & 7;
      u16* d0 = W13T + ((size_t)e * 1024 + nb * 128 + isw3 * 32) * 1024;
#if NEW_MASK & 0x20
      if (isw3) tr_item<w13_row_w3>(kargs_now()->w3 + (size_t)e * 1024 * 512, 512, kb * 64, nb * 64, kargs_now()->g_ffn, W13T + (size_t)e * 1024 * 1024, nullptr, 1024, scr, lane);
      else tr_item<w13_row_w1>(kargs_now()->w1 + (size_t)e * 1024 * 512, 512, kb * 64, nb * 64, kargs_now()->g_ffn, W13T + (size_t)e * 1024 * 1024, nullptr, 1024, scr, lane);
#else
      tr_item((isw3 ? kargs_now()->w3 : kargs_now()->w1) + (size_t)e * 1024 * 512, 512, kb * 64, nb * 64, kargs_now()->g_ffn, d0, d0 + 64 * 1024, 1024, scr, lane);
#endif
  }
  for (int r0_ = gw; r0_ < I_X; r0_ += NGW) {
    int r = r0_;
      const float4* xr = (const float4*)(kargs_now()->x + (size_t)r * 2048) + lane;
      float4 v[8];
#pragma unroll
      for (int j = 0; j < 8; ++j) { const f32x4 t = __builtin_nontemporal_load((const f32x4*)(xr + 64 * j)); v[j] = make_float4(t[0], t[1], t[2], t[3]); }
      float s0 = 0.f, s1 = 0.f;
#pragma unroll
      for (int j = 0; j < 4; ++j) { s0 += v[j].x * v[j].x + v[j].y * v[j].y + v[j].z * v[j].z + v[j].w * v[j].w; s1 += v[j + 4].x * v[j + 4].x + v[j + 4].y * v[j + 4].y + v[j + 4].z * v[j + 4].z + v[j + 4].w * v[j + 4].w; }
      s0 = wave_sum(s0); s1 = wave_sum(s1);
      if (lane == 0) { float* rx = (float*)(wsb + WS_RSTDX); rx[2 * r] = rsqrtf(s0 * (1.0f / 1024.0f) + EPS); rx[2 * r + 1] = rsqrtf(s1 * (1.0f / 1024.0f) + EPS); }
      uint2* o = (uint2*)((u16*)(wsb + A_XB) + (size_t)r * 2048) + lane;
#pragma unroll
      for (int j = 0; j < 8; ++j) o[64 * j] = make_uint2(pk2(v[j].x, v[j].y), pk2(v[j].z, v[j].w));
  }
  for (int r0_ = gw; r0_ < I_WIN; r0_ += NGW) {
    int r = r0_;
      const int kb = r / 48, nb = r % 48;
      u16* d0 = (u16*)(wsb + WS_WIN) + (size_t)(nb * 64) * 1024;
      tr_item<win8_row>(kargs_now()->w_in, DIN, kb * 64, nb * 64, kargs_now()->g_mix, (u16*)(wsb + WS_WIN), nullptr, 1024, scr, lane);
  }
  for (int r0_ = gw; r0_ < I_P; r0_ += NGW) {
    int r = r0_;
      const float4* pr = (const float4*)kargs_now()->p + (size_t)r * 512 + lane;
      uint2* o = (uint2*)(wsb + A_PB) + (size_t)r * 512 + lane;
      float4 v[8];
#pragma unroll
      for (int j = 0; j < 8; ++j) { const f32x4 t = __builtin_nontemporal_load((const f32x4*)(pr + 64 * j)); v[j] = make_float4(t[0], t[1], t[2], t[3]); }
#pragma unroll
      for (int j = 0; j < 8; ++j) o[64 * j] = make_uint2(pk2(v[j].x, v[j].y), pk2(v[j].z, v[j].w));
  }
  for (int r0_ = gw; r0_ < I_WOUT; r0_ += NGW) {
    int r = r0_;
      const int kb = r >> 4, nb = r & 15;
      u16* d0 = (u16*)(wsb + WS_WOUT) + (size_t)(nb * 64) * 1024;
#if NEW_MASK & 0x8
      tr_item<perm256>(kargs_now()->w_out, 1024, kb * 64, nb * 64, nullptr, (u16*)(wsb + WS_WOUT), nullptr, 1024, scr, lane);
#else
      tr_item(kargs_now()->w_out, 1024, kb * 64, nb * 64, nullptr, d0, d0 + 32 * 1024, 1024, scr, lane);
#endif
  }
  for (int r0_ = gw; r0_ < I_PLE; r0_ += NGW) {
    int r = r0_;
      const int kb = r >> 4, nb = r & 15;
      u16* d0 = (u16*)(wsb + WS_WPLE) + (size_t)(nb * 64) * 256;
#if NEW_MASK & 0x8
      tr_item<perm256>(kargs_now()->w_ple, 1024, kb * 64, nb * 64, nullptr, (u16*)(wsb + WS_WPLE), nullptr, 256, scr, lane);
#else
      tr_item(kargs_now()->w_ple, 1024, kb * 64, nb * 64, nullptr, d0, d0 + 32 * 256, 256, scr, lane);
#endif
  }
  for (int r0_ = gw; r0_ < I_WR; r0_ += NGW) {
    int r = r0_;
      const int idx = r * 64 + lane, rr = idx >> 10, k = idx & 1023;
      float v = 0.f;
      if (rr < 4) v = kargs_now()->w_rg[k * 4 + rr]; else if (rr < 36) v = kargs_now()->w_re[k * 32 + (rr - 4)];
      const float wv_ = v * kargs_now()->g_ffn[k];
      const unsigned hb_ = pk2(wv_, 0.f) & 0xffffu;
      const unsigned lb_ = pk2(wv_ - __uint_as_float(hb_ << 16), 0.f) & 0xffffu;
      ((u16*)(wsb + WS_WR))[idx] = (u16)hb_; ((u16*)(wsb + WS_WR))[48 * 1024 + idx] = (u16)lb_;
  }
  for (int r0_ = gw; r0_ < I_ROPE; r0_ += NGW) {
    int r = r0_;
      const int idx = r * 64 + lane, s = idx >> 5, i = idx & 31;
      const float inv = powf(10000.0f, -(float)(2 * i) / 64.0f);
      const float ang = (float)s * inv;
      float sn, cs; sincosf(ang, &sn, &cs);
      ((float2*)(wsb + WS_ROPE))[idx] = make_float2(cs, sn);
  }
  for (int r0_ = gw; r0_ < I_PAR; r0_ += NGW) {
    int r = r0_;
      const int idx = r * 64 + lane;
      if (idx < PAR_TOTAL) {
        float v;
        if (idx < PAR_GKA) v = kargs_now()->g_qa[idx]; else if (idx < PAR_GSUB) v = kargs_now()->g_ka[idx - PAR_GKA]; else if (idx < PAR_GQB) v = kargs_now()->g_sub[idx - PAR_GSUB];
        else if (idx < PAR_GKB) v = kargs_now()->g_qb[idx - PAR_GQB]; else if (idx < PAR_GPLE) v = kargs_now()->g_kb[idx - PAR_GKB]; else if (idx < PAR_RPB) v = kargs_now()->g_ple[idx - PAR_GPLE];
        else v = kargs_now()->rpb[idx - PAR_RPB];
        ((float*)(wsb + WS_PAR))[idx] = v;
      }
  }
  if (gw == 0) {
    if (lane == 0) {
      float s1 = 0, s2 = 0, mq = 0, mk = 0;
      for (int i = 0; i < 64; ++i) {
        s1 += kargs_now()->lam_q1[i] * kargs_now()->lam_k1[i]; s2 += kargs_now()->lam_q2[i] * kargs_now()->lam_k2[i];
        mq = fmaxf(mq, fabsf(kargs_now()->g_qa[i])); mk = fmaxf(mk, fabsf(kargs_now()->g_ka[i]));
      }
      float* sc = (float*)(wsb + WS_SCAL);
      sc[0] = expf(s1) - expf(s2) + LAM_INIT;
      sc[1] = 8.0f * mq * mk * LOG2E;
      float mqb = 0, mkb = 0;
      for (int i = 0; i < 32; ++i) { mqb = fmaxf(mqb, fabsf(kargs_now()->g_qb[i])); mkb = fmaxf(mkb, fabsf(kargs_now()->g_kb[i])); }
      sc[2] = 5.656854249f * mqb * mkb;
      int* cnt = (int*)(wsb + WS_CNT);
      for (int i = 0; i < 32; ++i) cnt[i * CNT_STRIDE] = 0;
    }
  }
}

DI uint4 pk8(const f32x4 a, const f32x4 b) { return make_uint4(pk2(a[0], a[1]), pk2(a[2], a[3]), pk2(b[0], b[1]), pk2(b[2], b[3])); }

typedef __attribute__((ext_vector_type(4))) unsigned u32x4;
DI bf16x8 packp(const f32x16& x, int s) {
  u32x4 p;
  p[0] = pk2(x[8 * s + 0], x[8 * s + 1]); p[1] = pk2(x[8 * s + 2], x[8 * s + 3]);
  p[2] = pk2(x[8 * s + 4], x[8 * s + 5]); p[3] = pk2(x[8 * s + 6], x[8 * s + 7]);
  return __builtin_bit_cast(bf16x8, p);
}
DI int grp_of(int kk) { return ((kk >> 2) == 1 || (kk >> 2) == 2 || (kk >> 2) == 4 || (kk >> 2) == 7) ? 1 : 0; }
DI int rank_of(int kk) { const int q = kk >> 2; return kk - ((q == 0) ? 0 : (q <= 2) ? 4 : (q == 3 || q == 4) ? 8 : (q <= 6) ? 12 : 16); }
DI int key_of(int grp, int jj) { return grp ? (jj < 8 ? jj + 4 : (jj < 12 ? jj + 8 : jj + 16)) : (jj < 4 ? jj : (jj < 8 ? jj + 8 : jj + 12)); }
constexpr int DA_STAGE = 33280, DA_VOFF = 16640;
typedef __attribute__((ext_vector_type(4))) short s16x4;
DI void ph4_router_t(const Ptrs& P, ldsp lds, int bid, int G) {
  const int tid = threadIdx.x, lane = tid & 63, wave = tid >> 6, t = lane & 15, kk = lane >> 4, kh = wave & 1;
  LAS float* lg = (LAS float*)(lds + wave * 3072);
  const u16* h1 = (const u16*)(P.ws + A_H1B); const u16* WrH = (const u16*)(P.ws + WS_WR);
  const int np = blockDim.x >> 7, trips = (1024 + G * np - 1) / (G * np);
  for (int it = 0; it < trips; ++it) {
    const int item = (it * G + bid) * np + (wave >> 1);
    const bool valid = item < 1024;
    const int tok0 = valid ? item * 16 : 0;
    f32x4 acc[3] = {{0.f, 0.f, 0.f, 0.f}, {0.f, 0.f, 0.f, 0.f}, {0.f, 0.f, 0.f, 0.f}};
    const u16* ap = h1 + (size_t)(tok0 + t) * 1024 + 8 * kk + 512 * kh;
    const u16* bp = WrH + (size_t)t * 1024 + 8 * kk + 512 * kh;
#pragma unroll 4
    for (int s = 0; s < 16; ++s) {
      const bf16x8 a = *(const bf16x8*)(ap + 32 * s);
#pragma unroll
      for (int et = 0; et < 3; ++et) {
        const bf16x8 bh = *(const bf16x8*)(bp + et * 16 * 1024 + 32 * s), bl = *(const bf16x8*)(bp + (48 + et * 16) * 1024 + 32 * s);
        acc[et] = __builtin_amdgcn_mfma_f32_16x16x32_bf16(a, bh, acc[et], 0, 0, 0);
        acc[et] = __builtin_amdgcn_mfma_f32_16x16x32_bf16(a, bl, acc[et], 0, 0, 0);
      }
    }
    __syncthreads();
#pragma unroll
    for (int et = 0; et < 3; ++et)
#pragma unroll
      for (int i = 0; i < 4; ++i) lg[(4 * kk + i) * 48 + 16 * et + t] = acc[et][i];
    __syncthreads();
    if (valid && kh == 0 && lane < 16) {
      const int tok = tok0 + lane;
      const float* sp = (const float*)(P.ws + WS_SSQ1P) + (size_t)tok * SSQ_PARTS;
      const float4 s0 = *(const float4*)sp, s1 = *(const float4*)(sp + 4), s2 = *(const float4*)(sp + 8), s3 = *(const float4*)(sp + 12);
      const float rstd = rsqrtf(((s0.x + s0.y + s0.z + s0.w) + (s1.x + s1.y + s1.z + s1.w) + (s2.x + s2.y + s2.z + s2.w) + (s3.x + s3.y + s3.z + s3.w)) * (1.0f / 1024.0f) + EPS);
      const LAS float* L = lg + lane * 48;
      const LAS float* L2 = L + 768;
      float gl[4];
#pragma unroll
      for (int i = 0; i < 4; ++i) gl[i] = L[i] + L2[i];
      int gi = 0; float gm = gl[0];
#pragma unroll
      for (int i = 1; i < 4; ++i) { if (gl[i] > gm) { gm = gl[i]; gi = i; } }
      float gs = 0.f;
#pragma unroll
      for (int i = 0; i < 4; ++i) gs += expf((gl[i] - gm) * rstd);
      const float gate = 1.0f / gs;
      const LAS float* el = L + 4 + 8 * gi; const LAS float* el2 = L2 + 4 + 8 * gi;
      float ev[8];
#pragma unroll
      for (int i = 0; i < 8; ++i) ev[i] = el[i] + el2[i];
      int e1 = 0; float m1 = ev[0];
#pragma unroll
      for (int i = 1; i < 8; ++i) { if (ev[i] > m1) { m1 = ev[i]; e1 = i; } }
      int e2 = 0; float m2v = -3.0e38f;
#pragma unroll
      for (int i = 0; i < 8; ++i) { if (i != e1 && ev[i] > m2v) { m2v = ev[i]; e2 = i; } }
      const float p2 = expf((m2v - m1) * rstd);
      const float wa = gate / (1.0f + p2), wb = gate * p2 / (1.0f + p2);
      int* cnt = (int*)(P.ws + WS_CNT); int* tokl = (int*)(P.ws + WS_TOKL); float* wl = (float*)(P.ws + WS_WL);
      const int ea = gi * 8 + e1, eb = gi * 8 + e2;
      {
        ((float*)(P.ws + WS_RSTD1))[tok] = rstd;
        const int pa = atomicAdd(&cnt[ea * CNT_STRIDE], 1); tokl[ea * 16384 + pa] = tok * 2; wl[ea * 16384 + pa] = wa;
        const int pb = atomicAdd(&cnt[eb * CNT_STRIDE], 1); tokl[eb * 16384 + pb] = tok * 2 + 1; wl[eb * 16384 + pb] = wb;
      }
    }
  }
}

DI void ph4_router(const Ptrs& P, ldsp lds, int bid, int G) {
  ph4_router_t(P, lds, bid, G);
}

DI void ph7_combine(const Ptrs& P, ldsp lds, int bid, int G) {
  const int lane = threadIdx.x & 63, wave = threadIdx.x >> 6;
  const int nwv = blockDim.x >> 6;
  for (int tok = bid * nwv + wave; tok < T; tok += G * nwv) {
    const uint2* hr = (const uint2*)((const u16*)(P.ws + A_H1B) + (size_t)tok * 1024) + lane;
    const uint2* y0 = (const uint2*)((const u16*)(P.ws + A_Y0) + (size_t)tok * 1024) + lane;
    const uint2* y1 = (const uint2*)((const u16*)(P.ws + A_Y1) + (size_t)tok * 1024) + lane;
    uint2* o = (uint2*)((u16*)(P.ws + A_H2B) + (size_t)tok * 1024) + lane;
    float ss = 0.f;
#pragma unroll
    for (int j = 0; j < 4; ++j) {
      const uint2 hv = hr[64 * j], a = y0[64 * j], c = y1[64 * j];
      const float v0 = __uint_as_float(hv.x << 16) + __uint_as_float(a.x << 16) + __uint_as_float(c.x << 16);
      const float v1 = __uint_as_float(hv.x & 0xffff0000u) + __uint_as_float(a.x & 0xffff0000u) + __uint_as_float(c.x & 0xffff0000u);
      const float v2 = __uint_as_float(hv.y << 16) + __uint_as_float(a.y << 16) + __uint_as_float(c.y << 16);
      const float v3 = __uint_as_float(hv.y & 0xffff0000u) + __uint_as_float(a.y & 0xffff0000u) + __uint_as_float(c.y & 0xffff0000u);
      ss += v0 * v0 + v1 * v1 + v2 * v2 + v3 * v3;
      o[64 * j] = make_uint2(pk2(v0, v1), pk2(v2, v3));
    }
    ss = wave_sum(ss);
    float se = (lane < SSQ_PARTS) ? ((const float*)(P.ws + WS_SSQEP))[(size_t)tok * SSQ_PARTS + lane] : 0.f;
    se = wave_sum(se);
    if (lane == 0) {
      ((float*)(P.ws + WS_RSTD2))[tok] = rsqrtf(ss * (1.0f / 1024.0f) + EPS);
      ((float*)(P.ws + WS_RSTDE))[tok] = rsqrtf(se * (1.0f / 1024.0f) + EPS);
    }
  }
}

namespace g8 {
constexpr int BM = 256, BK = 64, HALF = 128, HTB = HALF * BK * 2, STAGE_BYTES = 8 * HTB, NXCD = 8, WGM = 8;
constexpr int LDS_EXTRA8 = STAGE_BYTES;
constexpr int LDS_BYTES8 = STAGE_BYTES + 4096;
DI int lds_byte(int r, int c) { const int st = (r >> 4) * 2 + (c >> 5), rr = r & 15, cc = c & 31, ob = rr * 64 + cc * 2; return st * 1024 + (ob ^ (((ob >> 9) & 1) << 5)); }
DI void stage_rc(int b, int& R, int& C) { const int st = b / 1024, sb = b % 1024, swz = sb ^ (((sb >> 9) & 1) << 5); R = (st >> 1) * 16 + swz / 64; C = (st & 1) * 32 + (swz % 64) / 2; }

struct Unit { int pm, pn, e, ce; };
struct GridOrder {
  int nM, nN, nwg, G, c; unsigned pnmap;
  DI void init(int nM_, int nN_, int G_, int c_, unsigned pnmap_ = 0u) { nM = nM_; nN = nN_; nwg = nM * nN; G = G_; c = c_; pnmap = pnmap_; }
  DI bool next(int i, Unit& u) const {
    const int L = i * G + c; if (L >= nwg) return false;
    int wgid = L; { const int q = nwg / NXCD, r = nwg % NXCD, xcd = wgid % NXCD, off = wgid / NXCD; wgid = (xcd < r ? xcd * (q + 1) : r * (q + 1) + (xcd - r) * q) + off; }
    const int nig = WGM * nN, gid = wgid / nig, fm = gid * WGM, gsz = (nM - fm) < WGM ? (nM - fm) : WGM;
    u.pm = fm + ((wgid % nig) % gsz); u.pn = (wgid % nig) / gsz; if (pnmap) u.pn = (int)((pnmap >> (4 * u.pn)) & 15u); u.e = 0; u.ce = 0; return true;
  }
};

template <class Epi, class Sched, bool SWAP, bool GATHER>
DI void gemm_phase(ldsp lds, const unsigned char* Abase, const unsigned char* Bbase, int K, const Sched& S, const Epi& E, int pA = 0, int pB = 0) {
  if (pA == 0) pA = K; if (pB == 0) pB = K;
  int tid = threadIdx.x; asm volatile("" : "+v"(tid));
  const int wid = __builtin_amdgcn_readfirstlane(tid >> 6), lane = tid & 63, wr = wid >> 2, wc = wid & 3, fr = lane & 15, fq = lane >> 4;
  const int nt = K / BK;
  int sR[2], sC[2];
  unsigned voffB[2], voffA[2];
#pragma unroll
  for (int i = 0; i < 2; ++i) { stage_rc(tid * 16 + i * 8192, sR[i], sC[i]); voffB[i] = (unsigned)(sR[i] * pB + sC[i]) * 2u; voffA[i] = (unsigned)(sR[i] * pA + sC[i]) * 2u; }
  const size_t tstepA = (size_t)BM * pA * 2;
  const size_t kstep = (size_t)(BK * 2);
  const size_t hstep = (size_t)HALF * pB * 2, hstepA = (size_t)HALF * pA * 2;
  const unsigned ldsw = (unsigned)wid * 1024u;
  const int aoff = lds_byte(wr * 64 + fr, fq * 8), boff = lds_byte(wc * 32 + fr, fq * 8);
#define G8_SA(b, h) (((b) * 2 + (h)) * HTB)
#define G8_SB(b, h) ((4 + (b) * 2 + (h)) * HTB)
#define G8_STAGE_B(bufoff, gbase) do { _Pragma("unroll") for (int _i = 0; _i < 2; ++_i) \
    __builtin_amdgcn_global_load_lds((const GAS unsigned*)((const unsigned char*)(gbase) + voffB[_i]), (LAS unsigned*)(lds + (bufoff) + ldsw + _i * 8192), 16, 0, 0); } while (0)
#define G8_STAGE_A(bufoff, hsel, nx, koff) do { _Pragma("unroll") for (int _i = 0; _i < 2; ++_i) { \
    const unsigned char* _p; \
    if (GATHER) _p = Abase + (size_t)((nx) ? ((hsel) ? nv1[_i] : nv0[_i]) : ((hsel) ? cv1[_i] : cv0[_i])) + (koff); \
    else _p = ((nx) ? nA : cA) + ((hsel) ? hstepA : (size_t)0) + voffA[_i] + (koff); \
    __builtin_amdgcn_global_load_lds((const GAS unsigned*)_p, (LAS unsigned*)(lds + (bufoff) + ldsw + _i * 8192), 16, 0, 0); } } while (0)
#define G8_LDA(dst, b, h) do { _Pragma("unroll") for (int m = 0; m < 4; ++m) _Pragma("unroll") for (int k = 0; k < 2; ++k) dst[m][k] = *(const LAS bf16x8*)(lds + G8_SA(b, h) + aoff + m * 2048 + k * 1024); } while (0)
#define G8_LDB(dst, b, h) do { _Pragma("unroll") for (int n = 0; n < 2; ++n) _Pragma("unroll") for (int k = 0; k < 2; ++k) dst[n][k] = *(const LAS bf16x8*)(lds + G8_SB(b, h) + boff + n * 2048 + k * 1024); } while (0)
#define G8_MMA(ai, bj, At, Bt) do { __builtin_amdgcn_s_setprio(1); \
    _Pragma("unroll") for (int m = 0; m < 4; ++m) _Pragma("unroll") for (int n = 0; n < 2; ++n) _Pragma("unroll") for (int k = 0; k < 2; ++k) \
        acc[ai][bj][m][n] = SWAP ? __builtin_amdgcn_mfma_f32_16x16x32_bf16(At[m][k], Bt[n][k], acc[ai][bj][m][n], 0, 0, 0) \
                                 : __builtin_amdgcn_mfma_f32_16x16x32_bf16(Bt[n][k], At[m][k], acc[ai][bj][m][n], 0, 0, 0); \
    __builtin_amdgcn_s_setprio(0); } while (0)
#define G8_WAIT_V(n) asm volatile("s_waitcnt vmcnt(" #n ")" ::: "memory")
#define G8_WAIT_L(n) asm volatile("s_waitcnt lgkmcnt(" #n ")" ::: "memory")
#define G8_BAR __builtin_amdgcn_s_barrier()
#define G8_SCHED __builtin_amdgcn_sched_barrier(0)
  Unit cur, nxt; int ui = 0;
  if (!S.next(0, cur)) return;
  f32x4 acc[2][2][4][2];
#pragma unroll
  for (int a = 0; a < 2; ++a)
#pragma unroll
    for (int b = 0; b < 2; ++b)
#pragma unroll
      for (int m = 0; m < 4; ++m)
#pragma unroll
        for (int n = 0; n < 2; ++n) acc[a][b][m][n] = (f32x4){0.f, 0.f, 0.f, 0.f};
  bf16x8 At[4][2], B0[2][2], B1[2][2];
  unsigned cv0[2] = {0u, 0u}, cv1[2] = {0u, 0u}, nv0[2] = {0u, 0u}, nv1[2] = {0u, 0u};
  const unsigned char* cA = Abase; const unsigned char* nA = Abase;
  if (GATHER) E.a_off(cur, sR, sC, cv0, cv1); else cA = Abase + (size_t)cur.pm * tstepA;
  const unsigned char* cB = Bbase + E.b_off(cur);
  G8_STAGE_B(G8_SB(0, 0), cB); G8_STAGE_A(G8_SA(0, 0), 0, false, 0); G8_STAGE_B(G8_SB(0, 1), cB + hstep); G8_STAGE_A(G8_SA(0, 1), 1, false, 0);
  if (wr == 1) G8_BAR;
  G8_WAIT_V(4); G8_BAR;
  G8_STAGE_B(G8_SB(1, 0), cB + kstep); G8_STAGE_A(G8_SA(1, 0), 0, false, kstep); G8_STAGE_B(G8_SB(1, 1), cB + hstep + kstep);
  G8_WAIT_V(6); G8_BAR;
  for (;;) {
    const bool has_next = S.next(ui + 1, nxt);
    if (GATHER) { if (has_next) E.a_off(nxt, sR, sC, nv0, nv1); else { nv0[0] = cv0[0]; nv0[1] = cv0[1]; nv1[0] = cv1[0]; nv1[1] = cv1[1]; } }
    else nA = has_next ? Abase + (size_t)nxt.pm * tstepA : cA;
    const unsigned char* nB = has_next ? Bbase + E.b_off(nxt) : cB;
#pragma unroll 1
    for (int t = 0; t < nt; t += 2) {
      const bool last = (t == nt - 2);
      const size_t k1 = (size_t)(t + 1) * kstep;
      const size_t k2 = last ? 0 : (size_t)(t + 2) * kstep, k3 = k2 + kstep;
      const unsigned char* b2 = last ? nB : cB + (size_t)(t + 2) * kstep; const unsigned char* b3 = b2 + kstep;
      G8_LDB(B0, 0, 0); G8_SCHED; G8_LDA(At, 0, 0); G8_STAGE_A(G8_SA(1, 1), 1, false, k1);
      G8_WAIT_L(8); G8_BAR; G8_WAIT_L(0); G8_MMA(0, 0, At, B0); G8_BAR; G8_SCHED;
      G8_LDB(B1, 0, 1); G8_STAGE_B(G8_SB(0, 0), b2);
      G8_BAR; G8_WAIT_L(0); G8_MMA(0, 1, At, B1); G8_BAR;
      G8_LDA(At, 0, 1); G8_STAGE_A(G8_SA(0, 0), 0, last, k2);
      G8_BAR; G8_WAIT_L(0); G8_MMA(1, 0, At, B0); G8_BAR; G8_SCHED;
      G8_STAGE_B(G8_SB(0, 1), b2 + hstep);
      G8_WAIT_V(6); G8_BAR; G8_MMA(1, 1, At, B1); G8_BAR;
      G8_LDB(B0, 1, 0); G8_SCHED; G8_LDA(At, 1, 0); G8_STAGE_A(G8_SA(0, 1), 1, last, k2);
      G8_WAIT_L(8); G8_BAR; G8_WAIT_L(0); G8_MMA(0, 0, At, B0); G8_BAR; G8_SCHED;
      G8_LDB(B1, 1, 1); G8_STAGE_B(G8_SB(1, 0), b3);
      G8_BAR; G8_WAIT_L(0); G8_MMA(0, 1, At, B1); G8_BAR;
      G8_LDA(At, 1, 1); G8_STAGE_A(G8_SA(1, 0), 0, last, k3);
      G8_BAR; G8_WAIT_L(0); G8_MMA(1, 0, At, B0); G8_BAR; G8_SCHED;
      G8_STAGE_B(G8_SB(1, 1), b3 + hstep);
      G8_WAIT_V(6); G8_BAR; G8_MMA(1, 1, At, B1); G8_BAR;
    }
    E(acc, cur, wr, wc, fr, fq);
    if (!has_next) break;
#pragma unroll
    for (int a = 0; a < 2; ++a)
#pragma unroll
      for (int b = 0; b < 2; ++b)
#pragma unroll
        for (int m = 0; m < 4; ++m)
#pragma unroll
          for (int n = 0; n < 2; ++n) acc[a][b][m][n] = (f32x4){0.f, 0.f, 0.f, 0.f};
    cur = nxt; cB = nB; cA = nA; ++ui;
    if (GATHER) { cv0[0] = nv0[0]; cv0[1] = nv0[1]; cv1[0] = nv1[0]; cv1[1] = nv1[1]; }
  }
  G8_WAIT_V(0);
  if (wr == 0) G8_BAR;
  G8_BAR;
#undef G8_SA
#undef G8_SB
#undef G8_STAGE_A
#undef G8_STAGE_B
#undef G8_LDA
#undef G8_LDB
#undef G8_MMA
#undef G8_WAIT_V
#undef G8_WAIT_L
#undef G8_BAR
#undef G8_SCHED
}
DI void dense_a_off(int pm, int K, const int (&sR)[2], const int (&sC)[2], unsigned (&v0)[2], unsigned (&v1)[2]) {
#pragma unroll
  for (int i = 0; i < 2; ++i) { v0[i] = (unsigned)((pm * BM + sR[i]) * K + sC[i]) * 2u; v1[i] = v0[i] + (unsigned)(HALF * K * 2); }
}
}

DI int win8_row(int f) {
  if (f < 1024) {
    const int rel = f & 511, pn = (f >> 9) * 2 + (rel >> 8), hl = (rel >> 7) & 1, comp = (rel >> 6) & 1, i = rel & 63;
    const int bj = i >> 5, ip = i & 31, fq = ip >> 3, n = (ip >> 2) & 1, j = ip & 3;
    return pn * 256 + 128 * bj + 32 * (2 * hl + comp) + 16 * n + 4 * fq + j;
  }
  if (f < 1536 || f >= 2560) return f;
  const int rel = (f - 1536) & 511, pn = 6 + ((f - 1536) >> 9) * 2 + (rel >> 8), hl = (rel >> 5) & 7, ip = rel & 31;
  const int bj = hl >> 2, wc = hl & 3, fq = ip >> 3, n = (ip >> 2) & 1, j = ip & 3;
  return pn * 256 + 128 * bj + 32 * wc + 16 * n + 4 * fq + j;
}
struct EpiInproj {
  const Ptrs* Pp;
  DI void a_off(const g8::Unit& u, const int (&sR)[2], const int (&sC)[2], unsigned (&v0)[2], unsigned (&v1)[2]) const { g8::dense_a_off(u.pm, 1024, sR, sC, v0, v1); }
  DI size_t b_off(const g8::Unit& u) const { return (size_t)u.pn * 256 * 1024 * 2; }
  DI void operator()(const f32x4 (&acc)[2][2][4][2], const g8::Unit& u, int wr, int wc, int fr, int fq) const {
    const Ptrs& P = *Pp;
    const float* rstdx = (const float*)(P.ws + WS_RSTDX);
    asm volatile("" : "+v"(rstdx));
    const int pn = u.pn, row00 = u.pm * 256 + wr * 64, b = row00 >> 12;
    float rsr[8];
#pragma unroll
    for (int k = 0; k < 8; ++k) rsr[k] = rstdx[row00 + 128 * (k >> 2) + 16 * (k & 3) + fr];
    const float qsA = 0.125f * LOG2E, qsB = 0.17677669529663687f * LOG2E;
    if (pn < 4) {
      const int isk = pn >= 2, head = 2 * (pn & 1) + (wc >> 1), comp = wc & 1;
      const float* gg = ((const float*)(P.ws + WS_PAR)) + (isk ? PAR_GKA : PAR_GQA);
      asm volatile("" : "+v"(gg));
      const float4 g1a = *(const float4*)(gg + 8 * fq), g1b = *(const float4*)(gg + 8 * fq + 4), g2a = *(const float4*)(gg + 32 + 8 * fq), g2b = *(const float4*)(gg + 36 + 8 * fq);
      const float ga[8] = {g1a.x, g1a.y, g1a.z, g1a.w, g1b.x, g1b.y, g1b.z, g1b.w}, gb[8] = {g2a.x, g2a.y, g2a.z, g2a.w, g2b.x, g2b.y, g2b.z, g2b.w};
      u16* dstb = (u16*)(P.ws + (isk ? A_KA : A_QA)) + (size_t)(b * 4 + head) * 4096 * 128 + comp * 64 + 8 * fq;
      const float2* rope = (const float2*)(P.ws + WS_ROPE);
      struct Rp { f32x4 c0, c1, c2, c3; };
      auto ldrope = [&](int k) { const int s = (row00 + 128 * (k >> 2) + 16 * (k & 3) + fr) & 4095; const f32x4* rp = (const f32x4*)(rope + (size_t)s * 32 + 8 * fq);
        Rp r; r.c0 = rp[0]; r.c1 = rp[1]; r.c2 = rp[2]; r.c3 = rp[3]; return r; };
      Rp cur = ldrope(0);
#pragma unroll
      for (int k = 0; k < 8; ++k) {
        const int ai = k >> 2, m = k & 3;
        Rp nxt = cur;
        if (k < 7) nxt = ldrope(k + 1);
        const int row = row00 + 128 * ai + 16 * m + fr, s = row & 4095;
        const float rs = rsr[k];
        float x1[8], x2[8]; float ss = 0.f;
#pragma unroll
        for (int n = 0; n < 2; ++n)
#pragma unroll
          for (int j = 0; j < 4; ++j) { x1[4 * n + j] = acc[ai][0][m][n][j] * rs; x2[4 * n + j] = acc[ai][1][m][n][j] * rs; ss += x1[4 * n + j] * x1[4 * n + j] + x2[4 * n + j] * x2[4 * n + j]; }
        ss += __shfl_xor(ss, 16); ss += __shfl_xor(ss, 32);
        const float rn = rsqrtf(ss * (1.0f / 64.0f) + EPS) * (isk ? 1.0f : qsA);
        const float cs[8] = {cur.c0[0], cur.c0[2], cur.c1[0], cur.c1[2], cur.c2[0], cur.c2[2], cur.c3[0], cur.c3[2]}, sn[8] = {cur.c0[1], cur.c0[3], cur.c1[1], cur.c1[3], cur.c2[1], cur.c2[3], cur.c3[1], cur.c3[3]};
        f32x4 o1a, o1b, o2a, o2b;
#pragma unroll
        for (int e = 0; e < 8; ++e) {
          const float y = x1[e] * rn * ga[e], z = x2[e] * rn * gb[e];
          const float p1 = y * cs[e] - z * sn[e], p2 = z * cs[e] + y * sn[e];
          if (e < 4) { o1a[e] = p1; o2a[e] = p2; } else { o1b[e - 4] = p1; o2b[e - 4] = p2; }
        }
        u16* d = dstb + (size_t)s * 128;
        *(uint4*)d = pk8(o1a, o1b);
        *(uint4*)(d + 32) = pk8(o2a, o2b);
        asm volatile("" ::: "memory");
        cur = nxt;
      }
    } else if (pn >= 6 && pn < 10) {
      const int isk = pn >= 8;
      const float* gg = ((const float*)(P.ws + WS_PAR)) + (isk ? PAR_GKB : PAR_GQB);
      asm volatile("" : "+v"(gg));
      const float4 g1a = *(const float4*)(gg + 8 * fq), g1b = *(const float4*)(gg + 8 * fq + 4);
      const float ga[8] = {g1a.x, g1a.y, g1a.z, g1a.w, g1b.x, g1b.y, g1b.z, g1b.w};
#pragma unroll
      for (int bj = 0; bj < 2; ++bj) {
        const int hd = 8 * (pn & 1) + 4 * bj + wc;
        u16* dstb = (u16*)(P.ws + (isk ? A_KB : A_QB)) + (size_t)(b * 16 + hd) * 4096 * 32 + 8 * fq;
#pragma unroll
        for (int ai = 0; ai < 2; ++ai)
#pragma unroll
          for (int m = 0; m < 4; ++m) {
            const int row = row00 + 128 * ai + 16 * m + fr, s = row & 4095;
            const float rs = rsr[4 * ai + m];
            float x[8]; float ss = 0.f;
#pragma unroll
            for (int n = 0; n < 2; ++n)
#pragma unroll
              for (int j = 0; j < 4; ++j) { x[4 * n + j] = acc[ai][bj][m][n][j] * rs; ss += x[4 * n + j] * x[4 * n + j]; }
            ss += __shfl_xor(ss, 16); ss += __shfl_xor(ss, 32);
            const float rn = rsqrtf(ss * (1.0f / 32.0f) + EPS) * (isk ? 1.0f : qsB);
            f32x4 oa, ob;
#pragma unroll
            for (int e = 0; e < 4; ++e) { oa[e] = x[e] * rn * ga[e]; ob[e] = x[4 + e] * rn * ga[4 + e]; }
            *(uint4*)(dstb + (size_t)s * 32) = pk8(oa, ob);
          }
      }
    } else {
      const int isA = pn < 6;
#pragma unroll
      for (int ai = 0; ai < 2; ++ai)
#pragma unroll
        for (int m = 0; m < 4; ++m) {
          const int row0 = row00 + 128 * ai + 16 * m + 4 * fq, s0 = row0 & 4095;
          const float4 rs = *(const float4*)(rstdx + row0);
          const int sp = isA ? permpos(s0) : s0;
#pragma unroll
          for (int bj = 0; bj < 2; ++bj)
#pragma unroll
            for (int n = 0; n < 2; ++n) {
              const int c = 128 * bj + 32 * wc + 16 * n + fr;
              u16* dst;
              if (isA) dst = (u16*)(P.ws + A_VAT) + ((size_t)(b * 4 + 2 * (pn - 4) + (c >> 7)) * 128 + (c & 127)) * 4096;
              else dst = (u16*)(P.ws + A_VBT) + ((size_t)(b * 16 + 8 * (pn - 10) + (c >> 5)) * 32 + (c & 31)) * 4096;
              const f32x4 v = acc[ai][bj][m][n];
              *(uint2*)(dst + sp) = make_uint2(pk2(v[0] * rs.x, v[1] * rs.y), pk2(v[2] * rs.z, v[3] * rs.w));
            }
        }
    }
  }
};
DI void ph1_inproj8(const Ptrs& P, ldsp lds, int bid, int G) {
  EpiInproj E; E.Pp = &P;
  {
    g8::GridOrder S; S.init(64, 8, G, bid, 0x98763210u);
    g8::gemm_phase<EpiInproj, g8::GridOrder, false, false>(lds, (const unsigned char*)(P.ws + A_XB), (const unsigned char*)(P.ws + WS_WIN), 1024, S, E);
  }
  {
    g8::GridOrder S; S.init(64, 4, G, bid, 0xBA54u);
    g8::gemm_phase<EpiInproj, g8::GridOrder, true, false>(lds, (const unsigned char*)(P.ws + A_XB), (const unsigned char*)(P.ws + WS_WIN), 1024, S, E);
  }
}

DI int p32(int ip) { return 16 * ((ip >> 2) & 1) + 4 * (ip >> 3) + (ip & 3); }
DI int perm256(int f) { return (f & ~31) | p32(f & 31); }
DI int w13_row_w1(int f) { return ((f >> 7) << 8) | (f & 96) | p32(f & 31); }
DI int w13_row_w3(int f) { return (((f >> 7) << 8) | (f & 96) | p32(f & 31)) + 128; }

template <bool PLE>
struct EpiOut {
  const Ptrs* Pp;
  DI void a_off(const g8::Unit&, const int (&)[2], const int (&)[2], unsigned (&)[2], unsigned (&)[2]) const {}
  DI size_t b_off(const g8::Unit& u) const { return (size_t)u.pn * 256 * (PLE ? 256 : 1024) * 2; }
  struct Ld { float4 a0, a1, b0, b1; };
  DI void operator()(const f32x4 (&acc)[2][2][4][2], const g8::Unit& u, int wr, int wc, int fr, int fq) const {
    const Ptrs& P = *Pp;
    float* ssqp = (float*)(P.ws + (PLE ? WS_SSQEP : WS_SSQ1P));
    const int row0 = u.pm * 256 + 64 * wr + fr, col0 = u.pn * 256 + 32 * wc + 8 * fq;
    auto load = [&](int gidx) { const int ai = gidx >> 2, m = gidx & 3; const size_t go = (size_t)(row0 + 128 * ai + 16 * m) * 1024 + col0;
      Ld l; if (!PLE) { const u16* xbp = (const u16*)(P.ws + A_XB) + go; const uint4 ua = *(const uint4*)xbp, ub = *(const uint4*)(xbp + 128);
        l.a0 = make_float4(__uint_as_float(ua.x << 16), __uint_as_float(ua.x & 0xffff0000u), __uint_as_float(ua.y << 16), __uint_as_float(ua.y & 0xffff0000u));
        l.a1 = make_float4(__uint_as_float(ua.z << 16), __uint_as_float(ua.z & 0xffff0000u), __uint_as_float(ua.w << 16), __uint_as_float(ua.w & 0xffff0000u));
        l.b0 = make_float4(__uint_as_float(ub.x << 16), __uint_as_float(ub.x & 0xffff0000u), __uint_as_float(ub.y << 16), __uint_as_float(ub.y & 0xffff0000u));
        l.b1 = make_float4(__uint_as_float(ub.z << 16), __uint_as_float(ub.z & 0xffff0000u), __uint_as_float(ub.w << 16), __uint_as_float(ub.w & 0xffff0000u)); }
      else { l.a0 = l.a1 = l.b0 = l.b1 = make_float4(0.f, 0.f, 0.f, 0.f); } return l; };
    Ld cur = load(0);
#pragma unroll
    for (int gidx = 0; gidx < 8; ++gidx) {
      const int ai = gidx >> 2, m = gidx & 3;
      Ld nxt = cur;
      if (gidx < 7) nxt = load(gidx + 1);
      const int row = row0 + 128 * ai + 16 * m;
      float ss = 0.f;
#pragma unroll
      for (int bj = 0; bj < 2; ++bj) {
        const size_t go = (size_t)row * 1024 + col0 + 128 * bj;
        f32x4 a = acc[ai][bj][m][0], c4 = acc[ai][bj][m][1];
        if (!PLE) {
          const float4 xa = bj ? cur.b0 : cur.a0, xb4 = bj ? cur.b1 : cur.a1;
          a[0] += xa.x; a[1] += xa.y; a[2] += xa.z; a[3] += xa.w; c4[0] += xb4.x; c4[1] += xb4.y; c4[2] += xb4.z; c4[3] += xb4.w;
          *(uint4*)((u16*)(P.ws + A_H1B) + go) = pk8(a, c4);
        } else {
          *(uint4*)((u16*)(P.ws + A_EBF) + go) = pk8(a, c4);
        }
        ss += a[0] * a[0] + a[1] * a[1] + a[2] * a[2] + a[3] * a[3] + c4[0] * c4[0] + c4[1] * c4[1] + c4[2] * c4[2] + c4[3] * c4[3];
      }
      ss += __shfl_xor(ss, 16); ss += __shfl_xor(ss, 32);
      if (fq == 0) ssqp[(size_t)row * 16 + u.pn * 4 + wc] = ss;
      asm volatile("" ::: "memory");
      cur = nxt;
    }
  }
};
DI void ph3_outproj8(const Ptrs& P, ldsp lds, int bid, int G) {
  { EpiOut<false> E; E.Pp = &P; g8::GridOrder S; S.init(64, 4, G, bid);
    g8::gemm_phase<EpiOut<false>, g8::GridOrder, false, false>(lds, (const unsigned char*)(P.ws + A_AO), (const unsigned char*)(P.ws + WS_WOUT), 1024, S, E); }
}

DI int moe_plan8(const Ptrs& P, ldsp lds) {
  LAS int* smb = (LAS int*)(lds + g8::LDS_EXTRA8);
  __syncthreads();
  if (threadIdx.x == 0) {
    const int* cnt = (const int*)(P.ws + WS_CNT);
    int a = 0;
    for (int e = 0; e < 32; ++e) { smb[e] = a; a += (cnt[e * CNT_STRIDE] + 255) >> 8; smb[64 + e] = cnt[e * CNT_STRIDE]; }
    smb[32] = a;
  }
  __syncthreads();
  return smb[32];
}
struct MoeOrder {
  int MB, G, c; const LAS int* smb;
  DI bool next(int i, g8::Unit& u) const {
    const int L = i * G + c;
    if (L >= ((MB + 7) >> 3) * 32) return false;
    const int gmb = (L >> 5) * 8 + (L & 7);
    u.pn = (L >> 3) & 3;
    if (gmb >= MB) return false;
    int e = 0; while (gmb >= smb[e + 1]) ++e;
    u.pm = gmb; u.e = e; u.ce = smb[64 + e] - (gmb - smb[e]) * 256;
    return true;
  }
};
struct EpiUp {
  const Ptrs* Pp; const LAS int* smb;
  DI void a_off(const g8::Unit& u, const int (&sR)[2], const int (&sC)[2], unsigned (&v0)[2], unsigned (&v1)[2]) const {
    const int* tokl = (const int*)(Pp->ws + WS_TOKL) + u.e * 16384 + (u.pm - smb[u.e]) * 256;
#pragma unroll
    for (int i = 0; i < 2; ++i) {
      const int r0 = sR[i], r1 = 128 + sR[i];
      const int t0 = (r0 < u.ce) ? (tokl[r0] >> 1) : 0, t1 = (r1 < u.ce) ? (tokl[r1] >> 1) : 0;
      v0[i] = (unsigned)(t0 * 1024 + sC[i]) * 2u; v1[i] = (unsigned)(t1 * 1024 + sC[i]) * 2u;
    }
  }
  DI size_t b_off(const g8::Unit& u) const { return ((size_t)u.e * 1024 + u.pn * 256) * 1024 * 2; }
  DI void operator()(const f32x4 (&acc)[2][2][4][2], const g8::Unit& u, int wr, int wc, int fr, int fq) const {
    const Ptrs& P = *Pp;
    if (u.ce <= 0) return;
    const int* tokl = (const int*)(P.ws + WS_TOKL) + u.e * 16384 + (u.pm - smb[u.e]) * 256;
    const float* rstd1 = (const float*)(P.ws + WS_RSTD1);
    u16* hid = (u16*)(P.ws + A_HID);
    float rsv[8];
    {
      int tk[8];
#pragma unroll
      for (int k = 0; k < 8; ++k) { const int rl = 128 * (k >> 2) + 64 * wr + 16 * (k & 3) + fr; tk[k] = (rl < u.ce) ? (tokl[rl] >> 1) : -1; }
#pragma unroll
      for (int k = 0; k < 8; ++k) rsv[k] = (tk[k] >= 0) ? rstd1[tk[k]] : 0.0f;
    }
#pragma unroll
    for (int ai = 0; ai < 2; ++ai)
#pragma unroll
      for (int m = 0; m < 4; ++m) {
        const int rl = 128 * ai + 64 * wr + 16 * m + fr;
        const float rs = rsv[4 * ai + m];
        f32x4 h0, h1;
#pragma unroll
        for (int j = 0; j < 4; ++j) {
          const float a = acc[ai][0][m][0][j] * rs, b = acc[ai][0][m][1][j] * rs;
          h0[j] = a / (1.0f + __expf(-a)) * (acc[ai][1][m][0][j] * rs); h1[j] = b / (1.0f + __expf(-b)) * (acc[ai][1][m][1][j] * rs);
        }
        *(uint4*)(hid + (size_t)(u.pm * 256 + rl) * 512 + u.pn * 128 + 32 * wc + 8 * fq) = pk8(h0, h1);
      }
  }
};
DI void ph5_up8(const Ptrs& P, ldsp lds, int bid, int G) {
  const int MB = moe_plan8(P, lds);
  const LAS int* smb = (const LAS int*)(lds + g8::LDS_EXTRA8);
  MoeOrder S; S.MB = MB; S.G = G; S.c = bid; S.smb = smb;
  EpiUp E; E.Pp = &P; E.smb = smb;
  g8::gemm_phase<EpiUp, MoeOrder, false, true>(lds, (const unsigned char*)(P.ws + A_H1B), (const unsigned char*)(P.ws + WS_W13), 1024, S, E);
  {
    const int NU = ((MB + 7) >> 3) * 32, rem = NU % G, nl = rem ? G - rem : G, li = rem ? bid - rem : bid;
    EpiOut<true> E2; E2.Pp = &P; g8::GridOrder S2; S2.init(64, 4, nl, li < 0 ? 0 : li);
    if (li < 0) S2.nwg = 0;
    g8::gemm_phase<EpiOut<true>, g8::GridOrder, false, false>(lds, (const unsigned char*)(P.ws + A_PB), (const unsigned char*)(P.ws + WS_WPLE), 256, S2, E2);
    if (li >= 0) {
      const int lane = threadIdx.x & 63, wave = threadIdx.x >> 6, nwv = blockDim.x >> 6;
      LAS float* scr = (LAS float*)(lds + wave * 16640);
      for (int r = li * nwv + wave; r < 4096 + 256; r += nl * nwv) late_weight_item(r, scr, lane);
    }
  }
}
struct EpiDown {
  const Ptrs* Pp; const LAS int* smb;
  DI void a_off(const g8::Unit&, const int (&)[2], const int (&)[2], unsigned (&)[2], unsigned (&)[2]) const {}
  DI size_t b_off(const g8::Unit& u) const { return ((size_t)u.e * 1024 + u.pn * 256) * 512 * 2; }
  DI void operator()(const f32x4 (&acc)[2][2][4][2], const g8::Unit& u, int wr, int wc, int fr, int fq) const {
    const Ptrs& P = *Pp;
    if (u.ce <= 0) return;
    const int base = u.e * 16384 + (u.pm - smb[u.e]) * 256;
    const int* tokl = (const int*)(P.ws + WS_TOKL) + base; const float* wl = (const float*)(P.ws + WS_WL) + base;
    int tkv[8]; float wv[8];
#pragma unroll
    for (int k = 0; k < 8; ++k) { const int rl = 128 * (k >> 2) + 64 * wr + 16 * (k & 3) + fr; const bool v = rl < u.ce; tkv[k] = v ? tokl[rl] : -1; wv[k] = v ? wl[rl] : 0.0f; }
#pragma unroll
    for (int ai = 0; ai < 2; ++ai)
#pragma unroll
      for (int m = 0; m < 4; ++m) {
        const int tk = tkv[4 * ai + m];
        if (tk >= 0) {
          const float w = wv[4 * ai + m];
          u16* y = (u16*)(P.ws + ((tk & 1) ? A_Y1 : A_Y0)) + (size_t)(tk >> 1) * 1024 + u.pn * 256 + 32 * wc + 8 * fq;
#pragma unroll
          for (int bj = 0; bj < 2; ++bj) {
            f32x4 a = acc[ai][bj][m][0], c4 = acc[ai][bj][m][1];
#pragma unroll
            for (int j = 0; j < 4; ++j) { a[j] *= w; c4[j] *= w; }
            *(uint4*)(y + 128 * bj) = pk8(a, c4);
          }
        }
      }
  }
};
DI void ph6_down8(const Ptrs& P, ldsp lds, int bid, int G) {
  const int MB = moe_plan8(P, lds);
  const LAS int* smb = (const LAS int*)(lds + g8::LDS_EXTRA8);
  MoeOrder S; S.MB = MB; S.G = G; S.c = bid; S.smb = smb;
  EpiDown E; E.Pp = &P; E.smb = smb;
  g8::gemm_phase<EpiDown, MoeOrder, false, false>(lds, (const unsigned char*)(P.ws + A_HID), (const unsigned char*)(P.ws + WS_W2), 512, S, E);
}

struct EpiFinal {
  const Ptrs* Pp;
  DI void a_off(const g8::Unit&, const int (&)[2], const int (&)[2], unsigned (&)[2], unsigned (&)[2]) const {}
  DI size_t b_off(const g8::Unit& u) const { return (size_t)u.pn * 256 * 1024 * 2; }
  struct Ld { u32x4 hh; u32x4 ee; };
  DI void operator()(const f32x4 (&acc)[2][2][4][2], const g8::Unit& u, int wr, int wc, int fr, int fq) const {
    const Ptrs& P = *Pp;
    const float* rstd2 = (const float*)(P.ws + WS_RSTD2); const float* rstdE = (const float*)(P.ws + WS_RSTDE);
    const int row0 = u.pm * 256 + 64 * wr + fr, col0 = u.pn * 256 + 32 * wc + 8 * fq;
    auto load = [&](int gidx) { const int bj = gidx >> 3, ai = (gidx >> 2) & 1, m = gidx & 3; const int row = row0 + 128 * ai + 16 * m; const size_t go = (size_t)row * 1024 + col0 + 128 * bj;
      Ld l;
      l.hh = *(const u32x4*)((const u16*)(P.ws + A_H2B) + go); l.ee = *(const u32x4*)((const u16*)(P.ws + A_EBF) + go); return l; };
    Ld cur = load(0);
    float gv[8];
#pragma unroll
    for (int gidx = 0; gidx < 16; ++gidx) {
      const int bj = gidx >> 3, ai = (gidx >> 2) & 1, m = gidx & 3;
      if ((gidx & 7) == 0) { const float4 ga = *(const float4*)(P.g_ple + col0 + 128 * bj), gb = *(const float4*)(P.g_ple + col0 + 128 * bj + 4);
        gv[0] = ga.x; gv[1] = ga.y; gv[2] = ga.z; gv[3] = ga.w; gv[4] = gb.x; gv[5] = gb.y; gv[6] = gb.z; gv[7] = gb.w; }
      Ld nxt = cur;
      if (gidx < 15) nxt = load(gidx + 1);
      const size_t go = (size_t)(row0 + 128 * ai + 16 * m) * 1024 + col0 + 128 * bj;
      const int row = row0 + 128 * ai + 16 * m;
      const float rs2 = rstd2[row], rE = rstdE[row];
      float hv[8];
#pragma unroll
      for (int k = 0; k < 8; ++k) hv[k] = __uint_as_float((cur.hh[k >> 1] << ((k & 1) ? 0u : 16u)) & 0xffff0000u);
      const f32x4 a = acc[ai][bj][m][0], c4 = acc[ai][bj][m][1];
      const float av[8] = {a[0], a[1], a[2], a[3], c4[0], c4[1], c4[2], c4[3]};
      const unsigned eeu[4] = {cur.ee[0], cur.ee[1], cur.ee[2], cur.ee[3]};
#pragma unroll
      for (int k = 0; k < 8; ++k) {
        const unsigned sh = (k & 1) ? 0u : 16u;
        const float ev = __uint_as_float((eeu[k >> 1] << sh) & 0xffff0000u);
        const float sg = 1.0f / (1.0f + __expf(-av[k] * rs2));
        hv[k] = hv[k] + ev * rE * gv[k] * sg;
      }
      float* wr_ = P.out + go;
      __builtin_nontemporal_store((f32x4){hv[0], hv[1], hv[2], hv[3]}, (f32x4*)wr_); __builtin_nontemporal_store((f32x4){hv[4], hv[5], hv[6], hv[7]}, (f32x4*)(wr_ + 4));
      asm volatile("" ::: "memory");
      cur = nxt;
    }
  }
};
DI void ph8_final8(const Ptrs& P, ldsp lds, int bid, int G) {
  EpiFinal E; E.Pp = &P; g8::GridOrder S; S.init(64, 4, G, bid);
  g8::gemm_phase<EpiFinal, g8::GridOrder, false, false>(lds, (const unsigned char*)(P.ws + A_H2B), (const unsigned char*)(P.ws + WS_WPLG), 1024, S, E);
}

template <bool SHIFT>
DI void da_item8(const Ptrs& P, ldsp lds, int item, float lam, float m2) {
  const int tid = threadIdx.x, lane = tid & 63, wave = __builtin_amdgcn_readfirstlane(tid >> 6), h = lane >> 5, i31 = lane & 31;
  const int xcd = item & 7, loc = item >> 3, bh = 2 * xcd + (loc >> 4), qblk = loc & 15;
  const u16* qA = (const u16*)(P.ws + A_QA) + (size_t)bh * 4096 * 128;
  const u16* kA = (const u16*)(P.ws + A_KA) + (size_t)bh * 4096 * 128;
  const u16* vAt = (const u16*)(P.ws + A_VAT) + (size_t)bh * 128 * 4096;
  const int q = qblk * 256 + 32 * wave + i31;
  bf16x8 qf[2][4];
#pragma unroll
  for (int c = 0; c < 2; ++c)
#pragma unroll
    for (int s = 0; s < 4; ++s) qf[c][s] = *(const bf16x8*)(qA + (size_t)q * 128 + c * 64 + 16 * s + 8 * h);
  auto stage = [&](int buf, int tile) {
    int ln = lane; asm volatile("" : "+v"(ln));
    ldsp lk = lds + buf * DA_STAGE;
    const u16* kt = kA + (size_t)tile * 64 * 128;
    const u16* vt = vAt + tile * 64;
#pragma unroll
    for (int qq = 0; qq < 2; ++qq) {
      const int jj = 2 * wave + qq;
      const int ra = key_of(0, jj), rb = key_of(1, jj);
      const int ku = ln >> 4, key = 32 * (ku >> 1) + ((ku & 1) ? rb : ra);
      glds16(kt + key * 128 + (ln & 15) * 8, lk + jj * 1040);
      const int vu = ln >> 3, d = 32 * (vu >> 1) + ((vu & 1) ? rb : ra);
      glds16(vt + d * 4096 + (ln & 7) * 8, lk + DA_VOFF + jj * 1040);
    }
  };
  const int rk = rank_of(i31), gr = grp_of(i31);
  const int kbase = rk * 1040 + gr * 256 + h * 16;
  const int vbase = DA_VOFF + rk * 1040 + gr * 128 + h * 16;
  f32x16 O1[4], O2[4];
#pragma unroll
  for (int dt = 0; dt < 4; ++dt)
#pragma unroll
    for (int e = 0; e < 16; ++e) { O1[dt][e] = 0.f; O2[dt][e] = 0.f; }
  float l1 = 0.f, l2 = 0.f;
  __syncthreads();
  stage(0, 0);
  stage(1, 1);
  asm volatile("s_waitcnt vmcnt(4)" ::: "memory");
  __builtin_amdgcn_s_barrier();
  int buf = 0;
  for (int tile = 0; tile < 64; ++tile) {
    if (tile + 2 < 64) stage(buf >= 1 ? buf - 1 : 2, tile + 2);
    ldsp lb = lds + buf * DA_STAGE;
#pragma unroll 1
    for (int kt2 = 0; kt2 < 2; ++kt2) {
      bf16x8 pf[2][2];
      ldsp lk = lb + kbase + kt2 * 512;
      ldsp lv = lb + vbase + kt2 * 64;
#pragma unroll
      for (int c = 0; c < 2; ++c) {
        f32x16 sa;
#pragma unroll
        for (int e = 0; e < 16; ++e) sa[e] = 0.f;
#pragma unroll
        for (int s = 0; s < 4; ++s) {
          const bf16x8 kf = *(LAS bf16x8*)(lk + c * 128 + s * 32);
          sa = __builtin_amdgcn_mfma_f32_32x32x16_bf16(kf, qf[c][s], sa, 0, 0, 0);
        }
        float ls = 0.f;
#pragma unroll
        for (int e = 0; e < 16; ++e) { sa[e] = __builtin_amdgcn_exp2f(SHIFT ? sa[e] - m2 : sa[e]); ls += sa[e]; }
        if (c == 0) l1 += ls; else l2 += ls;
        pf[c][0] = packp(sa, 0); pf[c][1] = packp(sa, 1);
      }
      __builtin_amdgcn_sched_barrier(0);
      bf16x8 va = *(LAS bf16x8*)(lv), vb = *(LAS bf16x8*)(lv + 256);
#pragma unroll
      for (int st = 0; st < 4; ++st) {
        const int s2 = st >> 1, dtp = st & 1;
        bf16x8 na = va, nb = vb;
        if (st < 3) { const int s2n = (st + 1) >> 1, dn = (st + 1) & 1; na = *(LAS bf16x8*)(lv + s2n * 32 + dn * 512); nb = *(LAS bf16x8*)(lv + s2n * 32 + dn * 512 + 256); }
        __builtin_amdgcn_sched_barrier(0);
        __builtin_amdgcn_s_setprio(1);
        O1[2 * dtp] = __builtin_amdgcn_mfma_f32_32x32x16_bf16(va, pf[0][s2], O1[2 * dtp], 0, 0, 0);
        O2[2 * dtp] = __builtin_amdgcn_mfma_f32_32x32x16_bf16(va, pf[1][s2], O2[2 * dtp], 0, 0, 0);
        O1[2 * dtp + 1] = __builtin_amdgcn_mfma_f32_32x32x16_bf16(vb, pf[0][s2], O1[2 * dtp + 1], 0, 0, 0);
        O2[2 * dtp + 1] = __builtin_amdgcn_mfma_f32_32x32x16_bf16(vb, pf[1][s2], O2[2 * dtp + 1], 0, 0, 0);
        __builtin_amdgcn_s_setprio(0);
        __builtin_amdgcn_sched_barrier(0);
        va = na; vb = nb;
      }
    }
    if (tile + 2 < 64) asm volatile("s_waitcnt vmcnt(4)" ::: "memory"); else asm volatile("s_waitcnt vmcnt(0)" ::: "memory");
    __builtin_amdgcn_s_barrier();
    buf = (buf == 2) ? 0 : buf + 1;
  }
  l1 += __shfl_xor(l1, 32); l2 += __shfl_xor(l2, 32);
  const float i1 = 1.0f / l1, i2 = lam / l2;
  float ss = 0.f;
#pragma unroll
  for (int dt = 0; dt < 4; ++dt)
#pragma unroll
    for (int e = 0; e < 16; ++e) { const float o = O1[dt][e] * i1 - O2[dt][e] * i2; O1[dt][e] = o; ss += o * o; }
  ss += __shfl_xor(ss, 32);
  const float rn = rsqrtf(ss * (1.0f / 128.0f) + EPS) * (1.0f - LAM_INIT);
  const int b = bh >> 2, hh = bh & 3;
  u16* dst = (u16*)(P.ws + A_AO) + ((size_t)b * 4096 + q) * 1024 + hh * 128;
#pragma unroll
  for (int dt = 0; dt < 4; ++dt)
#pragma unroll
    for (int g = 0; g < 4; ++g) {
      const int d0 = 32 * dt + 8 * g + 4 * h;
      const float4 gs = *(const float4*)(P.g_sub + d0);
      *(uint2*)(dst + d0) = make_uint2(pk2(O1[dt][4 * g] * rn * gs.x, O1[dt][4 * g + 1] * rn * gs.y), pk2(O1[dt][4 * g + 2] * rn * gs.z, O1[dt][4 * g + 3] * rn * gs.w));
    }
}

constexpr int NA8_VSTRIDE = 1936;
constexpr int NA8_TAB = 32 * NA8_VSTRIDE;
DI void na_block8(const Ptrs& P, ldsp lds, int item, float qkbound) {
  const int tid = threadIdx.x, lane = tid & 63, wave = tid >> 6;
  const int r0 = (item & 7) * 8, hd = (item >> 3) & 15, b = item >> 7;
  const int qi = lane & 15, g = lane >> 4;
  LAS float* EB = (LAS float*)(lds + NA8_TAB);
  LAS float* RW = EB + 960;
  const int R0 = min(max(r0 - 4, 0), 56), NR = min(15, 64 - R0);
  const u16* vB = (const u16*)(P.ws + A_VBT) + (size_t)(b * 16 + hd) * 32 * 4096;
  __syncthreads();
  {
    u32x4 vv[8];
#pragma unroll
    for (int k = 0; k < 8; ++k) {
      const int sg = (tid >> 3) + 64 * k, d = sg / NR, kr = sg - d * NR;
      vv[k] = *(const u32x4*)(vB + (size_t)min(d, 31) * 4096 + (R0 + min(kr, NR - 1)) * 64 + 8 * (tid & 7));
    }
    float mxa = 0.f;
    const float r0v = (tid < 465) ? P.rpb[hd * 465 + tid] : 0.f;
    mxa = fabsf(r0v);
#pragma unroll
    for (int o = 1; o < 64; o <<= 1) mxa = fmaxf(mxa, __shfl_xor(mxa, o));
    LAS float* red = (LAS float*)(lds + NA8_TAB + 7680);
    if (lane == 0) red[wave] = mxa;
#pragma unroll
    for (int k = 0; k < 8; ++k) {
      const int sg = (tid >> 3) + 64 * k, d = sg / NR, kr = sg - d * NR;
      if (sg < 32 * NR) *(LAS u32x4*)(lds + d * NA8_VSTRIDE + kr * 128 + 16 * (tid & 7)) = vv[k];
    }
    __syncthreads();
    const float m2 = (qkbound + fmaxf(fmaxf(fmaxf(red[0], red[1]), fmaxf(red[2], red[3])), fmaxf(fmaxf(red[4], red[5]), fmaxf(red[6], red[7])))) * LOG2E;
    for (int e = tid; e < 960; e += 512) {
      const int br = e >> 6, co = (e & 63) - 16;
      const float v = (co >= 0 && co <= 30) ? P.rpb[hd * 465 + br * 31 + co] * LOG2E - m2 : -1e30f;
      RW[e] = v;
      EB[e] = (co >= 7 && co <= 22) ? v : -1e30f;
    }
    __syncthreads();
  }
  const int r = r0 + wave;
  const int rs = min(max(r - 4, 0), 56), rb0 = rs - r + 7;
  const u16* qB = (const u16*)(P.ws + A_QB) + (size_t)(b * 16 + hd) * 4096 * 32;
  const u16* kBp = (const u16*)(P.ws + A_KB) + (size_t)(b * 16 + hd) * 4096 * 32;
  bf16x8 kf[16], qf;
  auto issue_kq = [&](int jq) {
    const int kb = min(min(max(16 * jq - 8, 0), 48), 32);
    const u16* kp = kBp + (size_t)(rs * 64 + kb + qi) * 32 + 8 * g;
    qf = *(const bf16x8*)(qB + (size_t)(r * 64 + 16 * jq + qi) * 32 + 8 * g);
#pragma unroll
    for (int ri = 0; ri < 8; ++ri)
#pragma unroll
      for (int t = 0; t < 2; ++t) kf[2 * ri + t] = *(const bf16x8*)(kp + (ri * 64 + 16 * t) * 32);
  };
  issue_kq(0);
#pragma unroll 1
  for (int jq = 0; jq < 4; ++jq) {
    const int kb = min(min(max(16 * jq - 8, 0), 48), 32);
    const LAS float* tb[2];
    {
      const int cobase = (jq == 0) ? 15 : ((jq == 3) ? -1 : 7);
#pragma unroll
      for (int t = 0; t < 2; ++t) {
        const int off = rb0 * 64 + cobase + 16 * t + 4 * g - qi + 16;
        const LAS float* pe = EB + off; const LAS float* pr = RW + off; const LAS float* pn = RW + 48;
        const LAS float* sel = pe;
        if (jq == 0 && qi < 8) sel = (t == 0) ? pr : pn;
        if (jq == 3 && qi > 8) sel = (t == 1) ? pr : pn;
        tb[t] = sel;
      }
    }
    f32x4 sa[8][2];
#pragma unroll
    for (int ri = 0; ri < 8; ++ri)
#pragma unroll
      for (int t = 0; t < 2; ++t) {
        const LAS float* tp = tb[t] + ri * 64;
        const f32x4 ci = {tp[0], tp[1], tp[2], tp[3]};
        sa[ri][t] = __builtin_amdgcn_mfma_f32_16x16x32_bf16(kf[2 * ri + t], qf, ci, 0, 0, 0);
      }
    __builtin_amdgcn_sched_barrier(0);
    if (jq + 1 < 4) issue_kq(jq + 1);
    __builtin_amdgcn_sched_barrier(0);
    float l = 0.f;
    f32x4 oa[2] = {{0.f, 0.f, 0.f, 0.f}, {0.f, 0.f, 0.f, 0.f}};
    ldsp vl = lds + qi * NA8_VSTRIDE + (rs - R0) * 128 + (kb + 4 * g) * 2;
#pragma unroll
    for (int ri = 0; ri < 8; ++ri) {
      float p[8];
#pragma unroll
      for (int t = 0; t < 2; ++t)
#pragma unroll
        for (int i = 0; i < 4; ++i) { const float e = __builtin_amdgcn_exp2f(sa[ri][t][i]); p[4 * t + i] = e; l += e; }
      u32x4 pp; pp[0] = pk2(p[0], p[1]); pp[1] = pk2(p[2], p[3]); pp[2] = pk2(p[4], p[5]); pp[3] = pk2(p[6], p[7]);
      const bf16x8 pfr = __builtin_bit_cast(bf16x8, pp);
#pragma unroll
      for (int dtl = 0; dtl < 2; ++dtl) {
        const s16x4 lo = *(LAS s16x4*)(vl + dtl * 16 * NA8_VSTRIDE + ri * 128), hi = *(LAS s16x4*)(vl + dtl * 16 * NA8_VSTRIDE + ri * 128 + 32);
        const bf16x8 vf = __builtin_shufflevector(lo, hi, 0, 1, 2, 3, 4, 5, 6, 7);
        oa[dtl] = __builtin_amdgcn_mfma_f32_16x16x32_bf16(vf, pfr, oa[dtl], 0, 0, 0);
      }
    }
    l += __shfl_xor(l, 16); l += __shfl_xor(l, 32);
    const float il = 1.0f / l;
    u16* dst = (u16*)(P.ws + A_AO) + ((size_t)b * 4096 + r * 64 + 16 * jq + qi) * 1024 + 512 + hd * 32;
#pragma unroll
    for (int dtl = 0; dtl < 2; ++dtl)
      *(uint2*)(dst + 16 * dtl + 4 * g) = make_uint2(pk2(oa[dtl][0] * il, oa[dtl][1] * il), pk2(oa[dtl][2] * il, oa[dtl][3] * il));
  }
}

DI void ph2_attn8(const Ptrs& P, ldsp lds, int bid, int G) {
  const float* sc = (const float*)(P.ws + WS_SCAL);
  const float lam = sc[0], m2 = sc[1], qkb = sc[2];
  if (m2 < 64.0f) { for (int it = bid; it < 256; it += G) da_item8<false>(P, lds, it, lam, m2); }
  else { for (int it = bid; it < 256; it += G) da_item8<true>(P, lds, it, lam, m2); }
  for (int it = bid; it < 512; it += G) na_block8(P, lds, it, qkb);
}

__global__ void __launch_bounds__(512, 2) mega8(Ptrs Pk, int ph_lo, int ph_hi) {
  extern __shared__ __attribute__((aligned(16))) unsigned char smem[];
  ldsp lds = (ldsp)smem;
  const int bid = blockIdx.x, G = gridDim.x;
  volatile LAS unsigned* st = (volatile LAS unsigned*)(lds + g8::LDS_EXTRA8 + 4080);
  XcdBarrier xb; xb.bar = (unsigned*)(Pk.ws + WS_CTL); xb.x = 0; xb.st = st;
  if (ph_hi - ph_lo > 1) {
    if (threadIdx.x == 0) { st[0] = 0u; st[1] = 0u; }
    __syncthreads();
    xb = xcd_barrier_post((unsigned*)(Pk.ws + WS_CTL), st);
  }
#define RUN_PHASE8(k, call) if (ph_lo <= k && k < ph_hi) { { const Ptrs P = load_args(); call; } if (k + 1 < ph_hi) xcd_barrier(xb); }
  RUN_PHASE8(0, ph0_prep(P, lds, bid, G))
  RUN_PHASE8(1, ph1_inproj8(P, lds, bid, G))
  RUN_PHASE8(2, ph2_attn8(P, lds, bid, G))
  RUN_PHASE8(3, ph3_outproj8(P, lds, bid, G))
  RUN_PHASE8(4, ph4_router(P, lds, bid, G))
  RUN_PHASE8(5, ph5_up8(P, lds, bid, G))
  RUN_PHASE8(6, ph6_down8(P, lds, bid, G))
  RUN_PHASE8(7, ph7_combine(P, lds, bid, G))
  RUN_PHASE8(8, ph8_final8(P, lds, bid, G))
}
extern "C" void kernel_launch(void* const* d_in, const int* in_sizes, int n_in, void* d_out, int out_size, void* d_ws, size_t ws_size,
                              hipStream_t stream) {
  static int grid = 0;
  if (grid == 0) {
    if (n_in != 25 || ws_size < WS_END || out_size != T * DM) { fprintf(stderr, "kernel_launch: unexpected n_in %d / out %d / ws_size %zu (need %zu)\\n", n_in, out_size, ws_size, (size_t)WS_END); grid = -1; return; }
    int dev = 0, cus = 0, per_cu = 0;
    (void)hipGetDevice(&dev);
    (void)hipDeviceGetAttribute(&cus, hipDeviceAttributeMultiprocessorCount, dev);
    (void)hipFuncSetAttribute((const void*)mega8, hipFuncAttributeMaxDynamicSharedMemorySize, g8::LDS_BYTES8);
    (void)hipOccupancyMaxActiveBlocksPerMultiprocessor(&per_cu, (const void*)mega8, 512, g8::LDS_BYTES8);
    if (per_cu < 1) { fprintf(stderr, "kernel_launch: occupancy query returned %d\\n", per_cu); grid = -1; return; }
    grid = cus;
  }
  if (grid < 0) return;
  Ptrs P{};
  const float** pp = (const float**)&P;
  for (int i = 0; i < 25; ++i) pp[i] = (const float*)d_in[i];
  P.out = (float*)d_out; P.ws = (unsigned char*)d_ws;
  (void)hipMemsetAsync((unsigned char*)d_ws + WS_CTL, 0, XCD_BAR_WORDS * 4, stream);
  mega8<<<grid, 512, g8::LDS_BYTES8, stream>>>(P, 0, 9);
}
```

```cpp
#define ONE_LAUNCH 2
#define NEW_MASK 0x1ff
#include <hip/hip_runtime.h>
#include <cstdio>
#include <cstdint>

typedef unsigned short u16;
#define DI __device__ __forceinline__

constexpr int T = 16384, S = 4096, DM = 1024, NB = 4;
constexpr int DIN = 3072, DPLE = 256;
constexpr int HA = 4, HB = 16;
constexpr int NE = 32, DE = 512;
constexpr float EPS = 1e-6f;
constexpr float LOG2E = 1.4426950408889634f;
constexpr float LAM_INIT = 0.2f;

constexpr size_t MiB = 1ull << 20;
constexpr size_t WS_WIN = 0, WS_WOUT = 6 * MiB, WS_W13 = 8 * MiB, WS_W2 = 72 * MiB, WS_WPLG = 104 * MiB,
                 WS_WPLE = 106 * MiB, WS_WR = 106 * MiB + 512 * 1024, WS_ROPE = 107 * MiB;
constexpr size_t WS_SMALL = 108 * MiB;
constexpr size_t WS_RSTDX = WS_SMALL;
constexpr size_t WS_SSQ1P = 250 * MiB;
constexpr size_t WS_SSQEP = 251 * MiB;
constexpr int SSQ_PARTS = 16;
constexpr size_t WS_RSTD1 = WS_RSTDX + 65536;
constexpr size_t WS_RSTD2 = WS_RSTD1 + 65536;
constexpr size_t WS_SCAL  = WS_RSTD2 + 65536;
constexpr size_t WS_CNT   = WS_SCAL + 256;
constexpr int CNT_STRIDE = 64;
constexpr size_t WS_PADST = WS_CNT + 8192;
constexpr size_t WS_CTL   = WS_PADST + 256;
constexpr size_t WS_RSTDE = WS_CTL + 16384;
constexpr size_t WS_PAR   = WS_SMALL + 1 * MiB;
constexpr int PAR_GQA = 0, PAR_GKA = 64, PAR_GSUB = 128, PAR_GQB = 256, PAR_GKB = 288, PAR_GPLE = 320, PAR_RPB = 1344, PAR_TOTAL = 1344 + 7440;
constexpr size_t WS_TOKL  = WS_SMALL + 2 * MiB;
constexpr size_t WS_WL    = WS_SMALL + 4 * MiB;
constexpr size_t WS_ACT   = 114 * MiB;
constexpr size_t A_XB = WS_ACT, A_AO = 260 * MiB, A_HID = WS_ACT, A_H2B = WS_ACT;
constexpr size_t A_PB = 252 * MiB;
constexpr size_t A_QA = WS_ACT + 40 * MiB, A_KA = WS_ACT + 56 * MiB, A_VAT = WS_ACT + 72 * MiB,
                 A_QB = WS_ACT + 88 * MiB, A_KB = WS_ACT + 104 * MiB, A_VBT = WS_ACT + 120 * MiB;
constexpr size_t A_H1B = WS_ACT + 40 * MiB, A_EBF = WS_ACT + 72 * MiB, A_Y0 = WS_ACT + 104 * MiB, A_Y1 = 260 * MiB;
constexpr size_t WS_END = 292 * MiB;

DI float bf2f(u16 u) { return __uint_as_float(((unsigned)u) << 16); }
DI u16 f2bf(float f) { __bf16 b = (__bf16)f; return __builtin_bit_cast(u16, b); }
DI int permpos(int s) { return (s & ~12) | ((s & 8) >> 1) | ((s & 4) << 1); }

struct Ptrs {
  const float *x, *p, *g_mix, *w_in, *g_qa, *g_ka, *lam_q1, *lam_k1, *lam_q2, *lam_k2, *g_sub, *g_qb, *g_kb, *rpb, *w_out,
      *g_ffn, *w_rg, *w_re, *w1, *w3, *w2, *g_plg, *w_plg, *w_ple, *g_ple;
  float* out;
  unsigned char* ws;
};

#define GAS __attribute__((address_space(1)))
#define LAS __attribute__((address_space(3)))
typedef LAS unsigned char* ldsp;
typedef __attribute__((ext_vector_type(8))) short bf16x8;
typedef __attribute__((ext_vector_type(16))) float f32x16;
typedef __attribute__((ext_vector_type(4))) float f32x4;
typedef __attribute__((ext_vector_type(2))) float f32x2v;
typedef __attribute__((ext_vector_type(2))) __bf16 bf16x2v;
DI unsigned pk2(float a, float b) { bf16x2v v = __builtin_convertvector((f32x2v){a, b}, bf16x2v); return __builtin_bit_cast(unsigned, v); }
DI float wave_sum(float v) {
#pragma unroll
  for (int o = 1; o < 64; o <<= 1) v += __shfl_xor(v, o);
  return v;
}
DI void glds16(const void* g, ldsp l) { __builtin_amdgcn_global_load_lds((const GAS unsigned*)g, (LAS unsigned*)l, 16, 0, 0); }
DI void lds_wave_sync() { asm volatile("s_waitcnt lgkmcnt(0)" ::: "memory"); }

#define XB_TMO      128
#define XB_XCNT(j)  (256  + 64 * (j))
#define XB_XSUB(j)  (1280 + 64 * (j))
#define XB_XGEN(j)  (2304 + 64 * (j))
#define XB_TOP      3328
#define XB_TOPGEN   3392
#define XCD_BAR_WORDS 3456
#define XB_SPIN_CAP (1u << 22)
DI unsigned xb_ld(unsigned* p) { return __hip_atomic_load(p, __ATOMIC_RELAXED, __HIP_MEMORY_SCOPE_AGENT); }
DI unsigned xb_add(unsigned* p, unsigned v) { return __hip_atomic_fetch_add(p, v, __ATOMIC_RELAXED, __HIP_MEMORY_SCOPE_AGENT); }
DI unsigned xb_xcc_id() { return (unsigned)__builtin_amdgcn_s_getreg((3 << 11) | 20) & 0xFu; }
#define XB_SPIN(cond, bar) do { unsigned _sp = 0; while (cond) { __builtin_amdgcn_s_sleep(1); \
    if ((++_sp & 255u) == 0u) { if (xb_ld(&(bar)[XB_TMO])) break; if (_sp > XB_SPIN_CAP) { atomicAdd(&(bar)[XB_TMO], 1u); break; } } } } while (0)
struct XcdBarrier { unsigned* bar; unsigned x; volatile LAS unsigned* st; };
DI XcdBarrier xcd_barrier_post(unsigned* bar, volatile LAS unsigned* st) {
  XcdBarrier b; b.bar = bar; b.x = xb_xcc_id(); b.st = st;
  if (threadIdx.x == 0) (void)xb_add(&bar[XB_XCNT(b.x)], 1u);
  return b;
}
DI void xcd_barrier_complete(unsigned* bar, unsigned x, unsigned& nloc, unsigned& nx) {
  const unsigned G = gridDim.x;
  unsigned sum, cnt, mine, sp = 0u;
  for (;;) {
    sum = 0u; cnt = 0u; mine = 0u;
#pragma unroll
    for (unsigned j = 0; j < 16; ++j) { const unsigned c = xb_ld(&bar[XB_XCNT(j)]); sum += c; cnt += (c > 0u) ? 1u : 0u; mine = (j == x) ? c : mine; }
    if (sum == G) break;
    __builtin_amdgcn_s_sleep(1);
    if ((++sp & 255u) == 0u) { if (xb_ld(&bar[XB_TMO])) break; if (sp > XB_SPIN_CAP) { atomicAdd(&bar[XB_TMO], 1u); break; } }
  }
  nloc = mine > 0u ? mine : 1u; nx = cnt > 0u ? cnt : 1u;
}
DI void xcd_barrier(const XcdBarrier& b) {
  asm volatile("s_waitcnt vmcnt(0)" ::: "memory");
  __syncthreads();
  if (threadIdx.x == 0) {
    unsigned* bar = b.bar;
    __builtin_amdgcn_s_waitcnt(0);
    unsigned nloc = b.st[0], nx = b.st[1];
    if (nloc == 0u) { xcd_barrier_complete(bar, b.x, nloc, nx); b.st[0] = nloc; b.st[1] = nx; }
    const unsigned old = xb_add(&bar[XB_XSUB(b.x)], 1u);
    const unsigned gen = old / nloc;
    if (old + 1u == (gen + 1u) * nloc) {
      __builtin_amdgcn_fence(__ATOMIC_RELEASE, "agent");
      asm volatile("s_waitcnt vmcnt(0)" ::: "memory");
      const unsigned og = xb_add(&bar[XB_TOP], 1u);
      const unsigned tg = og / nx;
      if (og + 1u == (tg + 1u) * nx) xb_add(&bar[XB_TOPGEN], 1u);
      else XB_SPIN(xb_ld(&bar[XB_TOPGEN]) == tg, bar);
      __builtin_amdgcn_fence(__ATOMIC_ACQUIRE, "agent");
      xb_add(&bar[XB_XGEN(b.x)], 1u);
      asm volatile("s_waitcnt vmcnt(0)" ::: "memory");
    } else {
      XB_SPIN(xb_ld(&bar[XB_XGEN(b.x)]) == gen, bar);
      __builtin_amdgcn_fence(__ATOMIC_ACQUIRE, "agent");
      asm volatile("s_waitcnt vmcnt(0)" ::: "memory");
    }
  }
  __syncthreads();
}

DI int win8_row(int f);
DI int perm256(int f);
DI int w13_row_w1(int f);
DI int w13_row_w3(int f);
typedef int (*rowmap_t)(int);
template <rowmap_t rowmap = (rowmap_t) nullptr>
DI void tr_item(const float* W, int ldw, int k0, int n0, const float* gk, u16* dst0, u16* dst1, int ldd, LAS float* scr, int lane) {
  float4 v[16];
  const float* src = W + (size_t)(k0 + (lane >> 4)) * ldw + n0 + 4 * (lane & 15);
#pragma unroll
  for (int j = 0; j < 16; ++j) { const f32x4 t = __builtin_nontemporal_load((const f32x4*)(src + (size_t)(4 * j) * ldw)); v[j] = make_float4(t[0], t[1], t[2], t[3]); }
  if (gk) {
#pragma unroll
    for (int j = 0; j < 16; ++j) { const float g = gk[k0 + 4 * j + (lane >> 4)]; v[j].x *= g; v[j].y *= g; v[j].z *= g; v[j].w *= g; }
  }
  LAS float* w = scr + (lane >> 4) * 65 + 4 * (lane & 15);
#pragma unroll
  for (int j = 0; j < 16; ++j) { w[(4 * j) * 65] = v[j].x; w[(4 * j) * 65 + 1] = v[j].y; w[(4 * j) * 65 + 2] = v[j].z; w[(4 * j) * 65 + 3] = v[j].w; }
  lds_wave_sync();
  const int c = lane & 7;
#pragma unroll
  for (int j = 0; j < 8; ++j) {
    const int n = (lane >> 3) + 8 * j;
    const LAS float* s = scr + (8 * c) * 65 + n;
    uint4 o;
    o.x = pk2(s[0 * 65], s[1 * 65]); o.y = pk2(s[2 * 65], s[3 * 65]); o.z = pk2(s[4 * 65], s[5 * 65]); o.w = pk2(s[6 * 65], s[7 * 65]);
    u16* d = rowmap ? (dst0 + (size_t)rowmap(n0 + n) * ldd) : ((j < 4) ? (dst0 + (size_t)n * ldd) : (dst1 + (size_t)(n - 32) * ldd));
    *(uint4*)(d + k0 + 8 * c) = o;
  }
  lds_wave_sync();
}

typedef const __attribute__((address_space(4))) Ptrs* kargp_t;
DI kargp_t kargs_now() {
#if defined(__HIP_DEVICE_COMPILE__)
  kargp_t kp = (kargp_t)__builtin_amdgcn_kernarg_segment_ptr(); asm volatile("" : "+s"(kp)); return kp;
#else
  return nullptr;
#endif
}
DI Ptrs load_args() {
#if defined(__HIP_DEVICE_COMPILE__)
  kargp_t kp = kargs_now(); Ptrs r; __builtin_memcpy(&r, (const void*)kp, sizeof(Ptrs)); return r;
#else
  return Ptrs{};
#endif
}
DI void late_weight_item(int r, LAS float* scr, int lane) {
  unsigned char* const wsb = kargs_now()->ws;
  if (r < 4096) {
    u16* W2T = (u16*)(wsb + WS_W2);
    const int e = r >> 7, q = r & 127, kb = q >> 4, nb = q & 15;
    tr_item<perm256>(kargs_now()->w2 + (size_t)e * 512 * 1024, 1024, kb * 64, nb * 64, nullptr, W2T + (size_t)e * 1024 * 512, nullptr, 512, scr, lane);
  } else {
    r -= 4096;
    const int kb = r >> 4, nb = r & 15;
    tr_item<perm256>(kargs_now()->w_plg, 1024, kb * 64, nb * 64, kargs_now()->g_plg, (u16*)(wsb + WS_WPLG), nullptr, 1024, scr, lane);
  }
}
DI void ph0_prep(const Ptrs& Punused, ldsp lds, int bid, int G) {
  unsigned char* const wsb = kargs_now()->ws;
  const int tid = threadIdx.x, lane = tid & 63, wave = tid >> 6;
  LAS float* scr = (LAS float*)(lds + wave * 16640);
  const int nwv = blockDim.x >> 6, gw = bid * nwv + wave, NGW = G * nwv;
  constexpr int I_W1 = 4096, I_W3 = 4096, I_W2 = 4096, I_X = 8192, I_WIN = 768, I_P = 2048, I_WOUT = 256, I_PLG = 256, I_PLE = 64,
                I_WR = 768, I_ROPE = 2048, I_PAR = (PAR_TOTAL + 63) / 64, I_SC = 1;
  constexpr int TOTAL = I_W1 + I_W3 + I_W2 + I_X + I_WIN + I_P + I_WOUT + I_PLG + I_PLE + I_WR + I_ROPE + I_PAR + I_SC;
  u16* W13T = (u16*)(wsb + WS_W13); u16* W2T = (u16*)(wsb + WS_W2);
  for (int r0_ = gw; r0_ < I_W1 + I_W3; r0_ += NGW) {
    int r = r0_;
      const int isw3 = r >= I_W1; if (isw3) r -= I_W1;
      const int e = r >> 7, q = r & 127, kb = q >> 3, nb = q & 7;
      u16* d0 = W13T + ((size_t)e * 1024 + nb * 128 + isw3 * 32) * 1024;
#if NEW_MASK & 0x20
      if (isw3) tr_item<w13_row_w3>(kargs_now()->w3 + (size_t)e * 1024 * 512, 512, kb * 64, nb * 64, kargs_now()->g_ffn, W13T + (size_t)e * 1024 * 1024, nullptr, 1024, scr, lane);
      else tr_item<w13_row_w1>(kargs_now()->w1 + (size_t)e * 1024 * 512, 512, kb * 64, nb * 64, kargs_now()->g_ffn, W13T + (size_t)e * 1024 * 1024, nullptr, 1024, scr, lane);
#else
      tr_item((isw3 ? kargs_now()->w3 : kargs_now()->w1) + (size_t)e * 1024 * 512, 512, kb * 64, nb * 64, kargs_now()->g_ffn, d0, d0 + 64 * 1024, 1024, scr, lane);
#endif
  }
  for (int r0_ = gw; r0_ < I_X; r0_ += NGW) {
    int r = r0_;
      const float4* xr = (const float4*)(kargs_now()->x + (size_t)r * 2048) + lane;
      float4 v[8];
#pragma unroll
      for (int j = 0; j < 8; ++j) { const f32x4 t = __builtin_nontemporal_load((const f32x4*)(xr + 64 * j)); v[j] = make_float4(t[0], t[1], t[2], t[3]); }
      float s0 = 0.f, s1 = 0.f;
#pragma unroll
      for (int j = 0; j < 4; ++j) { s0 += v[j].x * v[j].x + v[j].y * v[j].y + v[j].z * v[j].z + v[j].w * v[j].w; s1 += v[j + 4].x * v[j + 4].x + v[j + 4].y * v[j + 4].y + v[j + 4].z * v[j + 4].z + v[j + 4].w * v[j + 4].w; }
      s0 = wave_sum(s0); s1 = wave_sum(s1);
      if (lane == 0) { float* rx = (float*)(wsb + WS_RSTDX); rx[2 * r] = rsqrtf(s0 * (1.0f / 1024.0f) + EPS); rx[2 * r + 1] = rsqrtf(s1 * (1.0f / 1024.0f) + EPS); }
      uint2* o = (uint2*)((u16*)(wsb + A_XB) + (size_t)r * 2048) + lane;
#pragma unroll
      for (int j = 0; j < 8; ++j) o[64 * j] = make_uint2(pk2(v[j].x, v[j].y), pk2(v[j].z, v[j].w));
  }
  for (int r0_ = gw; r0_ < I_WIN; r0_ += NGW) {
    int r = r0_;
      const int kb = r / 48, nb = r % 48;
      u16* d0 = (u16*)(wsb + WS_WIN) + (size_t)(nb * 64) * 1024;
      tr_item<win8_row>(kargs_now()->w_in, DIN, kb * 64, nb * 64, kargs_now()->g_mix, (u16*)(wsb + WS_WIN), nullptr, 1024, scr, lane);
  }
  for (int r0_ = gw; r0_ < I_P; r0_ += NGW) {
    int r = r0_;
      const float4* pr = (const float4*)kargs_now()->p + (size_t)r * 512 + lane;
      uint2* o = (uint2*)(wsb + A_PB) + (size_t)r * 512 + lane;
      float4 v[8];
#pragma unroll
      for (int j = 0; j < 8; ++j) { const f32x4 t = __builtin_nontemporal_load((const f32x4*)(pr + 64 * j)); v[j] = make_float4(t[0], t[1], t[2], t[3]); }
#pragma unroll
      for (int j = 0; j < 8; ++j) o[64 * j] = make_uint2(pk2(v[j].x, v[j].y), pk2(v[j].z, v[j].w));
  }
  for (int r0_ = gw; r0_ < I_WOUT; r0_ += NGW) {
    int r = r0_;
      const int kb = r >> 4, nb = r & 15;
      u16* d0 = (u16*)(wsb + WS_WOUT) + (size_t)(nb * 64) * 1024;
#if NEW_MASK & 0x8
      tr_item<perm256>(kargs_now()->w_out, 1024, kb * 64, nb * 64, nullptr, (u16*)(wsb + WS_WOUT), nullptr, 1024, scr, lane);
#else
      tr_item(kargs_now()->w_out, 1024, kb * 64, nb * 64, nullptr, d0, d0 + 32 * 1024, 1024, scr, lane);
#endif
  }
  for (int r0_ = gw; r0_ < I_PLE; r0_ += NGW) {
    int r = r0_;
      const int kb = r >> 4, nb = r & 15;
      u16* d0 = (u16*)(wsb + WS_WPLE) + (size_t)(nb * 64) * 256;
#if NEW_MASK & 0x8
      tr_item<perm256>(kargs_now()->w_ple, 1024, kb * 64, nb * 64, nullptr, (u16*)(wsb + WS_WPLE), nullptr, 256, scr, lane);
#else
      tr_item(kargs_now()->w_ple, 1024, kb * 64, nb * 64, nullptr, d0, d0 + 32 * 256, 256, scr, lane);
#endif
  }
  for (int r0_ = gw; r0_ < I_WR; r0_ += NGW) {
    int r = r0_;
      const int idx = r * 64 + lane, rr = idx >> 10, k = idx & 1023;
      float v = 0.f;
      if (rr < 4) v = kargs_now()->w_rg[k * 4 + rr]; else if (rr < 36) v = kargs_now()->w_re[k * 32 + (rr - 4)];
      const float wv_ = v * kargs_now()->g_ffn[k];
      const unsigned hb_ = pk2(wv_, 0.f) & 0xffffu;
      const unsigned lb_ = pk2(wv_ - __uint_as_float(hb_ << 16), 0.f) & 0xffffu;
      ((u16*)(wsb + WS_WR))[idx] = (u16)hb_; ((u16*)(wsb + WS_WR))[48 * 1024 + idx] = (u16)lb_;
  }
  for (int r0_ = gw; r0_ < I_ROPE; r0_ += NGW) {
    int r = r0_;
      const int idx = r * 64 + lane, s = idx >> 5, i = idx & 31;
      const float inv = powf(10000.0f, -(float)(2 * i) / 64.0f);
      const float ang = (float)s * inv;
      float sn, cs; sincosf(ang, &sn, &cs);
      ((float2*)(wsb + WS_ROPE))[idx] = make_float2(cs, sn);
  }
  for (int r0_ = gw; r0_ < I_PAR; r0_ += NGW) {
    int r = r0_;
      const int idx = r * 64 + lane;
      if (idx < PAR_TOTAL) {
        float v;
        if (idx < PAR_GKA) v = kargs_now()->g_qa[idx]; else if (idx < PAR_GSUB) v = kargs_now()->g_ka[idx - PAR_GKA]; else if (idx < PAR_GQB) v = kargs_now()->g_sub[idx - PAR_GSUB];
        else if (idx < PAR_GKB) v = kargs_now()->g_qb[idx - PAR_GQB]; else if (idx < PAR_GPLE) v = kargs_now()->g_kb[idx - PAR_GKB]; else if (idx < PAR_RPB) v = kargs_now()->g_ple[idx - PAR_GPLE];
        else v = kargs_now()->rpb[idx - PAR_RPB];
        ((float*)(wsb + WS_PAR))[idx] = v;
      }
  }
  if (gw == 0) {
    if (lane == 0) {
      float s1 = 0, s2 = 0, mq = 0, mk = 0;
      for (int i = 0; i < 64; ++i) {
        s1 += kargs_now()->lam_q1[i] * kargs_now()->lam_k1[i]; s2 += kargs_now()->lam_q2[i] * kargs_now()->lam_k2[i];
        mq = fmaxf(mq, fabsf(kargs_now()->g_qa[i])); mk = fmaxf(mk, fabsf(kargs_now()->g_ka[i]));
      }
      float* sc = (float*)(wsb + WS_SCAL);
      sc[0] = expf(s1) - expf(s2) + LAM_INIT;
      sc[1] = 8.0f * mq * mk * LOG2E;
      float mqb = 0, mkb = 0;
      for (int i = 0; i < 32; ++i) { mqb = fmaxf(mqb, fabsf(kargs_now()->g_qb[i])); mkb = fmaxf(mkb, fabsf(kargs_now()->g_kb[i])); }
      sc[2] = 5.656854249f * mqb * mkb;
      int* cnt = (int*)(wsb + WS_CNT);
      for (int i = 0; i < 32; ++i) cnt[i * CNT_STRIDE] = 0;
    }
  }
}

DI uint4 pk8(const f32x4 a, const f32x4 b) { return make_uint4(pk2(a[0], a[1]), pk2(a[2], a[3]), pk2(b[0], b[1]), pk2(b[2], b[3])); }

typedef __attribute__((ext_vector_type(4))) unsigned u32x4;
DI bf16x8 packp(const f32x16& x, int s) {
  u32x4 p;
  p[0] = pk2(x[8 * s + 0], x[8 * s + 1]); p[1] = pk2(x[8 * s + 2], x[8 * s + 3]);
  p[2] = pk2(x[8 * s + 4], x[8 * s + 5]); p[3] = pk2(x[8 * s + 6], x[8 * s + 7]);
  return __builtin_bit_cast(bf16x8, p);
}
DI int grp_of(int kk) { return ((kk >> 2) == 1 || (kk >> 2) == 2 || (kk >> 2) == 4 || (kk >> 2) == 7) ? 1 : 0; }
DI int rank_of(int kk) { const int q = kk >> 2; return kk - ((q == 0) ? 0 : (q <= 2) ? 4 : (q == 3 || q == 4) ? 8 : (q <= 6) ? 12 : 16); }
DI int key_of(int grp, int jj) { return grp ? (jj < 8 ? jj + 4 : (jj < 12 ? jj + 8 : jj + 16)) : (jj < 4 ? jj : (jj < 8 ? jj + 8 : jj + 12)); }
constexpr int DA_STAGE = 33280, DA_VOFF = 16640;
typedef __attribute__((ext_vector_type(4))) short s16x4;
DI void ph4_router_t(const Ptrs& P, ldsp lds, int bid, int G) {
  const int tid = threadIdx.x, lane = tid & 63, wave = __builtin_amdgcn_readfirstlane(tid >> 6), t = lane & 15, kk = lane >> 4;
  LAS float* lg = (LAS float*)lds;
  const u16* h1 = (const u16*)(P.ws + A_H1B); const u16* WrH = (const u16*)(P.ws + WS_WR);
  for (int item = bid; item < 256; item += G) {
    const int tok0 = item * 64;
    float4 s0 = make_float4(0.f, 0.f, 0.f, 0.f), s1 = s0, s2 = s0, s3 = s0;
    if (wave == 0) {
      const float* sp = (const float*)(P.ws + WS_SSQ1P) + (size_t)(tok0 + lane) * SSQ_PARTS;
      s0 = *(const float4*)sp; s1 = *(const float4*)(sp + 4); s2 = *(const float4*)(sp + 8); s3 = *(const float4*)(sp + 12);
    }
    f32x4 acc[4][3];
#pragma unroll
    for (int tt = 0; tt < 4; ++tt)
#pragma unroll
      for (int et = 0; et < 3; ++et) acc[tt][et] = (f32x4){0.f, 0.f, 0.f, 0.f};
    const u16* ap = h1 + (size_t)(tok0 + t) * 1024 + 128 * wave + 8 * kk;
    const u16* bp = WrH + (size_t)t * 1024 + 128 * wave + 8 * kk;
#pragma unroll
    for (int s = 0; s < 4; ++s) {
      bf16x8 a[4];
#pragma unroll
      for (int tt = 0; tt < 4; ++tt) a[tt] = *(const bf16x8*)(ap + (size_t)tt * 16 * 1024 + 32 * s);
#pragma unroll
      for (int et = 0; et < 3; ++et) {
        const bf16x8 bh = *(const bf16x8*)(bp + et * 16 * 1024 + 32 * s), bl = *(const bf16x8*)(bp + (48 + et * 16) * 1024 + 32 * s);
#pragma unroll
        for (int tt = 0; tt < 4; ++tt) {
          acc[tt][et] = __builtin_amdgcn_mfma_f32_16x16x32_bf16(a[tt], bh, acc[tt][et], 0, 0, 0);
          acc[tt][et] = __builtin_amdgcn_mfma_f32_16x16x32_bf16(a[tt], bl, acc[tt][et], 0, 0, 0);
        }
      }
    }
    __syncthreads();
#pragma unroll
    for (int tt = 0; tt < 4; ++tt)
#pragma unroll
      for (int et = 0; et < 3; ++et)
#pragma unroll
        for (int i = 0; i < 4; ++i) lg[wave * (64 * 49) + (16 * tt + 4 * kk + i) * 49 + 16 * et + t] = acc[tt][et][i];
    __syncthreads();
    if (wave == 0) {
      const int tok = tok0 + lane;
      const float rstd = rsqrtf(((s0.x + s0.y + s0.z + s0.w) + (s1.x + s1.y + s1.z + s1.w) + (s2.x + s2.y + s2.z + s2.w) + (s3.x + s3.y + s3.z + s3.w)) * (1.0f / 1024.0f) + EPS);
      const LAS float* L = lg + lane * 49;
      float gl[4] = {0.f, 0.f, 0.f, 0.f};
#pragma unroll
      for (int w = 0; w < 8; ++w)
#pragma unroll
        for (int i = 0; i < 4; ++i) gl[i] += L[w * (64 * 49) + i];
      int gi = 0; float gm = gl[0];
#pragma unroll
      for (int i = 1; i < 4; ++i) { if (gl[i] > gm) { gm = gl[i]; gi = i; } }
      float gs = 0.f;
#pragma unroll
      for (int i = 0; i < 4; ++i) gs += expf((gl[i] - gm) * rstd);
      const float gate = 1.0f / gs;
      const LAS float* el = L + 4 + 8 * gi;
      float ev[8] = {0.f, 0.f, 0.f, 0.f, 0.f, 0.f, 0.f, 0.f};
#pragma unroll
      for (int w = 0; w < 8; ++w)
#pragma unroll
        for (int i = 0; i < 8; ++i) ev[i] += el[w * (64 * 49) + i];
      int e1 = 0; float m1 = ev[0];
#pragma unroll
      for (int i = 1; i < 8; ++i) { if (ev[i] > m1) { m1 = ev[i]; e1 = i; } }
      int e2 = 0; float m2v = -3.0e38f;
#pragma unroll
      for (int i = 0; i < 8; ++i) { if (i != e1 && ev[i] > m2v) { m2v = ev[i]; e2 = i; } }
      const float p2 = expf((m2v - m1) * rstd);
      const float wa = gate / (1.0f + p2), wb = gate * p2 / (1.0f + p2);
      int* cnt = (int*)(P.ws + WS_CNT); int* tokl = (int*)(P.ws + WS_TOKL); float* wl = (float*)(P.ws + WS_WL);
      const int ea = gi * 8 + e1, eb = gi * 8 + e2;
      ((float*)(P.ws + WS_RSTD1))[tok] = rstd;
      int mycnt = 0, ra = 0, rb = 0;
#pragma unroll 4
      for (int e = 0; e < 32; ++e) {
        const unsigned long long ma = __ballot(ea == e), mb = __ballot(eb == e);
        const int ca = __popcll(ma);
        if (lane == e) mycnt = ca + __popcll(mb);
        if (ea == e) ra = __builtin_amdgcn_mbcnt_hi((unsigned)(ma >> 32), __builtin_amdgcn_mbcnt_lo((unsigned)ma, 0u));
        if (eb == e) rb = ca + __builtin_amdgcn_mbcnt_hi((unsigned)(mb >> 32), __builtin_amdgcn_mbcnt_lo((unsigned)mb, 0u));
      }
      int base = 0;
      if (lane < 32 && mycnt > 0) base = atomicAdd(&cnt[lane * CNT_STRIDE], mycnt);
      const int pa = __shfl(base, ea) + ra, pb = __shfl(base, eb) + rb;
      tokl[ea * 16384 + pa] = tok * 2; wl[ea * 16384 + pa] = wa;
      tokl[eb * 16384 + pb] = tok * 2 + 1; wl[eb * 16384 + pb] = wb;
    }
  }
}

DI void ph4_router(const Ptrs& P, ldsp lds, int bid, int G) {
  ph4_router_t(P, lds, bid, G);
}

DI void ph7_combine(const Ptrs& P, ldsp lds, int bid, int G) {
  const int lane = threadIdx.x & 63, wave = threadIdx.x >> 6;
  const int nwv = blockDim.x >> 6;
  for (int tok = bid * nwv + wave; tok < T; tok += G * nwv) {
    const uint2* hr = (const uint2*)((const u16*)(P.ws + A_H1B) + (size_t)tok * 1024) + lane;
    const uint2* y0 = (const uint2*)((const u16*)(P.ws + A_Y0) + (size_t)tok * 1024) + lane;
    const uint2* y1 = (const uint2*)((const u16*)(P.ws + A_Y1) + (size_t)tok * 1024) + lane;
    uint2* o = (uint2*)((u16*)(P.ws + A_H2B) + (size_t)tok * 1024) + lane;
    float ss = 0.f;
#pragma unroll
    for (int j = 0; j < 4; ++j) {
      const uint2 hv = hr[64 * j], a = y0[64 * j], c = y1[64 * j];
      const float v0 = __uint_as_float(hv.x << 16) + __uint_as_float(a.x << 16) + __uint_as_float(c.x << 16);
      const float v1 = __uint_as_float(hv.x & 0xffff0000u) + __uint_as_float(a.x & 0xffff0000u) + __uint_as_float(c.x & 0xffff0000u);
      const float v2 = __uint_as_float(hv.y << 16) + __uint_as_float(a.y << 16) + __uint_as_float(c.y << 16);
      const float v3 = __uint_as_float(hv.y & 0xffff0000u) + __uint_as_float(a.y & 0xffff0000u) + __uint_as_float(c.y & 0xffff0000u);
      ss += v0 * v0 + v1 * v1 + v2 * v2 + v3 * v3;
      o[64 * j] = make_uint2(pk2(v0, v1), pk2(v2, v3));
    }
    ss = wave_sum(ss);
    float se = (lane < SSQ_PARTS) ? ((const float*)(P.ws + WS_SSQEP))[(size_t)tok * SSQ_PARTS + lane] : 0.f;
    se = wave_sum(se);
    if (lane == 0) {
      ((float*)(P.ws + WS_RSTD2))[tok] = rsqrtf(ss * (1.0f / 1024.0f) + EPS);
      ((float*)(P.ws + WS_RSTDE))[tok] = rsqrtf(se * (1.0f / 1024.0f) + EPS);
    }
  }
}

namespace g8 {
constexpr int BM = 256, BK = 64, HALF = 128, HTB = HALF * BK * 2, STAGE_BYTES = 8 * HTB, NXCD = 8, WGM = 8;
constexpr int LDS_EXTRA8 = STAGE_BYTES;
constexpr int LDS_BYTES8 = STAGE_BYTES + 4096;
DI int lds_byte(int r, int c) { const int st = (r >> 4) * 2 + (c >> 5), rr = r & 15, cc = c & 31, ob = rr * 64 + cc * 2; return st * 1024 + (ob ^ (((ob >> 9) & 1) << 5)); }
DI void stage_rc(int b, int& R, int& C) { const int st = b / 1024, sb = b % 1024, swz = sb ^ (((sb >> 9) & 1) << 5); R = (st >> 1) * 16 + swz / 64; C = (st & 1) * 32 + (swz % 64) / 2; }

struct Unit { int pm, pn, e, ce; };
struct GridOrder {
  int nM, nN, nwg, G, c; unsigned pnmap;
  DI void init(int nM_, int nN_, int G_, int c_, unsigned pnmap_ = 0u) { nM = nM_; nN = nN_; nwg = nM * nN; G = G_; c = c_; pnmap = pnmap_; }
  DI bool next(int i, Unit& u) const {
    const int L = i * G + c; if (L >= nwg) return false;
    int wgid = L; { const int q = nwg / NXCD, r = nwg % NXCD, xcd = wgid % NXCD, off = wgid / NXCD; wgid = (xcd < r ? xcd * (q + 1) : r * (q + 1) + (xcd - r) * q) + off; }
    const int nig = WGM * nN, gid = wgid / nig, fm = gid * WGM, gsz = (nM - fm) < WGM ? (nM - fm) : WGM;
    u.pm = fm + ((wgid % nig) % gsz); u.pn = (wgid % nig) / gsz; if (pnmap) u.pn = (int)((pnmap >> (4 * u.pn)) & 15u); u.e = 0; u.ce = 0; return true;
  }
};

template <class Epi, class Sched, bool SWAP, bool GATHER>
DI void gemm_phase(ldsp lds, const unsigned char* Abase, const unsigned char* Bbase, int K, const Sched& S, const Epi& E, int pA = 0, int pB = 0) {
  if (pA == 0) pA = K; if (pB == 0) pB = K;
  int tid = threadIdx.x; asm volatile("" : "+v"(tid));
  const int wid = __builtin_amdgcn_readfirstlane(tid >> 6), lane = tid & 63, wr = wid >> 2, wc = wid & 3, fr = lane & 15, fq = lane >> 4;
  const int nt = K / BK;
  int sR[2], sC[2];
  unsigned voffB[2], voffA[2];
#pragma unroll
  for (int i = 0; i < 2; ++i) { stage_rc(tid * 16 + i * 8192, sR[i], sC[i]); voffB[i] = (unsigned)(sR[i] * pB + sC[i]) * 2u; voffA[i] = (unsigned)(sR[i] * pA + sC[i]) * 2u; }
  const size_t tstepA = (size_t)BM * pA * 2;
  const size_t kstep = (size_t)(BK * 2);
  const size_t hstep = (size_t)HALF * pB * 2, hstepA = (size_t)HALF * pA * 2;
  const unsigned ldsw = (unsigned)wid * 1024u;
  const int aoff = lds_byte(wr * 64 + fr, fq * 8), boff = lds_byte(wc * 32 + fr, fq * 8);
#define G8_SA(b, h) (((b) * 2 + (h)) * HTB)
#define G8_SB(b, h) ((4 + (b) * 2 + (h)) * HTB)
#define G8_STAGE_B(bufoff, gbase) do { _Pragma("unroll") for (int _i = 0; _i < 2; ++_i) \
    __builtin_amdgcn_global_load_lds((const GAS unsigned*)((const unsigned char*)(gbase) + voffB[_i]), (LAS unsigned*)(lds + (bufoff) + ldsw + _i * 8192), 16, 0, 0); } while (0)
#define G8_STAGE_A(bufoff, hsel, nx, koff) do { _Pragma("unroll") for (int _i = 0; _i < 2; ++_i) { \
    const unsigned char* _p; \
    if (GATHER) _p = Abase + (size_t)((nx) ? ((hsel) ? nv1[_i] : nv0[_i]) : ((hsel) ? cv1[_i] : cv0[_i])) + (koff); \
    else _p = ((nx) ? nA : cA) + ((hsel) ? hstepA : (size_t)0) + voffA[_i] + (koff); \
    __builtin_amdgcn_global_load_lds((const GAS unsigned*)_p, (LAS unsigned*)(lds + (bufoff) + ldsw + _i * 8192), 16, 0, 0); } } while (0)
#define G8_LDA(dst, b, h) do { _Pragma("unroll") for (int m = 0; m < 4; ++m) _Pragma("unroll") for (int k = 0; k < 2; ++k) dst[m][k] = *(const LAS bf16x8*)(lds + G8_SA(b, h) + aoff + m * 2048 + k * 1024); } while (0)
#define G8_LDB(dst, b, h) do { _Pragma("unroll") for (int n = 0; n < 2; ++n) _Pragma("unroll") for (int k = 0; k < 2; ++k) dst[n][k] = *(const LAS bf16x8*)(lds + G8_SB(b, h) + boff + n * 2048 + k * 1024); } while (0)
#define G8_MMA(ai, bj, At, Bt) do { __builtin_amdgcn_s_setprio(1); \
    _Pragma("unroll") for (int m = 0; m < 4; ++m) _Pragma("unroll") for (int n = 0; n < 2; ++n) _Pragma("unroll") for (int k = 0; k < 2; ++k) \
        acc[ai][bj][m][n] = SWAP ? __builtin_amdgcn_mfma_f32_16x16x32_bf16(At[m][k], Bt[n][k], acc[ai][bj][m][n], 0, 0, 0) \
                                 : __builtin_amdgcn_mfma_f32_16x16x32_bf16(Bt[n][k], At[m][k], acc[ai][bj][m][n], 0, 0, 0); \
    __builtin_amdgcn_s_setprio(0); } while (0)
#define G8_WAIT_V(n) asm volatile("s_waitcnt vmcnt(" #n ")" ::: "memory")
#define G8_WAIT_L(n) asm volatile("s_waitcnt lgkmcnt(" #n ")" ::: "memory")
#define G8_BAR __builtin_amdgcn_s_barrier()
#define G8_SCHED __builtin_amdgcn_sched_barrier(0)
  Unit cur, nxt; int ui = 0;
  if (!S.next(0, cur)) return;
  f32x4 acc[2][2][4][2];
#pragma unroll
  for (int a = 0; a < 2; ++a)
#pragma unroll
    for (int b = 0; b < 2; ++b)
#pragma unroll
      for (int m = 0; m < 4; ++m)
#pragma unroll
        for (int n = 0; n < 2; ++n) acc[a][b][m][n] = (f32x4){0.f, 0.f, 0.f, 0.f};
  bf16x8 At[4][2], B0[2][2], B1[2][2];
  unsigned cv0[2] = {0u, 0u}, cv1[2] = {0u, 0u}, nv0[2] = {0u, 0u}, nv1[2] = {0u, 0u};
  const unsigned char* cA = Abase; const unsigned char* nA = Abase;
  if (GATHER) E.a_off(cur, sR, sC, cv0, cv1); else cA = Abase + (size_t)cur.pm * tstepA;
  const unsigned char* cB = Bbase + E.b_off(cur);
  G8_STAGE_B(G8_SB(0, 0), cB); G8_STAGE_A(G8_SA(0, 0), 0, false, 0); G8_STAGE_B(G8_SB(0, 1), cB + hstep); G8_STAGE_A(G8_SA(0, 1), 1, false, 0);
  if (wr == 1) G8_BAR;
  G8_WAIT_V(4); G8_BAR;
  G8_STAGE_B(G8_SB(1, 0), cB + kstep); G8_STAGE_A(G8_SA(1, 0), 0, false, kstep); G8_STAGE_B(G8_SB(1, 1), cB + hstep + kstep);
  G8_WAIT_V(6); G8_BAR;
  for (;;) {
    const bool has_next = S.next(ui + 1, nxt);
    if (GATHER) { if (has_next) E.a_off(nxt, sR, sC, nv0, nv1); else { nv0[0] = cv0[0]; nv0[1] = cv0[1]; nv1[0] = cv1[0]; nv1[1] = cv1[1]; } }
    else nA = has_next ? Abase + (size_t)nxt.pm * tstepA : cA;
    const unsigned char* nB = has_next ? Bbase + E.b_off(nxt) : cB;
#pragma unroll 1
    for (int t = 0; t < nt; t += 2) {
      const bool last = (t == nt - 2);
      const size_t k1 = (size_t)(t + 1) * kstep;
      const size_t k2 = last ? 0 : (size_t)(t + 2) * kstep, k3 = k2 + kstep;
      const unsigned char* b2 = last ? nB : cB + (size_t)(t + 2) * kstep; const unsigned char* b3 = b2 + kstep;
      G8_LDB(B0, 0, 0); G8_SCHED; G8_LDA(At, 0, 0); G8_STAGE_A(G8_SA(1, 1), 1, false, k1);
      G8_WAIT_L(8); G8_BAR; G8_WAIT_L(0); G8_MMA(0, 0, At, B0); G8_BAR; G8_SCHED;
      G8_LDB(B1, 0, 1); G8_STAGE_B(G8_SB(0, 0), b2);
      G8_BAR; G8_WAIT_L(0); G8_MMA(0, 1, At, B1); G8_BAR;
      G8_LDA(At, 0, 1); G8_STAGE_A(G8_SA(0, 0), 0, last, k2);
      G8_BAR; G8_WAIT_L(0); G8_MMA(1, 0, At, B0); G8_BAR; G8_SCHED;
      G8_STAGE_B(G8_SB(0, 1), b2 + hstep);
      G8_WAIT_V(6); G8_BAR; G8_MMA(1, 1, At, B1); G8_BAR;
      G8_LDB(B0, 1, 0); G8_SCHED; G8_LDA(At, 1, 0); G8_STAGE_A(G8_SA(0, 1), 1, last, k2);
      G8_WAIT_L(8); G8_BAR; G8_WAIT_L(0); G8_MMA(0, 0, At, B0); G8_BAR; G8_SCHED;
      G8_LDB(B1, 1, 1); G8_STAGE_B(G8_SB(1, 0), b3);
      G8_BAR; G8_WAIT_L(0); G8_MMA(0, 1, At, B1); G8_BAR;
      G8_LDA(At, 1, 1); G8_STAGE_A(G8_SA(1, 0), 0, last, k3);
      G8_BAR; G8_WAIT_L(0); G8_MMA(1, 0, At, B0); G8_BAR; G8_SCHED;
      G8_STAGE_B(G8_SB(1, 1), b3 + hstep);
      G8_WAIT_V(6); G8_BAR; G8_MMA(1, 1, At, B1); G8_BAR;
    }
    E(acc, cur, wr, wc, fr, fq);
    if (!has_next) break;
#pragma unroll
    for (int a = 0; a < 2; ++a)
#pragma unroll
      for (int b = 0; b < 2; ++b)
#pragma unroll
        for (int m = 0; m < 4; ++m)
#pragma unroll
          for (int n = 0; n < 2; ++n) acc[a][b][m][n] = (f32x4){0.f, 0.f, 0.f, 0.f};
    cur = nxt; cB = nB; cA = nA; ++ui;
    if (GATHER) { cv0[0] = nv0[0]; cv0[1] = nv0[1]; cv1[0] = nv1[0]; cv1[1] = nv1[1]; }
  }
  G8_WAIT_V(0);
  if (wr == 0) G8_BAR;
  G8_BAR;
#undef G8_SA
#undef G8_SB
#undef G8_STAGE_A
#undef G8_STAGE_B
#undef G8_LDA
#undef G8_LDB
#undef G8_MMA
#undef G8_WAIT_V
#undef G8_WAIT_L
#undef G8_BAR
#undef G8_SCHED
}
DI void dense_a_off(int pm, int K, const int (&sR)[2], const int (&sC)[2], unsigned (&v0)[2], unsigned (&v1)[2]) {
#pragma unroll
  for (int i = 0; i < 2; ++i) { v0[i] = (unsigned)((pm * BM + sR[i]) * K + sC[i]) * 2u; v1[i] = v0[i] + (unsigned)(HALF * K * 2); }
}
}

DI int win8_row(int f) {
  if (f < 1024) {
    const int rel = f & 511, pn = (f >> 9) * 2 + (rel >> 8), hl = (rel >> 7) & 1, comp = (rel >> 6) & 1, i = rel & 63;
    const int bj = i >> 5, ip = i & 31, fq = ip >> 3, n = (ip >> 2) & 1, j = ip & 3;
    return pn * 256 + 128 * bj + 32 * (2 * hl + comp) + 16 * n + 4 * fq + j;
  }
  if (f < 1536 || f >= 2560) return f;
  const int rel = (f - 1536) & 511, pn = 6 + ((f - 1536) >> 9) * 2 + (rel >> 8), hl = (rel >> 5) & 7, ip = rel & 31;
  const int bj = hl >> 2, wc = hl & 3, fq = ip >> 3, n = (ip >> 2) & 1, j = ip & 3;
  return pn * 256 + 128 * bj + 32 * wc + 16 * n + 4 * fq + j;
}
struct EpiInproj {
  const Ptrs* Pp;
  DI void a_off(const g8::Unit& u, const int (&sR)[2], const int (&sC)[2], unsigned (&v0)[2], unsigned (&v1)[2]) const { g8::dense_a_off(u.pm, 1024, sR, sC, v0, v1); }
  DI size_t b_off(const g8::Unit& u) const { return (size_t)u.pn * 256 * 1024 * 2; }
  DI void operator()(const f32x4 (&acc)[2][2][4][2], const g8::Unit& u, int wr, int wc, int fr, int fq) const {
    const Ptrs& P = *Pp;
    const float* rstdx = (const float*)(P.ws + WS_RSTDX);
    asm volatile("" : "+v"(rstdx));
    const int pn = u.pn, row00 = u.pm * 256 + wr * 64, b = row00 >> 12;
    float rsr[8];
#pragma unroll
    for (int k = 0; k < 8; ++k) rsr[k] = rstdx[row00 + 128 * (k >> 2) + 16 * (k & 3) + fr];
    const float qsA = 0.125f * LOG2E, qsB = 0.17677669529663687f * LOG2E;
    if (pn < 4) {
      const int isk = pn >= 2, head = 2 * (pn & 1) + (wc >> 1), comp = wc & 1;
      const float* gg = ((const float*)(P.ws + WS_PAR)) + (isk ? PAR_GKA : PAR_GQA);
      asm volatile("" : "+v"(gg));
      const float4 g1a = *(const float4*)(gg + 8 * fq), g1b = *(const float4*)(gg + 8 * fq + 4), g2a = *(const float4*)(gg + 32 + 8 * fq), g2b = *(const float4*)(gg + 36 + 8 * fq);
      const float ga[8] = {g1a.x, g1a.y, g1a.z, g1a.w, g1b.x, g1b.y, g1b.z, g1b.w}, gb[8] = {g2a.x, g2a.y, g2a.z, g2a.w, g2b.x, g2b.y, g2b.z, g2b.w};
      u16* dstb = (u16*)(P.ws + (isk ? A_KA : A_QA)) + (size_t)(b * 4 + head) * 4096 * 128 + comp * 64 + 8 * fq;
      const float2* rope = (const float2*)(P.ws + WS_ROPE);
      struct Rp { f32x4 c0, c1, c2, c3; };
      auto ldrope = [&](int k) { const int s = (row00 + 128 * (k >> 2) + 16 * (k & 3) + fr) & 4095; const f32x4* rp = (const f32x4*)(rope + (size_t)s * 32 + 8 * fq);
        Rp r; r.c0 = rp[0]; r.c1 = rp[1]; r.c2 = rp[2]; r.c3 = rp[3]; return r; };
      Rp cur = ldrope(0);
#pragma unroll
      for (int k = 0; k < 8; ++k) {
        const int ai = k >> 2, m = k & 3;
        Rp nxt = cur;
        if (k < 7) nxt = ldrope(k + 1);
        const int row = row00 + 128 * ai + 16 * m + fr, s = row & 4095;
        const float rs = rsr[k];
        float x1[8], x2[8]; float ss = 0.f;
#pragma unroll
        for (int n = 0; n < 2; ++n)
#pragma unroll
          for (int j = 0; j < 4; ++j) { x1[4 * n + j] = acc[ai][0][m][n][j] * rs; x2[4 * n + j] = acc[ai][1][m][n][j] * rs; ss += x1[4 * n + j] * x1[4 * n + j] + x2[4 * n + j] * x2[4 * n + j]; }
        ss += __shfl_xor(ss, 16); ss += __shfl_xor(ss, 32);
        const float rn = rsqrtf(ss * (1.0f / 64.0f) + EPS) * (isk ? 1.0f : qsA);
        const float cs[8] = {cur.c0[0], cur.c0[2], cur.c1[0], cur.c1[2], cur.c2[0], cur.c2[2], cur.c3[0], cur.c3[2]}, sn[8] = {cur.c0[1], cur.c0[3], cur.c1[1], cur.c1[3], cur.c2[1], cur.c2[3], cur.c3[1], cur.c3[3]};
        f32x4 o1a, o1b, o2a, o2b;
#pragma unroll
        for (int e = 0; e < 8; ++e) {
          const float y = x1[e] * rn * ga[e], z = x2[e] * rn * gb[e];
          const float p1 = y * cs[e] - z * sn[e], p2 = z * cs[e] + y * sn[e];
          if (e < 4) { o1a[e] = p1; o2a[e] = p2; } else { o1b[e - 4] = p1; o2b[e - 4] = p2; }
        }
        u16* d = dstb + (size_t)s * 128;
        *(uint4*)d = pk8(o1a, o1b);
        *(uint4*)(d + 32) = pk8(o2a, o2b);
        asm volatile("" ::: "memory");
        cur = nxt;
      }
    } else if (pn >= 6 && pn < 10) {
      const int isk = pn >= 8;
      const float* gg = ((const float*)(P.ws + WS_PAR)) + (isk ? PAR_GKB : PAR_GQB);
      asm volatile("" : "+v"(gg));
      const float4 g1a = *(const float4*)(gg + 8 * fq), g1b = *(const float4*)(gg + 8 * fq + 4);
      const float ga[8] = {g1a.x, g1a.y, g1a.z, g1a.w, g1b.x, g1b.y, g1b.z, g1b.w};
#pragma unroll
      for (int bj = 0; bj < 2; ++bj) {
        const int hd = 8 * (pn & 1) + 4 * bj + wc;
        u16* dstb = (u16*)(P.ws + (isk ? A_KB : A_QB)) + (size_t)(b * 16 + hd) * 4096 * 32 + 8 * fq;
#pragma unroll
        for (int ai = 0; ai < 2; ++ai)
#pragma unroll
          for (int m = 0; m < 4; ++m) {
            const int row = row00 + 128 * ai + 16 * m + fr, s = row & 4095;
            const float rs = rsr[4 * ai + m];
            float x[8]; float ss = 0.f;
#pragma unroll
            for (int n = 0; n < 2; ++n)
#pragma unroll
              for (int j = 0; j < 4; ++j) { x[4 * n + j] = acc[ai][bj][m][n][j] * rs; ss += x[4 * n + j] * x[4 * n + j]; }
            ss += __shfl_xor(ss, 16); ss += __shfl_xor(ss, 32);
            const float rn = rsqrtf(ss * (1.0f / 32.0f) + EPS) * (isk ? 1.0f : qsB);
            f32x4 oa, ob;
#pragma unroll
            for (int e = 0; e < 4; ++e) { oa[e] = x[e] * rn * ga[e]; ob[e] = x[4 + e] * rn * ga[4 + e]; }
            *(uint4*)(dstb + (size_t)s * 32) = pk8(oa, ob);
          }
      }
    } else {
      const int isA = pn < 6;
#pragma unroll
      for (int ai = 0; ai < 2; ++ai)
#pragma unroll
        for (int m = 0; m < 4; ++m) {
          const int row0 = row00 + 128 * ai + 16 * m + 4 * fq, s0 = row0 & 4095;
          const float4 rs = *(const float4*)(rstdx + row0);
          const int sp = isA ? permpos(s0) : s0;
#pragma unroll
          for (int bj = 0; bj < 2; ++bj)
#pragma unroll
            for (int n = 0; n < 2; ++n) {
              const int c = 128 * bj + 32 * wc + 16 * n + fr;
              u16* dst;
              if (isA) dst = (u16*)(P.ws + A_VAT) + ((size_t)(b * 4 + 2 * (pn - 4) + (c >> 7)) * 128 + (c & 127)) * 4096;
              else dst = (u16*)(P.ws + A_VBT) + ((size_t)(b * 16 + 8 * (pn - 10) + (c >> 5)) * 32 + (c & 31)) * 4096;
              const f32x4 v = acc[ai][bj][m][n];
              *(uint2*)(dst + sp) = make_uint2(pk2(v[0] * rs.x, v[1] * rs.y), pk2(v[2] * rs.z, v[3] * rs.w));
            }
        }
    }
  }
};
DI void ph1_inproj8(const Ptrs& P, ldsp lds, int bid, int G) {
  EpiInproj E; E.Pp = &P;
  {
    g8::GridOrder S; S.init(64, 8, G, bid, 0x98763210u);
    g8::gemm_phase<EpiInproj, g8::GridOrder, false, false>(lds, (const unsigned char*)(P.ws + A_XB), (const unsigned char*)(P.ws + WS_WIN), 1024, S, E);
  }
  {
    g8::GridOrder S; S.init(64, 4, G, bid, 0xBA54u);
    g8::gemm_phase<EpiInproj, g8::GridOrder, true, false>(lds, (const unsigned char*)(P.ws + A_XB), (const unsigned char*)(P.ws + WS_WIN), 1024, S, E);
  }
}

DI int p32(int ip) { return 16 * ((ip >> 2) & 1) + 4 * (ip >> 3) + (ip & 3); }
DI int perm256(int f) { return (f & ~31) | p32(f & 31); }
DI int w13_row_w1(int f) { return ((f >> 7) << 8) | (f & 96) | p32(f & 31); }
DI int w13_row_w3(int f) { return (((f >> 7) << 8) | (f & 96) | p32(f & 31)) + 128; }

template <bool PLE>
struct EpiOut {
  const Ptrs* Pp;
  DI void a_off(const g8::Unit&, const int (&)[2], const int (&)[2], unsigned (&)[2], unsigned (&)[2]) const {}
  DI size_t b_off(const g8::Unit& u) const { return (size_t)u.pn * 256 * (PLE ? 256 : 1024) * 2; }
  struct Ld { float4 a0, a1, b0, b1; };
  DI void operator()(const f32x4 (&acc)[2][2][4][2], const g8::Unit& u, int wr, int wc, int fr, int fq) const {
    const Ptrs& P = *Pp;
    float* ssqp = (float*)(P.ws + (PLE ? WS_SSQEP : WS_SSQ1P));
    const int row0 = u.pm * 256 + 64 * wr + fr, col0 = u.pn * 256 + 32 * wc + 8 * fq;
    auto load = [&](int gidx) { const int ai = gidx >> 2, m = gidx & 3; const size_t go = (size_t)(row0 + 128 * ai + 16 * m) * 1024 + col0;
      Ld l; if (!PLE) { const u16* xbp = (const u16*)(P.ws + A_XB) + go; const uint4 ua = *(const uint4*)xbp, ub = *(const uint4*)(xbp + 128);
        l.a0 = make_float4(__uint_as_float(ua.x << 16), __uint_as_float(ua.x & 0xffff0000u), __uint_as_float(ua.y << 16), __uint_as_float(ua.y & 0xffff0000u));
        l.a1 = make_float4(__uint_as_float(ua.z << 16), __uint_as_float(ua.z & 0xffff0000u), __uint_as_float(ua.w << 16), __uint_as_float(ua.w & 0xffff0000u));
        l.b0 = make_float4(__uint_as_float(ub.x << 16), __uint_as_float(ub.x & 0xffff0000u), __uint_as_float(ub.y << 16), __uint_as_float(ub.y & 0xffff0000u));
        l.b1 = make_float4(__uint_as_float(ub.z << 16), __uint_as_float(ub.z & 0xffff0000u), __uint_as_float(ub.w << 16), __uint_as_float(ub.w & 0xffff0000u)); }
      else { l.a0 = l.a1 = l.b0 = l.b1 = make_float4(0.f, 0.f, 0.f, 0.f); } return l; };
    Ld cur = load(0);
#pragma unroll
    for (int gidx = 0; gidx < 8; ++gidx) {
      const int ai = gidx >> 2, m = gidx & 3;
      Ld nxt = cur;
      if (gidx < 7) nxt = load(gidx + 1);
      const int row = row0 + 128 * ai + 16 * m;
      float ss = 0.f;
#pragma unroll
      for (int bj = 0; bj < 2; ++bj) {
        const size_t go = (size_t)row * 1024 + col0 + 128 * bj;
        f32x4 a = acc[ai][bj][m][0], c4 = acc[ai][bj][m][1];
        if (!PLE) {
          const float4 xa = bj ? cur.b0 : cur.a0, xb4 = bj ? cur.b1 : cur.a1;
          a[0] += xa.x; a[1] += xa.y; a[2] += xa.z; a[3] += xa.w; c4[0] += xb4.x; c4[1] += xb4.y; c4[2] += xb4.z; c4[3] += xb4.w;
          *(uint4*)((u16*)(P.ws + A_H1B) + go) = pk8(a, c4);
        } else {
          *(uint4*)((u16*)(P.ws + A_EBF) + go) = pk8(a, c4);
        }
        ss += a[0] * a[0] + a[1] * a[1] + a[2] * a[2] + a[3] * a[3] + c4[0] * c4[0] + c4[1] * c4[1] + c4[2] * c4[2] + c4[3] * c4[3];
      }
      ss += __shfl_xor(ss, 16); ss += __shfl_xor(ss, 32);
      if (fq == 0) ssqp[(size_t)row * 16 + u.pn * 4 + wc] = ss;
      asm volatile("" ::: "memory");
      cur = nxt;
    }
  }
};
DI void ph3_outproj8(const Ptrs& P, ldsp lds, int bid, int G) {
  { EpiOut<false> E; E.Pp = &P; g8::GridOrder S; S.init(64, 4, G, bid);
    g8::gemm_phase<EpiOut<false>, g8::GridOrder, false, false>(lds, (const unsigned char*)(P.ws + A_AO), (const unsigned char*)(P.ws + WS_WOUT), 1024, S, E); }
}

DI int moe_plan8(const Ptrs& P, ldsp lds) {
  LAS int* smb = (LAS int*)(lds + g8::LDS_EXTRA8);
  __syncthreads();
  if (threadIdx.x == 0) {
    const int* cnt = (const int*)(P.ws + WS_CNT);
    int a = 0;
    for (int e = 0; e < 32; ++e) { smb[e] = a; a += (cnt[e * CNT_STRIDE] + 255) >> 8; smb[64 + e] = cnt[e * CNT_STRIDE]; }
    smb[32] = a;
  }
  __syncthreads();
  return smb[32];
}
struct MoeOrder {
  int MB, G, c; const LAS int* smb;
  DI bool next(int i, g8::Unit& u) const {
    const int L = i * G + c;
    if (L >= ((MB + 7) >> 3) * 32) return false;
    const int gmb = (L >> 5) * 8 + (L & 7);
    u.pn = (L >> 3) & 3;
    if (gmb >= MB) return false;
    int e = 0; while (gmb >= smb[e + 1]) ++e;
    u.pm = gmb; u.e = e; u.ce = smb[64 + e] - (gmb - smb[e]) * 256;
    return true;
  }
};
struct EpiUp {
  const Ptrs* Pp; const LAS int* smb;
  DI void a_off(const g8::Unit& u, const int (&sR)[2], const int (&sC)[2], unsigned (&v0)[2], unsigned (&v1)[2]) const {
    const int* tokl = (const int*)(Pp->ws + WS_TOKL) + u.e * 16384 + (u.pm - smb[u.e]) * 256;
#pragma unroll
    for (int i = 0; i < 2; ++i) {
      const int r0 = sR[i], r1 = 128 + sR[i];
      const int t0 = (r0 < u.ce) ? (tokl[r0] >> 1) : 0, t1 = (r1 < u.ce) ? (tokl[r1] >> 1) : 0;
      v0[i] = (unsigned)(t0 * 1024 + sC[i]) * 2u; v1[i] = (unsigned)(t1 * 1024 + sC[i]) * 2u;
    }
  }
  DI size_t b_off(const g8::Unit& u) const { return ((size_t)u.e * 1024 + u.pn * 256) * 1024 * 2; }
  DI void operator()(const f32x4 (&acc)[2][2][4][2], const g8::Unit& u, int wr, int wc, int fr, int fq) const {
    const Ptrs& P = *Pp;
    if (u.ce <= 0) return;
    const int* tokl = (const int*)(P.ws + WS_TOKL) + u.e * 16384 + (u.pm - smb[u.e]) * 256;
    const float* rstd1 = (const float*)(P.ws + WS_RSTD1);
    u16* hid = (u16*)(P.ws + A_HID);
    float rsv[8];
    {
      int tk[8];
#pragma unroll
      for (int k = 0; k < 8; ++k) { const int rl = 128 * (k >> 2) + 64 * wr + 16 * (k & 3) + fr; tk[k] = (rl < u.ce) ? (tokl[rl] >> 1) : -1; }
#pragma unroll
      for (int k = 0; k < 8; ++k) rsv[k] = (tk[k] >= 0) ? rstd1[tk[k]] : 0.0f;
    }
#pragma unroll
    for (int ai = 0; ai < 2; ++ai)
#pragma unroll
      for (int m = 0; m < 4; ++m) {
        const int rl = 128 * ai + 64 * wr + 16 * m + fr;
        const float rs = rsv[4 * ai + m];
        f32x4 h0, h1;
#pragma unroll
        for (int j = 0; j < 4; ++j) {
          const float a = acc[ai][0][m][0][j] * rs, b = acc[ai][0][m][1][j] * rs;
          h0[j] = a / (1.0f + __expf(-a)) * (acc[ai][1][m][0][j] * rs); h1[j] = b / (1.0f + __expf(-b)) * (acc[ai][1][m][1][j] * rs);
        }
        *(uint4*)(hid + (size_t)(u.pm * 256 + rl) * 512 + u.pn * 128 + 32 * wc + 8 * fq) = pk8(h0, h1);
      }
  }
};
DI void ph5_up8(const Ptrs& P, ldsp lds, int bid, int G) {
  const int MB = moe_plan8(P, lds);
  const LAS int* smb = (const LAS int*)(lds + g8::LDS_EXTRA8);
  MoeOrder S; S.MB = MB; S.G = G; S.c = bid; S.smb = smb;
  EpiUp E; E.Pp = &P; E.smb = smb;
  g8::gemm_phase<EpiUp, MoeOrder, false, true>(lds, (const unsigned char*)(P.ws + A_H1B), (const unsigned char*)(P.ws + WS_W13), 1024, S, E);
  {
    const int NU = ((MB + 7) >> 3) * 32, rem = NU % G, nl = rem ? G - rem : G, li = rem ? bid - rem : bid;
    EpiOut<true> E2; E2.Pp = &P; g8::GridOrder S2; S2.init(64, 4, nl, li < 0 ? 0 : li);
    if (li < 0) S2.nwg = 0;
    g8::gemm_phase<EpiOut<true>, g8::GridOrder, false, false>(lds, (const unsigned char*)(P.ws + A_PB), (const unsigned char*)(P.ws + WS_WPLE), 256, S2, E2);
    if (li >= 0) {
      const int lane = threadIdx.x & 63, wave = threadIdx.x >> 6, nwv = blockDim.x >> 6;
      LAS float* scr = (LAS float*)(lds + wave * 16640);
      for (int r = li * nwv + wave; r < 4096 + 256; r += nl * nwv) late_weight_item(r, scr, lane);
    }
  }
}
struct EpiDown {
  const Ptrs* Pp; const LAS int* smb;
  DI void a_off(const g8::Unit&, const int (&)[2], const int (&)[2], unsigned (&)[2], unsigned (&)[2]) const {}
  DI size_t b_off(const g8::Unit& u) const { return ((size_t)u.e * 1024 + u.pn * 256) * 512 * 2; }
  DI void operator()(const f32x4 (&acc)[2][2][4][2], const g8::Unit& u, int wr, int wc, int fr, int fq) const {
    const Ptrs& P = *Pp;
    if (u.ce <= 0) return;
    const int base = u.e * 16384 + (u.pm - smb[u.e]) * 256;
    const int* tokl = (const int*)(P.ws + WS_TOKL) + base; const float* wl = (const float*)(P.ws + WS_WL) + base;
    int tkv[8]; float wv[8];
#pragma unroll
    for (int k = 0; k < 8; ++k) { const int rl = 128 * (k >> 2) + 64 * wr + 16 * (k & 3) + fr; const bool v = rl < u.ce; tkv[k] = v ? tokl[rl] : -1; wv[k] = v ? wl[rl] : 0.0f; }
#pragma unroll
    for (int ai = 0; ai < 2; ++ai)
#pragma unroll
      for (int m = 0; m < 4; ++m) {
        const int tk = tkv[4 * ai + m];
        if (tk >= 0) {
          const float w = wv[4 * ai + m];
          u16* y = (u16*)(P.ws + ((tk & 1) ? A_Y1 : A_Y0)) + (size_t)(tk >> 1) * 1024 + u.pn * 256 + 32 * wc + 8 * fq;
#pragma unroll
          for (int bj = 0; bj < 2; ++bj) {
            f32x4 a = acc[ai][bj][m][0], c4 = acc[ai][bj][m][1];
#pragma unroll
            for (int j = 0; j < 4; ++j) { a[j] *= w; c4[j] *= w; }
            *(uint4*)(y + 128 * bj) = pk8(a, c4);
          }
        }
      }
  }
};
DI void ph6_down8(const Ptrs& P, ldsp lds, int bid, int G) {
  const int MB = moe_plan8(P, lds);
  const LAS int* smb = (const LAS int*)(lds + g8::LDS_EXTRA8);
  MoeOrder S; S.MB = MB; S.G = G; S.c = bid; S.smb = smb;
  EpiDown E; E.Pp = &P; E.smb = smb;
  g8::gemm_phase<EpiDown, MoeOrder, false, false>(lds, (const unsigned char*)(P.ws + A_HID), (const unsigned char*)(P.ws + WS_W2), 512, S, E);
}

struct EpiFinal {
  const Ptrs* Pp;
  DI void a_off(const g8::Unit&, const int (&)[2], const int (&)[2], unsigned (&)[2], unsigned (&)[2]) const {}
  DI size_t b_off(const g8::Unit& u) const { return (size_t)u.pn * 256 * 1024 * 2; }
  struct Ld { u32x4 hh; u32x4 ee; };
  DI void operator()(const f32x4 (&acc)[2][2][4][2], const g8::Unit& u, int wr, int wc, int fr, int fq) const {
    const Ptrs& P = *Pp;
    const float* rstd2 = (const float*)(P.ws + WS_RSTD2); const float* rstdE = (const float*)(P.ws + WS_RSTDE);
    const int row0 = u.pm * 256 + 64 * wr + fr, col0 = u.pn * 256 + 32 * wc + 8 * fq;
    auto load = [&](int gidx) { const int bj = gidx >> 3, ai = (gidx >> 2) & 1, m = gidx & 3; const int row = row0 + 128 * ai + 16 * m; const size_t go = (size_t)row * 1024 + col0 + 128 * bj;
      Ld l;
      l.hh = *(const u32x4*)((const u16*)(P.ws + A_H2B) + go); l.ee = *(const u32x4*)((const u16*)(P.ws + A_EBF) + go); return l; };
    Ld cur = load(0);
    float gv[8];
#pragma unroll
    for (int gidx = 0; gidx < 16; ++gidx) {
      const int bj = gidx >> 3, ai = (gidx >> 2) & 1, m = gidx & 3;
      if ((gidx & 7) == 0) { const float4 ga = *(const float4*)(P.g_ple + col0 + 128 * bj), gb = *(const float4*)(P.g_ple + col0 + 128 * bj + 4);
        gv[0] = ga.x; gv[1] = ga.y; gv[2] = ga.z; gv[3] = ga.w; gv[4] = gb.x; gv[5] = gb.y; gv[6] = gb.z; gv[7] = gb.w; }
      Ld nxt = cur;
      if (gidx < 15) nxt = load(gidx + 1);
      const size_t go = (size_t)(row0 + 128 * ai + 16 * m) * 1024 + col0 + 128 * bj;
      const int row = row0 + 128 * ai + 16 * m;
      const float rs2 = rstd2[row], rE = rstdE[row];
      float hv[8];
#pragma unroll
      for (int k = 0; k < 8; ++k) hv[k] = __uint_as_float((cur.hh[k >> 1] << ((k & 1) ? 0u : 16u)) & 0xffff0000u);
      const f32x4 a = acc[ai][bj][m][0], c4 = acc[ai][bj][m][1];
      const float av[8] = {a[0], a[1], a[2], a[3], c4[0], c4[1], c4[2], c4[3]};
      const unsigned eeu[4] = {cur.ee[0], cur.ee[1], cur.ee[2], cur.ee[3]};
#pragma unroll
      for (int k = 0; k < 8; ++k) {
        const unsigned sh = (k & 1) ? 0u : 16u;
        const float ev = __uint_as_float((eeu[k >> 1] << sh) & 0xffff0000u);
        const float sg = 1.0f / (1.0f + __expf(-av[k] * rs2));
        hv[k] = hv[k] + ev * rE * gv[k] * sg;
      }
      float* wr_ = P.out + go;
      __builtin_nontemporal_store((f32x4){hv[0], hv[1], hv[2], hv[3]}, (f32x4*)wr_); __builtin_nontemporal_store((f32x4){hv[4], hv[5], hv[6], hv[7]}, (f32x4*)(wr_ + 4));
      asm volatile("" ::: "memory");
      cur = nxt;
    }
  }
};
DI void ph8_final8(const Ptrs& P, ldsp lds, int bid, int G) {
  EpiFinal E; E.Pp = &P; g8::GridOrder S; S.init(64, 4, G, bid);
  g8::gemm_phase<EpiFinal, g8::GridOrder, false, false>(lds, (const unsigned char*)(P.ws + A_H2B), (const unsigned char*)(P.ws + WS_WPLG), 1024, S, E);
}

template <bool SHIFT>
DI void da_item8(const Ptrs& P, ldsp lds, int item, float lam, float m2) {
  const int tid = threadIdx.x, lane = tid & 63, wave = __builtin_amdgcn_readfirstlane(tid >> 6), h = lane >> 5, i31 = lane & 31;
  const int xcd = item & 7, loc = item >> 3, bh = 2 * xcd + (loc >> 4), qblk = loc & 15;
  const u16* qA = (const u16*)(P.ws + A_QA) + (size_t)bh * 4096 * 128;
  const u16* kA = (const u16*)(P.ws + A_KA) + (size_t)bh * 4096 * 128;
  const u16* vAt = (const u16*)(P.ws + A_VAT) + (size_t)bh * 128 * 4096;
  const int q = qblk * 256 + 32 * wave + i31;
  bf16x8 qf[2][4];
#pragma unroll
  for (int c = 0; c < 2; ++c)
#pragma unroll
    for (int s = 0; s < 4; ++s) qf[c][s] = *(const bf16x8*)(qA + (size_t)q * 128 + c * 64 + 16 * s + 8 * h);
  auto stage = [&](int buf, int tile) {
    int ln = lane; asm volatile("" : "+v"(ln));
    ldsp lk = lds + buf * DA_STAGE;
    const u16* kt = kA + (size_t)tile * 64 * 128;
    const u16* vt = vAt + tile * 64;
#pragma unroll
    for (int qq = 0; qq < 2; ++qq) {
      const int jj = 2 * wave + qq;
      const int ra = key_of(0, jj), rb = key_of(1, jj);
      const int ku = ln >> 4, key = 32 * (ku >> 1) + ((ku & 1) ? rb : ra);
      glds16(kt + key * 128 + (ln & 15) * 8, lk + jj * 1040);
      const int vu = ln >> 3, d = 32 * (vu >> 1) + ((vu & 1) ? rb : ra);
      glds16(vt + d * 4096 + (ln & 7) * 8, lk + DA_VOFF + jj * 1040);
    }
  };
  const int rk = rank_of(i31), gr = grp_of(i31);
  const int kbase = rk * 1040 + gr * 256 + h * 16;
  const int vbase = DA_VOFF + rk * 1040 + gr * 128 + h * 16;
  f32x16 O1[4], O2[4];
#pragma unroll
  for (int dt = 0; dt < 4; ++dt)
#pragma unroll
    for (int e = 0; e < 16; ++e) { O1[dt][e] = 0.f; O2[dt][e] = 0.f; }
  float l1 = 0.f, l2 = 0.f;
  __syncthreads();
  stage(0, 0);
  stage(1, 1);
  asm volatile("s_waitcnt vmcnt(4)" ::: "memory");
  __builtin_amdgcn_s_barrier();
  int buf = 0;
  for (int tile = 0; tile < 64; ++tile) {
    if (tile + 2 < 64) stage(buf >= 1 ? buf - 1 : 2, tile + 2);
    ldsp lb = lds + buf * DA_STAGE;
#pragma unroll 1
    for (int kt2 = 0; kt2 < 2; ++kt2) {
      bf16x8 pf[2][2];
      ldsp lk = lb + kbase + kt2 * 512;
      ldsp lv = lb + vbase + kt2 * 64;
#pragma unroll
      for (int c = 0; c < 2; ++c) {
        f32x16 sa;
#pragma unroll
        for (int e = 0; e < 16; ++e) sa[e] = 0.f;
#pragma unroll
        for (int s = 0; s < 4; ++s) {
          const bf16x8 kf = *(LAS bf16x8*)(lk + c * 128 + s * 32);
          sa = __builtin_amdgcn_mfma_f32_32x32x16_bf16(kf, qf[c][s], sa, 0, 0, 0);
        }
        float ls = 0.f;
#pragma unroll
        for (int e = 0; e < 16; ++e) { sa[e] = __builtin_amdgcn_exp2f(SHIFT ? sa[e] - m2 : sa[e]); ls += sa[e]; }
        if (c == 0) l1 += ls; else l2 += ls;
        pf[c][0] = packp(sa, 0); pf[c][1] = packp(sa, 1);
      }
      __builtin_amdgcn_sched_barrier(0);
      bf16x8 va = *(LAS bf16x8*)(lv), vb = *(LAS bf16x8*)(lv + 256);
#pragma unroll
      for (int st = 0; st < 4; ++st) {
        const int s2 = st >> 1, dtp = st & 1;
        bf16x8 na = va, nb = vb;
        if (st < 3) { const int s2n = (st + 1) >> 1, dn = (st + 1) & 1; na = *(LAS bf16x8*)(lv + s2n * 32 + dn * 512); nb = *(LAS bf16x8*)(lv + s2n * 32 + dn * 512 + 256); }
        __builtin_amdgcn_sched_barrier(0);
        __builtin_amdgcn_s_setprio(1);
        O1[2 * dtp] = __builtin_amdgcn_mfma_f32_32x32x16_bf16(va, pf[0][s2], O1[2 * dtp], 0, 0, 0);
        O2[2 * dtp] = __builtin_amdgcn_mfma_f32_32x32x16_bf16(va, pf[1][s2], O2[2 * dtp], 0, 0, 0);
        O1[2 * dtp + 1] = __builtin_amdgcn_mfma_f32_32x32x16_bf16(vb, pf[0][s2], O1[2 * dtp + 1], 0, 0, 0);
        O2[2 * dtp + 1] = __builtin_amdgcn_mfma_f32_32x32x16_bf16(vb, pf[1][s2], O2[2 * dtp + 1], 0, 0, 0);
        __builtin_amdgcn_s_setprio(0);
        __builtin_amdgcn_sched_barrier(0);
        va = na; vb = nb;
      }
    }
    if (tile + 2 < 64) asm volatile("s_waitcnt vmcnt(4)" ::: "memory"); else asm volatile("s_waitcnt vmcnt(0)" ::: "memory");
    __builtin_amdgcn_s_barrier();
    buf = (buf == 2) ? 0 : buf + 1;
  }
  l1 += __shfl_xor(l1, 32); l2 += __shfl_xor(l2, 32);
  const float i1 = 1.0f / l1, i2 = lam / l2;
  float ss = 0.f;
#pragma unroll
  for (int dt = 0; dt < 4; ++dt)
#pragma unroll
    for (int e = 0; e < 16; ++e) { const float o = O1[dt][e] * i1 - O2[dt][e] * i2; O1[dt][e] = o; ss += o * o; }
  ss += __shfl_xor(ss, 32);
  const float rn = rsqrtf(ss * (1.0f / 128.0f) + EPS) * (1.0f - LAM_INIT);
  const int b = bh >> 2, hh = bh & 3;
  u16* dst = (u16*)(P.ws + A_AO) + ((size_t)b * 4096 + q) * 1024 + hh * 128;
#pragma unroll
  for (int dt = 0; dt < 4; ++dt)
#pragma unroll
    for (int g = 0; g < 4; ++g) {
      const int d0 = 32 * dt + 8 * g + 4 * h;
      const float4 gs = *(const float4*)(P.g_sub + d0);
      *(uint2*)(dst + d0) = make_uint2(pk2(O1[dt][4 * g] * rn * gs.x, O1[dt][4 * g + 1] * rn * gs.y), pk2(O1[dt][4 * g + 2] * rn * gs.z, O1[dt][4 * g + 3] * rn * gs.w));
    }
}

constexpr int NA8_VSTRIDE = 1936;
constexpr int NA8_TAB = 32 * NA8_VSTRIDE;
DI void na_block8(const Ptrs& P, ldsp lds, int item, float qkbound) {
  const int tid = threadIdx.x, lane = tid & 63, wave = tid >> 6;
  const int r0 = (item & 7) * 8, hd = (item >> 3) & 15, b = item >> 7;
  const int qi = lane & 15, g = lane >> 4;
  LAS float* EB = (LAS float*)(lds + NA8_TAB);
  LAS float* RW = EB + 960;
  const int R0 = min(max(r0 - 4, 0), 56), NR = min(15, 64 - R0);
  const u16* vB = (const u16*)(P.ws + A_VBT) + (size_t)(b * 16 + hd) * 32 * 4096;
  __syncthreads();
  {
    u32x4 vv[8];
#pragma unroll
    for (int k = 0; k < 8; ++k) {
      const int sg = (tid >> 3) + 64 * k, d = sg / NR, kr = sg - d * NR;
      vv[k] = *(const u32x4*)(vB + (size_t)min(d, 31) * 4096 + (R0 + min(kr, NR - 1)) * 64 + 8 * (tid & 7));
    }
    float mxa = 0.f;
    const float r0v = (tid < 465) ? P.rpb[hd * 465 + tid] : 0.f;
    mxa = fabsf(r0v);
#pragma unroll
    for (int o = 1; o < 64; o <<= 1) mxa = fmaxf(mxa, __shfl_xor(mxa, o));
    LAS float* red = (LAS float*)(lds + NA8_TAB + 7680);
    if (lane == 0) red[wave] = mxa;
#pragma unroll
    for (int k = 0; k < 8; ++k) {
      const int sg = (tid >> 3) + 64 * k, d = sg / NR, kr = sg - d * NR;
      if (sg < 32 * NR) *(LAS u32x4*)(lds + d * NA8_VSTRIDE + kr * 128 + 16 * (tid & 7)) = vv[k];
    }
    __syncthreads();
    const float m2 = (qkbound + fmaxf(fmaxf(fmaxf(red[0], red[1]), fmaxf(red[2], red[3])), fmaxf(fmaxf(red[4], red[5]), fmaxf(red[6], red[7])))) * LOG2E;
    for (int e = tid; e < 960; e += 512) {
      const int br = e >> 6, co = (e & 63) - 16;
      const float v = (co >= 0 && co <= 30) ? P.rpb[hd * 465 + br * 31 + co] * LOG2E - m2 : -1e30f;
      RW[e] = v;
      EB[e] = (co >= 7 && co <= 22) ? v : -1e30f;
    }
    __syncthreads();
  }
  const int r = r0 + wave;
  const int rs = min(max(r - 4, 0), 56), rb0 = rs - r + 7;
  const u16* qB = (const u16*)(P.ws + A_QB) + (size_t)(b * 16 + hd) * 4096 * 32;
  const u16* kBp = (const u16*)(P.ws + A_KB) + (size_t)(b * 16 + hd) * 4096 * 32;
  bf16x8 kf[16], qf;
  auto issue_kq = [&](int jq) {
    const int kb = min(min(max(16 * jq - 8, 0), 48), 32);
    const u16* kp = kBp + (size_t)(rs * 64 + kb + qi) * 32 + 8 * g;
    qf = *(const bf16x8*)(qB + (size_t)(r * 64 + 16 * jq + qi) * 32 + 8 * g);
#pragma unroll
    for (int ri = 0; ri < 8; ++ri)
#pragma unroll
      for (int t = 0; t < 2; ++t) kf[2 * ri + t] = *(const bf16x8*)(kp + (ri * 64 + 16 * t) * 32);
  };
  issue_kq(0);
#pragma unroll 1
  for (int jq = 0; jq < 4; ++jq) {
    const int kb = min(min(max(16 * jq - 8, 0), 48), 32);
    const LAS float* tb[2];
    {
      const int cobase = (jq == 0) ? 15 : ((jq == 3) ? -1 : 7);
#pragma unroll
      for (int t = 0; t < 2; ++t) {
        const int off = rb0 * 64 + cobase + 16 * t + 4 * g - qi + 16;
        const LAS float* pe = EB + off; const LAS float* pr = RW + off; const LAS float* pn = RW + 48;
        const LAS float* sel = pe;
        if (jq == 0 && qi < 8) sel = (t == 0) ? pr : pn;
        if (jq == 3 && qi > 8) sel = (t == 1) ? pr : pn;
        tb[t] = sel;
      }
    }
    f32x4 sa[8][2];
#pragma unroll
    for (int ri = 0; ri < 8; ++ri)
#pragma unroll
      for (int t = 0; t < 2; ++t) {
        const LAS float* tp = tb[t] + ri * 64;
        const f32x4 ci = {tp[0], tp[1], tp[2], tp[3]};
        sa[ri][t] = __builtin_amdgcn_mfma_f32_16x16x32_bf16(kf[2 * ri + t], qf, ci, 0, 0, 0);
      }
    __builtin_amdgcn_sched_barrier(0);
    if (jq + 1 < 4) issue_kq(jq + 1);
    __builtin_amdgcn_sched_barrier(0);
    float l = 0.f;
    f32x4 oa[2] = {{0.f, 0.f, 0.f, 0.f}, {0.f, 0.f, 0.f, 0.f}};
    ldsp vl = lds + qi * NA8_VSTRIDE + (rs - R0) * 128 + (kb + 4 * g) * 2;
#pragma unroll
    for (int ri = 0; ri < 8; ++ri) {
      float p[8];
#pragma unroll
      for (int t = 0; t < 2; ++t)
#pragma unroll
        for (int i = 0; i < 4; ++i) { const float e = __builtin_amdgcn_exp2f(sa[ri][t][i]); p[4 * t + i] = e; l += e; }
      u32x4 pp; pp[0] = pk2(p[0], p[1]); pp[1] = pk2(p[2], p[3]); pp[2] = pk2(p[4], p[5]); pp[3] = pk2(p[6], p[7]);
      const bf16x8 pfr = __builtin_bit_cast(bf16x8, pp);
#pragma unroll
      for (int dtl = 0; dtl < 2; ++dtl) {
        const s16x4 lo = *(LAS s16x4*)(vl + dtl * 16 * NA8_VSTRIDE + ri * 128), hi = *(LAS s16x4*)(vl + dtl * 16 * NA8_VSTRIDE + ri * 128 + 32);
        const bf16x8 vf = __builtin_shufflevector(lo, hi, 0, 1, 2, 3, 4, 5, 6, 7);
        oa[dtl] = __builtin_amdgcn_mfma_f32_16x16x32_bf16(vf, pfr, oa[dtl], 0, 0, 0);
      }
    }
    l += __shfl_xor(l, 16); l += __shfl_xor(l, 32);
    const float il = 1.0f / l;
    u16* dst = (u16*)(P.ws + A_AO) + ((size_t)b * 4096 + r * 64 + 16 * jq + qi) * 1024 + 512 + hd * 32;
#pragma unroll
    for (int dtl = 0; dtl < 2; ++dtl)
      *(uint2*)(dst + 16 * dtl + 4 * g) = make_uint2(pk2(oa[dtl][0] * il, oa[dtl][1] * il), pk2(oa[dtl][2] * il, oa[dtl][3] * il));
  }
}

DI void ph2_attn8(const Ptrs& P, ldsp lds, int bid, int G) {
  const float* sc = (const float*)(P.ws + WS_SCAL);
  const float lam = sc[0], m2 = sc[1], qkb = sc[2];
  if (m2 < 64.0f) { for (int it = bid; it < 256; it += G) da_item8<false>(P, lds, it, lam, m2); }
  else { for (int it = bid; it < 256; it += G) da_item8<true>(P, lds, it, lam, m2); }
  for (int it = bid; it < 512; it += G) na_block8(P, lds, it, qkb);
}

__global__ void __launch_bounds__(512, 2) mega8(Ptrs Pk, int ph_lo, int ph_hi) {
  extern __shared__ __attribute__((aligned(16))) unsigned char smem[];
  ldsp lds = (ldsp)smem;
  const int bid = blockIdx.x, G = gridDim.x;
  volatile LAS unsigned* st = (volatile LAS unsigned*)(lds + g8::LDS_EXTRA8 + 4080);
  XcdBarrier xb; xb.bar = (unsigned*)(Pk.ws + WS_CTL); xb.x = 0; xb.st = st;
  if (ph_hi - ph_lo > 1) {
    if (threadIdx.x == 0) { st[0] = 0u; st[1] = 0u; }
    __syncthreads();
    xb = xcd_barrier_post((unsigned*)(Pk.ws + WS_CTL), st);
  }
#define RUN_PHASE8(k, call) if (ph_lo <= k && k < ph_hi) { { const Ptrs P = load_args(); call; } if (k + 1 < ph_hi) xcd_barrier(xb); }
  RUN_PHASE8(0, ph0_prep(P, lds, bid, G))
  RUN_PHASE8(1, ph1_inproj8(P, lds, bid, G))
  RUN_PHASE8(2, ph2_attn8(P, lds, bid, G))
  RUN_PHASE8(3, ph3_outproj8(P, lds, bid, G))
  RUN_PHASE8(4, ph4_router(P, lds, bid, G))
  RUN_PHASE8(5, ph5_up8(P, lds, bid, G))
  RUN_PHASE8(6, ph6_down8(P, lds, bid, G))
  RUN_PHASE8(7, ph7_combine(P, lds, bid, G))
  RUN_PHASE8(8, ph8_final8(P, lds, bid, G))
}
extern "C" void kernel_launch(void* const* d_in, const int* in_sizes, int n_in, void* d_out, int out_size, void* d_ws, size_t ws_size,
                              hipStream_t stream) {
  static int grid = 0;
  if (grid == 0) {
    if (n_in != 25 || ws_size < WS_END || out_size != T * DM) { fprintf(stderr, "kernel_launch: unexpected n_in %d / out %d / ws_size %zu (need %zu)\\n", n_in, out_size, ws_size, (size_t)WS_END); grid = -1; return; }
    int dev = 0, cus = 0, per_cu = 0;
    (void)hipGetDevice(&dev);
    (void)hipDeviceGetAttribute(&cus, hipDeviceAttributeMultiprocessorCount, dev);
    (void)hipFuncSetAttribute((const void*)mega8, hipFuncAttributeMaxDynamicSharedMemorySize, g8::LDS_BYTES8);
    (void)hipOccupancyMaxActiveBlocksPerMultiprocessor(&per_cu, (const void*)mega8, 512, g8::LDS_BYTES8);
    if (per_cu < 1) { fprintf(stderr, "kernel_launch: occupancy query returned %d\\n", per_cu); grid = -1; return; }
    grid = cus;
  }
  if (grid < 0) return;
  Ptrs P{};
  const float** pp = (const float**)&P;
  for (int i = 0; i < 25; ++i) pp[i] = (const float*)d_in[i];
  P.out = (float*)d_out; P.ws = (unsigned char*)d_ws;
  (void)hipMemsetAsync((unsigned char*)d_ws + WS_CTL, 0, XCD_BAR_WORDS * 4, stream);
  mega8<<<grid, 512, g8::LDS_BYTES8, stream>>>(P, 0, 9);
}
```

```cpp
#define ONE_LAUNCH 2
#define NEW_MASK 0x1ff
#include <hip/hip_runtime.h>
#include <cstdio>
#include <cstdint>

typedef unsigned short u16;
#define DI __device__ __forceinline__

constexpr int T = 16384, S = 4096, DM = 1024, NB = 4;
constexpr int DIN = 3072, DPLE = 256;
constexpr int HA = 4, HB = 16;
constexpr int NE = 32, DE = 512;
constexpr float EPS = 1e-6f;
constexpr float LOG2E = 1.4426950408889634f;
constexpr float LAM_INIT = 0.2f;

constexpr size_t MiB = 1ull << 20;
constexpr size_t WS_WIN = 0, WS_WOUT = 6 * MiB, WS_W13 = 8 * MiB, WS_W2 = 72 * MiB, WS_WPLG = 104 * MiB,
                 WS_WPLE = 106 * MiB, WS_WR = 106 * MiB + 512 * 1024, WS_ROPE = 107 * MiB;
constexpr size_t WS_SMALL = 108 * MiB;
constexpr size_t WS_RSTDX = WS_SMALL;
constexpr size_t WS_SSQ1P = 250 * MiB;
constexpr size_t WS_SSQEP = 251 * MiB;
constexpr int SSQ_PARTS = 16;
constexpr size_t WS_RSTD1 = WS_RSTDX + 65536;
constexpr size_t WS_RSTD2 = WS_RSTD1 + 65536;
constexpr size_t WS_SCAL  = WS_RSTD2 + 65536;
constexpr size_t WS_CNT   = WS_SCAL + 256;
constexpr int CNT_STRIDE = 64;
constexpr size_t WS_PADST = WS_CNT + 8192;
constexpr size_t WS_CTL   = WS_PADST + 256;
constexpr size_t WS_RSTDE = WS_CTL + 16384;
constexpr size_t WS_PAR   = WS_SMALL + 1 * MiB;
constexpr int PAR_GQA = 0, PAR_GKA = 64, PAR_GSUB = 128, PAR_GQB = 256, PAR_GKB = 288, PAR_GPLE = 320, PAR_RPB = 1344, PAR_TOTAL = 1344 + 7440;
constexpr size_t WS_TOKL  = WS_SMALL + 2 * MiB;
constexpr size_t WS_WL    = WS_SMALL + 4 * MiB;
constexpr size_t WS_ACT   = 114 * MiB;
constexpr size_t A_XB = WS_ACT, A_AO = 260 * MiB, A_HID = WS_ACT, A_H2B = WS_ACT;
constexpr size_t A_PB = 252 * MiB;
constexpr size_t A_QA = WS_ACT + 40 * MiB, A_KA = WS_ACT + 56 * MiB, A_VAT = WS_ACT + 72 * MiB,
                 A_QB = WS_ACT + 88 * MiB, A_KB = WS_ACT + 104 * MiB, A_VBT = WS_ACT + 120 * MiB;
constexpr size_t A_H1B = WS_ACT + 40 * MiB, A_EBF = WS_ACT + 72 * MiB, A_Y0 = WS_ACT + 104 * MiB, A_Y1 = 260 * MiB;
constexpr size_t WS_END = 292 * MiB;

DI float bf2f(u16 u) { return __uint_as_float(((unsigned)u) << 16); }
DI u16 f2bf(float f) { __bf16 b = (__bf16)f; return __builtin_bit_cast(u16, b); }
DI int permpos(int s) { return (s & ~12) | ((s & 8) >> 1) | ((s & 4) << 1); }

struct Ptrs {
  const float *x, *p, *g_mix, *w_in, *g_qa, *g_ka, *lam_q1, *lam_k1, *lam_q2, *lam_k2, *g_sub, *g_qb, *g_kb, *rpb, *w_out,
      *g_ffn, *w_rg, *w_re, *w1, *w3, *w2, *g_plg, *w_plg, *w_ple, *g_ple;
  float* out;
  unsigned char* ws;
};

#define GAS __attribute__((address_space(1)))
#define LAS __attribute__((address_space(3)))
typedef LAS unsigned char* ldsp;
typedef __attribute__((ext_vector_type(8))) short bf16x8;
typedef __attribute__((ext_vector_type(16))) float f32x16;
typedef __attribute__((ext_vector_type(4))) float f32x4;
typedef __attribute__((ext_vector_type(2))) float f32x2v;
typedef __attribute__((ext_vector_type(2))) __bf16 bf16x2v;
DI unsigned pk2(float a, float b) { bf16x2v v = __builtin_convertvector((f32x2v){a, b}, bf16x2v); return __builtin_bit_cast(unsigned, v); }
DI float wave_sum(float v) {
#pragma unroll
  for (int o = 1; o < 64; o <<= 1) v += __shfl_xor(v, o);
  return v;
}
DI void glds16(const void* g, ldsp l) { __builtin_amdgcn_global_load_lds((const GAS unsigned*)g, (LAS unsigned*)l, 16, 0, 0); }
DI void lds_wave_sync() { asm volatile("s_waitcnt lgkmcnt(0)" ::: "memory"); }

#define XB_TMO      128
#define XB_XCNT(j)  (256  + 64 * (j))
#define XB_XSUB(j)  (1280 + 64 * (j))
#define XB_XGEN(j)  (2304 + 64 * (j))
#define XB_TOP      3328
#define XB_TOPGEN   3392
#define XCD_BAR_WORDS 3456
#define XB_SPIN_CAP (1u << 22)
DI unsigned xb_ld(unsigned* p) { return __hip_atomic_load(p, __ATOMIC_RELAXED, __HIP_MEMORY_SCOPE_AGENT); }
DI unsigned xb_add(unsigned* p, unsigned v) { return __hip_atomic_fetch_add(p, v, __ATOMIC_RELAXED, __HIP_MEMORY_SCOPE_AGENT); }
DI unsigned xb_xcc_id() { return (unsigned)__builtin_amdgcn_s_getreg((3 << 11) | 20) & 0xFu; }
#define XB_SPIN(cond, bar) do { unsigned _sp = 0; while (cond) { __builtin_amdgcn_s_sleep(1); \
    if ((++_sp & 255u) == 0u) { if (xb_ld(&(bar)[XB_TMO])) break; if (_sp > XB_SPIN_CAP) { atomicAdd(&(bar)[XB_TMO], 1u); break; } } } } while (0)
struct XcdBarrier { unsigned* bar; unsigned x; volatile LAS unsigned* st; };
DI XcdBarrier xcd_barrier_post(unsigned* bar, volatile LAS unsigned* st) {
  XcdBarrier b; b.bar = bar; b.x = xb_xcc_id(); b.st = st;
  if (threadIdx.x == 0) (void)xb_add(&bar[XB_XCNT(b.x)], 1u);
  return b;
}
DI void xcd_barrier_complete(unsigned* bar, unsigned x, unsigned& nloc, unsigned& nx) {
  const unsigned G = gridDim.x;
  unsigned sum, cnt, mine, sp = 0u;
  for (;;) {
    sum = 0u; cnt = 0u; mine = 0u;
#pragma unroll
    for (unsigned j = 0; j < 16; ++j) { const unsigned c = xb_ld(&bar[XB_XCNT(j)]); sum += c; cnt += (c > 0u) ? 1u : 0u; mine = (j == x) ? c : mine; }
    if (sum == G) break;
    __builtin_amdgcn_s_sleep(1);
    if ((++sp & 255u) == 0u) { if (xb_ld(&bar[XB_TMO])) break; if (sp > XB_SPIN_CAP) { atomicAdd(&bar[XB_TMO], 1u); break; } }
  }
  nloc = mine > 0u ? mine : 1u; nx = cnt > 0u ? cnt : 1u;
}
DI void xcd_barrier(const XcdBarrier& b) {
  asm volatile("s_waitcnt vmcnt(0)" ::: "memory");
  __syncthreads();
  if (threadIdx.x == 0) {
    unsigned* bar = b.bar;
    __builtin_amdgcn_s_waitcnt(0);
    unsigned nloc = b.st[0], nx = b.st[1];
    if (nloc == 0u) { xcd_barrier_complete(bar, b.x, nloc, nx); b.st[0] = nloc; b.st[1] = nx; }
    const unsigned old = xb_add(&bar[XB_XSUB(b.x)], 1u);
    const unsigned gen = old / nloc;
    if (old + 1u == (gen + 1u) * nloc) {
      __builtin_amdgcn_fence(__ATOMIC_RELEASE, "agent");
      asm volatile("s_waitcnt vmcnt(0)" ::: "memory");
      const unsigned og = xb_add(&bar[XB_TOP], 1u);
      const unsigned tg = og / nx;
      if (og + 1u == (tg + 1u) * nx) xb_add(&bar[XB_TOPGEN], 1u);
      else XB_SPIN(xb_ld(&bar[XB_TOPGEN]) == tg, bar);
      __builtin_amdgcn_fence(__ATOMIC_ACQUIRE, "agent");
      xb_add(&bar[XB_XGEN(b.x)], 1u);
      asm volatile("s_waitcnt vmcnt(0)" ::: "memory");
    } else {
      XB_SPIN(xb_ld(&bar[XB_XGEN(b.x)]) == gen, bar);
      __builtin_amdgcn_fence(__ATOMIC_ACQUIRE, "agent");
      asm volatile("s_waitcnt vmcnt(0)" ::: "memory");
    }
  }
  __syncthreads();
}

DI int win8_row(int f);
DI int perm256(int f);
DI int w13_row_w1(int f);
DI int w13_row_w3(int f);
typedef int (*rowmap_t)(int);
template <rowmap_t rowmap = (rowmap_t) nullptr>
DI void tr_item(const float* W, int ldw, int k0, int n0, const float* gk, u16* dst0, u16* dst1, int ldd, LAS float* scr, int lane) {
  float4 v[16];
  const float* src = W + (size_t)(k0 + (lane >> 4)) * ldw + n0 + 4 * (lane & 15);
#pragma unroll
  for (int j = 0; j < 16; ++j) { const f32x4 t = __builtin_nontemporal_load((const f32x4*)(src + (size_t)(4 * j) * ldw)); v[j] = make_float4(t[0], t[1], t[2], t[3]); }
  if (gk) {
#pragma unroll
    for (int j = 0; j < 16; ++j) { const float g = gk[k0 + 4 * j + (lane >> 4)]; v[j].x *= g; v[j].y *= g; v[j].z *= g; v[j].w *= g; }
  }
  LAS float* w = scr + (lane >> 4) * 65 + 4 * (lane & 15);
#pragma unroll
  for (int j = 0; j < 16; ++j) { w[(4 * j) * 65] = v[j].x; w[(4 * j) * 65 + 1] = v[j].y; w[(4 * j) * 65 + 2] = v[j].z; w[(4 * j) * 65 + 3] = v[j].w; }
  lds_wave_sync();
  const int c = lane & 7;
#pragma unroll
  for (int j = 0; j < 8; ++j) {
    const int n = (lane >> 3) + 8 * j;
    const LAS float* s = scr + (8 * c) * 65 + n;
    uint4 o;
    o.x = pk2(s[0 * 65], s[1 * 65]); o.y = pk2(s[2 * 65], s[3 * 65]); o.z = pk2(s[4 * 65], s[5 * 65]); o.w = pk2(s[6 * 65], s[7 * 65]);
    u16* d = rowmap ? (dst0 + (size_t)rowmap(n0 + n) * ldd) : ((j < 4) ? (dst0 + (size_t)n * ldd) : (dst1 + (size_t)(n - 32) * ldd));
    *(uint4*)(d + k0 + 8 * c) = o;
  }
  lds_wave_sync();
}

typedef const __attribute__((address_space(4))) Ptrs* kargp_t;
DI kargp_t kargs_now() {
#if defined(__HIP_DEVICE_COMPILE__)
  kargp_t kp = (kargp_t)__builtin_amdgcn_kernarg_segment_ptr(); asm volatile("" : "+s"(kp)); return kp;
#else
  return nullptr;
#endif
}
DI Ptrs load_args() {
#if defined(__HIP_DEVICE_COMPILE__)
  kargp_t kp = kargs_now(); Ptrs r; __builtin_memcpy(&r, (const void*)kp, sizeof(Ptrs)); return r;
#else
  return Ptrs{};
#endif
}
DI void late_weight_item(int r, LAS float* scr, int lane) {
  unsigned char* const wsb = kargs_now()->ws;
  if (r < 4096) {
    u16* W2T = (u16*)(wsb + WS_W2);
    const int e = r >> 7, q = r & 127, kb = q >> 4, nb = q & 15;
    tr_item<perm256>(kargs_now()->w2 + (size_t)e * 512 * 1024, 1024, kb * 64, nb * 64, nullptr, W2T + (size_t)e * 1024 * 512, nullptr, 512, scr, lane);
  } else {
    r -= 4096;
    const int kb = r >> 4, nb = r & 15;
    tr_item<perm256>(kargs_now()->w_plg, 1024, kb * 64, nb * 64, kargs_now()->g_plg, (u16*)(wsb + WS_WPLG), nullptr, 1024, scr, lane);
  }
}
DI void ph0_prep(const Ptrs& Punused, ldsp lds, int bid, int G) {
  unsigned char* const wsb = kargs_now()->ws;
  const int tid = threadIdx.x, lane = tid & 63, wave = tid >> 6;
  LAS float* scr = (LAS float*)(lds + wave * 16640);
  const int nwv = blockDim.x >> 6, gw = bid * nwv + wave, NGW = G * nwv;
  constexpr int I_W1 = 4096, I_W3 = 4096, I_W2 = 4096, I_X = 8192, I_WIN = 768, I_P = 2048, I_WOUT = 256, I_PLG = 256, I_PLE = 64,
                I_WR = 768, I_ROPE = 2048, I_PAR = (PAR_TOTAL + 63) / 64, I_SC = 1;
  constexpr int TOTAL = I_W1 + I_W3 + I_W2 + I_X + I_WIN + I_P + I_WOUT + I_PLG + I_PLE + I_WR + I_ROPE + I_PAR + I_SC;
  u16* W13T = (u16*)(wsb + WS_W13); u16* W2T = (u16*)(wsb + WS_W2);
  for (int r0_ = gw; r0_ < I_W1 + I_W3; r0_ += NGW) {
    int r = r0_;
      const int isw3 = r >= I_W1; if (isw3) r -= I_W1;
      const int e = r >> 7, q = r & 127, kb = q >> 3, nb = q & 7;
      u16* d0 = W13T + ((size_t)e * 1024 + nb * 128 + isw3 * 32) * 1024;
#if NEW_MASK & 0x20
      if (isw3) tr_item<w13_row_w3>(kargs_now()->w3 + (size_t)e * 1024 * 512, 512, kb * 64, nb * 64, kargs_now()->g_ffn, W13T + (size_t)e * 1024 * 1024, nullptr, 1024, scr, lane);
      else tr_item<w13_row_w1>(kargs_now()->w1 + (size_t)e * 1024 * 512, 512, kb * 64, nb * 64, kargs_now()->g_ffn, W13T + (size_t)e * 1024 * 1024, nullptr, 1024, scr, lane);
#else
      tr_item((isw3 ? kargs_now()->w3 : kargs_now()->w1) + (size_t)e * 1024 * 512, 512, kb * 64, nb * 64, kargs_now()->g_ffn, d0, d0 + 64 * 1024, 1024, scr, lane);
#endif
  }
  for (int r0_ = gw; r0_ < I_X; r0_ += NGW) {
    int r = r0_;
      const float4* xr = (const float4*)(kargs_now()->x + (size_t)r * 2048) + lane;
      float4 v[8];
#pragma unroll
      for (int j = 0; j < 8; ++j) { const f32x4 t = __builtin_nontemporal_load((const f32x4*)(xr + 64 * j)); v[j] = make_float4(t[0], t[1], t[2], t[3]); }
      float s0 = 0.f, s1 = 0.f;
#pragma unroll
      for (int j = 0; j < 4; ++j) { s0 += v[j].x * v[j].x + v[j].y * v[j].y + v[j].z * v[j].z + v[j].w * v[j].w; s1 += v[j + 4].x * v[j + 4].x + v[j + 4].y * v[j + 4].y + v[j + 4].z * v[j + 4].z + v[j + 4].w * v[j + 4].w; }
      s0 = wave_sum(s0); s1 = wave_sum(s1);
      if (lane == 0) { float* rx = (float*)(wsb + WS_RSTDX); rx[2 * r] = rsqrtf(s0 * (1.0f / 1024.0f) + EPS); rx[2 * r + 1] = rsqrtf(s1 * (1.0f / 1024.0f) + EPS); }
      uint2* o = (uint2*)((u16*)(wsb + A_XB) + (size_t)r * 2048) + lane;
#pragma unroll
      for (int j = 0; j < 8; ++j) o[64 * j] = make_uint2(pk2(v[j].x, v[j].y), pk2(v[j].z, v[j].w));
  }
  for (int r0_ = gw; r0_ < I_WIN; r0_ += NGW) {
    int r = r0_;
      const int kb = r / 48, nb = r % 48;
      u16* d0 = (u16*)(wsb + WS_WIN) + (size_t)(nb * 64) * 1024;
      tr_item<win8_row>(kargs_now()->w_in, DIN, kb * 64, nb * 64, kargs_now()->g_mix, (u16*)(wsb + WS_WIN), nullptr, 1024, scr, lane);
  }
  for (int r0_ = gw; r0_ < I_P; r0_ += NGW) {
    int r = r0_;
      const float4* pr = (const float4*)kargs_now()->p + (size_t)r * 512 + lane;
      uint2* o = (uint2*)(wsb + A_PB) + (size_t)r * 512 + lane;
      float4 v[8];
#pragma unroll
      for (int j = 0; j < 8; ++j) { const f32x4 t = __builtin_nontemporal_load((const f32x4*)(pr + 64 * j)); v[j] = make_float4(t[0], t[1], t[2], t[3]); }
#pragma unroll
      for (int j = 0; j < 8; ++j) o[64 * j] = make_uint2(pk2(v[j].x, v[j].y), pk2(v[j].z, v[j].w));
  }
  for (int r0_ = gw; r0_ < I_WOUT; r0_ += NGW) {
    int r = r0_;
      const int kb = r >> 4, nb = r & 15;
      u16* d0 = (u16*)(wsb + WS_WOUT) + (size_t)(nb * 64) * 1024;
#if NEW_MASK & 0x8
      tr_item<perm256>(kargs_now()->w_out, 1024, kb * 64, nb * 64, nullptr, (u16*)(wsb + WS_WOUT), nullptr, 1024, scr, lane);
#else
      tr_item(kargs_now()->w_out, 1024, kb * 64, nb * 64, nullptr, d0, d0 + 32 * 1024, 1024, scr, lane);
#endif
  }
  for (int r0_ = gw; r0_ < I_PLE; r0_ += NGW) {
    int r = r0_;
      const int kb = r >> 4, nb = r & 15;
      u16* d0 = (u16*)(wsb + WS_WPLE) + (size_t)(nb * 64) * 256;
#if NEW_MASK & 0x8
      tr_item<perm256>(kargs_now()->w_ple, 1024, kb * 64, nb * 64, nullptr, (u16*)(wsb + WS_WPLE), nullptr, 256, scr, lane);
#else
      tr_item(kargs_now()->w_ple, 1024, kb * 64, nb * 64, nullptr, d0, d0 + 32 * 256, 256, scr, lane);
#endif
  }
  for (int r0_ = gw; r0_ < I_WR; r0_ += NGW) {
    int r = r0_;
      const int idx = r * 64 + lane, rr = idx >> 10, k = idx & 1023;
      float v = 0.f;
      if (rr < 4) v = kargs_now()->w_rg[k * 4 + rr]; else if (rr < 36) v = kargs_now()->w_re[k * 32 + (rr - 4)];
      const float wv_ = v * kargs_now()->g_ffn[k];
      const unsigned hb_ = pk2(wv_, 0.f) & 0xffffu;
      const unsigned lb_ = pk2(wv_ - __uint_as_float(hb_ << 16), 0.f) & 0xffffu;
      ((u16*)(wsb + WS_WR))[idx] = (u16)hb_; ((u16*)(wsb + WS_WR))[48 * 1024 + idx] = (u16)lb_;
  }
  for (int r0_ = gw; r0_ < I_ROPE; r0_ += NGW) {
    int r = r0_;
      const int idx = r * 64 + lane, s = idx >> 5, i = idx & 31;
      const float inv = powf(10000.0f, -(float)(2 * i) / 64.0f);
      const float ang = (float)s * inv;
      float sn, cs; sincosf(ang, &sn, &cs);
      ((float2*)(wsb + WS_ROPE))[idx] = make_float2(cs, sn);
  }
  for (int r0_ = gw; r0_ < I_PAR; r0_ += NGW) {
    int r = r0_;
      const int idx = r * 64 + lane;
      if (idx < PAR_TOTAL) {
        float v;
        if (idx < PAR_GKA) v = kargs_now()->g_qa[idx]; else if (idx < PAR_GSUB) v = kargs_now()->g_ka[idx - PAR_GKA]; else if (idx < PAR_GQB) v = kargs_now()->g_sub[idx - PAR_GSUB];
        else if (idx < PAR_GKB) v = kargs_now()->g_qb[idx - PAR_GQB]; else if (idx < PAR_GPLE) v = kargs_now()->g_kb[idx - PAR_GKB]; else if (idx < PAR_RPB) v = kargs_now()->g_ple[idx - PAR_GPLE];
        else v = kargs_now()->rpb[idx - PAR_RPB];
        ((float*)(wsb + WS_PAR))[idx] = v;
      }
  }
  if (gw == 0) {
    if (lane == 0) {
      float s1 = 0, s2 = 0, mq = 0, mk = 0;
      for (int i = 0; i < 64; ++i) {
        s1 += kargs_now()->lam_q1[i] * kargs_now()->lam_k1[i]; s2 += kargs_now()->lam_q2[i] * kargs_now()->lam_k2[i];
        mq = fmaxf(mq, fabsf(kargs_now()->g_qa[i])); mk = fmaxf(mk, fabsf(kargs_now()->g_ka[i]));
      }
      float* sc = (float*)(wsb + WS_SCAL);
      sc[0] = expf(s1) - expf(s2) + LAM_INIT;
      sc[1] = 8.0f * mq * mk * LOG2E;
      float mqb = 0, mkb = 0;
      for (int i = 0; i < 32; ++i) { mqb = fmaxf(mqb, fabsf(kargs_now()->g_qb[i])); mkb = fmaxf(mkb, fabsf(kargs_now()->g_kb[i])); }
      sc[2] = 5.656854249f * mqb * mkb;
      int* cnt = (int*)(wsb + WS_CNT);
      for (int i = 0; i < 32; ++i) cnt[i * CNT_STRIDE] = 0;
    }
  }
}

DI uint4 pk8(const f32x4 a, const f32x4 b) { return make_uint4(pk2(a[0], a[1]), pk2(a[2], a[3]), pk2(b[0], b[1]), pk2(b[2], b[3])); }

typedef __attribute__((ext_vector_type(4))) unsigned u32x4;
DI bf16x8 packp(const f32x16& x, int s) {
  u32x4 p;
  p[0] = pk2(x[8 * s + 0], x[8 * s + 1]); p[1] = pk2(x[8 * s + 2], x[8 * s + 3]);
  p[2] = pk2(x[8 * s + 4], x[8 * s + 5]); p[3] = pk2(x[8 * s + 6], x[8 * s + 7]);
  return __builtin_bit_cast(bf16x8, p);
}
DI int grp_of(int kk) { return ((kk >> 2) == 1 || (kk >> 2) == 2 || (kk >> 2) == 4 || (kk >> 2) == 7) ? 1 : 0; }
DI int rank_of(int kk) { const int q = kk >> 2; return kk - ((q == 0) ? 0 : (q <= 2) ? 4 : (q == 3 || q == 4) ? 8 : (q <= 6) ? 12 : 16); }
DI int key_of(int grp, int jj) { return grp ? (jj < 8 ? jj + 4 : (jj < 12 ? jj + 8 : jj + 16)) : (jj < 4 ? jj : (jj < 8 ? jj + 8 : jj + 12)); }
constexpr int DA_STAGE = 33280, DA_VOFF = 16640;
typedef __attribute__((ext_vector_type(4))) short s16x4;
DI void ph4_router_t(const Ptrs& P, ldsp lds, int bid, int G) {
  const int tid = threadIdx.x, lane = tid & 63, wave = __builtin_amdgcn_readfirstlane(tid >> 6), t = lane & 15, kk = lane >> 4;
  LAS float* lg = (LAS float*)lds;
  const u16* h1 = (const u16*)(P.ws + A_H1B); const u16* WrH = (const u16*)(P.ws + WS_WR);
  for (int item = bid; item < 256; item += G) {
    const int tok0 = item * 64;
    float4 s0 = make_float4(0.f, 0.f, 0.f, 0.f), s1 = s0, s2 = s0, s3 = s0;
    if (wave == 0) {
      const float* sp = (const float*)(P.ws + WS_SSQ1P) + (size_t)(tok0 + lane) * SSQ_PARTS;
      s0 = *(const float4*)sp; s1 = *(const float4*)(sp + 4); s2 = *(const float4*)(sp + 8); s3 = *(const float4*)(sp + 12);
    }
    f32x4 acc[4][3];
#pragma unroll
    for (int tt = 0; tt < 4; ++tt)
#pragma unroll
      for (int et = 0; et < 3; ++et) acc[tt][et] = (f32x4){0.f, 0.f, 0.f, 0.f};
    const u16* ap = h1 + (size_t)(tok0 + t) * 1024 + 128 * wave + 8 * kk;
    const u16* bp = WrH + (size_t)t * 1024 + 128 * wave + 8 * kk;
#pragma unroll
    for (int s = 0; s < 4; ++s) {
      bf16x8 a[4];
#pragma unroll
      for (int tt = 0; tt < 4; ++tt) a[tt] = *(const bf16x8*)(ap + (size_t)tt * 16 * 1024 + 32 * s);
#pragma unroll
      for (int et = 0; et < 3; ++et) {
        const bf16x8 bh = *(const bf16x8*)(bp + et * 16 * 1024 + 32 * s), bl = *(const bf16x8*)(bp + (48 + et * 16) * 1024 + 32 * s);
#pragma unroll
        for (int tt = 0; tt < 4; ++tt) {
          acc[tt][et] = __builtin_amdgcn_mfma_f32_16x16x32_bf16(a[tt], bh, acc[tt][et], 0, 0, 0);
          acc[tt][et] = __builtin_amdgcn_mfma_f32_16x16x32_bf16(a[tt], bl, acc[tt][et], 0, 0, 0);
        }
      }
    }
    __syncthreads();
#pragma unroll
    for (int tt = 0; tt < 4; ++tt)
#pragma unroll
      for (int et = 0; et < 3; ++et)
#pragma unroll
        for (int i = 0; i < 4; ++i) lg[wave * (64 * 49) + (16 * tt + 4 * kk + i) * 49 + 16 * et + t] = acc[tt][et][i];
    __syncthreads();
    if (wave == 0) {
      const int tok = tok0 + lane;
      const float rstd = rsqrtf(((s0.x + s0.y + s0.z + s0.w) + (s1.x + s1.y + s1.z + s1.w) + (s2.x + s2.y + s2.z + s2.w) + (s3.x + s3.y + s3.z + s3.w)) * (1.0f / 1024.0f) + EPS);
      const LAS float* L = lg + lane * 49;
      float gl[4] = {0.f, 0.f, 0.f, 0.f};
#pragma unroll
      for (int w = 0; w < 8; ++w)
#pragma unroll
        for (int i = 0; i < 4; ++i) gl[i] += L[w * (64 * 49) + i];
      int gi = 0; float gm = gl[0];
#pragma unroll
      for (int i = 1; i < 4; ++i) { if (gl[i] > gm) { gm = gl[i]; gi = i; } }
      float gs = 0.f;
#pragma unroll
      for (int i = 0; i < 4; ++i) gs += expf((gl[i] - gm) * rstd);
      const float gate = 1.0f / gs;
      const LAS float* el = L + 4 + 8 * gi;
      float ev[8] = {0.f, 0.f, 0.f, 0.f, 0.f, 0.f, 0.f, 0.f};
#pragma unroll
      for (int w = 0; w < 8; ++w)
#pragma unroll
        for (int i = 0; i < 8; ++i) ev[i] += el[w * (64 * 49) + i];
      int e1 = 0; float m1 = ev[0];
#pragma unroll
      for (int i = 1; i < 8; ++i) { if (ev[i] > m1) { m1 = ev[i]; e1 = i; } }
      int e2 = 0; float m2v = -3.0e38f;
#pragma unroll
      for (int i = 0; i < 8; ++i) { if (i != e1 && ev[i] > m2v) { m2v = ev[i]; e2 = i; } }
      const float p2 = expf((m2v - m1) * rstd);
      const float wa = gate / (1.0f + p2), wb = gate * p2 / (1.0f + p2);
      int* cnt = (int*)(P.ws + WS_CNT); int* tokl = (int*)(P.ws + WS_TOKL); float* wl = (float*)(P.ws + WS_WL);
      const int ea = gi * 8 + e1, eb = gi * 8 + e2;
      ((float*)(P.ws + WS_RSTD1))[tok] = rstd;
      int mycnt = 0, ra = 0, rb = 0;
#pragma unroll 4
      for (int e = 0; e < 32; ++e) {
        const unsigned long long ma = __ballot(ea == e), mb = __ballot(eb == e);
        const int ca = __popcll(ma);
        if (lane == e) mycnt = ca + __popcll(mb);
        if (ea == e) ra = __builtin_amdgcn_mbcnt_hi((unsigned)(ma >> 32), __builtin_amdgcn_mbcnt_lo((unsigned)ma, 0u));
        if (eb == e) rb = ca + __builtin_amdgcn_mbcnt_hi((unsigned)(mb >> 32), __builtin_amdgcn_mbcnt_lo((unsigned)mb, 0u));
      }
      int base = 0;
      if (lane < 32 && mycnt > 0) base = atomicAdd(&cnt[lane * CNT_STRIDE], mycnt);
      const int pa = __shfl(base, ea) + ra, pb = __shfl(base, eb) + rb;
      tokl[ea * 16384 + pa] = tok * 2; wl[ea * 16384 + pa] = wa;
      tokl[eb * 16384 + pb] = tok * 2 + 1; wl[eb * 16384 + pb] = wb;
    }
  }
}

DI void ph4_router(const Ptrs& P, ldsp lds, int bid, int G) {
  ph4_router_t(P, lds, bid, G);
}

DI void ph7_combine(const Ptrs& P, ldsp lds, int bid, int G) {
  const int lane = threadIdx.x & 63, wave = threadIdx.x >> 6;
  const int nwv = blockDim.x >> 6;
  for (int tok = bid * nwv + wave; tok < T; tok += G * nwv) {
    const uint2* hr = (const uint2*)((const u16*)(P.ws + A_H1B) + (size_t)tok * 1024) + lane;
    const uint2* y0 = (const uint2*)((const u16*)(P.ws + A_Y0) + (size_t)tok * 1024) + lane;
    const uint2* y1 = (const uint2*)((const u16*)(P.ws + A_Y1) + (size_t)tok * 1024) + lane;
    uint2* o = (uint2*)((u16*)(P.ws + A_H2B) + (size_t)tok * 1024) + lane;
    float ss = 0.f;
#pragma unroll
    for (int j = 0; j < 4; ++j) {
      const uint2 hv = hr[64 * j], a = y0[64 * j], c = y1[64 * j];
      const float v0 = __uint_as_float(hv.x << 16) + __uint_as_float(a.x << 16) + __uint_as_float(c.x << 16);
      const float v1 = __uint_as_float(hv.x & 0xffff0000u) + __uint_as_float(a.x & 0xffff0000u) + __uint_as_float(c.x & 0xffff0000u);
      const float v2 = __uint_as_float(hv.y << 16) + __uint_as_float(a.y << 16) + __uint_as_float(c.y << 16);
      const float v3 = __uint_as_float(hv.y & 0xffff0000u) + __uint_as_float(a.y & 0xffff0000u) + __uint_as_float(c.y & 0xffff0000u);
      ss += v0 * v0 + v1 * v1 + v2 * v2 + v3 * v3;
      o[64 * j] = make_uint2(pk2(v0, v1), pk2(v2, v3));
    }
    ss = wave_sum(ss);
    float se = (lane < SSQ_PARTS) ? ((const float*)(P.ws + WS_SSQEP))[(size_t)tok * SSQ_PARTS + lane] : 0.f;
    se = wave_sum(se);
    if (lane == 0) {
      ((float*)(P.ws + WS_RSTD2))[tok] = rsqrtf(ss * (1.0f / 1024.0f) + EPS);
      ((float*)(P.ws + WS_RSTDE))[tok] = rsqrtf(se * (1.0f / 1024.0f) + EPS);
    }
  }
}

namespace g8 {
constexpr int BM = 256, BK = 64, HALF = 128, HTB = HALF * BK * 2, STAGE_BYTES = 8 * HTB, NXCD = 8, WGM = 8;
constexpr int LDS_EXTRA8 = STAGE_BYTES;
constexpr int LDS_BYTES8 = STAGE_BYTES + 4096;
DI int lds_byte(int r, int c) { const int st = (r >> 4) * 2 + (c >> 5), rr = r & 15, cc = c & 31, ob = rr * 64 + cc * 2; return st * 1024 + (ob ^ (((ob >> 9) & 1) << 5)); }
DI void stage_rc(int b, int& R, int& C) { const int st = b / 1024, sb = b % 1024, swz = sb ^ (((sb >> 9) & 1) << 5); R = (st >> 1) * 16 + swz / 64; C = (st & 1) * 32 + (swz % 64) / 2; }

struct Unit { int pm, pn, e, ce; };
struct GridOrder {
  int nM, nN, nwg, G, c; unsigned pnmap;
  DI void init(int nM_, int nN_, int G_, int c_, unsigned pnmap_ = 0u) { nM = nM_; nN = nN_; nwg = nM * nN; G = G_; c = c_; pnmap = pnmap_; }
  DI bool next(int i, Unit& u) const {
    const int L = i * G + c; if (L >= nwg) return false;
    int wgid = L; { const int q = nwg / NXCD, r = nwg % NXCD, xcd = wgid % NXCD, off = wgid / NXCD; wgid = (xcd < r ? xcd * (q + 1) : r * (q + 1) + (xcd - r) * q) + off; }
    const int nig = WGM * nN, gid = wgid / nig, fm = gid * WGM, gsz = (nM - fm) < WGM ? (nM - fm) : WGM;
    u.pm = fm + ((wgid % nig) % gsz); u.pn = (wgid % nig) / gsz; if (pnmap) u.pn = (int)((pnmap >> (4 * u.pn)) & 15u); u.e = 0; u.ce = 0; return true;
  }
};

template <class Epi, class Sched, bool SWAP, bool GATHER>
DI void gemm_phase(ldsp lds, const unsigned char* Abase, const unsigned char* Bbase, int K, const Sched& S, const Epi& E, int pA = 0, int pB = 0) {
  if (pA == 0) pA = K; if (pB == 0) pB = K;
  int tid = threadIdx.x; asm volatile("" : "+v"(tid));
  const int wid = __builtin_amdgcn_readfirstlane(tid >> 6), lane = tid & 63, wr = wid >> 2, wc = wid & 3, fr = lane & 15, fq = lane >> 4;
  const int nt = K / BK;
  int sR[2], sC[2];
  unsigned voffB[2], voffA[2];
#pragma unroll
  for (int i = 0; i < 2; ++i) { stage_rc(tid * 16 + i * 8192, sR[i], sC[i]); voffB[i] = (unsigned)(sR[i] * pB + sC[i]) * 2u; voffA[i] = (unsigned)(sR[i] * pA + sC[i]) * 2u; }
  const size_t tstepA = (size_t)BM * pA * 2;
  const size_t kstep = (size_t)(BK * 2);
  const size_t hstep = (size_t)HALF * pB * 2, hstepA = (size_t)HALF * pA * 2;
  const unsigned ldsw = (unsigned)wid * 1024u;
  const int aoff = lds_byte(wr * 64 + fr, fq * 8), boff = lds_byte(wc * 32 + fr, fq * 8);
#define G8_SA(b, h) (((b) * 2 + (h)) * HTB)
#define G8_SB(b, h) ((4 + (b) * 2 + (h)) * HTB)
#define G8_STAGE_B(bufoff, gbase) do { _Pragma("unroll") for (int _i = 0; _i < 2; ++_i) \
    __builtin_amdgcn_global_load_lds((const GAS unsigned*)((const unsigned char*)(gbase) + voffB[_i]), (LAS unsigned*)(lds + (bufoff) + ldsw + _i * 8192), 16, 0, 0); } while (0)
#define G8_STAGE_A(bufoff, hsel, nx, koff) do { _Pragma("unroll") for (int _i = 0; _i < 2; ++_i) { \
    const unsigned char* _p; \
    if (GATHER) _p = Abase + (size_t)((nx) ? ((hsel) ? nv1[_i] : nv0[_i]) : ((hsel) ? cv1[_i] : cv0[_i])) + (koff); \
    else _p = ((nx) ? nA : cA) + ((hsel) ? hstepA : (size_t)0) + voffA[_i] + (koff); \
    __builtin_amdgcn_global_load_lds((const GAS unsigned*)_p, (LAS unsigned*)(lds + (bufoff) + ldsw + _i * 8192), 16, 0, 0); } } while (0)
#define G8_LDA(dst, b, h) do { _Pragma("unroll") for (int m = 0; m < 4; ++m) _Pragma("unroll") for (int k = 0; k < 2; ++k) dst[m][k] = *(const LAS bf16x8*)(lds + G8_SA(b, h) + aoff + m * 2048 + k * 1024); } while (0)
#define G8_LDB(dst, b, h) do { _Pragma("unroll") for (int n = 0; n < 2; ++n) _Pragma("unroll") for (int k = 0; k < 2; ++k) dst[n][k] = *(const LAS bf16x8*)(lds + G8_SB(b, h) + boff + n * 2048 + k * 1024); } while (0)
#define G8_MMA(ai, bj, At, Bt) do { __builtin_amdgcn_s_setprio(1); \
    _Pragma("unroll") for (int m = 0; m < 4; ++m) _Pragma("unroll") for (int n = 0; n < 2; ++n) _Pragma("unroll") for (int k = 0; k < 2; ++k) \
        acc[ai][bj][m][n] = SWAP ? __builtin_amdgcn_mfma_f32_16x16x32_bf16(At[m][k], Bt[n][k], acc[ai][bj][m][n], 0, 0, 0) \
                                 : __builtin_amdgcn_mfma_f32_16x16x32_bf16(Bt[n][k], At[m][k], acc[ai][bj][m][n], 0, 0, 0); \
    __builtin_amdgcn_s_setprio(0); } while (0)
#define G8_WAIT_V(n) asm volatile("s_waitcnt vmcnt(" #n ")" ::: "memory")
#define G8_WAIT_L(n) asm volatile("s_waitcnt lgkmcnt(" #n ")" ::: "memory")
#define G8_BAR __builtin_amdgcn_s_barrier()
#define G8_SCHED __builtin_amdgcn_sched_barrier(0)
  Unit cur, nxt; int ui = 0;
  if (!S.next(0, cur)) return;
  f32x4 acc[2][2][4][2];
#pragma unroll
  for (int a = 0; a < 2; ++a)
#pragma unroll
    for (int b = 0; b < 2; ++b)
#pragma unroll
      for (int m = 0; m < 4; ++m)
#pragma unroll
        for (int n = 0; n < 2; ++n) acc[a][b][m][n] = (f32x4){0.f, 0.f, 0.f, 0.f};
  bf16x8 At[4][2], B0[2][2], B1[2][2];
  unsigned cv0[2] = {0u, 0u}, cv1[2] = {0u, 0u}, nv0[2] = {0u, 0u}, nv1[2] = {0u, 0u};
  const unsigned char* cA = Abase; const unsigned char* nA = Abase;
  if (GATHER) E.a_off(cur, sR, sC, cv0, cv1); else cA = Abase + (size_t)cur.pm * tstepA;
  const unsigned char* cB = Bbase + E.b_off(cur);
  G8_STAGE_B(G8_SB(0, 0), cB); G8_STAGE_A(G8_SA(0, 0), 0, false, 0); G8_STAGE_B(G8_SB(0, 1), cB + hstep); G8_STAGE_A(G8_SA(0, 1), 1, false, 0);
  if (wr == 1) G8_BAR;
  G8_WAIT_V(4); G8_BAR;
  G8_STAGE_B(G8_SB(1, 0), cB + kstep); G8_STAGE_A(G8_SA(1, 0), 0, false, kstep); G8_STAGE_B(G8_SB(1, 1), cB + hstep + kstep);
  G8_WAIT_V(6); G8_BAR;
  for (;;) {
    const bool has_next = S.next(ui + 1, nxt);
    if (GATHER) { if (has_next) E.a_off(nxt, sR, sC, nv0, nv1); else { nv0[0] = cv0[0]; nv0[1] = cv0[1]; nv1[0] = cv1[0]; nv1[1] = cv1[1]; } }
    else nA = has_next ? Abase + (size_t)nxt.pm * tstepA : cA;
    const unsigned char* nB = has_next ? Bbase + E.b_off(nxt) : cB;
#pragma unroll 1
    for (int t = 0; t < nt; t += 2) {
      const bool last = (t == nt - 2);
      const size_t k1 = (size_t)(t + 1) * kstep;
      const size_t k2 = last ? 0 : (size_t)(t + 2) * kstep, k3 = k2 + kstep;
      const unsigned char* b2 = last ? nB : cB + (size_t)(t + 2) * kstep; const unsigned char* b3 = b2 + kstep;
      G8_LDB(B0, 0, 0); G8_SCHED; G8_LDA(At, 0, 0); G8_STAGE_A(G8_SA(1, 1), 1, false, k1);
      G8_WAIT_L(8); G8_BAR; G8_WAIT_L(0); G8_MMA(0, 0, At, B0); G8_BAR; G8_SCHED;
      G8_LDB(B1, 0, 1); G8_STAGE_B(G8_SB(0, 0), b2);
      G8_BAR; G8_WAIT_L(0); G8_MMA(0, 1, At, B1); G8_BAR;
      G8_LDA(At, 0, 1); G8_STAGE_A(G8_SA(0, 0), 0, last, k2);
      G8_BAR; G8_WAIT_L(0); G8_MMA(1, 0, At, B0); G8_BAR; G8_SCHED;
      G8_STAGE_B(G8_SB(0, 1), b2 + hstep);
      G8_WAIT_V(6); G8_BAR; G8_MMA(1, 1, At, B1); G8_BAR;
      G8_LDB(B0, 1, 0); G8_SCHED; G8_LDA(At, 1, 0); G8_STAGE_A(G8_SA(0, 1), 1, last, k2);
      G8_WAIT_L(8); G8_BAR; G8_WAIT_L(0); G8_MMA(0, 0, At, B0); G8_BAR; G8_SCHED;
      G8_LDB(B1, 1, 1); G8_STAGE_B(G8_SB(1, 0), b3);
      G8_BAR; G8_WAIT_L(0); G8_MMA(0, 1, At, B1); G8_BAR;
      G8_LDA(At, 1, 1); G8_STAGE_A(G8_SA(1, 0), 0, last, k3);
      G8_BAR; G8_WAIT_L(0); G8_MMA(1, 0, At, B0); G8_BAR; G8_SCHED;
      G8_STAGE_B(G8_SB(1, 1), b3 + hstep);
      G8_WAIT_V(6); G8_BAR; G8_MMA(1, 1, At, B1); G8_BAR;
    }
    E(acc, cur, wr, wc, fr, fq);
    if (!has_next) break;
#pragma unroll
    for (int a = 0; a < 2; ++a)
#pragma unroll
      for (int b = 0; b < 2; ++b)
#pragma unroll
        for (int m = 0; m < 4; ++m)
#pragma unroll
          for (int n = 0; n < 2; ++n) acc[a][b][m][n] = (f32x4){0.f, 0.f, 0.f, 0.f};
    cur = nxt; cB = nB; cA = nA; ++ui;
    if (GATHER) { cv0[0] = nv0[0]; cv0[1] = nv0[1]; cv1[0] = nv1[0]; cv1[1] = nv1[1]; }
  }
  G8_WAIT_V(0);
  if (wr == 0) G8_BAR;
  G8_BAR;
#undef G8_SA
#undef G8_SB
#undef G8_STAGE_A
#undef G8_STAGE_B
#undef G8_LDA
#undef G8_LDB
#undef G8_MMA
#undef G8_WAIT_V
#undef G8_WAIT_L
#undef G8_BAR
#undef G8_SCHED
}
DI void dense_a_off(int pm, int K, const int (&sR)[2], const int (&sC)[2], unsigned (&v0)[2], unsigned (&v1)[2]) {
#pragma unroll
  for (int i = 0; i < 2; ++i) { v0[i] = (unsigned)((pm * BM + sR[i]) * K + sC[i]) * 2u; v1[i] = v0[i] + (unsigned)(HALF * K * 2); }
}
}

DI int win8_row(int f) {
  if (f < 1024) {
    const int rel = f & 511, pn = (f >> 9) * 2 + (rel >> 8), hl = (rel >> 7) & 1, comp = (rel >> 6) & 1, i = rel & 63;
    const int bj = i >> 5, ip = i & 31, fq = ip >> 3, n = (ip >> 2) & 1, j = ip & 3;
    return pn * 256 + 128 * bj + 32 * (2 * hl + comp) + 16 * n + 4 * fq + j;
  }
  if (f < 1536 || f >= 2560) return f;
  const int rel = (f - 1536) & 511, pn = 6 + ((f - 1536) >> 9) * 2 + (rel >> 8), hl = (rel >> 5) & 7, ip = rel & 31;
  const int bj = hl >> 2, wc = hl & 3, fq = ip >> 3, n = (ip >> 2) & 1, j = ip & 3;
  return pn * 256 + 128 * bj + 32 * wc + 16 * n + 4 * fq + j;
}
struct EpiInproj {
  const Ptrs* Pp;
  DI void a_off(const g8::Unit& u, const int (&sR)[2], const int (&sC)[2], unsigned (&v0)[2], unsigned (&v1)[2]) const { g8::dense_a_off(u.pm, 1024, sR, sC, v0, v1); }
  DI size_t b_off(const g8::Unit& u) const { return (size_t)u.pn * 256 * 1024 * 2; }
  DI void operator()(const f32x4 (&acc)[2][2][4][2], const g8::Unit& u, int wr, int wc, int fr, int fq) const {
    const Ptrs& P = *Pp;
    const float* rstdx = (const float*)(P.ws + WS_RSTDX);
    asm volatile("" : "+v"(rstdx));
    const int pn = u.pn, row00 = u.pm * 256 + wr * 64, b = row00 >> 12;
    float rsr[8];
#pragma unroll
    for (int k = 0; k < 8; ++k) rsr[k] = rstdx[row00 + 128 * (k >> 2) + 16 * (k & 3) + fr];
    const float qsA = 0.125f * LOG2E, qsB = 0.17677669529663687f * LOG2E;
    if (pn < 4) {
      const int isk = pn >= 2, head = 2 * (pn & 1) + (wc >> 1), comp = wc & 1;
      const float* gg = ((const float*)(P.ws + WS_PAR)) + (isk ? PAR_GKA : PAR_GQA);
      asm volatile("" : "+v"(gg));
      const float4 g1a = *(const float4*)(gg + 8 * fq), g1b = *(const float4*)(gg + 8 * fq + 4), g2a = *(const float4*)(gg + 32 + 8 * fq), g2b = *(const float4*)(gg + 36 + 8 * fq);
      const float ga[8] = {g1a.x, g1a.y, g1a.z, g1a.w, g1b.x, g1b.y, g1b.z, g1b.w}, gb[8] = {g2a.x, g2a.y, g2a.z, g2a.w, g2b.x, g2b.y, g2b.z, g2b.w};
      u16* dstb = (u16*)(P.ws + (isk ? A_KA : A_QA)) + (size_t)(b * 4 + head) * 4096 * 128 + comp * 64 + 8 * fq;
      const float2* rope = (const float2*)(P.ws + WS_ROPE);
      struct Rp { f32x4 c0, c1, c2, c3; };
      auto ldrope = [&](int k) { const int s = (row00 + 128 * (k >> 2) + 16 * (k & 3) + fr) & 4095; const f32x4* rp = (const f32x4*)(rope + (size_t)s * 32 + 8 * fq);
        Rp r; r.c0 = rp[0]; r.c1 = rp[1]; r.c2 = rp[2]; r.c3 = rp[3]; return r; };
      Rp cur = ldrope(0);
#pragma unroll
      for (int k = 0; k < 8; ++k) {
        const int ai = k >> 2, m = k & 3;
        Rp nxt = cur;
        if (k < 7) nxt = ldrope(k + 1);
        const int row = row00 + 128 * ai + 16 * m + fr, s = row & 4095;
        const float rs = rsr[k];
        float x1[8], x2[8]; float ss = 0.f;
#pragma unroll
        for (int n = 0; n < 2; ++n)
#pragma unroll
          for (int j = 0; j < 4; ++j) { x1[4 * n + j] = acc[ai][0][m][n][j] * rs; x2[4 * n + j] = acc[ai][1][m][n][j] * rs; ss += x1[4 * n + j] * x1[4 * n + j] + x2[4 * n + j] * x2[4 * n + j]; }
        ss += __shfl_xor(ss, 16); ss += __shfl_xor(ss, 32);
        const float rn = rsqrtf(ss * (1.0f / 64.0f) + EPS) * (isk ? 1.0f : qsA);
        const float cs[8] = {cur.c0[0], cur.c0[2], cur.c1[0], cur.c1[2], cur.c2[0], cur.c2[2], cur.c3[0], cur.c3[2]}, sn[8] = {cur.c0[1], cur.c0[3], cur.c1[1], cur.c1[3], cur.c2[1], cur.c2[3], cur.c3[1], cur.c3[3]};
        f32x4 o1a, o1b, o2a, o2b;
#pragma unroll
        for (int e = 0; e < 8; ++e) {
          const float y = x1[e] * rn * ga[e], z = x2[e] * rn * gb[e];
          const float p1 = y * cs[e] - z * sn[e], p2 = z * cs[e] + y * sn[e];
          if (e < 4) { o1a[e] = p1; o2a[e] = p2; } else { o1b[e - 4] = p1; o2b[e - 4] = p2; }
        }
        u16* d = dstb + (size_t)s * 128;
        *(uint4*)d = pk8(o1a, o1b);
        *(uint4*)(d + 32) = pk8(o2a, o2b);
        asm volatile("" ::: "memory");
        cur = nxt;
      }
    } else if (pn >= 6 && pn < 10) {
      const int isk = pn >= 8;
      const float* gg = ((const float*)(P.ws + WS_PAR)) + (isk ? PAR_GKB : PAR_GQB);
      asm volatile("" : "+v"(gg));
      const float4 g1a = *(const float4*)(gg + 8 * fq), g1b = *(const float4*)(gg + 8 * fq + 4);
      const float ga[8] = {g1a.x, g1a.y, g1a.z, g1a.w, g1b.x, g1b.y, g1b.z, g1b.w};
#pragma unroll
      for (int bj = 0; bj < 2; ++bj) {
        const int hd = 8 * (pn & 1) + 4 * bj + wc;
        u16* dstb = (u16*)(P.ws + (isk ? A_KB : A_QB)) + (size_t)(b * 16 + hd) * 4096 * 32 + 8 * fq;
#pragma unroll
        for (int ai = 0; ai < 2; ++ai)
#pragma unroll
          for (int m = 0; m < 4; ++m) {
            const int row = row00 + 128 * ai + 16 * m + fr, s = row & 4095;
            const float rs = rsr[4 * ai + m];
            float x[8]; float ss = 0.f;
#pragma unroll
            for (int n = 0; n < 2; ++n)
#pragma unroll
              for (int j = 0; j < 4; ++j) { x[4 * n + j] = acc[ai][bj][m][n][j] * rs; ss += x[4 * n + j] * x[4 * n + j]; }
            ss += __shfl_xor(ss, 16); ss += __shfl_xor(ss, 32);
            const float rn = rsqrtf(ss * (1.0f / 32.0f) + EPS) * (isk ? 1.0f : qsB);
            f32x4 oa, ob;
#pragma unroll
            for (int e = 0; e < 4; ++e) { oa[e] = x[e] * rn * ga[e]; ob[e] = x[4 + e] * rn * ga[4 + e]; }
            *(uint4*)(dstb + (size_t)s * 32) = pk8(oa, ob);
          }
      }
    } else {
      const int isA = pn < 6;
#pragma unroll
      for (int ai = 0; ai < 2; ++ai)
#pragma unroll
        for (int m = 0; m < 4; ++m) {
          const int row0 = row00 + 128 * ai + 16 * m + 4 * fq, s0 = row0 & 4095;
          const float4 rs = *(const float4*)(rstdx + row0);
          const int sp = isA ? permpos(s0) : s0;
#pragma unroll
          for (int bj = 0; bj < 2; ++bj)
#pragma unroll
            for (int n = 0; n < 2; ++n) {
              const int c = 128 * bj + 32 * wc + 16 * n + fr;
              u16* dst;
              if (isA) dst = (u16*)(P.ws + A_VAT) + ((size_t)(b * 4 + 2 * (pn - 4) + (c >> 7)) * 128 + (c & 127)) * 4096;
              else dst = (u16*)(P.ws + A_VBT) + ((size_t)(b * 16 + 8 * (pn - 10) + (c >> 5)) * 32 + (c & 31)) * 4096;
              const f32x4 v = acc[ai][bj][m][n];
              *(uint2*)(dst + sp) = make_uint2(pk2(v[0] * rs.x, v[1] * rs.y), pk2(v[2] * rs.z, v[3] * rs.w));
            }
        }
    }
  }
};
DI void ph1_inproj8(const Ptrs& P, ldsp lds, int bid, int G) {
  EpiInproj E; E.Pp = &P;
  {
    g8::GridOrder S; S.init(64, 8, G, bid, 0x98763210u);
    g8::gemm_phase<EpiInproj, g8::GridOrder, false, false>(lds, (const unsigned char*)(P.ws + A_XB), (const unsigned char*)(P.ws + WS_WIN), 1024, S, E);
  }
  {
    g8::GridOrder S; S.init(64, 4, G, bid, 0xBA54u);
    g8::gemm_phase<EpiInproj, g8::GridOrder, true, false>(lds, (const unsigned char*)(P.ws + A_XB), (const unsigned char*)(P.ws + WS_WIN), 1024, S, E);
  }
}

DI int p32(int ip) { return 16 * ((ip >> 2) & 1) + 4 * (ip >> 3) + (ip & 3); }
DI int perm256(int f) { return (f & ~31) | p32(f & 31); }
DI int w13_row_w1(int f) { return ((f >> 7) << 8) | (f & 96) | p32(f & 31); }
DI int w13_row_w3(int f) { return (((f >> 7) << 8) | (f & 96) | p32(f & 31)) + 128; }

template <bool PLE>
struct EpiOut {
  const Ptrs* Pp;
  DI void a_off(const g8::Unit&, const int (&)[2], const int (&)[2], unsigned (&)[2], unsigned (&)[2]) const {}
  DI size_t b_off(const g8::Unit& u) const { return (size_t)u.pn * 256 * (PLE ? 256 : 1024) * 2; }
  struct Ld { float4 a0, a1, b0, b1; };
  DI void operator()(const f32x4 (&acc)[2][2][4][2], const g8::Unit& u, int wr, int wc, int fr, int fq) const {
    const Ptrs& P = *Pp;
    float* ssqp = (float*)(P.ws + (PLE ? WS_SSQEP : WS_SSQ1P));
    const int row0 = u.pm * 256 + 64 * wr + fr, col0 = u.pn * 256 + 32 * wc + 8 * fq;
    auto load = [&](int gidx) { const int ai = gidx >> 2, m = gidx & 3; const size_t go = (size_t)(row0 + 128 * ai + 16 * m) * 1024 + col0;
      Ld l; if (!PLE) { const u16* xbp = (const u16*)(P.ws + A_XB) + go; const uint4 ua = *(const uint4*)xbp, ub = *(const uint4*)(xbp + 128);
        l.a0 = make_float4(__uint_as_float(ua.x << 16), __uint_as_float(ua.x & 0xffff0000u), __uint_as_float(ua.y << 16), __uint_as_float(ua.y & 0xffff0000u));
        l.a1 = make_float4(__uint_as_float(ua.z << 16), __uint_as_float(ua.z & 0xffff0000u), __uint_as_float(ua.w << 16), __uint_as_float(ua.w & 0xffff0000u));
        l.b0 = make_float4(__uint_as_float(ub.x << 16), __uint_as_float(ub.x & 0xffff0000u), __uint_as_float(ub.y << 16), __uint_as_float(ub.y & 0xffff0000u));
        l.b1 = make_float4(__uint_as_float(ub.z << 16), __uint_as_float(ub.z & 0xffff0000u), __uint_as_float(ub.w << 16), __uint_as_float(ub.w & 0xffff0000u)); }
      else { l.a0 = l.a1 = l.b0 = l.b1 = make_float4(0.f, 0.f, 0.f, 0.f); } return l; };
    Ld cur = load(0);
#pragma unroll
    for (int gidx = 0; gidx < 8; ++gidx) {
      const int ai = gidx >> 2, m = gidx & 3;
      Ld nxt = cur;
      if (gidx < 7) nxt = load(gidx + 1);
      const int row = row0 + 128 * ai + 16 * m;
      float ss = 0.f;
#pragma unroll
      for (int bj = 0; bj < 2; ++bj) {
        const size_t go = (size_t)row * 1024 + col0 + 128 * bj;
        f32x4 a = acc[ai][bj][m][0], c4 = acc[ai][bj][m][1];
        if (!PLE) {
          const float4 xa = bj ? cur.b0 : cur.a0, xb4 = bj ? cur.b1 : cur.a1;
          a[0] += xa.x; a[1] += xa.y; a[2] += xa.z; a[3] += xa.w; c4[0] += xb4.x; c4[1] += xb4.y; c4[2] += xb4.z; c4[3] += xb4.w;
          *(uint4*)((u16*)(P.ws + A_H1B) + go) = pk8(a, c4);
        } else {
          *(uint4*)((u16*)(P.ws + A_EBF) + go) = pk8(a, c4);
        }
        ss += a[0] * a[0] + a[1] * a[1] + a[2] * a[2] + a[3] * a[3] + c4[0] * c4[0] + c4[1] * c4[1] + c4[2] * c4[2] + c4[3] * c4[3];
      }
      ss += __shfl_xor(ss, 16); ss += __shfl_xor(ss, 32);
      if (fq == 0) ssqp[(size_t)row * 16 + u.pn * 4 + wc] = ss;
      asm volatile("" ::: "memory");
      cur = nxt;
    }
  }
};
DI void ph3_outproj8(const Ptrs& P, ldsp lds, int bid, int G) {
  { EpiOut<false> E; E.Pp = &P; g8::GridOrder S; S.init(64, 4, G, bid);
    g8::gemm_phase<EpiOut<false>, g8::GridOrder, false, false>(lds, (const unsigned char*)(P.ws + A_AO), (const unsigned char*)(P.ws + WS_WOUT), 1024, S, E); }
}

DI int moe_plan8(const Ptrs& P, ldsp lds) {
  LAS int* smb = (LAS int*)(lds + g8::LDS_EXTRA8);
  __syncthreads();
  if (threadIdx.x == 0) {
    const int* cnt = (const int*)(P.ws + WS_CNT);
    int a = 0;
    for (int e = 0; e < 32; ++e) { smb[e] = a; a += (cnt[e * CNT_STRIDE] + 255) >> 8; smb[64 + e] = cnt[e * CNT_STRIDE]; }
    smb[32] = a;
  }
  __syncthreads();
  return smb[32];
}
template <class T> DI T* uni_ptr(T* p) {
  const unsigned long long v = (unsigned long long)p;
  const unsigned lo = __builtin_amdgcn_readfirstlane((unsigned)v), hi = __builtin_amdgcn_readfirstlane((unsigned)(v >> 32));
  return (T*)(((unsigned long long)hi << 32) | lo);
}
struct MoeOrder {
  int MB, G, c; const LAS int* smb;
  DI bool next(int i, g8::Unit& u) const {
    const int L = i * G + c;
    if (L >= ((MB + 7) >> 3) * 32) return false;
    const int gmb = (L >> 5) * 8 + (L & 7);
    u.pn = (L >> 3) & 3;
    if (gmb >= MB) return false;
    int e = 0; while (gmb >= smb[e + 1]) ++e;
    e = __builtin_amdgcn_readfirstlane(e);
    u.pm = gmb; u.e = e; u.ce = __builtin_amdgcn_readfirstlane(smb[64 + e] - (gmb - smb[e]) * 256);
    return true;
  }
};
struct EpiUp {
  const Ptrs* Pp; const LAS int* smb;
  DI void a_off(const g8::Unit& u, const int (&sR)[2], const int (&sC)[2], unsigned (&v0)[2], unsigned (&v1)[2]) const {
    const int* tokl = uni_ptr((const int*)(Pp->ws + WS_TOKL) + __builtin_amdgcn_readfirstlane(u.e * 16384 + (u.pm - smb[u.e]) * 256));
#pragma unroll
    for (int i = 0; i < 2; ++i) {
      const int r0 = sR[i], r1 = 128 + sR[i];
      const int t0 = (r0 < u.ce) ? (tokl[r0] >> 1) : 0, t1 = (r1 < u.ce) ? (tokl[r1] >> 1) : 0;
      v0[i] = (unsigned)(t0 * 1024 + sC[i]) * 2u; v1[i] = (unsigned)(t1 * 1024 + sC[i]) * 2u;
    }
  }
  DI size_t b_off(const g8::Unit& u) const { return ((size_t)u.e * 1024 + u.pn * 256) * 1024 * 2; }
  DI void operator()(const f32x4 (&acc)[2][2][4][2], const g8::Unit& u, int wr, int wc, int fr, int fq) const {
    const Ptrs& P = *Pp;
    if (u.ce <= 0) return;
    const int* tokl = uni_ptr((const int*)(P.ws + WS_TOKL) + __builtin_amdgcn_readfirstlane(u.e * 16384 + (u.pm - smb[u.e]) * 256));
    const float* rstd1 = (const float*)(P.ws + WS_RSTD1);
    u16* hid = (u16*)(P.ws + A_HID);
    float rsv[8];
    {
      int tk[8];
#pragma unroll
      for (int k = 0; k < 8; ++k) { const int rl = 128 * (k >> 2) + 64 * wr + 16 * (k & 3) + fr; tk[k] = (rl < u.ce) ? (tokl[rl] >> 1) : -1; }
#pragma unroll
      for (int k = 0; k < 8; ++k) rsv[k] = (tk[k] >= 0) ? rstd1[tk[k]] : 0.0f;
    }
#pragma unroll
    for (int ai = 0; ai < 2; ++ai)
#pragma unroll
      for (int m = 0; m < 4; ++m) {
        const int rl = 128 * ai + 64 * wr + 16 * m + fr;
        const float rs = rsv[4 * ai + m];
        f32x4 h0, h1;
#pragma unroll
        for (int j = 0; j < 4; ++j) {
          const float a = acc[ai][0][m][0][j] * rs, b = acc[ai][0][m][1][j] * rs;
          h0[j] = a / (1.0f + __expf(-a)) * (acc[ai][1][m][0][j] * rs); h1[j] = b / (1.0f + __expf(-b)) * (acc[ai][1][m][1][j] * rs);
        }
        *(uint4*)(hid + (size_t)(u.pm * 256 + rl) * 512 + u.pn * 128 + 32 * wc + 8 * fq) = pk8(h0, h1);
      }
  }
};
DI void ph5_up8(const Ptrs& P, ldsp lds, int bid, int G) {
  const int MB = moe_plan8(P, lds);
  const LAS int* smb = (const LAS int*)(lds + g8::LDS_EXTRA8);
  MoeOrder S; S.MB = MB; S.G = G; S.c = bid; S.smb = smb;
  EpiUp E; E.Pp = &P; E.smb = smb;
  g8::gemm_phase<EpiUp, MoeOrder, false, true>(lds, (const unsigned char*)(P.ws + A_H1B), (const unsigned char*)(P.ws + WS_W13), 1024, S, E);
  {
    const int NU = ((MB + 7) >> 3) * 32, rem = NU % G, nl = rem ? G - rem : G, li = rem ? bid - rem : bid;
    if (li >= 0) {
      const int lane = threadIdx.x & 63, wave = threadIdx.x >> 6, nwv = blockDim.x >> 6;
      LAS float* scr = (LAS float*)(lds + wave * 16640);
      for (int r = li * nwv + wave; r < 4096 + 256; r += nl * nwv) late_weight_item(r, scr, lane);
    }
  }
}
struct EpiDown {
  const Ptrs* Pp; const LAS int* smb;
  DI void a_off(const g8::Unit&, const int (&)[2], const int (&)[2], unsigned (&)[2], unsigned (&)[2]) const {}
  DI size_t b_off(const g8::Unit& u) const { return ((size_t)u.e * 1024 + u.pn * 256) * 512 * 2; }
  DI void operator()(const f32x4 (&acc)[2][2][4][2], const g8::Unit& u, int wr, int wc, int fr, int fq) const {
    const Ptrs& P = *Pp;
    if (u.ce <= 0) return;
    const int base = __builtin_amdgcn_readfirstlane(u.e * 16384 + (u.pm - smb[u.e]) * 256);
    const int* tokl = (const int*)(P.ws + WS_TOKL) + base; const float* wl = (const float*)(P.ws + WS_WL) + base;
    int tkv[8]; float wv[8];
#pragma unroll
    for (int k = 0; k < 8; ++k) { const int rl = 128 * (k >> 2) + 64 * wr + 16 * (k & 3) + fr; const bool v = rl < u.ce; tkv[k] = v ? tokl[rl] : -1; wv[k] = v ? wl[rl] : 0.0f; }
#pragma unroll
    for (int ai = 0; ai < 2; ++ai)
#pragma unroll
      for (int m = 0; m < 4; ++m) {
        const int tk = tkv[4 * ai + m];
        if (tk >= 0) {
          const float w = wv[4 * ai + m];
          u16* y = (u16*)(P.ws + ((tk & 1) ? A_Y1 : A_Y0)) + (size_t)(tk >> 1) * 1024 + u.pn * 256 + 32 * wc + 8 * fq;
#pragma unroll
          for (int bj = 0; bj < 2; ++bj) {
            f32x4 a = acc[ai][bj][m][0], c4 = acc[ai][bj][m][1];
#pragma unroll
            for (int j = 0; j < 4; ++j) { a[j] *= w; c4[j] *= w; }
            *(uint4*)(y + 128 * bj) = pk8(a, c4);
          }
        }
      }
  }
};
DI void ph6_down8(const Ptrs& P, ldsp lds, int bid, int G) {
  const int MB = moe_plan8(P, lds);
  const LAS int* smb = (const LAS int*)(lds + g8::LDS_EXTRA8);
  MoeOrder S; S.MB = MB; S.G = G; S.c = bid; S.smb = smb;
  EpiDown E; E.Pp = &P; E.smb = smb;
  g8::gemm_phase<EpiDown, MoeOrder, false, false>(lds, (const unsigned char*)(P.ws + A_HID), (const unsigned char*)(P.ws + WS_W2), 512, S, E);
  {
    const int NU = ((MB + 7) >> 3) * 32, rem = NU % G, nl = rem ? G - rem : G, li = rem ? bid - rem : bid;
    EpiOut<true> E2; E2.Pp = &P; g8::GridOrder S2; S2.init(64, 4, nl, li < 0 ? 0 : li);
    if (li < 0) S2.nwg = 0;
    g8::gemm_phase<EpiOut<true>, g8::GridOrder, false, false>(lds, (const unsigned char*)(P.ws + A_PB), (const unsigned char*)(P.ws + WS_WPLE), 256, S2, E2);
  }
}

struct EpiFinal {
  const Ptrs* Pp;
  DI void a_off(const g8::Unit&, const int (&)[2], const int (&)[2], unsigned (&)[2], unsigned (&)[2]) const {}
  DI size_t b_off(const g8::Unit& u) const { return (size_t)u.pn * 256 * 1024 * 2; }
  struct Ld { u32x4 hh; u32x4 ee; };
  DI void operator()(const f32x4 (&acc)[2][2][4][2], const g8::Unit& u, int wr, int wc, int fr, int fq) const {
    const Ptrs& P = *Pp;
    const float* rstd2 = (const float*)(P.ws + WS_RSTD2); const float* rstdE = (const float*)(P.ws + WS_RSTDE);
    const int row0 = u.pm * 256 + 64 * wr + fr, col0 = u.pn * 256 + 32 * wc + 8 * fq;
    auto load = [&](int gidx) { const int bj = gidx >> 3, ai = (gidx >> 2) & 1, m = gidx & 3; const int row = row0 + 128 * ai + 16 * m; const size_t go = (size_t)row * 1024 + col0 + 128 * bj;
      Ld l;
      l.hh = *(const u32x4*)((const u16*)(P.ws + A_H2B) + go); l.ee = *(const u32x4*)((const u16*)(P.ws + A_EBF) + go); return l; };
    Ld cur = load(0);
    float gv[8];
#pragma unroll
    for (int gidx = 0; gidx < 16; ++gidx) {
      const int bj = gidx >> 3, ai = (gidx >> 2) & 1, m = gidx & 3;
      if ((gidx & 7) == 0) { const float4 ga = *(const float4*)(P.g_ple + col0 + 128 * bj), gb = *(const float4*)(P.g_ple + col0 + 128 * bj + 4);
        gv[0] = ga.x; gv[1] = ga.y; gv[2] = ga.z; gv[3] = ga.w; gv[4] = gb.x; gv[5] = gb.y; gv[6] = gb.z; gv[7] = gb.w; }
      Ld nxt = cur;
      if (gidx < 15) nxt = load(gidx + 1);
      const size_t go = (size_t)(row0 + 128 * ai + 16 * m) * 1024 + col0 + 128 * bj;
      const int row = row0 + 128 * ai + 16 * m;
      const float rs2 = rstd2[row], rE = rstdE[row];
      float hv[8];
#pragma unroll
      for (int k = 0; k < 8; ++k) hv[k] = __uint_as_float((cur.hh[k >> 1] << ((k & 1) ? 0u : 16u)) & 0xffff0000u);
      const f32x4 a = acc[ai][bj][m][0], c4 = acc[ai][bj][m][1];
      const float av[8] = {a[0], a[1], a[2], a[3], c4[0], c4[1], c4[2], c4[3]};
      const unsigned eeu[4] = {cur.ee[0], cur.ee[1], cur.ee[2], cur.ee[3]};
#pragma unroll
      for (int k = 0; k < 8; ++k) {
        const unsigned sh = (k & 1) ? 0u : 16u;
        const float ev = __uint_as_float((eeu[k >> 1] << sh) & 0xffff0000u);
        const float sg = 1.0f / (1.0f + __expf(-av[k] * rs2));
        hv[k] = hv[k] + ev * rE * gv[k] * sg;
      }
      float* wr_ = P.out + go;
      __builtin_nontemporal_store((f32x4){hv[0], hv[1], hv[2], hv[3]}, (f32x4*)wr_); __builtin_nontemporal_store((f32x4){hv[4], hv[5], hv[6], hv[7]}, (f32x4*)(wr_ + 4));
      asm volatile("" ::: "memory");
      cur = nxt;
    }
  }
};
DI void ph8_final8(const Ptrs& P, ldsp lds, int bid, int G) {
  EpiFinal E; E.Pp = &P; g8::GridOrder S; S.init(64, 4, G, bid);
  g8::gemm_phase<EpiFinal, g8::GridOrder, false, false>(lds, (const unsigned char*)(P.ws + A_H2B), (const unsigned char*)(P.ws + WS_WPLG), 1024, S, E);
}

template <bool SHIFT>
DI void da_item8(const Ptrs& P, ldsp lds, int item, float lam, float m2) {
  const int tid = threadIdx.x, lane = tid & 63, wave = __builtin_amdgcn_readfirstlane(tid >> 6), h = lane >> 5, i31 = lane & 31;
  const int xcd = item & 7, loc = item >> 3, bh = 2 * xcd + (loc >> 4), qblk = loc & 15;
  const u16* qA = (const u16*)(P.ws + A_QA) + (size_t)bh * 4096 * 128;
  const u16* kA = (const u16*)(P.ws + A_KA) + (size_t)bh * 4096 * 128;
  const u16* vAt = (const u16*)(P.ws + A_VAT) + (size_t)bh * 128 * 4096;
  const int q = qblk * 256 + 32 * wave + i31;
  bf16x8 qf[2][4];
#pragma unroll
  for (int c = 0; c < 2; ++c)
#pragma unroll
    for (int s = 0; s < 4; ++s) qf[c][s] = *(const bf16x8*)(qA + (size_t)q * 128 + c * 64 + 16 * s + 8 * h);
  auto stage = [&](int buf, int tile) {
    int ln = lane; asm volatile("" : "+v"(ln));
    ldsp lk = lds + buf * DA_STAGE;
    const u16* kt = kA + (size_t)tile * 64 * 128;
    const u16* vt = vAt + tile * 64;
#pragma unroll
    for (int qq = 0; qq < 2; ++qq) {
      const int jj = 2 * wave + qq;
      const int ra = key_of(0, jj), rb = key_of(1, jj);
      const int ku = ln >> 4, key = 32 * (ku >> 1) + ((ku & 1) ? rb : ra);
      glds16(kt + key * 128 + (ln & 15) * 8, lk + jj * 1040);
      const int vu = ln >> 3, d = 32 * (vu >> 1) + ((vu & 1) ? rb : ra);
      glds16(vt + d * 4096 + (ln & 7) * 8, lk + DA_VOFF + jj * 1040);
    }
  };
  const int rk = rank_of(i31), gr = grp_of(i31);
  const int kbase = rk * 1040 + gr * 256 + h * 16;
  const int vbase = DA_VOFF + rk * 1040 + gr * 128 + h * 16;
  f32x16 O1[4], O2[4];
#pragma unroll
  for (int dt = 0; dt < 4; ++dt)
#pragma unroll
    for (int e = 0; e < 16; ++e) { O1[dt][e] = 0.f; O2[dt][e] = 0.f; }
  float l1 = 0.f, l2 = 0.f;
  __syncthreads();
  stage(0, 0);
  stage(1, 1);
  asm volatile("s_waitcnt vmcnt(4)" ::: "memory");
  __builtin_amdgcn_s_barrier();
  int buf = 0;
  for (int tile = 0; tile < 64; ++tile) {
    if (tile + 2 < 64) stage(buf >= 1 ? buf - 1 : 2, tile + 2);
    ldsp lb = lds + buf * DA_STAGE;
#pragma unroll 1
    for (int kt2 = 0; kt2 < 2; ++kt2) {
      bf16x8 pf[2][2];
      ldsp lk = lb + kbase + kt2 * 512;
      ldsp lv = lb + vbase + kt2 * 64;
#pragma unroll
      for (int c = 0; c < 2; ++c) {
        f32x16 sa;
#pragma unroll
        for (int e = 0; e < 16; ++e) sa[e] = 0.f;
#pragma unroll
        for (int s = 0; s < 4; ++s) {
          const bf16x8 kf = *(LAS bf16x8*)(lk + c * 128 + s * 32);
          sa = __builtin_amdgcn_mfma_f32_32x32x16_bf16(kf, qf[c][s], sa, 0, 0, 0);
        }
        float ls = 0.f;
#pragma unroll
        for (int e = 0; e < 16; ++e) { sa[e] = __builtin_amdgcn_exp2f(SHIFT ? sa[e] - m2 : sa[e]); ls += sa[e]; }
        if (c == 0) l1 += ls; else l2 += ls;
        pf[c][0] = packp(sa, 0); pf[c][1] = packp(sa, 1);
      }
      __builtin_amdgcn_sched_barrier(0);
      bf16x8 va = *(LAS bf16x8*)(lv), vb = *(LAS bf16x8*)(lv + 256);
#pragma unroll
      for (int st = 0; st < 4; ++st) {
        const int s2 = st >> 1, dtp = st & 1;
        bf16x8 na = va, nb = vb;
        if (st < 3) { const int s2n = (st + 1) >> 1, dn = (st + 1) & 1; na = *(LAS bf16x8*)(lv + s2n * 32 + dn * 512); nb = *(LAS bf16x8*)(lv + s2n * 32 + dn * 512 + 256); }
        __builtin_amdgcn_sched_barrier(0);
        __builtin_amdgcn_s_setprio(1);
        O1[2 * dtp] = __builtin_amdgcn_mfma_f32_32x32x16_bf16(va, pf[0][s2], O1[2 * dtp], 0, 0, 0);
        O2[2 * dtp] = __builtin_amdgcn_mfma_f32_32x32x16_bf16(va, pf[1][s2], O2[2 * dtp], 0, 0, 0);
        O1[2 * dtp + 1] = __builtin_amdgcn_mfma_f32_32x32x16_bf16(vb, pf[0][s2], O1[2 * dtp + 1], 0, 0, 0);
        O2[2 * dtp + 1] = __builtin_amdgcn_mfma_f32_32x32x16_bf16(vb, pf[1][s2], O2[2 * dtp + 1], 0, 0, 0);
        __builtin_amdgcn_s_setprio(0);
        __builtin_amdgcn_sched_barrier(0);
        va = na; vb = nb;
      }
    }
    if (tile + 2 < 64) asm volatile("s_waitcnt vmcnt(4)" ::: "memory"); else asm volatile("s_waitcnt vmcnt(0)" ::: "memory");
    __builtin_amdgcn_s_barrier();
    buf = (buf == 2) ? 0 : buf + 1;
  }
  l1 += __shfl_xor(l1, 32); l2 += __shfl_xor(l2, 32);
  const float i1 = 1.0f / l1, i2 = lam / l2;
  float ss = 0.f;
#pragma unroll
  for (int dt = 0; dt < 4; ++dt)
#pragma unroll
    for (int e = 0; e < 16; ++e) { const float o = O1[dt][e] * i1 - O2[dt][e] * i2; O1[dt][e] = o; ss += o * o; }
  ss += __shfl_xor(ss, 32);
  const float rn = rsqrtf(ss * (1.0f / 128.0f) + EPS) * (1.0f - LAM_INIT);
  const int b = bh >> 2, hh = bh & 3;
  u16* dst = (u16*)(P.ws + A_AO) + ((size_t)b * 4096 + q) * 1024 + hh * 128;
#pragma unroll
  for (int dt = 0; dt < 4; ++dt)
#pragma unroll
    for (int g = 0; g < 4; ++g) {
      const int d0 = 32 * dt + 8 * g + 4 * h;
      const float4 gs = *(const float4*)(P.g_sub + d0);
      *(uint2*)(dst + d0) = make_uint2(pk2(O1[dt][4 * g] * rn * gs.x, O1[dt][4 * g + 1] * rn * gs.y), pk2(O1[dt][4 * g + 2] * rn * gs.z, O1[dt][4 * g + 3] * rn * gs.w));
    }
}

constexpr int NA8_VSTRIDE = 1936;
constexpr int NA8_TAB = 32 * NA8_VSTRIDE;
DI void na_block8(const Ptrs& P, ldsp lds, int item, float qkbound) {
  const int tid = threadIdx.x, lane = tid & 63, wave = tid >> 6;
  const int r0 = (item & 7) * 8, hd = (item >> 3) & 15, b = item >> 7;
  const int qi = lane & 15, g = lane >> 4;
  LAS float* EB = (LAS float*)(lds + NA8_TAB);
  LAS float* RW = EB + 960;
  const int R0 = min(max(r0 - 4, 0), 56), NR = min(15, 64 - R0);
  const u16* vB = (const u16*)(P.ws + A_VBT) + (size_t)(b * 16 + hd) * 32 * 4096;
  __syncthreads();
  {
    u32x4 vv[8];
#pragma unroll
    for (int k = 0; k < 8; ++k) {
      const int sg = (tid >> 3) + 64 * k, d = sg / NR, kr = sg - d * NR;
      vv[k] = *(const u32x4*)(vB + (size_t)min(d, 31) * 4096 + (R0 + min(kr, NR - 1)) * 64 + 8 * (tid & 7));
    }
    float mxa = 0.f;
    const float r0v = (tid < 465) ? P.rpb[hd * 465 + tid] : 0.f;
    mxa = fabsf(r0v);
#pragma unroll
    for (int o = 1; o < 64; o <<= 1) mxa = fmaxf(mxa, __shfl_xor(mxa, o));
    LAS float* red = (LAS float*)(lds + NA8_TAB + 7680);
    if (lane == 0) red[wave] = mxa;
#pragma unroll
    for (int k = 0; k < 8; ++k) {
      const int sg = (tid >> 3) + 64 * k, d = sg / NR, kr = sg - d * NR;
      if (sg < 32 * NR) *(LAS u32x4*)(lds + d * NA8_VSTRIDE + kr * 128 + 16 * (tid & 7)) = vv[k];
    }
    __syncthreads();
    const float m2 = (qkbound + fmaxf(fmaxf(fmaxf(red[0], red[1]), fmaxf(red[2], red[3])), fmaxf(fmaxf(red[4], red[5]), fmaxf(red[6], red[7])))) * LOG2E;
    for (int e = tid; e < 960; e += 512) {
      const int br = e >> 6, co = (e & 63) - 16;
      const float v = (co >= 0 && co <= 30) ? P.rpb[hd * 465 + br * 31 + co] * LOG2E - m2 : -1e30f;
      RW[e] = v;
      EB[e] = (co >= 7 && co <= 22) ? v : -1e30f;
    }
    __syncthreads();
  }
  const int r = r0 + wave;
  const int rs = min(max(r - 4, 0), 56), rb0 = rs - r + 7;
  const u16* qB = (const u16*)(P.ws + A_QB) + (size_t)(b * 16 + hd) * 4096 * 32;
  const u16* kBp = (const u16*)(P.ws + A_KB) + (size_t)(b * 16 + hd) * 4096 * 32;
  bf16x8 kf[16], qf;
  auto issue_kq = [&](int jq) {
    const int kb = min(min(max(16 * jq - 8, 0), 48), 32);
    const u16* kp = kBp + (size_t)(rs * 64 + kb + qi) * 32 + 8 * g;
    qf = *(const bf16x8*)(qB + (size_t)(r * 64 + 16 * jq + qi) * 32 + 8 * g);
#pragma unroll
    for (int ri = 0; ri < 8; ++ri)
#pragma unroll
      for (int t = 0; t < 2; ++t) kf[2 * ri + t] = *(const bf16x8*)(kp + (ri * 64 + 16 * t) * 32);
  };
  issue_kq(0);
#pragma unroll 1
  for (int jq = 0; jq < 4; ++jq) {
    const int kb = min(min(max(16 * jq - 8, 0), 48), 32);
    const LAS float* tb[2];
    {
      const int cobase = (jq == 0) ? 15 : ((jq == 3) ? -1 : 7);
#pragma unroll
      for (int t = 0; t < 2; ++t) {
        const int off = rb0 * 64 + cobase + 16 * t + 4 * g - qi + 16;
        const LAS float* pe = EB + off; const LAS float* pr = RW + off; const LAS float* pn = RW + 48;
        const LAS float* sel = pe;
        if (jq == 0 && qi < 8) sel = (t == 0) ? pr : pn;
        if (jq == 3 && qi > 8) sel = (t == 1) ? pr : pn;
        tb[t] = sel;
      }
    }
    f32x4 sa[8][2];
#pragma unroll
    for (int ri = 0; ri < 8; ++ri)
#pragma unroll
      for (int t = 0; t < 2; ++t) {
        const LAS float* tp = tb[t] + ri * 64;
        const f32x4 ci = {tp[0], tp[1], tp[2], tp[3]};
        sa[ri][t] = __builtin_amdgcn_mfma_f32_16x16x32_bf16(kf[2 * ri + t], qf, ci, 0, 0, 0);
      }
    __builtin_amdgcn_sched_barrier(0);
    if (jq + 1 < 4) issue_kq(jq + 1);
    __builtin_amdgcn_sched_barrier(0);
    float l = 0.f;
    f32x4 oa[2] = {{0.f, 0.f, 0.f, 0.f}, {0.f, 0.f, 0.f, 0.f}};
    ldsp vl = lds + qi * NA8_VSTRIDE + (rs - R0) * 128 + (kb + 4 * g) * 2;
#pragma unroll
    for (int ri = 0; ri < 8; ++ri) {
      float p[8];
#pragma unroll
      for (int t = 0; t < 2; ++t)
#pragma unroll
        for (int i = 0; i < 4; ++i) { const float e = __builtin_amdgcn_exp2f(sa[ri][t][i]); p[4 * t + i] = e; l += e; }
      u32x4 pp; pp[0] = pk2(p[0], p[1]); pp[1] = pk2(p[2], p[3]); pp[2] = pk2(p[4], p[5]); pp[3] = pk2(p[6], p[7]);
      const bf16x8 pfr = __builtin_bit_cast(bf16x8, pp);
#pragma unroll
      for (int dtl = 0; dtl < 2; ++dtl) {
        const s16x4 lo = *(LAS s16x4*)(vl + dtl * 16 * NA8_VSTRIDE + ri * 128), hi = *(LAS s16x4*)(vl + dtl * 16 * NA8_VSTRIDE + ri * 128 + 32);
        const bf16x8 vf = __builtin_shufflevector(lo, hi, 0, 1, 2, 3, 4, 5, 6, 7);
        oa[dtl] = __builtin_amdgcn_mfma_f32_16x16x32_bf16(vf, pfr, oa[dtl], 0, 0, 0);
      }
    }
    l += __shfl_xor(l, 16); l += __shfl_xor(l, 32);
    const float il = 1.0f / l;
    u16* dst = (u16*)(P.ws + A_AO) + ((size_t)b * 4096 + r * 64 + 16 * jq + qi) * 1024 + 512 + hd * 32;
#pragma unroll
    for (int dtl = 0; dtl < 2; ++dtl)
      *(uint2*)(dst + 16 * dtl + 4 * g) = make_uint2(pk2(oa[dtl][0] * il, oa[dtl][1] * il), pk2(oa[dtl][2] * il, oa[dtl][3] * il));
  }
}

DI void ph2_attn8(const Ptrs& P, ldsp lds, int bid, int G) {
  const float* sc = (const float*)(P.ws + WS_SCAL);
  const float lam = sc[0], m2 = sc[1], qkb = sc[2];
  if (m2 < 64.0f) { for (int it = bid; it < 256; it += G) da_item8<false>(P, lds, it, lam, m2); }
  else { for (int it = bid; it < 256; it += G) da_item8<true>(P, lds, it, lam, m2); }
  for (int it = bid; it < 512; it += G) na_block8(P, lds, it, qkb);
}

__global__ void __launch_bounds__(512, 2) mega8(Ptrs Pk, int ph_lo, int ph_hi) {
  extern __shared__ __attribute__((aligned(16))) unsigned char smem[];
  ldsp lds = (ldsp)smem;
  const int bid = blockIdx.x, G = gridDim.x;
  volatile LAS unsigned* st = (volatile LAS unsigned*)(lds + g8::LDS_EXTRA8 + 4080);
  XcdBarrier xb; xb.bar = (unsigned*)(Pk.ws + WS_CTL); xb.x = 0; xb.st = st;
  if (ph_hi - ph_lo > 1) {
    if (threadIdx.x == 0) { st[0] = 0u; st[1] = 0u; }
    __syncthreads();
    xb = xcd_barrier_post((unsigned*)(Pk.ws + WS_CTL), st);
  }
#define RUN_PHASE8(k, call) if (ph_lo <= k && k < ph_hi) { { const Ptrs P = load_args(); call; } if (k + 1 < ph_hi) xcd_barrier(xb); }
  RUN_PHASE8(0, ph0_prep(P, lds, bid, G))
  RUN_PHASE8(1, ph1_inproj8(P, lds, bid, G))
  RUN_PHASE8(2, ph2_attn8(P, lds, bid, G))
  RUN_PHASE8(3, ph3_outproj8(P, lds, bid, G))
  RUN_PHASE8(4, ph4_router(P, lds, bid, G))
  RUN_PHASE8(5, ph5_up8(P, lds, bid, G))
  RUN_PHASE8(6, ph6_down8(P, lds, bid, G))
  RUN_PHASE8(7, ph7_combine(P, lds, bid, G))
  RUN_PHASE8(8, ph8_final8(P, lds, bid, G))
}
extern "C" void kernel_launch(void* const* d_in, const int* in_sizes, int n_in, void* d_out, int out_size, void* d_ws, size_t ws_size,
                              hipStream_t stream) {
  static int grid = 0;
  if (grid == 0) {
    if (n_in != 25 || ws_size < WS_END || out_size != T * DM) { fprintf(stderr, "kernel_launch: unexpected n_in %d / out %d / ws_size %zu (need %zu)\\n", n_in, out_size, ws_size, (size_t)WS_END); grid = -1; return; }
    int dev = 0, cus = 0, per_cu = 0;
    (void)hipGetDevice(&dev);
    (void)hipDeviceGetAttribute(&cus, hipDeviceAttributeMultiprocessorCount, dev);
    (void)hipFuncSetAttribute((const void*)mega8, hipFuncAttributeMaxDynamicSharedMemorySize, g8::LDS_BYTES8);
    (void)hipOccupancyMaxActiveBlocksPerMultiprocessor(&per_cu, (const void*)mega8, 512, g8::LDS_BYTES8);
    if (per_cu < 1) { fprintf(stderr, "kernel_launch: occupancy query returned %d\\n", per_cu); grid = -1; return; }
    grid = cus;
  }
  if (grid < 0) return;
  Ptrs P{};
  const float** pp = (const float**)&P;
  for (int i = 0; i < 25; ++i) pp[i] = (const float*)d_in[i];
  P.out = (float*)d_out; P.ws = (unsigned char*)d_ws;
  (void)hipMemsetAsync((unsigned char*)d_ws + WS_CTL, 0, XCD_BAR_WORDS * 4, stream);
  mega8<<<grid, 512, g8::LDS_BYTES8, stream>>>(P, 0, 9);
}
```

```cpp
#define ONE_LAUNCH 2
#define NEW_MASK 0x1ff
#include <hip/hip_runtime.h>
#include <cstdio>
#include <cstdint>

typedef unsigned short u16;
#define DI __device__ __forceinline__

constexpr int T = 16384, S = 4096, DM = 1024, NB = 4;
constexpr int DIN = 3072, DPLE = 256;
constexpr int HA = 4, HB = 16;
constexpr int NE = 32, DE = 512;
constexpr float EPS = 1e-6f;
constexpr float LOG2E = 1.4426950408889634f;
constexpr float LAM_INIT = 0.2f;

constexpr size_t MiB = 1ull << 20;
constexpr size_t WS_WIN = 0, WS_WOUT = 6 * MiB, WS_W13 = 8 * MiB, WS_W2 = 72 * MiB, WS_WPLG = 104 * MiB,
                 WS_WPLE = 106 * MiB, WS_WR = 106 * MiB + 512 * 1024, WS_ROPE = 107 * MiB;
constexpr size_t WS_SMALL = 108 * MiB;
constexpr size_t WS_RSTDX = WS_SMALL;
constexpr size_t WS_SSQ1P = 250 * MiB;
constexpr size_t WS_SSQEP = 251 * MiB;
constexpr int SSQ_PARTS = 16;
constexpr size_t WS_RSTD1 = WS_RSTDX + 65536;
constexpr size_t WS_RSTD2 = WS_RSTD1 + 65536;
constexpr size_t WS_SCAL  = WS_RSTD2 + 65536;
constexpr size_t WS_CNT   = WS_SCAL + 256;
constexpr int CNT_STRIDE = 64;
constexpr size_t WS_PADST = WS_CNT + 8192;
constexpr size_t WS_CTL   = WS_PADST + 256;
constexpr size_t WS_RSTDE = WS_CTL + 16384;
constexpr size_t WS_PAR   = WS_SMALL + 1 * MiB;
constexpr int PAR_GQA = 0, PAR_GKA = 64, PAR_GSUB = 128, PAR_GQB = 256, PAR_GKB = 288, PAR_GPLE = 320, PAR_RPB = 1344, PAR_TOTAL = 1344 + 7440;
constexpr size_t WS_TOKL  = WS_SMALL + 2 * MiB;
constexpr size_t WS_WL    = WS_SMALL + 4 * MiB;
constexpr size_t WS_ACT   = 114 * MiB;
constexpr size_t A_XB = WS_ACT, A_AO = 260 * MiB, A_HID = WS_ACT, A_H2B = WS_ACT;
constexpr size_t A_PB = 252 * MiB;
constexpr size_t A_QA = WS_ACT + 40 * MiB, A_KA = WS_ACT + 56 * MiB, A_VAT = WS_ACT + 72 * MiB,
                 A_QB = WS_ACT + 88 * MiB, A_KB = WS_ACT + 104 * MiB, A_VBT = WS_ACT + 120 * MiB;
constexpr size_t A_RSL = 260 * MiB;
constexpr size_t A_H1B = WS_ACT + 40 * MiB, A_EBF = WS_ACT + 72 * MiB, A_Y0 = WS_ACT + 104 * MiB, A_Y1 = 260 * MiB;
constexpr size_t WS_END = 292 * MiB;

DI float bf2f(u16 u) { return __uint_as_float(((unsigned)u) << 16); }
DI u16 f2bf(float f) { __bf16 b = (__bf16)f; return __builtin_bit_cast(u16, b); }
DI int permpos(int s) { return (s & ~12) | ((s & 8) >> 1) | ((s & 4) << 1); }

struct Ptrs {
  const float *x, *p, *g_mix, *w_in, *g_qa, *g_ka, *lam_q1, *lam_k1, *lam_q2, *lam_k2, *g_sub, *g_qb, *g_kb, *rpb, *w_out,
      *g_ffn, *w_rg, *w_re, *w1, *w3, *w2, *g_plg, *w_plg, *w_ple, *g_ple;
  float* out;
  unsigned char* ws;
};

#define GAS __attribute__((address_space(1)))
#define LAS __attribute__((address_space(3)))
typedef LAS unsigned char* ldsp;
typedef __attribute__((ext_vector_type(8))) short bf16x8;
typedef __attribute__((ext_vector_type(16))) float f32x16;
typedef __attribute__((ext_vector_type(4))) float f32x4;
typedef __attribute__((ext_vector_type(2))) float f32x2v;
typedef __attribute__((ext_vector_type(2))) __bf16 bf16x2v;
DI unsigned pk2(float a, float b) { bf16x2v v = __builtin_convertvector((f32x2v){a, b}, bf16x2v); return __builtin_bit_cast(unsigned, v); }
DI float wave_sum(float v) {
#pragma unroll
  for (int o = 1; o < 64; o <<= 1) v += __shfl_xor(v, o);
  return v;
}
DI void glds16(const void* g, ldsp l) { __builtin_amdgcn_global_load_lds((const GAS unsigned*)g, (LAS unsigned*)l, 16, 0, 0); }
DI void lds_wave_sync() { asm volatile("s_waitcnt lgkmcnt(0)" ::: "memory"); }

#define XB_TMO      128
#define XB_XCNT(j)  (256  + 64 * (j))
#define XB_XSUB(j)  (1280 + 64 * (j))
#define XB_XGEN(j)  (2304 + 64 * (j))
#define XB_TOP      3328
#define XB_TOPGEN   3392
#define XCD_BAR_WORDS 3456
#define XB_SPIN_CAP (1u << 22)
DI unsigned xb_ld(unsigned* p) { return __hip_atomic_load(p, __ATOMIC_RELAXED, __HIP_MEMORY_SCOPE_AGENT); }
DI unsigned xb_add(unsigned* p, unsigned v) { return __hip_atomic_fetch_add(p, v, __ATOMIC_RELAXED, __HIP_MEMORY_SCOPE_AGENT); }
DI unsigned xb_xcc_id() { return (unsigned)__builtin_amdgcn_s_getreg((3 << 11) | 20) & 0xFu; }
#define XB_SPIN(cond, bar) do { unsigned _sp = 0; while (cond) { __builtin_amdgcn_s_sleep(1); \
    if ((++_sp & 255u) == 0u) { if (xb_ld(&(bar)[XB_TMO])) break; if (_sp > XB_SPIN_CAP) { atomicAdd(&(bar)[XB_TMO], 1u); break; } } } } while (0)
struct XcdBarrier { unsigned* bar; unsigned x; volatile LAS unsigned* st; };
DI XcdBarrier xcd_barrier_post(unsigned* bar, volatile LAS unsigned* st) {
  XcdBarrier b; b.bar = bar; b.x = xb_xcc_id(); b.st = st;
  if (threadIdx.x == 0) (void)xb_add(&bar[XB_XCNT(b.x)], 1u);
  return b;
}
DI void xcd_barrier_complete(unsigned* bar, unsigned x, unsigned& nloc, unsigned& nx) {
  const unsigned G = gridDim.x;
  unsigned sum, cnt, mine, sp = 0u;
  for (;;) {
    sum = 0u; cnt = 0u; mine = 0u;
#pragma unroll
    for (unsigned j = 0; j < 16; ++j) { const unsigned c = xb_ld(&bar[XB_XCNT(j)]); sum += c; cnt += (c > 0u) ? 1u : 0u; mine = (j == x) ? c : mine; }
    if (sum == G) break;
    __builtin_amdgcn_s_sleep(1);
    if ((++sp & 255u) == 0u) { if (xb_ld(&bar[XB_TMO])) break; if (sp > XB_SPIN_CAP) { atomicAdd(&bar[XB_TMO], 1u); break; } }
  }
  nloc = mine > 0u ? mine : 1u; nx = cnt > 0u ? cnt : 1u;
}
DI void xcd_barrier(const XcdBarrier& b) {
  asm volatile("s_waitcnt vmcnt(0)" ::: "memory");
  __syncthreads();
  if (threadIdx.x == 0) {
    unsigned* bar = b.bar;
    __builtin_amdgcn_s_waitcnt(0);
    unsigned nloc = b.st[0], nx = b.st[1];
    if (nloc == 0u) { xcd_barrier_complete(bar, b.x, nloc, nx); b.st[0] = nloc; b.st[1] = nx; }
    const unsigned old = xb_add(&bar[XB_XSUB(b.x)], 1u);
    const unsigned gen = old / nloc;
    if (old + 1u == (gen + 1u) * nloc) {
      __builtin_amdgcn_fence(__ATOMIC_RELEASE, "agent");
      asm volatile("s_waitcnt vmcnt(0)" ::: "memory");
      const unsigned og = xb_add(&bar[XB_TOP], 1u);
      const unsigned tg = og / nx;
      if (og + 1u == (tg + 1u) * nx) xb_add(&bar[XB_TOPGEN], 1u);
      else XB_SPIN(xb_ld(&bar[XB_TOPGEN]) == tg, bar);
      __builtin_amdgcn_fence(__ATOMIC_ACQUIRE, "agent");
      xb_add(&bar[XB_XGEN(b.x)], 1u);
      asm volatile("s_waitcnt vmcnt(0)" ::: "memory");
    } else {
      XB_SPIN(xb_ld(&bar[XB_XGEN(b.x)]) == gen, bar);
      __builtin_amdgcn_fence(__ATOMIC_ACQUIRE, "agent");
      asm volatile("s_waitcnt vmcnt(0)" ::: "memory");
    }
  }
  __syncthreads();
}

DI int win8_row(int f);
DI int perm256(int f);
DI int w13_row_w1(int f);
DI int w13_row_w3(int f);
typedef int (*rowmap_t)(int);
template <rowmap_t rowmap = (rowmap_t) nullptr>
DI void tr_item(const float* W, int ldw, int k0, int n0, const float* gk, u16* dst0, u16* dst1, int ldd, LAS float* scr, int lane) {
  float4 v[16];
  const float* src = W + (size_t)(k0 + (lane >> 4)) * ldw + n0 + 4 * (lane & 15);
#pragma unroll
  for (int j = 0; j < 16; ++j) { const f32x4 t = __builtin_nontemporal_load((const f32x4*)(src + (size_t)(4 * j) * ldw)); v[j] = make_float4(t[0], t[1], t[2], t[3]); }
  if (gk) {
#pragma unroll
    for (int j = 0; j < 16; ++j) { const float g = gk[k0 + 4 * j + (lane >> 4)]; v[j].x *= g; v[j].y *= g; v[j].z *= g; v[j].w *= g; }
  }
  LAS float* w = scr + (lane >> 4) * 65 + 4 * (lane & 15);
#pragma unroll
  for (int j = 0; j < 16; ++j) { w[(4 * j) * 65] = v[j].x; w[(4 * j) * 65 + 1] = v[j].y; w[(4 * j) * 65 + 2] = v[j].z; w[(4 * j) * 65 + 3] = v[j].w; }
  lds_wave_sync();
  const int c = lane & 7;
#pragma unroll
  for (int j = 0; j < 8; ++j) {
    const int n = (lane >> 3) + 8 * j;
    const LAS float* s = scr + (8 * c) * 65 + n;
    uint4 o;
    o.x = pk2(s[0 * 65], s[1 * 65]); o.y = pk2(s[2 * 65], s[3 * 65]); o.z = pk2(s[4 * 65], s[5 * 65]); o.w = pk2(s[6 * 65], s[7 * 65]);
    u16* d = rowmap ? (dst0 + (size_t)rowmap(n0 + n) * ldd) : ((j < 4) ? (dst0 + (size_t)n * ldd) : (dst1 + (size_t)(n - 32) * ldd));
    *(uint4*)(d + k0 + 8 * c) = o;
  }
  lds_wave_sync();
}

typedef const __attribute__((address_space(4))) Ptrs* kargp_t;
DI kargp_t kargs_now() {
#if defined(__HIP_DEVICE_COMPILE__)
  kargp_t kp = (kargp_t)__builtin_amdgcn_kernarg_segment_ptr(); asm volatile("" : "+s"(kp)); return kp;
#else
  return nullptr;
#endif
}
DI Ptrs load_args() {
#if defined(__HIP_DEVICE_COMPILE__)
  kargp_t kp = kargs_now(); Ptrs r; __builtin_memcpy(&r, (const void*)kp, sizeof(Ptrs)); return r;
#else
  return Ptrs{};
#endif
}
DI void late_weight_item(int r, LAS float* scr, int lane) {
  unsigned char* const wsb = kargs_now()->ws;
  if (r < 4096) {
    u16* W2T = (u16*)(wsb + WS_W2);
    const int e = r >> 7, q = r & 127, kb = q >> 4, nb = q & 15;
    tr_item<perm256>(kargs_now()->w2 + (size_t)e * 512 * 1024, 1024, kb * 64, nb * 64, nullptr, W2T + (size_t)e * 1024 * 512, nullptr, 512, scr, lane);
  } else {
    r -= 4096;
    const int kb = r >> 4, nb = r & 15;
    tr_item<perm256>(kargs_now()->w_plg, 1024, kb * 64, nb * 64, kargs_now()->g_plg, (u16*)(wsb + WS_WPLG), nullptr, 1024, scr, lane);
  }
}
DI void ph0_prep(const Ptrs& Punused, ldsp lds, int bid, int G) {
  unsigned char* const wsb = kargs_now()->ws;
  const int tid = threadIdx.x, lane = tid & 63, wave = tid >> 6;
  LAS float* scr = (LAS float*)(lds + wave * 16640);
  const int nwv = blockDim.x >> 6, gw = bid * nwv + wave, NGW = G * nwv;
  constexpr int I_W1 = 4096, I_W3 = 4096, I_W2 = 4096, I_X = 8192, I_WIN = 768, I_P = 2048, I_WOUT = 256, I_PLG = 256, I_PLE = 64,
                I_WR = 768, I_ROPE = 2048, I_PAR = (PAR_TOTAL + 63) / 64, I_SC = 1;
  constexpr int TOTAL = I_W1 + I_W3 + I_W2 + I_X + I_WIN + I_P + I_WOUT + I_PLG + I_PLE + I_WR + I_ROPE + I_PAR + I_SC;
  u16* W13T = (u16*)(wsb + WS_W13); u16* W2T = (u16*)(wsb + WS_W2);
  for (int r0_ = gw; r0_ < I_W1 + I_W3; r0_ += NGW) {
    int r = r0_;
      const int isw3 = r >= I_W1; if (isw3) r -= I_W1;
      const int e = r >> 7, q = r & 127, kb = q >> 3, nb = q & 7;
      u16* d0 = W13T + ((size_t)e * 1024 + nb * 128 + isw3 * 32) * 1024;
#if NEW_MASK & 0x20
      if (isw3) tr_item<w13_row_w3>(kargs_now()->w3 + (size_t)e * 1024 * 512, 512, kb * 64, nb * 64, kargs_now()->g_ffn, W13T + (size_t)e * 1024 * 1024, nullptr, 1024, scr, lane);
      else tr_item<w13_row_w1>(kargs_now()->w1 + (size_t)e * 1024 * 512, 512, kb * 64, nb * 64, kargs_now()->g_ffn, W13T + (size_t)e * 1024 * 1024, nullptr, 1024, scr, lane);
#else
      tr_item((isw3 ? kargs_now()->w3 : kargs_now()->w1) + (size_t)e * 1024 * 512, 512, kb * 64, nb * 64, kargs_now()->g_ffn, d0, d0 + 64 * 1024, 1024, scr, lane);
#endif
  }
  for (int r0_ = gw; r0_ < I_X; r0_ += NGW) {
    int r = r0_;
      const float4* xr = (const float4*)(kargs_now()->x + (size_t)r * 2048) + lane;
      float4 v[8];
#pragma unroll
      for (int j = 0; j < 8; ++j) { const f32x4 t = __builtin_nontemporal_load((const f32x4*)(xr + 64 * j)); v[j] = make_float4(t[0], t[1], t[2], t[3]); }
      float s0 = 0.f, s1 = 0.f;
#pragma unroll
      for (int j = 0; j < 4; ++j) { s0 += v[j].x * v[j].x + v[j].y * v[j].y + v[j].z * v[j].z + v[j].w * v[j].w; s1 += v[j + 4].x * v[j + 4].x + v[j + 4].y * v[j + 4].y + v[j + 4].z * v[j + 4].z + v[j + 4].w * v[j + 4].w; }
      s0 = wave_sum(s0); s1 = wave_sum(s1);
      if (lane == 0) { float* rx = (float*)(wsb + WS_RSTDX); rx[2 * r] = rsqrtf(s0 * (1.0f / 1024.0f) + EPS); rx[2 * r + 1] = rsqrtf(s1 * (1.0f / 1024.0f) + EPS); }
      uint2* o = (uint2*)((u16*)(wsb + A_XB) + (size_t)r * 2048) + lane;
#pragma unroll
      for (int j = 0; j < 8; ++j) o[64 * j] = make_uint2(pk2(v[j].x, v[j].y), pk2(v[j].z, v[j].w));
  }
  for (int r0_ = gw; r0_ < I_WIN; r0_ += NGW) {
    int r = r0_;
      const int kb = r / 48, nb = r % 48;
      u16* d0 = (u16*)(wsb + WS_WIN) + (size_t)(nb * 64) * 1024;
      tr_item<win8_row>(kargs_now()->w_in, DIN, kb * 64, nb * 64, kargs_now()->g_mix, (u16*)(wsb + WS_WIN), nullptr, 1024, scr, lane);
  }
  for (int r0_ = gw; r0_ < I_P; r0_ += NGW) {
    int r = r0_;
      const float4* pr = (const float4*)kargs_now()->p + (size_t)r * 512 + lane;
      uint2* o = (uint2*)(wsb + A_PB) + (size_t)r * 512 + lane;
      float4 v[8];
#pragma unroll
      for (int j = 0; j < 8; ++j) { const f32x4 t = __builtin_nontemporal_load((const f32x4*)(pr + 64 * j)); v[j] = make_float4(t[0], t[1], t[2], t[3]); }
#pragma unroll
      for (int j = 0; j < 8; ++j) o[64 * j] = make_uint2(pk2(v[j].x, v[j].y), pk2(v[j].z, v[j].w));
  }
  for (int r0_ = gw; r0_ < I_WOUT; r0_ += NGW) {
    int r = r0_;
      const int kb = r >> 4, nb = r & 15;
      u16* d0 = (u16*)(wsb + WS_WOUT) + (size_t)(nb * 64) * 1024;
#if NEW_MASK & 0x8
      tr_item<perm256>(kargs_now()->w_out, 1024, kb * 64, nb * 64, nullptr, (u16*)(wsb + WS_WOUT), nullptr, 1024, scr, lane);
#else
      tr_item(kargs_now()->w_out, 1024, kb * 64, nb * 64, nullptr, d0, d0 + 32 * 1024, 1024, scr, lane);
#endif
  }
  for (int r0_ = gw; r0_ < I_PLE; r0_ += NGW) {
    int r = r0_;
      const int kb = r >> 4, nb = r & 15;
      u16* d0 = (u16*)(wsb + WS_WPLE) + (size_t)(nb * 64) * 256;
#if NEW_MASK & 0x8
      tr_item<perm256>(kargs_now()->w_ple, 1024, kb * 64, nb * 64, nullptr, (u16*)(wsb + WS_WPLE), nullptr, 256, scr, lane);
#else
      tr_item(kargs_now()->w_ple, 1024, kb * 64, nb * 64, nullptr, d0, d0 + 32 * 256, 256, scr, lane);
#endif
  }
  for (int r0_ = gw; r0_ < I_WR; r0_ += NGW) {
    int r = r0_;
      const int idx = r * 64 + lane, rr = idx >> 10, k = idx & 1023;
      float v = 0.f;
      if (rr < 4) v = kargs_now()->w_rg[k * 4 + rr]; else if (rr < 36) v = kargs_now()->w_re[k * 32 + (rr - 4)];
      const float wv_ = v * kargs_now()->g_ffn[k];
      const unsigned hb_ = pk2(wv_, 0.f) & 0xffffu;
      const unsigned lb_ = pk2(wv_ - __uint_as_float(hb_ << 16), 0.f) & 0xffffu;
      ((u16*)(wsb + WS_WR))[idx] = (u16)hb_; ((u16*)(wsb + WS_WR))[48 * 1024 + idx] = (u16)lb_;
  }
  for (int r0_ = gw; r0_ < I_ROPE; r0_ += NGW) {
    int r = r0_;
      const int idx = r * 64 + lane, s = idx >> 5, i = idx & 31;
      const float inv = powf(10000.0f, -(float)(2 * i) / 64.0f);
      const float ang = (float)s * inv;
      float sn, cs; sincosf(ang, &sn, &cs);
      ((float2*)(wsb + WS_ROPE))[idx] = make_float2(cs, sn);
  }
  for (int r0_ = gw; r0_ < I_PAR; r0_ += NGW) {
    int r = r0_;
      const int idx = r * 64 + lane;
      if (idx < PAR_TOTAL) {
        float v;
        if (idx < PAR_GKA) v = kargs_now()->g_qa[idx]; else if (idx < PAR_GSUB) v = kargs_now()->g_ka[idx - PAR_GKA]; else if (idx < PAR_GQB) v = kargs_now()->g_sub[idx - PAR_GSUB];
        else if (idx < PAR_GKB) v = kargs_now()->g_qb[idx - PAR_GQB]; else if (idx < PAR_GPLE) v = kargs_now()->g_kb[idx - PAR_GKB]; else if (idx < PAR_RPB) v = kargs_now()->g_ple[idx - PAR_GPLE];
        else v = kargs_now()->rpb[idx - PAR_RPB];
        ((float*)(wsb + WS_PAR))[idx] = v;
      }
  }
  if (gw == 0) {
    if (lane == 0) {
      float s1 = 0, s2 = 0, mq = 0, mk = 0;
      for (int i = 0; i < 64; ++i) {
        s1 += kargs_now()->lam_q1[i] * kargs_now()->lam_k1[i]; s2 += kargs_now()->lam_q2[i] * kargs_now()->lam_k2[i];
        mq = fmaxf(mq, fabsf(kargs_now()->g_qa[i])); mk = fmaxf(mk, fabsf(kargs_now()->g_ka[i]));
      }
      float* sc = (float*)(wsb + WS_SCAL);
      sc[0] = expf(s1) - expf(s2) + LAM_INIT;
      sc[1] = 8.0f * mq * mk * LOG2E;
      float mqb = 0, mkb = 0;
      for (int i = 0; i < 32; ++i) { mqb = fmaxf(mqb, fabsf(kargs_now()->g_qb[i])); mkb = fmaxf(mkb, fabsf(kargs_now()->g_kb[i])); }
      sc[2] = 5.656854249f * mqb * mkb;
      int* cnt = (int*)(wsb + WS_CNT);
      for (int i = 0; i < 32; ++i) cnt[i * CNT_STRIDE] = 0;
    }
  }
}

DI uint4 pk8(const f32x4 a, const f32x4 b) { return make_uint4(pk2(a[0], a[1]), pk2(a[2], a[3]), pk2(b[0], b[1]), pk2(b[2], b[3])); }

typedef __attribute__((ext_vector_type(4))) unsigned u32x4;
DI bf16x8 packp(const f32x16& x, int s) {
  u32x4 p;
  p[0] = pk2(x[8 * s + 0], x[8 * s + 1]); p[1] = pk2(x[8 * s + 2], x[8 * s + 3]);
  p[2] = pk2(x[8 * s + 4], x[8 * s + 5]); p[3] = pk2(x[8 * s + 6], x[8 * s + 7]);
  return __builtin_bit_cast(bf16x8, p);
}
DI int grp_of(int kk) { return ((kk >> 2) == 1 || (kk >> 2) == 2 || (kk >> 2) == 4 || (kk >> 2) == 7) ? 1 : 0; }
DI int rank_of(int kk) { const int q = kk >> 2; return kk - ((q == 0) ? 0 : (q <= 2) ? 4 : (q == 3 || q == 4) ? 8 : (q <= 6) ? 12 : 16); }
DI int key_of(int grp, int jj) { return grp ? (jj < 8 ? jj + 4 : (jj < 12 ? jj + 8 : jj + 16)) : (jj < 4 ? jj : (jj < 8 ? jj + 8 : jj + 12)); }
constexpr int DA_STAGE = 33280, DA_VOFF = 16640;
typedef __attribute__((ext_vector_type(4))) short s16x4;
DI void ph4_router_t(const Ptrs& P, ldsp lds, int bid, int G) {
  const int tid = threadIdx.x, lane = tid & 63, wave = __builtin_amdgcn_readfirstlane(tid >> 6), t = lane & 15, kk = lane >> 4;
  LAS float* lg = (LAS float*)lds;
  const u16* h1 = (const u16*)(P.ws + A_H1B); const u16* WrH = (const u16*)(P.ws + WS_WR);
  for (int item = bid; item < 256; item += G) {
    const int tok0 = item * 64;
    float4 s0 = make_float4(0.f, 0.f, 0.f, 0.f), s1 = s0, s2 = s0, s3 = s0;
    if (wave == 0) {
      const float* sp = (const float*)(P.ws + WS_SSQ1P) + (size_t)(tok0 + lane) * SSQ_PARTS;
      s0 = *(const float4*)sp; s1 = *(const float4*)(sp + 4); s2 = *(const float4*)(sp + 8); s3 = *(const float4*)(sp + 12);
    }
    f32x4 acc[4][3];
#pragma unroll
    for (int tt = 0; tt < 4; ++tt)
#pragma unroll
      for (int et = 0; et < 3; ++et) acc[tt][et] = (f32x4){0.f, 0.f, 0.f, 0.f};
    const u16* ap = h1 + (size_t)(tok0 + t) * 1024 + 128 * wave + 8 * kk;
    const u16* bp = WrH + (size_t)t * 1024 + 128 * wave + 8 * kk;
#pragma unroll
    for (int s = 0; s < 4; ++s) {
      bf16x8 a[4];
#pragma unroll
      for (int tt = 0; tt < 4; ++tt) a[tt] = *(const bf16x8*)(ap + (size_t)tt * 16 * 1024 + 32 * s);
#pragma unroll
      for (int et = 0; et < 3; ++et) {
        const bf16x8 bh = *(const bf16x8*)(bp + et * 16 * 1024 + 32 * s), bl = *(const bf16x8*)(bp + (48 + et * 16) * 1024 + 32 * s);
#pragma unroll
        for (int tt = 0; tt < 4; ++tt) {
          acc[tt][et] = __builtin_amdgcn_mfma_f32_16x16x32_bf16(a[tt], bh, acc[tt][et], 0, 0, 0);
          acc[tt][et] = __builtin_amdgcn_mfma_f32_16x16x32_bf16(a[tt], bl, acc[tt][et], 0, 0, 0);
        }
      }
    }
    __syncthreads();
#pragma unroll
    for (int tt = 0; tt < 4; ++tt)
#pragma unroll
      for (int et = 0; et < 3; ++et)
#pragma unroll
        for (int i = 0; i < 4; ++i) lg[wave * (64 * 49) + (16 * tt + 4 * kk + i) * 49 + 16 * et + t] = acc[tt][et][i];
    __syncthreads();
    if (wave == 0) {
      const int tok = tok0 + lane;
      const float rstd = rsqrtf(((s0.x + s0.y + s0.z + s0.w) + (s1.x + s1.y + s1.z + s1.w) + (s2.x + s2.y + s2.z + s2.w) + (s3.x + s3.y + s3.z + s3.w)) * (1.0f / 1024.0f) + EPS);
      const LAS float* L = lg + lane * 49;
      float gl[4] = {0.f, 0.f, 0.f, 0.f};
#pragma unroll
      for (int w = 0; w < 8; ++w)
#pragma unroll
        for (int i = 0; i < 4; ++i) gl[i] += L[w * (64 * 49) + i];
      int gi = 0; float gm = gl[0];
#pragma unroll
      for (int i = 1; i < 4; ++i) { if (gl[i] > gm) { gm = gl[i]; gi = i; } }
      float gs = 0.f;
#pragma unroll
      for (int i = 0; i < 4; ++i) gs += expf((gl[i] - gm) * rstd);
      const float gate = 1.0f / gs;
      const LAS float* el = L + 4 + 8 * gi;
      float ev[8] = {0.f, 0.f, 0.f, 0.f, 0.f, 0.f, 0.f, 0.f};
#pragma unroll
      for (int w = 0; w < 8; ++w)
#pragma unroll
        for (int i = 0; i < 8; ++i) ev[i] += el[w * (64 * 49) + i];
      int e1 = 0; float m1 = ev[0];
#pragma unroll
      for (int i = 1; i < 8; ++i) { if (ev[i] > m1) { m1 = ev[i]; e1 = i; } }
      int e2 = 0; float m2v = -3.0e38f;
#pragma unroll
      for (int i = 0; i < 8; ++i) { if (i != e1 && ev[i] > m2v) { m2v = ev[i]; e2 = i; } }
      const float p2 = expf((m2v - m1) * rstd);
      const float wa = gate / (1.0f + p2), wb = gate * p2 / (1.0f + p2);
      int* cnt = (int*)(P.ws + WS_CNT); int* tokl = (int*)(P.ws + WS_TOKL); float* wl = (float*)(P.ws + WS_WL);
      const int ea = gi * 8 + e1, eb = gi * 8 + e2;
      ((float*)(P.ws + WS_RSTD1))[tok] = rstd;
      int mycnt = 0, ra = 0, rb = 0;
#pragma unroll 4
      for (int e = 0; e < 32; ++e) {
        const unsigned long long ma = __ballot(ea == e), mb = __ballot(eb == e);
        const int ca = __popcll(ma);
        if (lane == e) mycnt = ca + __popcll(mb);
        if (ea == e) ra = __builtin_amdgcn_mbcnt_hi((unsigned)(ma >> 32), __builtin_amdgcn_mbcnt_lo((unsigned)ma, 0u));
        if (eb == e) rb = ca + __builtin_amdgcn_mbcnt_hi((unsigned)(mb >> 32), __builtin_amdgcn_mbcnt_lo((unsigned)mb, 0u));
      }
      int base = 0;
      if (lane < 32 && mycnt > 0) base = atomicAdd(&cnt[lane * CNT_STRIDE], mycnt);
      const int pa = __shfl(base, ea) + ra, pb = __shfl(base, eb) + rb;
      float* rsl = (float*)(P.ws + A_RSL);
      tokl[ea * 16384 + pa] = tok * 2; wl[ea * 16384 + pa] = wa; rsl[ea * 16384 + pa] = rstd;
      tokl[eb * 16384 + pb] = tok * 2 + 1; wl[eb * 16384 + pb] = wb; rsl[eb * 16384 + pb] = rstd;
    }
  }
}

DI void ph4_router(const Ptrs& P, ldsp lds, int bid, int G) {
  ph4_router_t(P, lds, bid, G);
}

DI void ph7_combine(const Ptrs& P, ldsp lds, int bid, int G) {
  const int lane = threadIdx.x & 63, wave = threadIdx.x >> 6;
  const int nwv = blockDim.x >> 6;
  for (int tok = bid * nwv + wave; tok < T; tok += G * nwv) {
    const uint2* hr = (const uint2*)((const u16*)(P.ws + A_H1B) + (size_t)tok * 1024) + lane;
    const uint2* y0 = (const uint2*)((const u16*)(P.ws + A_Y0) + (size_t)tok * 1024) + lane;
    const uint2* y1 = (const uint2*)((const u16*)(P.ws + A_Y1) + (size_t)tok * 1024) + lane;
    uint2* o = (uint2*)((u16*)(P.ws + A_H2B) + (size_t)tok * 1024) + lane;
    float ss = 0.f;
#pragma unroll
    for (int j = 0; j < 4; ++j) {
      const uint2 hv = hr[64 * j], a = y0[64 * j], c = y1[64 * j];
      const float v0 = __uint_as_float(hv.x << 16) + __uint_as_float(a.x << 16) + __uint_as_float(c.x << 16);
      const float v1 = __uint_as_float(hv.x & 0xffff0000u) + __uint_as_float(a.x & 0xffff0000u) + __uint_as_float(c.x & 0xffff0000u);
      const float v2 = __uint_as_float(hv.y << 16) + __uint_as_float(a.y << 16) + __uint_as_float(c.y << 16);
      const float v3 = __uint_as_float(hv.y & 0xffff0000u) + __uint_as_float(a.y & 0xffff0000u) + __uint_as_float(c.y & 0xffff0000u);
      ss += v0 * v0 + v1 * v1 + v2 * v2 + v3 * v3;
      o[64 * j] = make_uint2(pk2(v0, v1), pk2(v2, v3));
    }
    ss = wave_sum(ss);
    float se = (lane < SSQ_PARTS) ? ((const float*)(P.ws + WS_SSQEP))[(size_t)tok * SSQ_PARTS + lane] : 0.f;
    se = wave_sum(se);
    if (lane == 0) {
      ((float*)(P.ws + WS_RSTD2))[tok] = rsqrtf(ss * (1.0f / 1024.0f) + EPS);
      ((float*)(P.ws + WS_RSTDE))[tok] = rsqrtf(se * (1.0f / 1024.0f) + EPS);
    }
  }
}

namespace g8 {
constexpr int BM = 256, BK = 64, HALF = 128, HTB = HALF * BK * 2, STAGE_BYTES = 8 * HTB, NXCD = 8, WGM = 8;
constexpr int LDS_EXTRA8 = STAGE_BYTES;
constexpr int LDS_BYTES8 = STAGE_BYTES + 4096;
DI int lds_byte(int r, int c) { const int st = (r >> 4) * 2 + (c >> 5), rr = r & 15, cc = c & 31, ob = rr * 64 + cc * 2; return st * 1024 + (ob ^ (((ob >> 9) & 1) << 5)); }
DI void stage_rc(int b, int& R, int& C) { const int st = b / 1024, sb = b % 1024, swz = sb ^ (((sb >> 9) & 1) << 5); R = (st >> 1) * 16 + swz / 64; C = (st & 1) * 32 + (swz % 64) / 2; }

struct Unit { int pm, pn, e, ce; };
struct GridOrder {
  int nM, nN, nwg, G, c; unsigned pnmap;
  DI void init(int nM_, int nN_, int G_, int c_, unsigned pnmap_ = 0u) { nM = nM_; nN = nN_; nwg = nM * nN; G = G_; c = c_; pnmap = pnmap_; }
  DI bool next(int i, Unit& u) const {
    const int L = i * G + c; if (L >= nwg) return false;
    int wgid = L; { const int q = nwg / NXCD, r = nwg % NXCD, xcd = wgid % NXCD, off = wgid / NXCD; wgid = (xcd < r ? xcd * (q + 1) : r * (q + 1) + (xcd - r) * q) + off; }
    const int nig = WGM * nN, gid = wgid / nig, fm = gid * WGM, gsz = (nM - fm) < WGM ? (nM - fm) : WGM;
    u.pm = fm + ((wgid % nig) % gsz); u.pn = (wgid % nig) / gsz; if (pnmap) u.pn = (int)((pnmap >> (4 * u.pn)) & 15u); u.e = 0; u.ce = 0; return true;
  }
};

template <class Epi, class Sched, bool SWAP, bool GATHER>
DI void gemm_phase(ldsp lds, const unsigned char* Abase, const unsigned char* Bbase, int K, const Sched& S, const Epi& E, int pA = 0, int pB = 0) {
  if (pA == 0) pA = K; if (pB == 0) pB = K;
  int tid = threadIdx.x; asm volatile("" : "+v"(tid));
  const int wid = __builtin_amdgcn_readfirstlane(tid >> 6), lane = tid & 63, wr = wid >> 2, wc = wid & 3, fr = lane & 15, fq = lane >> 4;
  const int nt = K / BK;
  int sR[2], sC[2];
  unsigned voffB[2], voffA[2];
#pragma unroll
  for (int i = 0; i < 2; ++i) { stage_rc(tid * 16 + i * 8192, sR[i], sC[i]); voffB[i] = (unsigned)(sR[i] * pB + sC[i]) * 2u; voffA[i] = (unsigned)(sR[i] * pA + sC[i]) * 2u; }
  const size_t tstepA = (size_t)BM * pA * 2;
  const size_t kstep = (size_t)(BK * 2);
  const size_t hstep = (size_t)HALF * pB * 2, hstepA = (size_t)HALF * pA * 2;
  const unsigned ldsw = (unsigned)wid * 1024u;
  const int aoff = lds_byte(wr * 64 + fr, fq * 8), boff = lds_byte(wc * 32 + fr, fq * 8);
#define G8_SA(b, h) (((b) * 2 + (h)) * HTB)
#define G8_SB(b, h) ((4 + (b) * 2 + (h)) * HTB)
#define G8_STAGE_B(bufoff, gbase) do { _Pragma("unroll") for (int _i = 0; _i < 2; ++_i) \
    __builtin_amdgcn_global_load_lds((const GAS unsigned*)((const unsigned char*)(gbase) + voffB[_i]), (LAS unsigned*)(lds + (bufoff) + ldsw + _i * 8192), 16, 0, 0); } while (0)
#define G8_STAGE_A(bufoff, hsel, nx, koff) do { _Pragma("unroll") for (int _i = 0; _i < 2; ++_i) { \
    const unsigned char* _p; \
    if (GATHER) _p = Abase + (size_t)((nx) ? ((hsel) ? nv1[_i] : nv0[_i]) : ((hsel) ? cv1[_i] : cv0[_i])) + (koff); \
    else _p = ((nx) ? nA : cA) + ((hsel) ? hstepA : (size_t)0) + voffA[_i] + (koff); \
    __builtin_amdgcn_global_load_lds((const GAS unsigned*)_p, (LAS unsigned*)(lds + (bufoff) + ldsw + _i * 8192), 16, 0, 0); } } while (0)
#define G8_LDA(dst, b, h) do { _Pragma("unroll") for (int m = 0; m < 4; ++m) _Pragma("unroll") for (int k = 0; k < 2; ++k) dst[m][k] = *(const LAS bf16x8*)(lds + G8_SA(b, h) + aoff + m * 2048 + k * 1024); } while (0)
#define G8_LDB(dst, b, h) do { _Pragma("unroll") for (int n = 0; n < 2; ++n) _Pragma("unroll") for (int k = 0; k < 2; ++k) dst[n][k] = *(const LAS bf16x8*)(lds + G8_SB(b, h) + boff + n * 2048 + k * 1024); } while (0)
#define G8_MMA(ai, bj, At, Bt) do { __builtin_amdgcn_s_setprio(1); \
    _Pragma("unroll") for (int m = 0; m < 4; ++m) _Pragma("unroll") for (int n = 0; n < 2; ++n) _Pragma("unroll") for (int k = 0; k < 2; ++k) \
        acc[ai][bj][m][n] = SWAP ? __builtin_amdgcn_mfma_f32_16x16x32_bf16(At[m][k], Bt[n][k], acc[ai][bj][m][n], 0, 0, 0) \
                                 : __builtin_amdgcn_mfma_f32_16x16x32_bf16(Bt[n][k], At[m][k], acc[ai][bj][m][n], 0, 0, 0); \
    __builtin_amdgcn_s_setprio(0); } while (0)
#define G8_WAIT_V(n) asm volatile("s_waitcnt vmcnt(" #n ")" ::: "memory")
#define G8_WAIT_L(n) asm volatile("s_waitcnt lgkmcnt(" #n ")" ::: "memory")
#define G8_BAR __builtin_amdgcn_s_barrier()
#define G8_SCHED __builtin_amdgcn_sched_barrier(0)
  Unit cur, nxt; int ui = 0;
  if (!S.next(0, cur)) return;
  f32x4 acc[2][2][4][2];
#pragma unroll
  for (int a = 0; a < 2; ++a)
#pragma unroll
    for (int b = 0; b < 2; ++b)
#pragma unroll
      for (int m = 0; m < 4; ++m)
#pragma unroll
        for (int n = 0; n < 2; ++n) acc[a][b][m][n] = (f32x4){0.f, 0.f, 0.f, 0.f};
  bf16x8 At[4][2], B0[2][2], B1[2][2];
  unsigned cv0[2] = {0u, 0u}, cv1[2] = {0u, 0u}, nv0[2] = {0u, 0u}, nv1[2] = {0u, 0u};
  const unsigned char* cA = Abase; const unsigned char* nA = Abase;
  if (GATHER) E.a_off(cur, sR, sC, cv0, cv1); else cA = Abase + (size_t)cur.pm * tstepA;
  const unsigned char* cB = Bbase + E.b_off(cur);
  G8_STAGE_B(G8_SB(0, 0), cB); G8_STAGE_A(G8_SA(0, 0), 0, false, 0); G8_STAGE_B(G8_SB(0, 1), cB + hstep); G8_STAGE_A(G8_SA(0, 1), 1, false, 0);
  if (wr == 1) G8_BAR;
  G8_WAIT_V(4); G8_BAR;
  G8_STAGE_B(G8_SB(1, 0), cB + kstep); G8_STAGE_A(G8_SA(1, 0), 0, false, kstep); G8_STAGE_B(G8_SB(1, 1), cB + hstep + kstep);
  G8_WAIT_V(6); G8_BAR;
  for (;;) {
    const bool has_next = S.next(ui + 1, nxt);
    if (GATHER) { if (has_next) E.a_off(nxt, sR, sC, nv0, nv1); else { nv0[0] = cv0[0]; nv0[1] = cv0[1]; nv1[0] = cv1[0]; nv1[1] = cv1[1]; } }
    else nA = has_next ? Abase + (size_t)nxt.pm * tstepA : cA;
    const unsigned char* nB = has_next ? Bbase + E.b_off(nxt) : cB;
#pragma unroll 1
    for (int t = 0; t < nt; t += 2) {
      const bool last = (t == nt - 2);
      const size_t k1 = (size_t)(t + 1) * kstep;
      const size_t k2 = last ? 0 : (size_t)(t + 2) * kstep, k3 = k2 + kstep;
      const unsigned char* b2 = last ? nB : cB + (size_t)(t + 2) * kstep; const unsigned char* b3 = b2 + kstep;
      G8_LDB(B0, 0, 0); G8_SCHED; G8_LDA(At, 0, 0); G8_STAGE_A(G8_SA(1, 1), 1, false, k1);
      G8_WAIT_L(8); G8_BAR; G8_WAIT_L(0); G8_MMA(0, 0, At, B0); G8_BAR; G8_SCHED;
      G8_LDB(B1, 0, 1); G8_STAGE_B(G8_SB(0, 0), b2);
      G8_BAR; G8_WAIT_L(0); G8_MMA(0, 1, At, B1); G8_BAR;
      G8_LDA(At, 0, 1); G8_STAGE_A(G8_SA(0, 0), 0, last, k2);
      G8_BAR; G8_WAIT_L(0); G8_MMA(1, 0, At, B0); G8_BAR; G8_SCHED;
      G8_STAGE_B(G8_SB(0, 1), b2 + hstep);
      G8_WAIT_V(6); G8_BAR; G8_MMA(1, 1, At, B1); G8_BAR;
      G8_LDB(B0, 1, 0); G8_SCHED; G8_LDA(At, 1, 0); G8_STAGE_A(G8_SA(0, 1), 1, last, k2);
      G8_WAIT_L(8); G8_BAR; G8_WAIT_L(0); G8_MMA(0, 0, At, B0); G8_BAR; G8_SCHED;
      G8_LDB(B1, 1, 1); G8_STAGE_B(G8_SB(1, 0), b3);
      G8_BAR; G8_WAIT_L(0); G8_MMA(0, 1, At, B1); G8_BAR;
      G8_LDA(At, 1, 1); G8_STAGE_A(G8_SA(1, 0), 0, last, k3);
      G8_BAR; G8_WAIT_L(0); G8_MMA(1, 0, At, B0); G8_BAR; G8_SCHED;
      G8_STAGE_B(G8_SB(1, 1), b3 + hstep);
      G8_WAIT_V(6); G8_BAR; G8_MMA(1, 1, At, B1); G8_BAR;
    }
    E(acc, cur, wr, wc, fr, fq);
    if (!has_next) break;
#pragma unroll
    for (int a = 0; a < 2; ++a)
#pragma unroll
      for (int b = 0; b < 2; ++b)
#pragma unroll
        for (int m = 0; m < 4; ++m)
#pragma unroll
          for (int n = 0; n < 2; ++n) acc[a][b][m][n] = (f32x4){0.f, 0.f, 0.f, 0.f};
    cur = nxt; cB = nB; cA = nA; ++ui;
    if (GATHER) { cv0[0] = nv0[0]; cv0[1] = nv0[1]; cv1[0] = nv1[0]; cv1[1] = nv1[1]; }
  }
  G8_WAIT_V(0);
  if (wr == 0) G8_BAR;
  G8_BAR;
#undef G8_SA
#undef G8_SB
#undef G8_STAGE_A
#undef G8_STAGE_B
#undef G8_LDA
#undef G8_LDB
#undef G8_MMA
#undef G8_WAIT_V
#undef G8_WAIT_L
#undef G8_BAR
#undef G8_SCHED
}
DI void dense_a_off(int pm, int K, const int (&sR)[2], const int (&sC)[2], unsigned (&v0)[2], unsigned (&v1)[2]) {
#pragma unroll
  for (int i = 0; i < 2; ++i) { v0[i] = (unsigned)((pm * BM + sR[i]) * K + sC[i]) * 2u; v1[i] = v0[i] + (unsigned)(HALF * K * 2); }
}
}

DI int win8_row(int f) {
  if (f < 1024) {
    const int rel = f & 511, pn = (f >> 9) * 2 + (rel >> 8), hl = (rel >> 7) & 1, comp = (rel >> 6) & 1, i = rel & 63;
    const int bj = i >> 5, ip = i & 31, fq = ip >> 3, n = (ip >> 2) & 1, j = ip & 3;
    return pn * 256 + 128 * bj + 32 * (2 * hl + comp) + 16 * n + 4 * fq + j;
  }
  if (f < 1536 || f >= 2560) return f;
  const int rel = (f - 1536) & 511, pn = 6 + ((f - 1536) >> 9) * 2 + (rel >> 8), hl = (rel >> 5) & 7, ip = rel & 31;
  const int bj = hl >> 2, wc = hl & 3, fq = ip >> 3, n = (ip >> 2) & 1, j = ip & 3;
  return pn * 256 + 128 * bj + 32 * wc + 16 * n + 4 * fq + j;
}
struct EpiInproj {
  const Ptrs* Pp;
  DI void a_off(const g8::Unit& u, const int (&sR)[2], const int (&sC)[2], unsigned (&v0)[2], unsigned (&v1)[2]) const { g8::dense_a_off(u.pm, 1024, sR, sC, v0, v1); }
  DI size_t b_off(const g8::Unit& u) const { return (size_t)u.pn * 256 * 1024 * 2; }
  DI void operator()(const f32x4 (&acc)[2][2][4][2], const g8::Unit& u, int wr, int wc, int fr, int fq) const {
    const Ptrs& P = *Pp;
    const float* rstdx = (const float*)(P.ws + WS_RSTDX);
    asm volatile("" : "+v"(rstdx));
    const int pn = u.pn, row00 = u.pm * 256 + wr * 64, b = row00 >> 12;
    float rsr[8];
#pragma unroll
    for (int k = 0; k < 8; ++k) rsr[k] = rstdx[row00 + 128 * (k >> 2) + 16 * (k & 3) + fr];
    const float qsA = 0.125f * LOG2E, qsB = 0.17677669529663687f * LOG2E;
    if (pn < 4) {
      const int isk = pn >= 2, head = 2 * (pn & 1) + (wc >> 1), comp = wc & 1;
      const float* gg = ((const float*)(P.ws + WS_PAR)) + (isk ? PAR_GKA : PAR_GQA);
      asm volatile("" : "+v"(gg));
      const float4 g1a = *(const float4*)(gg + 8 * fq), g1b = *(const float4*)(gg + 8 * fq + 4), g2a = *(const float4*)(gg + 32 + 8 * fq), g2b = *(const float4*)(gg + 36 + 8 * fq);
      const float ga[8] = {g1a.x, g1a.y, g1a.z, g1a.w, g1b.x, g1b.y, g1b.z, g1b.w}, gb[8] = {g2a.x, g2a.y, g2a.z, g2a.w, g2b.x, g2b.y, g2b.z, g2b.w};
      u16* dstb = (u16*)(P.ws + (isk ? A_KA : A_QA)) + (size_t)(b * 4 + head) * 4096 * 128 + comp * 64 + 8 * fq;
      const float2* rope = (const float2*)(P.ws + WS_ROPE);
      struct Rp { f32x4 c0, c1, c2, c3; };
      auto ldrope = [&](int k) { const int s = (row00 + 128 * (k >> 2) + 16 * (k & 3) + fr) & 4095; const f32x4* rp = (const f32x4*)(rope + (size_t)s * 32 + 8 * fq);
        Rp r; r.c0 = rp[0]; r.c1 = rp[1]; r.c2 = rp[2]; r.c3 = rp[3]; return r; };
      Rp cur = ldrope(0);
#pragma unroll
      for (int k = 0; k < 8; ++k) {
        const int ai = k >> 2, m = k & 3;
        Rp nxt = cur;
        if (k < 7) nxt = ldrope(k + 1);
        const int row = row00 + 128 * ai + 16 * m + fr, s = row & 4095;
        const float rs = rsr[k];
        float x1[8], x2[8]; float ss = 0.f;
#pragma unroll
        for (int n = 0; n < 2; ++n)
#pragma unroll
          for (int j = 0; j < 4; ++j) { x1[4 * n + j] = acc[ai][0][m][n][j] * rs; x2[4 * n + j] = acc[ai][1][m][n][j] * rs; ss += x1[4 * n + j] * x1[4 * n + j] + x2[4 * n + j] * x2[4 * n + j]; }
        ss += __shfl_xor(ss, 16); ss += __shfl_xor(ss, 32);
        const float rn = rsqrtf(ss * (1.0f / 64.0f) + EPS) * (isk ? 1.0f : qsA);
        const float cs[8] = {cur.c0[0], cur.c0[2], cur.c1[0], cur.c1[2], cur.c2[0], cur.c2[2], cur.c3[0], cur.c3[2]}, sn[8] = {cur.c0[1], cur.c0[3], cur.c1[1], cur.c1[3], cur.c2[1], cur.c2[3], cur.c3[1], cur.c3[3]};
        f32x4 o1a, o1b, o2a, o2b;
#pragma unroll
        for (int e = 0; e < 8; ++e) {
          const float y = x1[e] * rn * ga[e], z = x2[e] * rn * gb[e];
          const float p1 = y * cs[e] - z * sn[e], p2 = z * cs[e] + y * sn[e];
          if (e < 4) { o1a[e] = p1; o2a[e] = p2; } else { o1b[e - 4] = p1; o2b[e - 4] = p2; }
        }
        u16* d = dstb + (size_t)s * 128;
        *(uint4*)d = pk8(o1a, o1b);
        *(uint4*)(d + 32) = pk8(o2a, o2b);
        asm volatile("" ::: "memory");
        cur = nxt;
      }
    } else if (pn >= 6 && pn < 10) {
      const int isk = pn >= 8;
      const float* gg = ((const float*)(P.ws + WS_PAR)) + (isk ? PAR_GKB : PAR_GQB);
      asm volatile("" : "+v"(gg));
      const float4 g1a = *(const float4*)(gg + 8 * fq), g1b = *(const float4*)(gg + 8 * fq + 4);
      const float ga[8] = {g1a.x, g1a.y, g1a.z, g1a.w, g1b.x, g1b.y, g1b.z, g1b.w};
#pragma unroll
      for (int bj = 0; bj < 2; ++bj) {
        const int hd = 8 * (pn & 1) + 4 * bj + wc;
        u16* dstb = (u16*)(P.ws + (isk ? A_KB : A_QB)) + (size_t)(b * 16 + hd) * 4096 * 32 + 8 * fq;
#pragma unroll
        for (int ai = 0; ai < 2; ++ai)
#pragma unroll
          for (int m = 0; m < 4; ++m) {
            const int row = row00 + 128 * ai + 16 * m + fr, s = row & 4095;
            const float rs = rsr[4 * ai + m];
            float x[8]; float ss = 0.f;
#pragma unroll
            for (int n = 0; n < 2; ++n)
#pragma unroll
              for (int j = 0; j < 4; ++j) { x[4 * n + j] = acc[ai][bj][m][n][j] * rs; ss += x[4 * n + j] * x[4 * n + j]; }
            ss += __shfl_xor(ss, 16); ss += __shfl_xor(ss, 32);
            const float rn = rsqrtf(ss * (1.0f / 32.0f) + EPS) * (isk ? 1.0f : qsB);
            f32x4 oa, ob;
#pragma unroll
            for (int e = 0; e < 4; ++e) { oa[e] = x[e] * rn * ga[e]; ob[e] = x[4 + e] * rn * ga[4 + e]; }
            *(uint4*)(dstb + (size_t)s * 32) = pk8(oa, ob);
          }
      }
    } else {
      const int isA = pn < 6;
#pragma unroll
      for (int ai = 0; ai < 2; ++ai)
#pragma unroll
        for (int m = 0; m < 4; ++m) {
          const int row0 = row00 + 128 * ai + 16 * m + 4 * fq, s0 = row0 & 4095;
          const float4 rs = *(const float4*)(rstdx + row0);
          const int sp = isA ? permpos(s0) : s0;
#pragma unroll
          for (int bj = 0; bj < 2; ++bj)
#pragma unroll
            for (int n = 0; n < 2; ++n) {
              const int c = 128 * bj + 32 * wc + 16 * n + fr;
              u16* dst;
              if (isA) dst = (u16*)(P.ws + A_VAT) + ((size_t)(b * 4 + 2 * (pn - 4) + (c >> 7)) * 128 + (c & 127)) * 4096;
              else dst = (u16*)(P.ws + A_VBT) + ((size_t)(b * 16 + 8 * (pn - 10) + (c >> 5)) * 32 + (c & 31)) * 4096;
              const f32x4 v = acc[ai][bj][m][n];
              *(uint2*)(dst + sp) = make_uint2(pk2(v[0] * rs.x, v[1] * rs.y), pk2(v[2] * rs.z, v[3] * rs.w));
            }
        }
    }
  }
};
DI void ph1_inproj8(const Ptrs& P, ldsp lds, int bid, int G) {
  EpiInproj E; E.Pp = &P;
  {
    g8::GridOrder S; S.init(64, 8, G, bid, 0x98763210u);
    g8::gemm_phase<EpiInproj, g8::GridOrder, false, false>(lds, (const unsigned char*)(P.ws + A_XB), (const unsigned char*)(P.ws + WS_WIN), 1024, S, E);
  }
  {
    g8::GridOrder S; S.init(64, 4, G, bid, 0xBA54u);
    g8::gemm_phase<EpiInproj, g8::GridOrder, true, false>(lds, (const unsigned char*)(P.ws + A_XB), (const unsigned char*)(P.ws + WS_WIN), 1024, S, E);
  }
}

DI int p32(int ip) { return 16 * ((ip >> 2) & 1) + 4 * (ip >> 3) + (ip & 3); }
DI int perm256(int f) { return (f & ~31) | p32(f & 31); }
DI int w13_row_w1(int f) { return ((f >> 7) << 8) | (f & 96) | p32(f & 31); }
DI int w13_row_w3(int f) { return (((f >> 7) << 8) | (f & 96) | p32(f & 31)) + 128; }

template <bool PLE>
struct EpiOut {
  const Ptrs* Pp;
  DI void a_off(const g8::Unit&, const int (&)[2], const int (&)[2], unsigned (&)[2], unsigned (&)[2]) const {}
  DI size_t b_off(const g8::Unit& u) const { return (size_t)u.pn * 256 * (PLE ? 256 : 1024) * 2; }
  struct Ld { float4 a0, a1, b0, b1; };
  DI void operator()(const f32x4 (&acc)[2][2][4][2], const g8::Unit& u, int wr, int wc, int fr, int fq) const {
    const Ptrs& P = *Pp;
    float* ssqp = (float*)(P.ws + (PLE ? WS_SSQEP : WS_SSQ1P));
    const int row0 = u.pm * 256 + 64 * wr + fr, col0 = u.pn * 256 + 32 * wc + 8 * fq;
    auto load = [&](int gidx) { const int ai = gidx >> 2, m = gidx & 3; const size_t go = (size_t)(row0 + 128 * ai + 16 * m) * 1024 + col0;
      Ld l; if (!PLE) { const u16* xbp = (const u16*)(P.ws + A_XB) + go; const uint4 ua = *(const uint4*)xbp, ub = *(const uint4*)(xbp + 128);
        l.a0 = make_float4(__uint_as_float(ua.x << 16), __uint_as_float(ua.x & 0xffff0000u), __uint_as_float(ua.y << 16), __uint_as_float(ua.y & 0xffff0000u));
        l.a1 = make_float4(__uint_as_float(ua.z << 16), __uint_as_float(ua.z & 0xffff0000u), __uint_as_float(ua.w << 16), __uint_as_float(ua.w & 0xffff0000u));
        l.b0 = make_float4(__uint_as_float(ub.x << 16), __uint_as_float(ub.x & 0xffff0000u), __uint_as_float(ub.y << 16), __uint_as_float(ub.y & 0xffff0000u));
        l.b1 = make_float4(__uint_as_float(ub.z << 16), __uint_as_float(ub.z & 0xffff0000u), __uint_as_float(ub.w << 16), __uint_as_float(ub.w & 0xffff0000u)); }
      else { l.a0 = l.a1 = l.b0 = l.b1 = make_float4(0.f, 0.f, 0.f, 0.f); } return l; };
    Ld cur = load(0);
#pragma unroll
    for (int gidx = 0; gidx < 8; ++gidx) {
      const int ai = gidx >> 2, m = gidx & 3;
      Ld nxt = cur;
      if (gidx < 7) nxt = load(gidx + 1);
      const int row = row0 + 128 * ai + 16 * m;
      float ss = 0.f;
#pragma unroll
      for (int bj = 0; bj < 2; ++bj) {
        const size_t go = (size_t)row * 1024 + col0 + 128 * bj;
        f32x4 a = acc[ai][bj][m][0], c4 = acc[ai][bj][m][1];
        if (!PLE) {
          const float4 xa = bj ? cur.b0 : cur.a0, xb4 = bj ? cur.b1 : cur.a1;
          a[0] += xa.x; a[1] += xa.y; a[2] += xa.z; a[3] += xa.w; c4[0] += xb4.x; c4[1] += xb4.y; c4[2] += xb4.z; c4[3] += xb4.w;
          *(uint4*)((u16*)(P.ws + A_H1B) + go) = pk8(a, c4);
        } else {
          *(uint4*)((u16*)(P.ws + A_EBF) + go) = pk8(a, c4);
        }
        ss += a[0] * a[0] + a[1] * a[1] + a[2] * a[2] + a[3] * a[3] + c4[0] * c4[0] + c4[1] * c4[1] + c4[2] * c4[2] + c4[3] * c4[3];
      }
      ss += __shfl_xor(ss, 16); ss += __shfl_xor(ss, 32);
      if (fq == 0) ssqp[(size_t)row * 16 + u.pn * 4 + wc] = ss;
      asm volatile("" ::: "memory");
      cur = nxt;
    }
  }
};
DI void ph3_outproj8(const Ptrs& P, ldsp lds, int bid, int G) {
  { EpiOut<false> E; E.Pp = &P; g8::GridOrder S; S.init(64, 4, G, bid);
    g8::gemm_phase<EpiOut<false>, g8::GridOrder, false, false>(lds, (const unsigned char*)(P.ws + A_AO), (const unsigned char*)(P.ws + WS_WOUT), 1024, S, E); }
}

DI int moe_plan8(const Ptrs& P, ldsp lds) {
  LAS int* smb = (LAS int*)(lds + g8::LDS_EXTRA8);
  __syncthreads();
  if (threadIdx.x == 0) {
    const int* cnt = (const int*)(P.ws + WS_CNT);
    int a = 0;
    for (int e = 0; e < 32; ++e) { smb[e] = a; a += (cnt[e * CNT_STRIDE] + 255) >> 8; smb[64 + e] = cnt[e * CNT_STRIDE]; }
    smb[32] = a;
  }
  __syncthreads();
  return smb[32];
}
template <class T> DI T* uni_ptr(T* p) {
  const unsigned long long v = (unsigned long long)p;
  const unsigned lo = __builtin_amdgcn_readfirstlane((unsigned)v), hi = __builtin_amdgcn_readfirstlane((unsigned)(v >> 32));
  return (T*)(((unsigned long long)hi << 32) | lo);
}
struct MoeOrder {
  int MB, G, c; const LAS int* smb;
  DI bool next(int i, g8::Unit& u) const {
    const int L = i * G + c;
    if (L >= ((MB + 7) >> 3) * 32) return false;
    const int gmb = (L >> 5) * 8 + (L & 7);
    u.pn = (L >> 3) & 3;
    if (gmb >= MB) return false;
    int e = 0; while (gmb >= smb[e + 1]) ++e;
    e = __builtin_amdgcn_readfirstlane(e);
    u.pm = gmb; u.e = e; u.ce = __builtin_amdgcn_readfirstlane(smb[64 + e] - (gmb - smb[e]) * 256);
    return true;
  }
};
struct EpiUp {
  const Ptrs* Pp; const LAS int* smb;
  DI void a_off(const g8::Unit& u, const int (&sR)[2], const int (&sC)[2], unsigned (&v0)[2], unsigned (&v1)[2]) const {
    const int* tokl = uni_ptr((const int*)(Pp->ws + WS_TOKL) + __builtin_amdgcn_readfirstlane(u.e * 16384 + (u.pm - smb[u.e]) * 256));
#pragma unroll
    for (int i = 0; i < 2; ++i) {
      const int r0 = sR[i], r1 = 128 + sR[i];
      const int t0 = (r0 < u.ce) ? (tokl[r0] >> 1) : 0, t1 = (r1 < u.ce) ? (tokl[r1] >> 1) : 0;
      v0[i] = (unsigned)(t0 * 1024 + sC[i]) * 2u; v1[i] = (unsigned)(t1 * 1024 + sC[i]) * 2u;
    }
  }
  DI size_t b_off(const g8::Unit& u) const { return ((size_t)u.e * 1024 + u.pn * 256) * 1024 * 2; }
  DI void operator()(const f32x4 (&acc)[2][2][4][2], const g8::Unit& u, int wr, int wc, int fr, int fq) const {
    const Ptrs& P = *Pp;
    if (u.ce <= 0) return;
    const float* rsl = uni_ptr((const float*)(P.ws + A_RSL) + __builtin_amdgcn_readfirstlane(u.e * 16384 + (u.pm - smb[u.e]) * 256));
    u16* hid = (u16*)(P.ws + A_HID);
    float rsv[8];
#pragma unroll
    for (int k = 0; k < 8; ++k) { const int rl = 128 * (k >> 2) + 64 * wr + 16 * (k & 3) + fr; rsv[k] = (rl < u.ce) ? rsl[rl] : 0.0f; }
#pragma unroll
    for (int ai = 0; ai < 2; ++ai)
#pragma unroll
      for (int m = 0; m < 4; ++m) {
        const int rl = 128 * ai + 64 * wr + 16 * m + fr;
        const float rs = rsv[4 * ai + m];
        f32x4 h0, h1;
#pragma unroll
        for (int j = 0; j < 4; ++j) {
          const float a = acc[ai][0][m][0][j] * rs, b = acc[ai][0][m][1][j] * rs;
          h0[j] = a * __builtin_amdgcn_rcpf(1.0f + __expf(-a)) * (acc[ai][1][m][0][j] * rs); h1[j] = b * __builtin_amdgcn_rcpf(1.0f + __expf(-b)) * (acc[ai][1][m][1][j] * rs);
        }
        *(uint4*)(hid + (size_t)(u.pm * 256 + rl) * 512 + u.pn * 128 + 32 * wc + 8 * fq) = pk8(h0, h1);
      }
  }
};
DI void ph5_up8(const Ptrs& P, ldsp lds, int bid, int G) {
  const int MB = moe_plan8(P, lds);
  const LAS int* smb = (const LAS int*)(lds + g8::LDS_EXTRA8);
  MoeOrder S; S.MB = MB; S.G = G; S.c = bid; S.smb = smb;
  EpiUp E; E.Pp = &P; E.smb = smb;
  g8::gemm_phase<EpiUp, MoeOrder, false, true>(lds, (const unsigned char*)(P.ws + A_H1B), (const unsigned char*)(P.ws + WS_W13), 1024, S, E);
  {
    const int NU = ((MB + 7) >> 3) * 32, rem = NU % G, nl = rem ? G - rem : G, li = rem ? bid - rem : bid;
    if (li >= 0) {
      const int lane = threadIdx.x & 63, wave = threadIdx.x >> 6, nwv = blockDim.x >> 6;
      LAS float* scr = (LAS float*)(lds + wave * 16640);
      for (int r = li * nwv + wave; r < 4096 + 256; r += nl * nwv) late_weight_item(r, scr, lane);
    }
  }
}
struct EpiDown {
  const Ptrs* Pp; const LAS int* smb;
  DI void a_off(const g8::Unit&, const int (&)[2], const int (&)[2], unsigned (&)[2], unsigned (&)[2]) const {}
  DI size_t b_off(const g8::Unit& u) const { return ((size_t)u.e * 1024 + u.pn * 256) * 512 * 2; }
  DI void operator()(const f32x4 (&acc)[2][2][4][2], const g8::Unit& u, int wr, int wc, int fr, int fq) const {
    const Ptrs& P = *Pp;
    if (u.ce <= 0) return;
    const int base = __builtin_amdgcn_readfirstlane(u.e * 16384 + (u.pm - smb[u.e]) * 256);
    const int* tokl = (const int*)(P.ws + WS_TOKL) + base; const float* wl = (const float*)(P.ws + WS_WL) + base;
    int tkv[8]; float wv[8];
#pragma unroll
    for (int k = 0; k < 8; ++k) { const int rl = 128 * (k >> 2) + 64 * wr + 16 * (k & 3) + fr; const bool v = rl < u.ce; tkv[k] = v ? tokl[rl] : -1; wv[k] = v ? wl[rl] : 0.0f; }
#pragma unroll
    for (int ai = 0; ai < 2; ++ai)
#pragma unroll
      for (int m = 0; m < 4; ++m) {
        const int tk = tkv[4 * ai + m];
        if (tk >= 0) {
          const float w = wv[4 * ai + m];
          u16* y = (u16*)(P.ws + ((tk & 1) ? A_Y1 : A_Y0)) + (size_t)(tk >> 1) * 1024 + u.pn * 256 + 32 * wc + 8 * fq;
#pragma unroll
          for (int bj = 0; bj < 2; ++bj) {
            f32x4 a = acc[ai][bj][m][0], c4 = acc[ai][bj][m][1];
#pragma unroll
            for (int j = 0; j < 4; ++j) { a[j] *= w; c4[j] *= w; }
            *(uint4*)(y + 128 * bj) = pk8(a, c4);
          }
        }
      }
  }
};
DI void ph6_down8(const Ptrs& P, ldsp lds, int bid, int G) {
  const int MB = moe_plan8(P, lds);
  const LAS int* smb = (const LAS int*)(lds + g8::LDS_EXTRA8);
  MoeOrder S; S.MB = MB; S.G = G; S.c = bid; S.smb = smb;
  EpiDown E; E.Pp = &P; E.smb = smb;
  g8::gemm_phase<EpiDown, MoeOrder, false, false>(lds, (const unsigned char*)(P.ws + A_HID), (const unsigned char*)(P.ws + WS_W2), 512, S, E);
  {
    const int NU = ((MB + 7) >> 3) * 32, rem = NU % G, nl = rem ? G - rem : G, li = rem ? bid - rem : bid;
    EpiOut<true> E2; E2.Pp = &P; g8::GridOrder S2; S2.init(64, 4, nl, li < 0 ? 0 : li);
    if (li < 0) S2.nwg = 0;
    g8::gemm_phase<EpiOut<true>, g8::GridOrder, false, false>(lds, (const unsigned char*)(P.ws + A_PB), (const unsigned char*)(P.ws + WS_WPLE), 256, S2, E2);
  }
}

struct EpiFinal {
  const Ptrs* Pp;
  DI void a_off(const g8::Unit&, const int (&)[2], const int (&)[2], unsigned (&)[2], unsigned (&)[2]) const {}
  DI size_t b_off(const g8::Unit& u) const { return (size_t)u.pn * 256 * 1024 * 2; }
  struct Ld { u32x4 hh; u32x4 ee; };
  DI void operator()(const f32x4 (&acc)[2][2][4][2], const g8::Unit& u, int wr, int wc, int fr, int fq) const {
    const Ptrs& P = *Pp;
    const float* rstd2 = (const float*)(P.ws + WS_RSTD2); const float* rstdE = (const float*)(P.ws + WS_RSTDE);
    const int row0 = u.pm * 256 + 64 * wr + fr, col0 = u.pn * 256 + 32 * wc + 8 * fq;
    auto load = [&](int gidx) { const int bj = gidx >> 3, ai = (gidx >> 2) & 1, m = gidx & 3; const int row = row0 + 128 * ai + 16 * m; const size_t go = (size_t)row * 1024 + col0 + 128 * bj;
      Ld l;
      l.hh = *(const u32x4*)((const u16*)(P.ws + A_H2B) + go); l.ee = *(const u32x4*)((const u16*)(P.ws + A_EBF) + go); return l; };
    Ld cur = load(0);
    float gv[8];
#pragma unroll
    for (int gidx = 0; gidx < 16; ++gidx) {
      const int bj = gidx >> 3, ai = (gidx >> 2) & 1, m = gidx & 3;
      if ((gidx & 7) == 0) { const float4 ga = *(const float4*)(P.g_ple + col0 + 128 * bj), gb = *(const float4*)(P.g_ple + col0 + 128 * bj + 4);
        gv[0] = ga.x; gv[1] = ga.y; gv[2] = ga.z; gv[3] = ga.w; gv[4] = gb.x; gv[5] = gb.y; gv[6] = gb.z; gv[7] = gb.w; }
      Ld nxt = cur;
      if (gidx < 15) nxt = load(gidx + 1);
      const size_t go = (size_t)(row0 + 128 * ai + 16 * m) * 1024 + col0 + 128 * bj;
      const int row = row0 + 128 * ai + 16 * m;
      const float rs2 = rstd2[row], rE = rstdE[row];
      float hv[8];
#pragma unroll
      for (int k = 0; k < 8; ++k) hv[k] = __uint_as_float((cur.hh[k >> 1] << ((k & 1) ? 0u : 16u)) & 0xffff0000u);
      const f32x4 a = acc[ai][bj][m][0], c4 = acc[ai][bj][m][1];
      const float av[8] = {a[0], a[1], a[2], a[3], c4[0], c4[1], c4[2], c4[3]};
      const unsigned eeu[4] = {cur.ee[0], cur.ee[1], cur.ee[2], cur.ee[3]};
#pragma unroll
      for (int k = 0; k < 8; ++k) {
        const unsigned sh = (k & 1) ? 0u : 16u;
        const float ev = __uint_as_float((eeu[k >> 1] << sh) & 0xffff0000u);
        const float sg = __builtin_amdgcn_rcpf(1.0f + __expf(-av[k] * rs2));
        hv[k] = hv[k] + ev * rE * gv[k] * sg;
      }
      float* wr_ = P.out + go;
      __builtin_nontemporal_store((f32x4){hv[0], hv[1], hv[2], hv[3]}, (f32x4*)wr_); __builtin_nontemporal_store((f32x4){hv[4], hv[5], hv[6], hv[7]}, (f32x4*)(wr_ + 4));
      asm volatile("" ::: "memory");
      cur = nxt;
    }
  }
};
DI void ph8_final8(const Ptrs& P, ldsp lds, int bid, int G) {
  EpiFinal E; E.Pp = &P; g8::GridOrder S; S.init(64, 4, G, bid);
  g8::gemm_phase<EpiFinal, g8::GridOrder, false, false>(lds, (const unsigned char*)(P.ws + A_H2B), (const unsigned char*)(P.ws + WS_WPLG), 1024, S, E);
}

template <bool SHIFT>
DI void da_item8(const Ptrs& P, ldsp lds, int item, float lam, float m2) {
  const int tid = threadIdx.x, lane = tid & 63, wave = __builtin_amdgcn_readfirstlane(tid >> 6), h = lane >> 5, i31 = lane & 31;
  const int xcd = item & 7, loc = item >> 3, bh = 2 * xcd + (loc >> 4), qblk = loc & 15;
  const u16* qA = (const u16*)(P.ws + A_QA) + (size_t)bh * 4096 * 128;
  const u16* kA = (const u16*)(P.ws + A_KA) + (size_t)bh * 4096 * 128;
  const u16* vAt = (const u16*)(P.ws + A_VAT) + (size_t)bh * 128 * 4096;
  const int q = qblk * 256 + 32 * wave + i31;
  bf16x8 qf[2][4];
#pragma unroll
  for (int c = 0; c < 2; ++c)
#pragma unroll
    for (int s = 0; s < 4; ++s) qf[c][s] = *(const bf16x8*)(qA + (size_t)q * 128 + c * 64 + 16 * s + 8 * h);
  auto stage = [&](int buf, int tile) {
    int ln = lane; asm volatile("" : "+v"(ln));
    ldsp lk = lds + buf * DA_STAGE;
    const u16* kt = kA + (size_t)tile * 64 * 128;
    const u16* vt = vAt + tile * 64;
#pragma unroll
    for (int qq = 0; qq < 2; ++qq) {
      const int jj = 2 * wave + qq;
      const int ra = key_of(0, jj), rb = key_of(1, jj);
      const int ku = ln >> 4, key = 32 * (ku >> 1) + ((ku & 1) ? rb : ra);
      glds16(kt + key * 128 + (ln & 15) * 8, lk + jj * 1040);
      const int vu = ln >> 3, d = 32 * (vu >> 1) + ((vu & 1) ? rb : ra);
      glds16(vt + d * 4096 + (ln & 7) * 8, lk + DA_VOFF + jj * 1040);
    }
  };
  const int rk = rank_of(i31), gr = grp_of(i31);
  const int kbase = rk * 1040 + gr * 256 + h * 16;
  const int vbase = DA_VOFF + rk * 1040 + gr * 128 + h * 16;
  f32x16 O1[4], O2[4];
#pragma unroll
  for (int dt = 0; dt < 4; ++dt)
#pragma unroll
    for (int e = 0; e < 16; ++e) { O1[dt][e] = 0.f; O2[dt][e] = 0.f; }
  float l1 = 0.f, l2 = 0.f;
  __syncthreads();
  stage(0, 0);
  stage(1, 1);
  asm volatile("s_waitcnt vmcnt(4)" ::: "memory");
  __builtin_amdgcn_s_barrier();
  int buf = 0;
  for (int tile = 0; tile < 64; ++tile) {
    if (tile + 2 < 64) stage(buf >= 1 ? buf - 1 : 2, tile + 2);
    ldsp lb = lds + buf * DA_STAGE;
#pragma unroll 1
    for (int kt2 = 0; kt2 < 2; ++kt2) {
      bf16x8 pf[2][2];
      ldsp lk = lb + kbase + kt2 * 512;
      ldsp lv = lb + vbase + kt2 * 64;
#pragma unroll
      for (int c = 0; c < 2; ++c) {
        f32x16 sa;
#pragma unroll
        for (int e = 0; e < 16; ++e) sa[e] = 0.f;
#pragma unroll
        for (int s = 0; s < 4; ++s) {
          const bf16x8 kf = *(LAS bf16x8*)(lk + c * 128 + s * 32);
          sa = __builtin_amdgcn_mfma_f32_32x32x16_bf16(kf, qf[c][s], sa, 0, 0, 0);
        }
        float ls = 0.f;
#pragma unroll
        for (int e = 0; e < 16; ++e) { sa[e] = __builtin_amdgcn_exp2f(SHIFT ? sa[e] - m2 : sa[e]); ls += sa[e]; }
        if (c == 0) l1 += ls; else l2 += ls;
        pf[c][0] = packp(sa, 0); pf[c][1] = packp(sa, 1);
      }
      __builtin_amdgcn_sched_barrier(0);
      bf16x8 va = *(LAS bf16x8*)(lv), vb = *(LAS bf16x8*)(lv + 256);
#pragma unroll
      for (int st = 0; st < 4; ++st) {
        const int s2 = st >> 1, dtp = st & 1;
        bf16x8 na = va, nb = vb;
        if (st < 3) { const int s2n = (st + 1) >> 1, dn = (st + 1) & 1; na = *(LAS bf16x8*)(lv + s2n * 32 + dn * 512); nb = *(LAS bf16x8*)(lv + s2n * 32 + dn * 512 + 256); }
        __builtin_amdgcn_sched_barrier(0);
        __builtin_amdgcn_s_setprio(1);
        O1[2 * dtp] = __builtin_amdgcn_mfma_f32_32x32x16_bf16(va, pf[0][s2], O1[2 * dtp], 0, 0, 0);
        O2[2 * dtp] = __builtin_amdgcn_mfma_f32_32x32x16_bf16(va, pf[1][s2], O2[2 * dtp], 0, 0, 0);
        O1[2 * dtp + 1] = __builtin_amdgcn_mfma_f32_32x32x16_bf16(vb, pf[0][s2], O1[2 * dtp + 1], 0, 0, 0);
        O2[2 * dtp + 1] = __builtin_amdgcn_mfma_f32_32x32x16_bf16(vb, pf[1][s2], O2[2 * dtp + 1], 0, 0, 0);
        __builtin_amdgcn_s_setprio(0);
        __builtin_amdgcn_sched_barrier(0);
        va = na; vb = nb;
      }
    }
    if (tile + 2 < 64) asm volatile("s_waitcnt vmcnt(4)" ::: "memory"); else asm volatile("s_waitcnt vmcnt(0)" ::: "memory");
    __builtin_amdgcn_s_barrier();
    buf = (buf == 2) ? 0 : buf + 1;
  }
  l1 += __shfl_xor(l1, 32); l2 += __shfl_xor(l2, 32);
  const float i1 = 1.0f / l1, i2 = lam / l2;
  float ss = 0.f;
#pragma unroll
  for (int dt = 0; dt < 4; ++dt)
#pragma unroll
    for (int e = 0; e < 16; ++e) { const float o = O1[dt][e] * i1 - O2[dt][e] * i2; O1[dt][e] = o; ss += o * o; }
  ss += __shfl_xor(ss, 32);
  const float rn = rsqrtf(ss * (1.0f / 128.0f) + EPS) * (1.0f - LAM_INIT);
  const int b = bh >> 2, hh = bh & 3;
  u16* dst = (u16*)(P.ws + A_AO) + ((size_t)b * 4096 + q) * 1024 + hh * 128;
#pragma unroll
  for (int dt = 0; dt < 4; ++dt)
#pragma unroll
    for (int g = 0; g < 4; ++g) {
      const int d0 = 32 * dt + 8 * g + 4 * h;
      const float4 gs = *(const float4*)(P.g_sub + d0);
      *(uint2*)(dst + d0) = make_uint2(pk2(O1[dt][4 * g] * rn * gs.x, O1[dt][4 * g + 1] * rn * gs.y), pk2(O1[dt][4 * g + 2] * rn * gs.z, O1[dt][4 * g + 3] * rn * gs.w));
    }
}

constexpr int NA8_VSTRIDE = 1936;
constexpr int NA8_TAB = 32 * NA8_VSTRIDE;
DI void na_block8(const Ptrs& P, ldsp lds, int item, float qkbound) {
  const int tid = threadIdx.x, lane = tid & 63, wave = tid >> 6;
  const int r0 = (item & 7) * 8, hd = (item >> 3) & 15, b = item >> 7;
  const int qi = lane & 15, g = lane >> 4;
  LAS float* EB = (LAS float*)(lds + NA8_TAB);
  LAS float* RW = EB + 960;
  const int R0 = min(max(r0 - 4, 0), 56), NR = min(15, 64 - R0);
  const u16* vB = (const u16*)(P.ws + A_VBT) + (size_t)(b * 16 + hd) * 32 * 4096;
  __syncthreads();
  {
    u32x4 vv[8];
#pragma unroll
    for (int k = 0; k < 8; ++k) {
      const int sg = (tid >> 3) + 64 * k, d = sg / NR, kr = sg - d * NR;
      vv[k] = *(const u32x4*)(vB + (size_t)min(d, 31) * 4096 + (R0 + min(kr, NR - 1)) * 64 + 8 * (tid & 7));
    }
    float mxa = 0.f;
    const float r0v = (tid < 465) ? P.rpb[hd * 465 + tid] : 0.f;
    mxa = fabsf(r0v);
#pragma unroll
    for (int o = 1; o < 64; o <<= 1) mxa = fmaxf(mxa, __shfl_xor(mxa, o));
    LAS float* red = (LAS float*)(lds + NA8_TAB + 7680);
    if (lane == 0) red[wave] = mxa;
#pragma unroll
    for (int k = 0; k < 8; ++k) {
      const int sg = (tid >> 3) + 64 * k, d = sg / NR, kr = sg - d * NR;
      if (sg < 32 * NR) *(LAS u32x4*)(lds + d * NA8_VSTRIDE + kr * 128 + 16 * (tid & 7)) = vv[k];
    }
    __syncthreads();
    const float m2 = (qkbound + fmaxf(fmaxf(fmaxf(red[0], red[1]), fmaxf(red[2], red[3])), fmaxf(fmaxf(red[4], red[5]), fmaxf(red[6], red[7])))) * LOG2E;
    for (int e = tid; e < 960; e += 512) {
      const int br = e >> 6, co = (e & 63) - 16;
      const float v = (co >= 0 && co <= 30) ? P.rpb[hd * 465 + br * 31 + co] * LOG2E - m2 : -1e30f;
      RW[e] = v;
      EB[e] = (co >= 7 && co <= 22) ? v : -1e30f;
    }
    __syncthreads();
  }
  const int r = r0 + wave;
  const int rs = min(max(r - 4, 0), 56), rb0 = rs - r + 7;
  const u16* qB = (const u16*)(P.ws + A_QB) + (size_t)(b * 16 + hd) * 4096 * 32;
  const u16* kBp = (const u16*)(P.ws + A_KB) + (size_t)(b * 16 + hd) * 4096 * 32;
  bf16x8 kf[16], qf;
  auto issue_kq = [&](int jq) {
    const int kb = min(min(max(16 * jq - 8, 0), 48), 32);
    const u16* kp = kBp + (size_t)(rs * 64 + kb + qi) * 32 + 8 * g;
    qf = *(const bf16x8*)(qB + (size_t)(r * 64 + 16 * jq + qi) * 32 + 8 * g);
#pragma unroll
    for (int ri = 0; ri < 8; ++ri)
#pragma unroll
      for (int t = 0; t < 2; ++t) kf[2 * ri + t] = *(const bf16x8*)(kp + (ri * 64 + 16 * t) * 32);
  };
  issue_kq(0);
#pragma unroll 1
  for (int jq = 0; jq < 4; ++jq) {
    const int kb = min(min(max(16 * jq - 8, 0), 48), 32);
    const LAS float* tb[2];
    {
      const int cobase = (jq == 0) ? 15 : ((jq == 3) ? -1 : 7);
#pragma unroll
      for (int t = 0; t < 2; ++t) {
        const int off = rb0 * 64 + cobase + 16 * t + 4 * g - qi + 16;
        const LAS float* pe = EB + off; const LAS float* pr = RW + off; const LAS float* pn = RW + 48;
        const LAS float* sel = pe;
        if (jq == 0 && qi < 8) sel = (t == 0) ? pr : pn;
        if (jq == 3 && qi > 8) sel = (t == 1) ? pr : pn;
        tb[t] = sel;
      }
    }
    f32x4 sa[8][2];
#pragma unroll
    for (int ri = 0; ri < 8; ++ri)
#pragma unroll
      for (int t = 0; t < 2; ++t) {
        const LAS float* tp = tb[t] + ri * 64;
        const f32x4 ci = {tp[0], tp[1], tp[2], tp[3]};
        sa[ri][t] = __builtin_amdgcn_mfma_f32_16x16x32_bf16(kf[2 * ri + t], qf, ci, 0, 0, 0);
      }
    __builtin_amdgcn_sched_barrier(0);
    if (jq + 1 < 4) issue_kq(jq + 1);
    __builtin_amdgcn_sched_barrier(0);
    float l = 0.f;
    f32x4 oa[2] = {{0.f, 0.f, 0.f, 0.f}, {0.f, 0.f, 0.f, 0.f}};
    ldsp vl = lds + qi * NA8_VSTRIDE + (rs - R0) * 128 + (kb + 4 * g) * 2;
#pragma unroll
    for (int ri = 0; ri < 8; ++ri) {
      float p[8];
#pragma unroll
      for (int t = 0; t < 2; ++t)
#pragma unroll
        for (int i = 0; i < 4; ++i) { const float e = __builtin_amdgcn_exp2f(sa[ri][t][i]); p[4 * t + i] = e; l += e; }
      u32x4 pp; pp[0] = pk2(p[0], p[1]); pp[1] = pk2(p[2], p[3]); pp[2] = pk2(p[4], p[5]); pp[3] = pk2(p[6], p[7]);
      const bf16x8 pfr = __builtin_bit_cast(bf16x8, pp);
#pragma unroll
      for (int dtl = 0; dtl < 2; ++dtl) {
        const s16x4 lo = *(LAS s16x4*)(vl + dtl * 16 * NA8_VSTRIDE + ri * 128), hi = *(LAS s16x4*)(vl + dtl * 16 * NA8_VSTRIDE + ri * 128 + 32);
        const bf16x8 vf = __builtin_shufflevector(lo, hi, 0, 1, 2, 3, 4, 5, 6, 7);
        oa[dtl] = __builtin_amdgcn_mfma_f32_16x16x32_bf16(vf, pfr, oa[dtl], 0, 0, 0);
      }
    }
    l += __shfl_xor(l, 16); l += __shfl_xor(l, 32);
    const float il = 1.0f / l;
    u16* dst = (u16*)(P.ws + A_AO) + ((size_t)b * 4096 + r * 64 + 16 * jq + qi) * 1024 + 512 + hd * 32;
#pragma unroll
    for (int dtl = 0; dtl < 2; ++dtl)
      *(uint2*)(dst + 16 * dtl + 4 * g) = make_uint2(pk2(oa[dtl][0] * il, oa[dtl][1] * il), pk2(oa[dtl][2] * il, oa[dtl][3] * il));
  }
}

DI void ph2_attn8(const Ptrs& P, ldsp lds, int bid, int G) {
  const float* sc = (const float*)(P.ws + WS_SCAL);
  const float lam = sc[0], m2 = sc[1], qkb = sc[2];
  if (m2 < 64.0f) { for (int it = bid; it < 256; it += G) da_item8<false>(P, lds, it, lam, m2); }
  else { for (int it = bid; it < 256; it += G) da_item8<true>(P, lds, it, lam, m2); }
  for (int it = bid; it < 512; it += G) na_block8(P, lds, it, qkb);
}

__global__ void __launch_bounds__(512, 2) mega8(Ptrs Pk, int ph_lo, int ph_hi) {
  extern __shared__ __attribute__((aligned(16))) unsigned char smem[];
  ldsp lds = (ldsp)smem;
  const int bid = blockIdx.x, G = gridDim.x;
  volatile LAS unsigned* st = (volatile LAS unsigned*)(lds + g8::LDS_EXTRA8 + 4080);
  XcdBarrier xb; xb.bar = (unsigned*)(Pk.ws + WS_CTL); xb.x = 0; xb.st = st;
  if (ph_hi - ph_lo > 1) {
    if (threadIdx.x == 0) { st[0] = 0u; st[1] = 0u; }
    __syncthreads();
    xb = xcd_barrier_post((unsigned*)(Pk.ws + WS_CTL), st);
  }
#define RUN_PHASE8(k, call) if (ph_lo <= k && k < ph_hi) { { const Ptrs P = load_args(); call; } if (k + 1 < ph_hi) xcd_barrier(xb); }
  RUN_PHASE8(0, ph0_prep(P, lds, bid, G))
  RUN_PHASE8(1, ph1_inproj8(P, lds, bid, G))
  RUN_PHASE8(2, ph2_attn8(P, lds, bid, G))
  RUN_PHASE8(3, ph3_outproj8(P, lds, bid, G))
  RUN_PHASE8(4, ph4_router(P, lds, bid, G))
  RUN_PHASE8(5, ph5_up8(P, lds, bid, G))
  RUN_PHASE8(6, ph6_down8(P, lds, bid, G))
  RUN_PHASE8(7, ph7_combine(P, lds, bid, G))
  RUN_PHASE8(8, ph8_final8(P, lds, bid, G))
}
extern "C" void kernel_launch(void* const* d_in, const int* in_sizes, int n_in, void* d_out, int out_size, void* d_ws, size_t ws_size,
                              hipStream_t stream) {
  static int grid = 0;
  if (grid == 0) {
    if (n_in != 25 || ws_size < WS_END || out_size != T * DM) { fprintf(stderr, "kernel_launch: unexpected n_in %d / out %d / ws_size %zu (need %zu)\\n", n_in, out_size, ws_size, (size_t)WS_END); grid = -1; return; }
    int dev = 0, cus = 0, per_cu = 0;
    (void)hipGetDevice(&dev);
    (void)hipDeviceGetAttribute(&cus, hipDeviceAttributeMultiprocessorCount, dev);
    (void)hipFuncSetAttribute((const void*)mega8, hipFuncAttributeMaxDynamicSharedMemorySize, g8::LDS_BYTES8);
    (void)hipOccupancyMaxActiveBlocksPerMultiprocessor(&per_cu, (const void*)mega8, 512, g8::LDS_BYTES8);
    if (per_cu < 1) { fprintf(stderr, "kernel_launch: occupancy query returned %d\\n", per_cu); grid = -1; return; }
    grid = cus;
  }
  if (grid < 0) return;
  Ptrs P{};
  const float** pp = (const float**)&P;
  for (int i = 0; i < 25; ++i) pp[i] = (const float*)d_in[i];
  P.out = (float*)d_out; P.ws = (unsigned char*)d_ws;
  (void)hipMemsetAsync((unsigned char*)d_ws + WS_CTL, 0, XCD_BAR_WORDS * 4, stream);
  mega8<<<grid, 512, g8::LDS_BYTES8, stream>>>(P, 0, 9);
}
```

```cpp
#define ONE_LAUNCH 2
#define NEW_MASK 0x1ff
#include <hip/hip_runtime.h>
#include <cstdio>
#include <cstdint>

typedef unsigned short u16;
#define DI __device__ __forceinline__

constexpr int T = 16384, S = 4096, DM = 1024, NB = 4;
constexpr int DIN = 3072, DPLE = 256;
constexpr int HA = 4, HB = 16;
constexpr int NE = 32, DE = 512;
constexpr float EPS = 1e-6f;
constexpr float LOG2E = 1.4426950408889634f;
constexpr float LAM_INIT = 0.2f;

constexpr size_t MiB = 1ull << 20;
constexpr size_t WS_WIN = 0, WS_WOUT = 6 * MiB, WS_W13 = 8 * MiB, WS_W2 = 72 * MiB, WS_WPLG = 104 * MiB,
                 WS_WPLE = 106 * MiB, WS_WR = 106 * MiB + 512 * 1024, WS_ROPE = 107 * MiB;
constexpr size_t WS_SMALL = 108 * MiB;
constexpr size_t WS_RSTDX = WS_SMALL;
constexpr size_t WS_SSQ1P = 250 * MiB;
constexpr size_t WS_SSQEP = 251 * MiB;
constexpr int SSQ_PARTS = 16;
constexpr size_t WS_RSTD1 = WS_RSTDX + 65536;
constexpr size_t WS_RSTD2 = WS_RSTD1 + 65536;
constexpr size_t WS_SCAL  = WS_RSTD2 + 65536;
constexpr size_t WS_CNT   = WS_SCAL + 256;
constexpr int CNT_STRIDE = 64;
constexpr size_t WS_PADST = WS_CNT + 8192;
constexpr size_t WS_CTL   = WS_PADST + 256;
constexpr size_t WS_RSTDE = WS_CTL + 16384;
constexpr size_t WS_PAR   = WS_SMALL + 1 * MiB;
constexpr int PAR_GQA = 0, PAR_GKA = 64, PAR_GSUB = 128, PAR_GQB = 256, PAR_GKB = 288, PAR_GPLE = 320, PAR_RPB = 1344, PAR_TOTAL = 1344 + 7440;
constexpr size_t WS_TOKL  = WS_SMALL + 2 * MiB;
constexpr size_t WS_WL    = WS_SMALL + 4 * MiB;
constexpr size_t WS_ACT   = 114 * MiB;
constexpr size_t A_XB = WS_ACT, A_AO = 260 * MiB, A_HID = WS_ACT, A_H2B = WS_ACT;
constexpr size_t A_PB = 252 * MiB;
constexpr size_t A_QA = WS_ACT + 40 * MiB, A_KA = WS_ACT + 56 * MiB, A_VAT = WS_ACT + 72 * MiB,
                 A_QB = WS_ACT + 88 * MiB, A_KB = WS_ACT + 104 * MiB, A_VBT = WS_ACT + 120 * MiB;
constexpr size_t A_RSL = 260 * MiB;
constexpr size_t A_H1B = WS_ACT + 40 * MiB, A_EBF = WS_ACT + 72 * MiB, A_Y0 = WS_ACT + 104 * MiB, A_Y1 = 260 * MiB;
constexpr size_t WS_END = 292 * MiB;

DI float bf2f(u16 u) { return __uint_as_float(((unsigned)u) << 16); }
DI u16 f2bf(float f) { __bf16 b = (__bf16)f; return __builtin_bit_cast(u16, b); }
DI int permpos(int s) { return (s & ~12) | ((s & 8) >> 1) | ((s & 4) << 1); }

struct Ptrs {
  const float *x, *p, *g_mix, *w_in, *g_qa, *g_ka, *lam_q1, *lam_k1, *lam_q2, *lam_k2, *g_sub, *g_qb, *g_kb, *rpb, *w_out,
      *g_ffn, *w_rg, *w_re, *w1, *w3, *w2, *g_plg, *w_plg, *w_ple, *g_ple;
  float* out;
  unsigned char* ws;
};

#define GAS __attribute__((address_space(1)))
#define LAS __attribute__((address_space(3)))
typedef LAS unsigned char* ldsp;
typedef __attribute__((ext_vector_type(8))) short bf16x8;
typedef __attribute__((ext_vector_type(16))) float f32x16;
typedef __attribute__((ext_vector_type(4))) float f32x4;
typedef __attribute__((ext_vector_type(2))) float f32x2v;
typedef __attribute__((ext_vector_type(2))) __bf16 bf16x2v;
DI unsigned pk2(float a, float b) { bf16x2v v = __builtin_convertvector((f32x2v){a, b}, bf16x2v); return __builtin_bit_cast(unsigned, v); }
DI float wave_sum(float v) {
#pragma unroll
  for (int o = 1; o < 64; o <<= 1) v += __shfl_xor(v, o);
  return v;
}
DI void glds16(const void* g, ldsp l) { __builtin_amdgcn_global_load_lds((const GAS unsigned*)g, (LAS unsigned*)l, 16, 0, 0); }
DI void lds_wave_sync() { asm volatile("s_waitcnt lgkmcnt(0)" ::: "memory"); }

#define XB_TMO      128
#define XB_XCNT(j)  (256  + 64 * (j))
#define XB_XSUB(j)  (1280 + 64 * (j))
#define XB_XGEN(j)  (2304 + 64 * (j))
#define XB_TOP      3328
#define XB_TOPGEN   3392
#define XCD_BAR_WORDS 3456
#define XB_SPIN_CAP (1u << 22)
DI unsigned xb_ld(unsigned* p) { return __hip_atomic_load(p, __ATOMIC_RELAXED, __HIP_MEMORY_SCOPE_AGENT); }
DI unsigned xb_add(unsigned* p, unsigned v) { return __hip_atomic_fetch_add(p, v, __ATOMIC_RELAXED, __HIP_MEMORY_SCOPE_AGENT); }
DI unsigned xb_xcc_id() { return (unsigned)__builtin_amdgcn_s_getreg((3 << 11) | 20) & 0xFu; }
#define XB_SPIN(cond, bar) do { unsigned _sp = 0; while (cond) { __builtin_amdgcn_s_sleep(1); \
    if ((++_sp & 255u) == 0u) { if (xb_ld(&(bar)[XB_TMO])) break; if (_sp > XB_SPIN_CAP) { atomicAdd(&(bar)[XB_TMO], 1u); break; } } } } while (0)
struct XcdBarrier { unsigned* bar; unsigned x; volatile LAS unsigned* st; };
DI XcdBarrier xcd_barrier_post(unsigned* bar, volatile LAS unsigned* st) {
  XcdBarrier b; b.bar = bar; b.x = xb_xcc_id(); b.st = st;
  if (threadIdx.x == 0) (void)xb_add(&bar[XB_XCNT(b.x)], 1u);
  return b;
}
DI void xcd_barrier_complete(unsigned* bar, unsigned x, unsigned& nloc, unsigned& nx) {
  const unsigned G = gridDim.x;
  unsigned sum, cnt, mine, sp = 0u;
  for (;;) {
    sum = 0u; cnt = 0u; mine = 0u;
#pragma unroll
    for (unsigned j = 0; j < 16; ++j) { const unsigned c = xb_ld(&bar[XB_XCNT(j)]); sum += c; cnt += (c > 0u) ? 1u : 0u; mine = (j == x) ? c : mine; }
    if (sum == G) break;
    __builtin_amdgcn_s_sleep(1);
    if ((++sp & 255u) == 0u) { if (xb_ld(&bar[XB_TMO])) break; if (sp > XB_SPIN_CAP) { atomicAdd(&bar[XB_TMO], 1u); break; } }
  }
  nloc = mine > 0u ? mine : 1u; nx = cnt > 0u ? cnt : 1u;
}
DI void xcd_barrier(const XcdBarrier& b) {
  asm volatile("s_waitcnt vmcnt(0)" ::: "memory");
  __syncthreads();
  if (threadIdx.x == 0) {
    unsigned* bar = b.bar;
    __builtin_amdgcn_s_waitcnt(0);
    unsigned nloc = b.st[0], nx = b.st[1];
    if (nloc == 0u) { xcd_barrier_complete(bar, b.x, nloc, nx); b.st[0] = nloc; b.st[1] = nx; }
    const unsigned old = xb_add(&bar[XB_XSUB(b.x)], 1u);
    const unsigned gen = old / nloc;
    if (old + 1u == (gen + 1u) * nloc) {
      __builtin_amdgcn_fence(__ATOMIC_RELEASE, "agent");
      asm volatile("s_waitcnt vmcnt(0)" ::: "memory");
      const unsigned og = xb_add(&bar[XB_TOP], 1u);
      const unsigned tg = og / nx;
      if (og + 1u == (tg + 1u) * nx) xb_add(&bar[XB_TOPGEN], 1u);
      else XB_SPIN(xb_ld(&bar[XB_TOPGEN]) == tg, bar);
      __builtin_amdgcn_fence(__ATOMIC_ACQUIRE, "agent");
      xb_add(&bar[XB_XGEN(b.x)], 1u);
      asm volatile("s_waitcnt vmcnt(0)" ::: "memory");
    } else {
      XB_SPIN(xb_ld(&bar[XB_XGEN(b.x)]) == gen, bar);
      __builtin_amdgcn_fence(__ATOMIC_ACQUIRE, "agent");
      asm volatile("s_waitcnt vmcnt(0)" ::: "memory");
    }
  }
  __syncthreads();
}

DI int win8_row(int f);
DI int perm256(int f);
DI int w13_row_w1(int f);
DI int w13_row_w3(int f);
typedef int (*rowmap_t)(int);
template <rowmap_t rowmap = (rowmap_t) nullptr>
DI void tr_item(const float* W, int ldw, int k0, int n0, const float* gk, u16* dst0, u16* dst1, int ldd, LAS float* scr, int lane) {
  float4 v[16];
  const float* src = W + (size_t)(k0 + (lane >> 4)) * ldw + n0 + 4 * (lane & 15);
#pragma unroll
  for (int j = 0; j < 16; ++j) { const f32x4 t = __builtin_nontemporal_load((const f32x4*)(src + (size_t)(4 * j) * ldw)); v[j] = make_float4(t[0], t[1], t[2], t[3]); }
  if (gk) {
#pragma unroll
    for (int j = 0; j < 16; ++j) { const float g = gk[k0 + 4 * j + (lane >> 4)]; v[j].x *= g; v[j].y *= g; v[j].z *= g; v[j].w *= g; }
  }
  LAS float* w = scr + (lane >> 4) * 65 + 4 * (lane & 15);
#pragma unroll
  for (int j = 0; j < 16; ++j) { w[(4 * j) * 65] = v[j].x; w[(4 * j) * 65 + 1] = v[j].y; w[(4 * j) * 65 + 2] = v[j].z; w[(4 * j) * 65 + 3] = v[j].w; }
  lds_wave_sync();
  const int c = lane & 7;
#pragma unroll
  for (int j = 0; j < 8; ++j) {
    const int n = (lane >> 3) + 8 * j;
    const LAS float* s = scr + (8 * c) * 65 + n;
    uint4 o;
    o.x = pk2(s[0 * 65], s[1 * 65]); o.y = pk2(s[2 * 65], s[3 * 65]); o.z = pk2(s[4 * 65], s[5 * 65]); o.w = pk2(s[6 * 65], s[7 * 65]);
    u16* d = rowmap ? (dst0 + (size_t)rowmap(n0 + n) * ldd) : ((j < 4) ? (dst0 + (size_t)n * ldd) : (dst1 + (size_t)(n - 32) * ldd));
    *(uint4*)(d + k0 + 8 * c) = o;
  }
  lds_wave_sync();
}

typedef const __attribute__((address_space(4))) Ptrs* kargp_t;
DI kargp_t kargs_now() {
#if defined(__HIP_DEVICE_COMPILE__)
  kargp_t kp = (kargp_t)__builtin_amdgcn_kernarg_segment_ptr(); asm volatile("" : "+s"(kp)); return kp;
#else
  return nullptr;
#endif
}
DI Ptrs load_args() {
#if defined(__HIP_DEVICE_COMPILE__)
  kargp_t kp = kargs_now(); Ptrs r; __builtin_memcpy(&r, (const void*)kp, sizeof(Ptrs)); return r;
#else
  return Ptrs{};
#endif
}
DI void late_weight_item(int r, LAS float* scr, int lane) {
  unsigned char* const wsb = kargs_now()->ws;
  if (r < 4096) {
    u16* W2T = (u16*)(wsb + WS_W2);
    const int e = r >> 7, q = r & 127, kb = q >> 4, nb = q & 15;
    tr_item<perm256>(kargs_now()->w2 + (size_t)e * 512 * 1024, 1024, kb * 64, nb * 64, nullptr, W2T + (size_t)e * 1024 * 512, nullptr, 512, scr, lane);
  } else {
    r -= 4096;
    const int kb = r >> 4, nb = r & 15;
    tr_item<perm256>(kargs_now()->w_plg, 1024, kb * 64, nb * 64, kargs_now()->g_plg, (u16*)(wsb + WS_WPLG), nullptr, 1024, scr, lane);
  }
}
DI void ph0_prep(const Ptrs& Punused, ldsp lds, int bid, int G) {
  unsigned char* const wsb = kargs_now()->ws;
  const int tid = threadIdx.x, lane = tid & 63, wave = tid >> 6;
  LAS float* scr = (LAS float*)(lds + wave * 16640);
  const int nwv = blockDim.x >> 6, gw = bid * nwv + wave, NGW = G * nwv;
  constexpr int I_W1 = 4096, I_W3 = 4096, I_W2 = 4096, I_X = 8192, I_WIN = 768, I_P = 2048, I_WOUT = 256, I_PLG = 256, I_PLE = 64,
                I_WR = 768, I_ROPE = 2048, I_PAR = (PAR_TOTAL + 63) / 64, I_SC = 1;
  constexpr int TOTAL = I_W1 + I_W3 + I_W2 + I_X + I_WIN + I_P + I_WOUT + I_PLG + I_PLE + I_WR + I_ROPE + I_PAR + I_SC;
  u16* W13T = (u16*)(wsb + WS_W13); u16* W2T = (u16*)(wsb + WS_W2);
  for (int r0_ = gw; r0_ < I_W1 + I_W3; r0_ += NGW) {
    int r = r0_;
      const int isw3 = r >= I_W1; if (isw3) r -= I_W1;
      const int e = r >> 7, q = r & 127, kb = q >> 3, nb = q & 7;
      u16* d0 = W13T + ((size_t)e * 1024 + nb * 128 + isw3 * 32) * 1024;
#if NEW_MASK & 0x20
      if (isw3) tr_item<w13_row_w3>(kargs_now()->w3 + (size_t)e * 1024 * 512, 512, kb * 64, nb * 64, kargs_now()->g_ffn, W13T + (size_t)e * 1024 * 1024, nullptr, 1024, scr, lane);
      else tr_item<w13_row_w1>(kargs_now()->w1 + (size_t)e * 1024 * 512, 512, kb * 64, nb * 64, kargs_now()->g_ffn, W13T + (size_t)e * 1024 * 1024, nullptr, 1024, scr, lane);
#else
      tr_item((isw3 ? kargs_now()->w3 : kargs_now()->w1) + (size_t)e * 1024 * 512, 512, kb * 64, nb * 64, kargs_now()->g_ffn, d0, d0 + 64 * 1024, 1024, scr, lane);
#endif
  }
  for (int r0_ = gw; r0_ < I_X; r0_ += NGW) {
    int r = r0_;
      const float4* xr = (const float4*)(kargs_now()->x + (size_t)r * 2048) + lane;
      float4 v[8];
#pragma unroll
      for (int j = 0; j < 8; ++j) { const f32x4 t = __builtin_nontemporal_load((const f32x4*)(xr + 64 * j)); v[j] = make_float4(t[0], t[1], t[2], t[3]); }
      float s0 = 0.f, s1 = 0.f;
#pragma unroll
      for (int j = 0; j < 4; ++j) { s0 += v[j].x * v[j].x + v[j].y * v[j].y + v[j].z * v[j].z + v[j].w * v[j].w; s1 += v[j + 4].x * v[j + 4].x + v[j + 4].y * v[j + 4].y + v[j + 4].z * v[j + 4].z + v[j + 4].w * v[j + 4].w; }
      s0 = wave_sum(s0); s1 = wave_sum(s1);
      if (lane == 0) { float* rx = (float*)(wsb + WS_RSTDX); rx[2 * r] = rsqrtf(s0 * (1.0f / 1024.0f) + EPS); rx[2 * r + 1] = rsqrtf(s1 * (1.0f / 1024.0f) + EPS); }
      uint2* o = (uint2*)((u16*)(wsb + A_XB) + (size_t)r * 2048) + lane;
#pragma unroll
      for (int j = 0; j < 8; ++j) o[64 * j] = make_uint2(pk2(v[j].x, v[j].y), pk2(v[j].z, v[j].w));
  }
  for (int r0_ = gw; r0_ < I_WIN; r0_ += NGW) {
    int r = r0_;
      const int kb = r / 48, nb = r % 48;
      u16* d0 = (u16*)(wsb + WS_WIN) + (size_t)(nb * 64) * 1024;
      tr_item<win8_row>(kargs_now()->w_in, DIN, kb * 64, nb * 64, kargs_now()->g_mix, (u16*)(wsb + WS_WIN), nullptr, 1024, scr, lane);
  }
  for (int r0_ = gw; r0_ < I_P; r0_ += NGW) {
    int r = r0_;
      const float4* pr = (const float4*)kargs_now()->p + (size_t)r * 512 + lane;
      uint2* o = (uint2*)(wsb + A_PB) + (size_t)r * 512 + lane;
      float4 v[8];
#pragma unroll
      for (int j = 0; j < 8; ++j) { const f32x4 t = __builtin_nontemporal_load((const f32x4*)(pr + 64 * j)); v[j] = make_float4(t[0], t[1], t[2], t[3]); }
#pragma unroll
      for (int j = 0; j < 8; ++j) o[64 * j] = make_uint2(pk2(v[j].x, v[j].y), pk2(v[j].z, v[j].w));
  }
  for (int r0_ = gw; r0_ < I_WOUT; r0_ += NGW) {
    int r = r0_;
      const int kb = r >> 4, nb = r & 15;
      u16* d0 = (u16*)(wsb + WS_WOUT) + (size_t)(nb * 64) * 1024;
#if NEW_MASK & 0x8
      tr_item<perm256>(kargs_now()->w_out, 1024, kb * 64, nb * 64, nullptr, (u16*)(wsb + WS_WOUT), nullptr, 1024, scr, lane);
#else
      tr_item(kargs_now()->w_out, 1024, kb * 64, nb * 64, nullptr, d0, d0 + 32 * 1024, 1024, scr, lane);
#endif
  }
  for (int r0_ = gw; r0_ < I_PLE; r0_ += NGW) {
    int r = r0_;
      const int kb = r >> 4, nb = r & 15;
      u16* d0 = (u16*)(wsb + WS_WPLE) + (size_t)(nb * 64) * 256;
#if NEW_MASK & 0x8
      tr_item<perm256>(kargs_now()->w_ple, 1024, kb * 64, nb * 64, nullptr, (u16*)(wsb + WS_WPLE), nullptr, 256, scr, lane);
#else
      tr_item(kargs_now()->w_ple, 1024, kb * 64, nb * 64, nullptr, d0, d0 + 32 * 256, 256, scr, lane);
#endif
  }
  for (int r0_ = gw; r0_ < I_WR; r0_ += NGW) {
    int r = r0_;
      const int idx = r * 64 + lane, rr = idx >> 10, k = idx & 1023;
      float v = 0.f;
      if (rr < 4) v = kargs_now()->w_rg[k * 4 + rr]; else if (rr < 36) v = kargs_now()->w_re[k * 32 + (rr - 4)];
      const float wv_ = v * kargs_now()->g_ffn[k];
      const unsigned hb_ = pk2(wv_, 0.f) & 0xffffu;
      const unsigned lb_ = pk2(wv_ - __uint_as_float(hb_ << 16), 0.f) & 0xffffu;
      ((u16*)(wsb + WS_WR))[idx] = (u16)hb_; ((u16*)(wsb + WS_WR))[48 * 1024 + idx] = (u16)lb_;
  }
  for (int r0_ = gw; r0_ < I_ROPE; r0_ += NGW) {
    int r = r0_;
      const int idx = r * 64 + lane, s = idx >> 5, i = idx & 31;
      const float inv = powf(10000.0f, -(float)(2 * i) / 64.0f);
      const float ang = (float)s * inv;
      float sn, cs; sincosf(ang, &sn, &cs);
      ((float2*)(wsb + WS_ROPE))[idx] = make_float2(cs, sn);
  }
  for (int r0_ = gw; r0_ < I_PAR; r0_ += NGW) {
    int r = r0_;
      const int idx = r * 64 + lane;
      if (idx < PAR_TOTAL) {
        float v;
        if (idx < PAR_GKA) v = kargs_now()->g_qa[idx]; else if (idx < PAR_GSUB) v = kargs_now()->g_ka[idx - PAR_GKA]; else if (idx < PAR_GQB) v = kargs_now()->g_sub[idx - PAR_GSUB];
        else if (idx < PAR_GKB) v = kargs_now()->g_qb[idx - PAR_GQB]; else if (idx < PAR_GPLE) v = kargs_now()->g_kb[idx - PAR_GKB]; else if (idx < PAR_RPB) v = kargs_now()->g_ple[idx - PAR_GPLE];
        else v = kargs_now()->rpb[idx - PAR_RPB];
        ((float*)(wsb + WS_PAR))[idx] = v;
      }
  }
  if (gw == 0) {
    if (lane == 0) {
      float s1 = 0, s2 = 0, mq = 0, mk = 0;
      for (int i = 0; i < 64; ++i) {
        s1 += kargs_now()->lam_q1[i] * kargs_now()->lam_k1[i]; s2 += kargs_now()->lam_q2[i] * kargs_now()->lam_k2[i];
        mq = fmaxf(mq, fabsf(kargs_now()->g_qa[i])); mk = fmaxf(mk, fabsf(kargs_now()->g_ka[i]));
      }
      float* sc = (float*)(wsb + WS_SCAL);
      sc[0] = expf(s1) - expf(s2) + LAM_INIT;
      sc[1] = 8.0f * mq * mk * LOG2E;
      float mqb = 0, mkb = 0;
      for (int i = 0; i < 32; ++i) { mqb = fmaxf(mqb, fabsf(kargs_now()->g_qb[i])); mkb = fmaxf(mkb, fabsf(kargs_now()->g_kb[i])); }
      sc[2] = 5.656854249f * mqb * mkb;
      int* cnt = (int*)(wsb + WS_CNT);
      for (int i = 0; i < 32; ++i) cnt[i * CNT_STRIDE] = 0;
    }
  }
}

DI uint4 pk8(const f32x4 a, const f32x4 b) { return make_uint4(pk2(a[0], a[1]), pk2(a[2], a[3]), pk2(b[0], b[1]), pk2(b[2], b[3])); }

typedef __attribute__((ext_vector_type(4))) unsigned u32x4;
DI bf16x8 packp(const f32x16& x, int s) {
  u32x4 p;
  p[0] = pk2(x[8 * s + 0], x[8 * s + 1]); p[1] = pk2(x[8 * s + 2], x[8 * s + 3]);
  p[2] = pk2(x[8 * s + 4], x[8 * s + 5]); p[3] = pk2(x[8 * s + 6], x[8 * s + 7]);
  return __builtin_bit_cast(bf16x8, p);
}
DI int grp_of(int kk) { return ((kk >> 2) == 1 || (kk >> 2) == 2 || (kk >> 2) == 4 || (kk >> 2) == 7) ? 1 : 0; }
DI int rank_of(int kk) { const int q = kk >> 2; return kk - ((q == 0) ? 0 : (q <= 2) ? 4 : (q == 3 || q == 4) ? 8 : (q <= 6) ? 12 : 16); }
DI int key_of(int grp, int jj) { return grp ? (jj < 8 ? jj + 4 : (jj < 12 ? jj + 8 : jj + 16)) : (jj < 4 ? jj : (jj < 8 ? jj + 8 : jj + 12)); }
constexpr int DA_STAGE = 33280, DA_VOFF = 16640;
typedef __attribute__((ext_vector_type(4))) short s16x4;
DI void ph4_router_t(const Ptrs& P, ldsp lds, int bid, int G) {
  const int tid = threadIdx.x, lane = tid & 63, wave = __builtin_amdgcn_readfirstlane(tid >> 6), t = lane & 15, kk = lane >> 4;
  LAS float* lg = (LAS float*)lds;
  const u16* h1 = (const u16*)(P.ws + A_H1B); const u16* WrH = (const u16*)(P.ws + WS_WR);
  for (int item = bid; item < 256; item += G) {
    const int tok0 = item * 64;
    float4 s0 = make_float4(0.f, 0.f, 0.f, 0.f), s1 = s0, s2 = s0, s3 = s0;
    if (wave == 0) {
      const float* sp = (const float*)(P.ws + WS_SSQ1P) + (size_t)(tok0 + lane) * SSQ_PARTS;
      s0 = *(const float4*)sp; s1 = *(const float4*)(sp + 4); s2 = *(const float4*)(sp + 8); s3 = *(const float4*)(sp + 12);
    }
    f32x4 acc[4][3];
#pragma unroll
    for (int tt = 0; tt < 4; ++tt)
#pragma unroll
      for (int et = 0; et < 3; ++et) acc[tt][et] = (f32x4){0.f, 0.f, 0.f, 0.f};
    const u16* ap = h1 + (size_t)(tok0 + t) * 1024 + 128 * wave + 8 * kk;
    const u16* bp = WrH + (size_t)t * 1024 + 128 * wave + 8 * kk;
#pragma unroll
    for (int s = 0; s < 4; ++s) {
      bf16x8 a[4];
#pragma unroll
      for (int tt = 0; tt < 4; ++tt) a[tt] = *(const bf16x8*)(ap + (size_t)tt * 16 * 1024 + 32 * s);
#pragma unroll
      for (int et = 0; et < 3; ++et) {
        const bf16x8 bh = *(const bf16x8*)(bp + et * 16 * 1024 + 32 * s), bl = *(const bf16x8*)(bp + (48 + et * 16) * 1024 + 32 * s);
#pragma unroll
        for (int tt = 0; tt < 4; ++tt) {
          acc[tt][et] = __builtin_amdgcn_mfma_f32_16x16x32_bf16(a[tt], bh, acc[tt][et], 0, 0, 0);
          acc[tt][et] = __builtin_amdgcn_mfma_f32_16x16x32_bf16(a[tt], bl, acc[tt][et], 0, 0, 0);
        }
      }
    }
    __syncthreads();
#pragma unroll
    for (int tt = 0; tt < 4; ++tt)
#pragma unroll
      for (int et = 0; et < 3; ++et)
#pragma unroll
        for (int i = 0; i < 4; ++i) lg[wave * (64 * 49) + (16 * tt + 4 * kk + i) * 49 + 16 * et + t] = acc[tt][et][i];
    __syncthreads();
    if (wave == 0) {
      const int tok = tok0 + lane;
      const float rstd = rsqrtf(((s0.x + s0.y + s0.z + s0.w) + (s1.x + s1.y + s1.z + s1.w) + (s2.x + s2.y + s2.z + s2.w) + (s3.x + s3.y + s3.z + s3.w)) * (1.0f / 1024.0f) + EPS);
      const LAS float* L = lg + lane * 49;
      float gl[4] = {0.f, 0.f, 0.f, 0.f};
#pragma unroll
      for (int w = 0; w < 8; ++w)
#pragma unroll
        for (int i = 0; i < 4; ++i) gl[i] += L[w * (64 * 49) + i];
      int gi = 0; float gm = gl[0];
#pragma unroll
      for (int i = 1; i < 4; ++i) { if (gl[i] > gm) { gm = gl[i]; gi = i; } }
      float gs = 0.f;
#pragma unroll
      for (int i = 0; i < 4; ++i) gs += expf((gl[i] - gm) * rstd);
      const float gate = 1.0f / gs;
      const LAS float* el = L + 4 + 8 * gi;
      float ev[8] = {0.f, 0.f, 0.f, 0.f, 0.f, 0.f, 0.f, 0.f};
#pragma unroll
      for (int w = 0; w < 8; ++w)
#pragma unroll
        for (int i = 0; i < 8; ++i) ev[i] += el[w * (64 * 49) + i];
      int e1 = 0; float m1 = ev[0];
#pragma unroll
      for (int i = 1; i < 8; ++i) { if (ev[i] > m1) { m1 = ev[i]; e1 = i; } }
      int e2 = 0; float m2v = -3.0e38f;
#pragma unroll
      for (int i = 0; i < 8; ++i) { if (i != e1 && ev[i] > m2v) { m2v = ev[i]; e2 = i; } }
      const float p2 = expf((m2v - m1) * rstd);
      const float wa = gate / (1.0f + p2), wb = gate * p2 / (1.0f + p2);
      int* cnt = (int*)(P.ws + WS_CNT); int* tokl = (int*)(P.ws + WS_TOKL); float* wl = (float*)(P.ws + WS_WL);
      const int ea = gi * 8 + e1, eb = gi * 8 + e2;
      ((float*)(P.ws + WS_RSTD1))[tok] = rstd;
      int mycnt = 0, ra = 0, rb = 0;
#pragma unroll 4
      for (int e = 0; e < 32; ++e) {
        const unsigned long long ma = __ballot(ea == e), mb = __ballot(eb == e);
        const int ca = __popcll(ma);
        if (lane == e) mycnt = ca + __popcll(mb);
        if (ea == e) ra = __builtin_amdgcn_mbcnt_hi((unsigned)(ma >> 32), __builtin_amdgcn_mbcnt_lo((unsigned)ma, 0u));
        if (eb == e) rb = ca + __builtin_amdgcn_mbcnt_hi((unsigned)(mb >> 32), __builtin_amdgcn_mbcnt_lo((unsigned)mb, 0u));
      }
      int base = 0;
      if (lane < 32 && mycnt > 0) base = atomicAdd(&cnt[lane * CNT_STRIDE], mycnt);
      const int pa = __shfl(base, ea) + ra, pb = __shfl(base, eb) + rb;
      float* rsl = (float*)(P.ws + A_RSL);
      tokl[ea * 16384 + pa] = tok * 2; wl[ea * 16384 + pa] = wa; rsl[ea * 16384 + pa] = rstd;
      tokl[eb * 16384 + pb] = tok * 2 + 1; wl[eb * 16384 + pb] = wb; rsl[eb * 16384 + pb] = rstd;
    }
  }
}

DI void ph4_router(const Ptrs& P, ldsp lds, int bid, int G) {
  ph4_router_t(P, lds, bid, G);
}

DI void ph7_combine(const Ptrs& P, ldsp lds, int bid, int G) {
  const int lane = threadIdx.x & 63, wave = threadIdx.x >> 6;
  const int nwv = blockDim.x >> 6;
  for (int tok = bid * nwv + wave; tok < T; tok += G * nwv) {
    const uint2* hr = (const uint2*)((const u16*)(P.ws + A_H1B) + (size_t)tok * 1024) + lane;
    const uint2* y0 = (const uint2*)((const u16*)(P.ws + A_Y0) + (size_t)tok * 1024) + lane;
    const uint2* y1 = (const uint2*)((const u16*)(P.ws + A_Y1) + (size_t)tok * 1024) + lane;
    uint2* o = (uint2*)((u16*)(P.ws + A_H2B) + (size_t)tok * 1024) + lane;
    float ss = 0.f;
#pragma unroll
    for (int j = 0; j < 4; ++j) {
      const uint2 hv = hr[64 * j], a = y0[64 * j], c = y1[64 * j];
      const float v0 = __uint_as_float(hv.x << 16) + __uint_as_float(a.x << 16) + __uint_as_float(c.x << 16);
      const float v1 = __uint_as_float(hv.x & 0xffff0000u) + __uint_as_float(a.x & 0xffff0000u) + __uint_as_float(c.x & 0xffff0000u);
      const float v2 = __uint_as_float(hv.y << 16) + __uint_as_float(a.y << 16) + __uint_as_float(c.y << 16);
      const float v3 = __uint_as_float(hv.y & 0xffff0000u) + __uint_as_float(a.y & 0xffff0000u) + __uint_as_float(c.y & 0xffff0000u);
      ss += v0 * v0 + v1 * v1 + v2 * v2 + v3 * v3;
      o[64 * j] = make_uint2(pk2(v0, v1), pk2(v2, v3));
    }
    ss = wave_sum(ss);
    float se = (lane < SSQ_PARTS) ? ((const float*)(P.ws + WS_SSQEP))[(size_t)tok * SSQ_PARTS + lane] : 0.f;
    se = wave_sum(se);
    if (lane == 0) {
      ((float*)(P.ws + WS_RSTD2))[tok] = rsqrtf(ss * (1.0f / 1024.0f) + EPS);
      ((float*)(P.ws + WS_RSTDE))[tok] = rsqrtf(se * (1.0f / 1024.0f) + EPS);
    }
  }
}

namespace g8 {
constexpr int BM = 256, BK = 64, HALF = 128, HTB = HALF * BK * 2, STAGE_BYTES = 8 * HTB, NXCD = 8, WGM = 8;
constexpr int LDS_EXTRA8 = STAGE_BYTES;
constexpr int LDS_BYTES8 = STAGE_BYTES + 4096;
DI int lds_byte(int r, int c) { const int st = (r >> 4) * 2 + (c >> 5), rr = r & 15, cc = c & 31, ob = rr * 64 + cc * 2; return st * 1024 + (ob ^ (((ob >> 9) & 1) << 5)); }
DI void stage_rc(int b, int& R, int& C) { const int st = b / 1024, sb = b % 1024, swz = sb ^ (((sb >> 9) & 1) << 5); R = (st >> 1) * 16 + swz / 64; C = (st & 1) * 32 + (swz % 64) / 2; }

struct Unit { int pm, pn, e, ce; };
struct GridOrder {
  int nM, nN, nwg, G, c; unsigned pnmap;
  DI void init(int nM_, int nN_, int G_, int c_, unsigned pnmap_ = 0u) { nM = nM_; nN = nN_; nwg = nM * nN; G = G_; c = c_; pnmap = pnmap_; }
  DI bool next(int i, Unit& u) const {
    const int L = i * G + c; if (L >= nwg) return false;
    int wgid = L; { const int q = nwg / NXCD, r = nwg % NXCD, xcd = wgid % NXCD, off = wgid / NXCD; wgid = (xcd < r ? xcd * (q + 1) : r * (q + 1) + (xcd - r) * q) + off; }
    const int nig = WGM * nN, gid = wgid / nig, fm = gid * WGM, gsz = (nM - fm) < WGM ? (nM - fm) : WGM;
    u.pm = fm + ((wgid % nig) % gsz); u.pn = (wgid % nig) / gsz; if (pnmap) u.pn = (int)((pnmap >> (4 * u.pn)) & 15u); u.e = 0; u.ce = 0; return true;
  }
};

template <class Epi, class Sched, bool SWAP, bool GATHER>
DI void gemm_phase(ldsp lds, const unsigned char* Abase, const unsigned char* Bbase, int K, const Sched& S, const Epi& E, int pA = 0, int pB = 0) {
  if (pA == 0) pA = K; if (pB == 0) pB = K;
  int tid = threadIdx.x; asm volatile("" : "+v"(tid));
  const int wid = __builtin_amdgcn_readfirstlane(tid >> 6), lane = tid & 63, wr = wid >> 2, wc = wid & 3, fr = lane & 15, fq = lane >> 4;
  const int nt = K / BK;
  int sR[2], sC[2];
  unsigned voffB[2], voffA[2];
#pragma unroll
  for (int i = 0; i < 2; ++i) { stage_rc(tid * 16 + i * 8192, sR[i], sC[i]); voffB[i] = (unsigned)(sR[i] * pB + sC[i]) * 2u; voffA[i] = (unsigned)(sR[i] * pA + sC[i]) * 2u; }
  const size_t tstepA = (size_t)BM * pA * 2;
  const size_t kstep = (size_t)(BK * 2);
  const size_t hstep = (size_t)HALF * pB * 2, hstepA = (size_t)HALF * pA * 2;
  const unsigned ldsw = (unsigned)wid * 1024u;
  const int aoff = lds_byte(wr * 64 + fr, fq * 8), boff = lds_byte(wc * 32 + fr, fq * 8);
#define G8_SA(b, h) (((b) * 2 + (h)) * HTB)
#define G8_SB(b, h) ((4 + (b) * 2 + (h)) * HTB)
#define G8_STAGE_B(bufoff, gbase) do { _Pragma("unroll") for (int _i = 0; _i < 2; ++_i) \
    __builtin_amdgcn_global_load_lds((const GAS unsigned*)((const unsigned char*)(gbase) + voffB[_i]), (LAS unsigned*)(lds + (bufoff) + ldsw + _i * 8192), 16, 0, 0); } while (0)
#define G8_STAGE_A(bufoff, hsel, nx, koff) do { _Pragma("unroll") for (int _i = 0; _i < 2; ++_i) { \
    const unsigned char* _p; \
    if (GATHER) _p = Abase + (size_t)((nx) ? ((hsel) ? nv1[_i] : nv0[_i]) : ((hsel) ? cv1[_i] : cv0[_i])) + (koff); \
    else _p = ((nx) ? nA : cA) + ((hsel) ? hstepA : (size_t)0) + voffA[_i] + (koff); \
    __builtin_amdgcn_global_load_lds((const GAS unsigned*)_p, (LAS unsigned*)(lds + (bufoff) + ldsw + _i * 8192), 16, 0, 0); } } while (0)
#define G8_LDA(dst, b, h) do { _Pragma("unroll") for (int m = 0; m < 4; ++m) _Pragma("unroll") for (int k = 0; k < 2; ++k) dst[m][k] = *(const LAS bf16x8*)(lds + G8_SA(b, h) + aoff + m * 2048 + k * 1024); } while (0)
#define G8_LDB(dst, b, h) do { _Pragma("unroll") for (int n = 0; n < 2; ++n) _Pragma("unroll") for (int k = 0; k < 2; ++k) dst[n][k] = *(const LAS bf16x8*)(lds + G8_SB(b, h) + boff + n * 2048 + k * 1024); } while (0)
#define G8_MMA(ai, bj, At, Bt) do { __builtin_amdgcn_s_setprio(1); \
    _Pragma("unroll") for (int m = 0; m < 4; ++m) _Pragma("unroll") for (int n = 0; n < 2; ++n) _Pragma("unroll") for (int k = 0; k < 2; ++k) \
        acc[ai][bj][m][n] = SWAP ? __builtin_amdgcn_mfma_f32_16x16x32_bf16(At[m][k], Bt[n][k], acc[ai][bj][m][n], 0, 0, 0) \
                                 : __builtin_amdgcn_mfma_f32_16x16x32_bf16(Bt[n][k], At[m][k], acc[ai][bj][m][n], 0, 0, 0); \
    __builtin_amdgcn_s_setprio(0); } while (0)
#define G8_WAIT_V(n) asm volatile("s_waitcnt vmcnt(" #n ")" ::: "memory")
#define G8_WAIT_L(n) asm volatile("s_waitcnt lgkmcnt(" #n ")" ::: "memory")
#define G8_BAR __builtin_amdgcn_s_barrier()
#define G8_SCHED __builtin_amdgcn_sched_barrier(0)
  Unit cur, nxt; int ui = 0;
  if (!S.next(0, cur)) return;
  f32x4 acc[2][2][4][2];
#pragma unroll
  for (int a = 0; a < 2; ++a)
#pragma unroll
    for (int b = 0; b < 2; ++b)
#pragma unroll
      for (int m = 0; m < 4; ++m)
#pragma unroll
        for (int n = 0; n < 2; ++n) acc[a][b][m][n] = (f32x4){0.f, 0.f, 0.f, 0.f};
  bf16x8 At[4][2], B0[2][2], B1[2][2];
  unsigned cv0[2] = {0u, 0u}, cv1[2] = {0u, 0u}, nv0[2] = {0u, 0u}, nv1[2] = {0u, 0u};
  const unsigned char* cA = Abase; const unsigned char* nA = Abase;
  if (GATHER) E.a_off(cur, sR, sC, cv0, cv1); else cA = Abase + (size_t)cur.pm * tstepA;
  const unsigned char* cB = Bbase + E.b_off(cur);
  G8_STAGE_B(G8_SB(0, 0), cB); G8_STAGE_A(G8_SA(0, 0), 0, false, 0); G8_STAGE_B(G8_SB(0, 1), cB + hstep); G8_STAGE_A(G8_SA(0, 1), 1, false, 0);
  if (wr == 1) G8_BAR;
  G8_WAIT_V(4); G8_BAR;
  G8_STAGE_B(G8_SB(1, 0), cB + kstep); G8_STAGE_A(G8_SA(1, 0), 0, false, kstep); G8_STAGE_B(G8_SB(1, 1), cB + hstep + kstep);
  G8_WAIT_V(6); G8_BAR;
  for (;;) {
    const bool has_next = S.next(ui + 1, nxt);
    if (GATHER) { if (has_next) E.a_off(nxt, sR, sC, nv0, nv1); else { nv0[0] = cv0[0]; nv0[1] = cv0[1]; nv1[0] = cv1[0]; nv1[1] = cv1[1]; } }
    else nA = has_next ? Abase + (size_t)nxt.pm * tstepA : cA;
    const unsigned char* nB = has_next ? Bbase + E.b_off(nxt) : cB;
#pragma unroll 1
    for (int t = 0; t < nt; t += 2) {
      const bool last = (t == nt - 2);
      const size_t k1 = (size_t)(t + 1) * kstep;
      const size_t k2 = last ? 0 : (size_t)(t + 2) * kstep, k3 = k2 + kstep;
      const unsigned char* b2 = last ? nB : cB + (size_t)(t + 2) * kstep; const unsigned char* b3 = b2 + kstep;
      G8_LDB(B0, 0, 0); G8_SCHED; G8_LDA(At, 0, 0); G8_STAGE_A(G8_SA(1, 1), 1, false, k1);
      G8_WAIT_L(8); G8_BAR; G8_WAIT_L(0); G8_MMA(0, 0, At, B0); G8_BAR; G8_SCHED;
      G8_LDB(B1, 0, 1); G8_STAGE_B(G8_SB(0, 0), b2);
      G8_BAR; G8_WAIT_L(0); G8_MMA(0, 1, At, B1); G8_BAR;
      G8_LDA(At, 0, 1); G8_STAGE_A(G8_SA(0, 0), 0, last, k2);
      G8_BAR; G8_WAIT_L(0); G8_MMA(1, 0, At, B0); G8_BAR; G8_SCHED;
      G8_STAGE_B(G8_SB(0, 1), b2 + hstep);
      G8_WAIT_V(6); G8_BAR; G8_MMA(1, 1, At, B1); G8_BAR;
      G8_LDB(B0, 1, 0); G8_SCHED; G8_LDA(At, 1, 0); G8_STAGE_A(G8_SA(0, 1), 1, last, k2);
      G8_WAIT_L(8); G8_BAR; G8_WAIT_L(0); G8_MMA(0, 0, At, B0); G8_BAR; G8_SCHED;
      G8_LDB(B1, 1, 1); G8_STAGE_B(G8_SB(1, 0), b3);
      G8_BAR; G8_WAIT_L(0); G8_MMA(0, 1, At, B1); G8_BAR;
      G8_LDA(At, 1, 1); G8_STAGE_A(G8_SA(1, 0), 0, last, k3);
      G8_BAR; G8_WAIT_L(0); G8_MMA(1, 0, At, B0); G8_BAR; G8_SCHED;
      G8_STAGE_B(G8_SB(1, 1), b3 + hstep);
      G8_WAIT_V(6); G8_BAR; G8_MMA(1, 1, At, B1); G8_BAR;
    }
    E(acc, cur, wr, wc, fr, fq);
    if (!has_next) break;
#pragma unroll
    for (int a = 0; a < 2; ++a)
#pragma unroll
      for (int b = 0; b < 2; ++b)
#pragma unroll
        for (int m = 0; m < 4; ++m)
#pragma unroll
          for (int n = 0; n < 2; ++n) acc[a][b][m][n] = (f32x4){0.f, 0.f, 0.f, 0.f};
    cur = nxt; cB = nB; cA = nA; ++ui;
    if (GATHER) { cv0[0] = nv0[0]; cv0[1] = nv0[1]; cv1[0] = nv1[0]; cv1[1] = nv1[1]; }
  }
  G8_WAIT_V(0);
  if (wr == 0) G8_BAR;
  G8_BAR;
#undef G8_SA
#undef G8_SB
#undef G8_STAGE_A
#undef G8_STAGE_B
#undef G8_LDA
#undef G8_LDB
#undef G8_MMA
#undef G8_WAIT_V
#undef G8_WAIT_L
#undef G8_BAR
#undef G8_SCHED
}
DI void dense_a_off(int pm, int K, const int (&sR)[2], const int (&sC)[2], unsigned (&v0)[2], unsigned (&v1)[2]) {
#pragma unroll
  for (int i = 0; i < 2; ++i) { v0[i] = (unsigned)((pm * BM + sR[i]) * K + sC[i]) * 2u; v1[i] = v0[i] + (unsigned)(HALF * K * 2); }
}
}

DI int win8_row(int f) {
  if (f < 1024) {
    const int rel = f & 511, pn = (f >> 9) * 2 + (rel >> 8), hl = (rel >> 7) & 1, comp = (rel >> 6) & 1, i = rel & 63;
    const int bj = i >> 5, ip = i & 31, fq = ip >> 3, n = (ip >> 2) & 1, j = ip & 3;
    return pn * 256 + 128 * bj + 32 * (2 * hl + comp) + 16 * n + 4 * fq + j;
  }
  if (f < 1536 || f >= 2560) return f;
  const int rel = (f - 1536) & 511, pn = 6 + ((f - 1536) >> 9) * 2 + (rel >> 8), hl = (rel >> 5) & 7, ip = rel & 31;
  const int bj = hl >> 2, wc = hl & 3, fq = ip >> 3, n = (ip >> 2) & 1, j = ip & 3;
  return pn * 256 + 128 * bj + 32 * wc + 16 * n + 4 * fq + j;
}
struct EpiInproj {
  const Ptrs* Pp;
  DI void a_off(const g8::Unit& u, const int (&sR)[2], const int (&sC)[2], unsigned (&v0)[2], unsigned (&v1)[2]) const { g8::dense_a_off(u.pm, 1024, sR, sC, v0, v1); }
  DI size_t b_off(const g8::Unit& u) const { return (size_t)u.pn * 256 * 1024 * 2; }
  DI void operator()(const f32x4 (&acc)[2][2][4][2], const g8::Unit& u, int wr, int wc, int fr, int fq) const {
    const Ptrs& P = *Pp;
    const float* rstdx = (const float*)(P.ws + WS_RSTDX);
    asm volatile("" : "+v"(rstdx));
    const int pn = u.pn, row00 = u.pm * 256 + wr * 64, b = row00 >> 12;
    float rsr[8];
#pragma unroll
    for (int k = 0; k < 8; ++k) rsr[k] = rstdx[row00 + 128 * (k >> 2) + 16 * (k & 3) + fr];
    const float qsA = 0.125f * LOG2E, qsB = 0.17677669529663687f * LOG2E;
    if (pn < 4) {
      const int isk = pn >= 2, head = 2 * (pn & 1) + (wc >> 1), comp = wc & 1;
      const float* gg = ((const float*)(P.ws + WS_PAR)) + (isk ? PAR_GKA : PAR_GQA);
      asm volatile("" : "+v"(gg));
      const float4 g1a = *(const float4*)(gg + 8 * fq), g1b = *(const float4*)(gg + 8 * fq + 4), g2a = *(const float4*)(gg + 32 + 8 * fq), g2b = *(const float4*)(gg + 36 + 8 * fq);
      const float ga[8] = {g1a.x, g1a.y, g1a.z, g1a.w, g1b.x, g1b.y, g1b.z, g1b.w}, gb[8] = {g2a.x, g2a.y, g2a.z, g2a.w, g2b.x, g2b.y, g2b.z, g2b.w};
      u16* dstb = (u16*)(P.ws + (isk ? A_KA : A_QA)) + (size_t)(b * 4 + head) * 4096 * 128 + comp * 64 + 8 * fq;
      const float2* rope = (const float2*)(P.ws + WS_ROPE);
      struct Rp { f32x4 c0, c1, c2, c3; };
      auto ldrope = [&](int k) { const int s = (row00 + 128 * (k >> 2) + 16 * (k & 3) + fr) & 4095; const f32x4* rp = (const f32x4*)(rope + (size_t)s * 32 + 8 * fq);
        Rp r; r.c0 = rp[0]; r.c1 = rp[1]; r.c2 = rp[2]; r.c3 = rp[3]; return r; };
      Rp cur = ldrope(0);
#pragma unroll
      for (int k = 0; k < 8; ++k) {
        const int ai = k >> 2, m = k & 3;
        Rp nxt = cur;
        if (k < 7) nxt = ldrope(k + 1);
        const int row = row00 + 128 * ai + 16 * m + fr, s = row & 4095;
        const float rs = rsr[k];
        float x1[8], x2[8]; float ss = 0.f;
#pragma unroll
        for (int n = 0; n < 2; ++n)
#pragma unroll
          for (int j = 0; j < 4; ++j) { x1[4 * n + j] = acc[ai][0][m][n][j] * rs; x2[4 * n + j] = acc[ai][1][m][n][j] * rs; ss += x1[4 * n + j] * x1[4 * n + j] + x2[4 * n + j] * x2[4 * n + j]; }
        ss += __shfl_xor(ss, 16); ss += __shfl_xor(ss, 32);
        const float rn = rsqrtf(ss * (1.0f / 64.0f) + EPS) * (isk ? 1.0f : qsA);
        const float cs[8] = {cur.c0[0], cur.c0[2], cur.c1[0], cur.c1[2], cur.c2[0], cur.c2[2], cur.c3[0], cur.c3[2]}, sn[8] = {cur.c0[1], cur.c0[3], cur.c1[1], cur.c1[3], cur.c2[1], cur.c2[3], cur.c3[1], cur.c3[3]};
        f32x4 o1a, o1b, o2a, o2b;
#pragma unroll
        for (int e = 0; e < 8; ++e) {
          const float y = x1[e] * rn * ga[e], z = x2[e] * rn * gb[e];
          const float p1 = y * cs[e] - z * sn[e], p2 = z * cs[e] + y * sn[e];
          if (e < 4) { o1a[e] = p1; o2a[e] = p2; } else { o1b[e - 4] = p1; o2b[e - 4] = p2; }
        }
        u16* d = dstb + (size_t)s * 128;
        *(uint4*)d = pk8(o1a, o1b);
        *(uint4*)(d + 32) = pk8(o2a, o2b);
        asm volatile("" ::: "memory");
        cur = nxt;
      }
    } else if (pn >= 6 && pn < 10) {
      const int isk = pn >= 8;
      const float* gg = ((const float*)(P.ws + WS_PAR)) + (isk ? PAR_GKB : PAR_GQB);
      asm volatile("" : "+v"(gg));
      const float4 g1a = *(const float4*)(gg + 8 * fq), g1b = *(const float4*)(gg + 8 * fq + 4);
      const float ga[8] = {g1a.x, g1a.y, g1a.z, g1a.w, g1b.x, g1b.y, g1b.z, g1b.w};
#pragma unroll
      for (int bj = 0; bj < 2; ++bj) {
        const int hd = 8 * (pn & 1) + 4 * bj + wc;
        u16* dstb = (u16*)(P.ws + (isk ? A_KB : A_QB)) + (size_t)(b * 16 + hd) * 4096 * 32 + 8 * fq;
#pragma unroll
        for (int ai = 0; ai < 2; ++ai)
#pragma unroll
          for (int m = 0; m < 4; ++m) {
            const int row = row00 + 128 * ai + 16 * m + fr, s = row & 4095;
            const float rs = rsr[4 * ai + m];
            float x[8]; float ss = 0.f;
#pragma unroll
            for (int n = 0; n < 2; ++n)
#pragma unroll
              for (int j = 0; j < 4; ++j) { x[4 * n + j] = acc[ai][bj][m][n][j] * rs; ss += x[4 * n + j] * x[4 * n + j]; }
            ss += __shfl_xor(ss, 16); ss += __shfl_xor(ss, 32);
            const float rn = rsqrtf(ss * (1.0f / 32.0f) + EPS) * (isk ? 1.0f : qsB);
            f32x4 oa, ob;
#pragma unroll
            for (int e = 0; e < 4; ++e) { oa[e] = x[e] * rn * ga[e]; ob[e] = x[4 + e] * rn * ga[4 + e]; }
            *(uint4*)(dstb + (size_t)s * 32) = pk8(oa, ob);
          }
      }
    } else {
      const int isA = pn < 6;
#pragma unroll
      for (int ai = 0; ai < 2; ++ai)
#pragma unroll
        for (int m = 0; m < 4; ++m) {
          const int row0 = row00 + 128 * ai + 16 * m + 4 * fq, s0 = row0 & 4095;
          const float4 rs = *(const float4*)(rstdx + row0);
          const int sp = isA ? permpos(s0) : s0;
#pragma unroll
          for (int bj = 0; bj < 2; ++bj)
#pragma unroll
            for (int n = 0; n < 2; ++n) {
              const int c = 128 * bj + 32 * wc + 16 * n + fr;
              u16* dst;
              if (isA) dst = (u16*)(P.ws + A_VAT) + ((size_t)(b * 4 + 2 * (pn - 4) + (c >> 7)) * 128 + (c & 127)) * 4096;
              else dst = (u16*)(P.ws + A_VBT) + ((size_t)(b * 16 + 8 * (pn - 10) + (c >> 5)) * 32 + (c & 31)) * 4096;
              const f32x4 v = acc[ai][bj][m][n];
              *(uint2*)(dst + sp) = make_uint2(pk2(v[0] * rs.x, v[1] * rs.y), pk2(v[2] * rs.z, v[3] * rs.w));
            }
        }
    }
  }
};
DI void ph1_inproj8(const Ptrs& P, ldsp lds, int bid, int G) {
  EpiInproj E; E.Pp = &P;
  {
    g8::GridOrder S; S.init(64, 8, G, bid, 0x98763210u);
    g8::gemm_phase<EpiInproj, g8::GridOrder, false, false>(lds, (const unsigned char*)(P.ws + A_XB), (const unsigned char*)(P.ws + WS_WIN), 1024, S, E);
  }
  {
    g8::GridOrder S; S.init(64, 4, G, bid, 0xBA54u);
    g8::gemm_phase<EpiInproj, g8::GridOrder, true, false>(lds, (const unsigned char*)(P.ws + A_XB), (const unsigned char*)(P.ws + WS_WIN), 1024, S, E);
  }
}

DI int p32(int ip) { return 16 * ((ip >> 2) & 1) + 4 * (ip >> 3) + (ip & 3); }
DI int perm256(int f) { return (f & ~31) | p32(f & 31); }
DI int w13_row_w1(int f) { return ((f >> 7) << 8) | (f & 96) | p32(f & 31); }
DI int w13_row_w3(int f) { return (((f >> 7) << 8) | (f & 96) | p32(f & 31)) + 128; }

template <bool PLE>
struct EpiOut {
  const Ptrs* Pp;
  DI void a_off(const g8::Unit&, const int (&)[2], const int (&)[2], unsigned (&)[2], unsigned (&)[2]) const {}
  DI size_t b_off(const g8::Unit& u) const { return (size_t)u.pn * 256 * (PLE ? 256 : 1024) * 2; }
  struct Ld { float4 a0, a1, b0, b1; };
  DI void operator()(const f32x4 (&acc)[2][2][4][2], const g8::Unit& u, int wr, int wc, int fr, int fq) const {
    const Ptrs& P = *Pp;
    float* ssqp = (float*)(P.ws + (PLE ? WS_SSQEP : WS_SSQ1P));
    const int row0 = u.pm * 256 + 64 * wr + fr, col0 = u.pn * 256 + 32 * wc + 8 * fq;
    auto load = [&](int gidx) { const int ai = gidx >> 2, m = gidx & 3; const size_t go = (size_t)(row0 + 128 * ai + 16 * m) * 1024 + col0;
      Ld l; if (!PLE) { const u16* xbp = (const u16*)(P.ws + A_XB) + go; const uint4 ua = *(const uint4*)xbp, ub = *(const uint4*)(xbp + 128);
        l.a0 = make_float4(__uint_as_float(ua.x << 16), __uint_as_float(ua.x & 0xffff0000u), __uint_as_float(ua.y << 16), __uint_as_float(ua.y & 0xffff0000u));
        l.a1 = make_float4(__uint_as_float(ua.z << 16), __uint_as_float(ua.z & 0xffff0000u), __uint_as_float(ua.w << 16), __uint_as_float(ua.w & 0xffff0000u));
        l.b0 = make_float4(__uint_as_float(ub.x << 16), __uint_as_float(ub.x & 0xffff0000u), __uint_as_float(ub.y << 16), __uint_as_float(ub.y & 0xffff0000u));
        l.b1 = make_float4(__uint_as_float(ub.z << 16), __uint_as_float(ub.z & 0xffff0000u), __uint_as_float(ub.w << 16), __uint_as_float(ub.w & 0xffff0000u)); }
      else { l.a0 = l.a1 = l.b0 = l.b1 = make_float4(0.f, 0.f, 0.f, 0.f); } return l; };
    Ld cur = load(0);
#pragma unroll
    for (int gidx = 0; gidx < 8; ++gidx) {
      const int ai = gidx >> 2, m = gidx & 3;
      Ld nxt = cur;
      if (gidx < 7) nxt = load(gidx + 1);
      const int row = row0 + 128 * ai + 16 * m;
      float ss = 0.f;
#pragma unroll
      for (int bj = 0; bj < 2; ++bj) {
        const size_t go = (size_t)row * 1024 + col0 + 128 * bj;
        f32x4 a = acc[ai][bj][m][0], c4 = acc[ai][bj][m][1];
        if (!PLE) {
          const float4 xa = bj ? cur.b0 : cur.a0, xb4 = bj ? cur.b1 : cur.a1;
          a[0] += xa.x; a[1] += xa.y; a[2] += xa.z; a[3] += xa.w; c4[0] += xb4.x; c4[1] += xb4.y; c4[2] += xb4.z; c4[3] += xb4.w;
          *(uint4*)((u16*)(P.ws + A_H1B) + go) = pk8(a, c4);
        } else {
          *(uint4*)((u16*)(P.ws + A_EBF) + go) = pk8(a, c4);
        }
        ss += a[0] * a[0] + a[1] * a[1] + a[2] * a[2] + a[3] * a[3] + c4[0] * c4[0] + c4[1] * c4[1] + c4[2] * c4[2] + c4[3] * c4[3];
      }
      ss += __shfl_xor(ss, 16); ss += __shfl_xor(ss, 32);
      if (fq == 0) ssqp[(size_t)row * 16 + u.pn * 4 + wc] = ss;
      asm volatile("" ::: "memory");
      cur = nxt;
    }
  }
};
DI void ph3_outproj8(const Ptrs& P, ldsp lds, int bid, int G) {
  { EpiOut<false> E; E.Pp = &P; g8::GridOrder S; S.init(64, 4, G, bid);
    g8::gemm_phase<EpiOut<false>, g8::GridOrder, false, false>(lds, (const unsigned char*)(P.ws + A_AO), (const unsigned char*)(P.ws + WS_WOUT), 1024, S, E); }
}

DI int moe_plan8(const Ptrs& P, ldsp lds) {
  LAS int* smb = (LAS int*)(lds + g8::LDS_EXTRA8);
  __syncthreads();
  if (threadIdx.x == 0) {
    const int* cnt = (const int*)(P.ws + WS_CNT);
    int a = 0;
    for (int e = 0; e < 32; ++e) { smb[e] = a; a += (cnt[e * CNT_STRIDE] + 255) >> 8; smb[64 + e] = cnt[e * CNT_STRIDE]; }
    smb[32] = a;
  }
  __syncthreads();
  return smb[32];
}
template <class T> DI T* uni_ptr(T* p) {
  const unsigned long long v = (unsigned long long)p;
  const unsigned lo = __builtin_amdgcn_readfirstlane((unsigned)v), hi = __builtin_amdgcn_readfirstlane((unsigned)(v >> 32));
  return (T*)(((unsigned long long)hi << 32) | lo);
}
struct MoeOrder {
  int MB, G, c; const LAS int* smb;
  DI bool next(int i, g8::Unit& u) const {
    const int L = i * G + c;
    if (L >= ((MB + 7) >> 3) * 32) return false;
    const int gmb = (L >> 5) * 8 + (L & 7);
    u.pn = (L >> 3) & 3;
    if (gmb >= MB) return false;
    int e = 0; while (gmb >= smb[e + 1]) ++e;
    e = __builtin_amdgcn_readfirstlane(e);
    u.pm = gmb; u.e = e; u.ce = __builtin_amdgcn_readfirstlane(smb[64 + e] - (gmb - smb[e]) * 256);
    return true;
  }
};
struct EpiUp {
  const Ptrs* Pp; const LAS int* smb;
  DI void a_off(const g8::Unit& u, const int (&sR)[2], const int (&sC)[2], unsigned (&v0)[2], unsigned (&v1)[2]) const {
    const int* tokl = uni_ptr((const int*)(Pp->ws + WS_TOKL) + __builtin_amdgcn_readfirstlane(u.e * 16384 + (u.pm - smb[u.e]) * 256));
#pragma unroll
    for (int i = 0; i < 2; ++i) {
      const int r0 = sR[i], r1 = 128 + sR[i];
      const int t0 = (r0 < u.ce) ? (tokl[r0] >> 1) : 0, t1 = (r1 < u.ce) ? (tokl[r1] >> 1) : 0;
      v0[i] = (unsigned)(t0 * 1024 + sC[i]) * 2u; v1[i] = (unsigned)(t1 * 1024 + sC[i]) * 2u;
    }
  }
  DI size_t b_off(const g8::Unit& u) const { return ((size_t)u.e * 1024 + u.pn * 256) * 1024 * 2; }
  DI void operator()(const f32x4 (&acc)[2][2][4][2], const g8::Unit& u, int wr, int wc, int fr, int fq) const {
    const Ptrs& P = *Pp;
    if (u.ce <= 0) return;
    const float* rsl = uni_ptr((const float*)(P.ws + A_RSL) + __builtin_amdgcn_readfirstlane(u.e * 16384 + (u.pm - smb[u.e]) * 256));
    u16* hid = (u16*)(P.ws + A_HID);
    float rsv[8];
#pragma unroll
    for (int k = 0; k < 8; ++k) { const int rl = 128 * (k >> 2) + 64 * wr + 16 * (k & 3) + fr; rsv[k] = (rl < u.ce) ? rsl[rl] : 0.0f; }
#pragma unroll
    for (int ai = 0; ai < 2; ++ai)
#pragma unroll
      for (int m = 0; m < 4; ++m) {
        const int rl = 128 * ai + 64 * wr + 16 * m + fr;
        const float rs = rsv[4 * ai + m];
        f32x4 h0, h1;
#pragma unroll
        for (int j = 0; j < 4; ++j) {
          const float a = acc[ai][0][m][0][j] * rs, b = acc[ai][0][m][1][j] * rs;
          h0[j] = a * __builtin_amdgcn_rcpf(1.0f + __expf(-a)) * (acc[ai][1][m][0][j] * rs); h1[j] = b * __builtin_amdgcn_rcpf(1.0f + __expf(-b)) * (acc[ai][1][m][1][j] * rs);
        }
        *(uint4*)(hid + (size_t)(u.pm * 256 + rl) * 512 + u.pn * 128 + 32 * wc + 8 * fq) = pk8(h0, h1);
      }
  }
};
DI void ph5_up8(const Ptrs& P, ldsp lds, int bid, int G) {
  const int MB = moe_plan8(P, lds);
  const LAS int* smb = (const LAS int*)(lds + g8::LDS_EXTRA8);
  MoeOrder S; S.MB = MB; S.G = G; S.c = bid; S.smb = smb;
  EpiUp E; E.Pp = &P; E.smb = smb;
  g8::gemm_phase<EpiUp, MoeOrder, false, true>(lds, (const unsigned char*)(P.ws + A_H1B), (const unsigned char*)(P.ws + WS_W13), 1024, S, E);
  {
    const int NU = ((MB + 7) >> 3) * 32, rem = NU % G, nl = rem ? G - rem : G, li = rem ? bid - rem : bid;
    if (li >= 0) {
      const int lane = threadIdx.x & 63, wave = threadIdx.x >> 6, nwv = blockDim.x >> 6;
      LAS float* scr = (LAS float*)(lds + wave * 16640);
      for (int r = li * nwv + wave; r < 4096 + 256; r += nl * nwv) late_weight_item(r, scr, lane);
    }
  }
}
struct EpiDown {
  const Ptrs* Pp; const LAS int* smb;
  DI void a_off(const g8::Unit&, const int (&)[2], const int (&)[2], unsigned (&)[2], unsigned (&)[2]) const {}
  DI size_t b_off(const g8::Unit& u) const { return ((size_t)u.e * 1024 + u.pn * 256) * 512 * 2; }
  DI void operator()(const f32x4 (&acc)[2][2][4][2], const g8::Unit& u, int wr, int wc, int fr, int fq) const {
    const Ptrs& P = *Pp;
    if (u.ce <= 0) return;
    const int base = __builtin_amdgcn_readfirstlane(u.e * 16384 + (u.pm - smb[u.e]) * 256);
    const int* tokl = (const int*)(P.ws + WS_TOKL) + base; const float* wl = (const float*)(P.ws + WS_WL) + base;
    int tkv[8]; float wv[8];
#pragma unroll
    for (int k = 0; k < 8; ++k) { const int rl = 128 * (k >> 2) + 64 * wr + 16 * (k & 3) + fr; const bool v = rl < u.ce; tkv[k] = v ? tokl[rl] : -1; wv[k] = v ? wl[rl] : 0.0f; }
#pragma unroll
    for (int ai = 0; ai < 2; ++ai)
#pragma unroll
      for (int m = 0; m < 4; ++m) {
        const int tk = tkv[4 * ai + m];
        if (tk >= 0) {
          const float w = wv[4 * ai + m];
          u16* y = (u16*)(P.ws + ((tk & 1) ? A_Y1 : A_Y0)) + (size_t)(tk >> 1) * 1024 + u.pn * 256 + 32 * wc + 8 * fq;
#pragma unroll
          for (int bj = 0; bj < 2; ++bj) {
            f32x4 a = acc[ai][bj][m][0], c4 = acc[ai][bj][m][1];
#pragma unroll
            for (int j = 0; j < 4; ++j) { a[j] *= w; c4[j] *= w; }
            *(uint4*)(y + 128 * bj) = pk8(a, c4);
          }
        }
      }
  }
};
DI void ph6_down8(const Ptrs& P, ldsp lds, int bid, int G) {
  const int MB = moe_plan8(P, lds);
  const LAS int* smb = (const LAS int*)(lds + g8::LDS_EXTRA8);
  MoeOrder S; S.MB = MB; S.G = G; S.c = bid; S.smb = smb;
  EpiDown E; E.Pp = &P; E.smb = smb;
  g8::gemm_phase<EpiDown, MoeOrder, false, false>(lds, (const unsigned char*)(P.ws + A_HID), (const unsigned char*)(P.ws + WS_W2), 512, S, E);
  {
    const int NU = ((MB + 7) >> 3) * 32, rem = NU % G, nl = rem ? G - rem : G, li = rem ? bid - rem : bid;
    EpiOut<true> E2; E2.Pp = &P; g8::GridOrder S2; S2.init(64, 4, nl, li < 0 ? 0 : li);
    if (li < 0) S2.nwg = 0;
    g8::gemm_phase<EpiOut<true>, g8::GridOrder, false, false>(lds, (const unsigned char*)(P.ws + A_PB), (const unsigned char*)(P.ws + WS_WPLE), 256, S2, E2);
  }
}

struct EpiFinal {
  const Ptrs* Pp;
  DI void a_off(const g8::Unit&, const int (&)[2], const int (&)[2], unsigned (&)[2], unsigned (&)[2]) const {}
  DI size_t b_off(const g8::Unit& u) const { return (size_t)u.pn * 256 * 1024 * 2; }
  struct Ld { u32x4 hh; u32x4 ee; };
  DI void operator()(const f32x4 (&acc)[2][2][4][2], const g8::Unit& u, int wr, int wc, int fr, int fq) const {
    const Ptrs& P = *Pp;
    const float* rstd2 = (const float*)(P.ws + WS_RSTD2); const float* rstdE = (const float*)(P.ws + WS_RSTDE);
    const int row0 = u.pm * 256 + 64 * wr + fr, col0 = u.pn * 256 + 32 * wc + 8 * fq;
    auto load = [&](int gidx) { const int bj = gidx >> 3, ai = (gidx >> 2) & 1, m = gidx & 3; const int row = row0 + 128 * ai + 16 * m; const size_t go = (size_t)row * 1024 + col0 + 128 * bj;
      Ld l;
      l.hh = *(const u32x4*)((const u16*)(P.ws + A_H2B) + go); l.ee = *(const u32x4*)((const u16*)(P.ws + A_EBF) + go); return l; };
    Ld cur = load(0);
    float gv[8];
#pragma unroll
    for (int gidx = 0; gidx < 16; ++gidx) {
      const int bj = gidx >> 3, ai = (gidx >> 2) & 1, m = gidx & 3;
      if ((gidx & 7) == 0) { const float4 ga = *(const float4*)(P.g_ple + col0 + 128 * bj), gb = *(const float4*)(P.g_ple + col0 + 128 * bj + 4);
        gv[0] = ga.x; gv[1] = ga.y; gv[2] = ga.z; gv[3] = ga.w; gv[4] = gb.x; gv[5] = gb.y; gv[6] = gb.z; gv[7] = gb.w; }
      Ld nxt = cur;
      if (gidx < 15) nxt = load(gidx + 1);
      const size_t go = (size_t)(row0 + 128 * ai + 16 * m) * 1024 + col0 + 128 * bj;
      const int row = row0 + 128 * ai + 16 * m;
      const float rs2 = rstd2[row], rE = rstdE[row];
      float hv[8];
#pragma unroll
      for (int k = 0; k < 8; ++k) hv[k] = __uint_as_float((cur.hh[k >> 1] << ((k & 1) ? 0u : 16u)) & 0xffff0000u);
      const f32x4 a = acc[ai][bj][m][0], c4 = acc[ai][bj][m][1];
      const float av[8] = {a[0], a[1], a[2], a[3], c4[0], c4[1], c4[2], c4[3]};
      const unsigned eeu[4] = {cur.ee[0], cur.ee[1], cur.ee[2], cur.ee[3]};
#pragma unroll
      for (int k = 0; k < 8; ++k) {
        const unsigned sh = (k & 1) ? 0u : 16u;
        const float ev = __uint_as_float((eeu[k >> 1] << sh) & 0xffff0000u);
        const float sg = __builtin_amdgcn_rcpf(1.0f + __expf(-av[k] * rs2));
        hv[k] = hv[k] + ev * rE * gv[k] * sg;
      }
      float* wr_ = P.out + go;
      __builtin_nontemporal_store((f32x4){hv[0], hv[1], hv[2], hv[3]}, (f32x4*)wr_); __builtin_nontemporal_store((f32x4){hv[4], hv[5], hv[6], hv[7]}, (f32x4*)(wr_ + 4));
      asm volatile("" ::: "memory");
      cur = nxt;
    }
  }
};
DI void ph8_final8(const Ptrs& P, ldsp lds, int bid, int G) {
  EpiFinal E; E.Pp = &P; g8::GridOrder S; S.init(64, 4, G, bid);
  g8::gemm_phase<EpiFinal, g8::GridOrder, false, false>(lds, (const unsigned char*)(P.ws + A_H2B), (const unsigned char*)(P.ws + WS_WPLG), 1024, S, E);
}

template <bool SHIFT>
DI void da_item8(const Ptrs& P, ldsp lds, int item, float lam, float m2) {
  const int tid = threadIdx.x, lane = tid & 63, wave = __builtin_amdgcn_readfirstlane(tid >> 6), h = lane >> 5, i31 = lane & 31;
  const int xcd = item & 7, loc = item >> 3, bh = 2 * xcd + (loc >> 4), qblk = loc & 15;
  const u16* qA = (const u16*)(P.ws + A_QA) + (size_t)bh * 4096 * 128;
  const u16* kA = (const u16*)(P.ws + A_KA) + (size_t)bh * 4096 * 128;
  const u16* vAt = (const u16*)(P.ws + A_VAT) + (size_t)bh * 128 * 4096;
  const int q = qblk * 256 + 32 * wave + i31;
  bf16x8 qf[2][4];
#pragma unroll
  for (int c = 0; c < 2; ++c)
#pragma unroll
    for (int s = 0; s < 4; ++s) qf[c][s] = *(const bf16x8*)(qA + (size_t)q * 128 + c * 64 + 16 * s + 8 * h);
  auto stage = [&](int buf, int tile) {
    int ln = lane; asm volatile("" : "+v"(ln));
    ldsp lk = lds + buf * DA_STAGE;
    const u16* kt = kA + (size_t)tile * 64 * 128;
    const u16* vt = vAt + tile * 64;
#pragma unroll
    for (int qq = 0; qq < 2; ++qq) {
      const int jj = 2 * wave + qq;
      const int ra = key_of(0, jj), rb = key_of(1, jj);
      const int ku = ln >> 4, key = 32 * (ku >> 1) + ((ku & 1) ? rb : ra);
      glds16(kt + key * 128 + (ln & 15) * 8, lk + jj * 1040);
      const int vu = ln >> 3, d = 32 * (vu >> 1) + ((vu & 1) ? rb : ra);
      glds16(vt + d * 4096 + (ln & 7) * 8, lk + DA_VOFF + jj * 1040);
    }
  };
  const int rk = rank_of(i31), gr = grp_of(i31);
  const int kbase = rk * 1040 + gr * 256 + h * 16;
  const int vbase = DA_VOFF + rk * 1040 + gr * 128 + h * 16;
  f32x16 O1[4], O2[4];
#pragma unroll
  for (int dt = 0; dt < 4; ++dt)
#pragma unroll
    for (int e = 0; e < 16; ++e) { O1[dt][e] = 0.f; O2[dt][e] = 0.f; }
  float l1 = 0.f, l2 = 0.f;
  bf16x8 pf[2][2];
  auto se = [&](ldsp lk) {
#pragma unroll
    for (int c = 0; c < 2; ++c) {
      f32x16 sa;
#pragma unroll
      for (int e = 0; e < 16; ++e) sa[e] = 0.f;
#pragma unroll
      for (int s = 0; s < 4; ++s) {
        const bf16x8 kf = *(LAS bf16x8*)(lk + c * 128 + s * 32);
        sa = __builtin_amdgcn_mfma_f32_32x32x16_bf16(kf, qf[c][s], sa, 0, 0, 0);
      }
      float ls = 0.f;
#pragma unroll
      for (int e = 0; e < 16; ++e) { sa[e] = __builtin_amdgcn_exp2f(SHIFT ? sa[e] - m2 : sa[e]); ls += sa[e]; }
      if (c == 0) l1 += ls; else l2 += ls;
      pf[c][0] = packp(sa, 0); pf[c][1] = packp(sa, 1);
    }
  };
  auto pv = [&](ldsp lv) {
    bf16x8 va = *(LAS bf16x8*)(lv), vb = *(LAS bf16x8*)(lv + 256);
#pragma unroll
    for (int st = 0; st < 4; ++st) {
      const int s2 = st >> 1, dtp = st & 1;
      bf16x8 na = va, nb = vb;
      if (st < 3) { const int s2n = (st + 1) >> 1, dn = (st + 1) & 1; na = *(LAS bf16x8*)(lv + s2n * 32 + dn * 512); nb = *(LAS bf16x8*)(lv + s2n * 32 + dn * 512 + 256); }
      __builtin_amdgcn_sched_barrier(0);
      __builtin_amdgcn_s_setprio(1);
      O1[2 * dtp] = __builtin_amdgcn_mfma_f32_32x32x16_bf16(va, pf[0][s2], O1[2 * dtp], 0, 0, 0);
      O2[2 * dtp] = __builtin_amdgcn_mfma_f32_32x32x16_bf16(va, pf[1][s2], O2[2 * dtp], 0, 0, 0);
      O1[2 * dtp + 1] = __builtin_amdgcn_mfma_f32_32x32x16_bf16(vb, pf[0][s2], O1[2 * dtp + 1], 0, 0, 0);
      O2[2 * dtp + 1] = __builtin_amdgcn_mfma_f32_32x32x16_bf16(vb, pf[1][s2], O2[2 * dtp + 1], 0, 0, 0);
      __builtin_amdgcn_s_setprio(0);
      __builtin_amdgcn_sched_barrier(0);
      va = na; vb = nb;
    }
  };
  __syncthreads();
  stage(0, 0);
  stage(1, 1);
  asm volatile("s_waitcnt vmcnt(4)" ::: "memory");
  __builtin_amdgcn_s_barrier();
  if (wave < 4) {
    for (int tile = 0; tile < 64; ++tile) {
      if (tile + 2 < 64) stage((tile + 2) & 3, tile + 2);
      ldsp lb = lds + (tile & 3) * DA_STAGE;
#pragma unroll 1
      for (int kt2 = 0; kt2 < 2; ++kt2) {
        se(lb + kbase + kt2 * 512);
        __builtin_amdgcn_sched_barrier(0);
        pv(lb + vbase + kt2 * 64);
      }
      if (tile + 2 < 64) asm volatile("s_waitcnt vmcnt(4)" ::: "memory"); else asm volatile("s_waitcnt vmcnt(0)" ::: "memory");
      __builtin_amdgcn_s_barrier();
    }
  } else {
    for (int tile = 0; tile < 64; ++tile) {
      if (tile + 2 < 64) stage((tile + 2) & 3, tile + 2);
      ldsp lb = lds + (tile & 3) * DA_STAGE;
      ldsp lbp = lds + ((tile + 3) & 3) * DA_STAGE;
#pragma unroll 1
      for (int kt2 = 0; kt2 < 2; ++kt2) {
        if (tile + kt2 > 0) pv(kt2 == 0 ? lbp + vbase + 64 : lb + vbase);
        __builtin_amdgcn_sched_barrier(0);
        se(lb + kbase + kt2 * 512);
        __builtin_amdgcn_sched_barrier(0);
      }
      if (tile + 2 < 64) asm volatile("s_waitcnt vmcnt(4)" ::: "memory"); else asm volatile("s_waitcnt vmcnt(0)" ::: "memory");
      __builtin_amdgcn_s_barrier();
    }
    pv(lds + 3 * DA_STAGE + vbase + 64);
  }
  l1 += __shfl_xor(l1, 32); l2 += __shfl_xor(l2, 32);
  const float i1 = 1.0f / l1, i2 = lam / l2;
  float ss = 0.f;
#pragma unroll
  for (int dt = 0; dt < 4; ++dt)
#pragma unroll
    for (int e = 0; e < 16; ++e) { const float o = O1[dt][e] * i1 - O2[dt][e] * i2; O1[dt][e] = o; ss += o * o; }
  ss += __shfl_xor(ss, 32);
  const float rn = rsqrtf(ss * (1.0f / 128.0f) + EPS) * (1.0f - LAM_INIT);
  const int b = bh >> 2, hh = bh & 3;
  u16* dst = (u16*)(P.ws + A_AO) + ((size_t)b * 4096 + q) * 1024 + hh * 128;
#pragma unroll
  for (int dt = 0; dt < 4; ++dt)
#pragma unroll
    for (int g = 0; g < 4; ++g) {
      const int d0 = 32 * dt + 8 * g + 4 * h;
      const float4 gs = *(const float4*)(kargs_now()->g_sub + d0);
      *(uint2*)(dst + d0) = make_uint2(pk2(O1[dt][4 * g] * rn * gs.x, O1[dt][4 * g + 1] * rn * gs.y), pk2(O1[dt][4 * g + 2] * rn * gs.z, O1[dt][4 * g + 3] * rn * gs.w));
    }
}

constexpr int NA8_VSTRIDE = 1936;
constexpr int NA8_TAB = 32 * NA8_VSTRIDE;
DI void na_block8(const Ptrs& P, ldsp lds, int item, float qkbound) {
  const int tid = threadIdx.x, lane = tid & 63, wave = tid >> 6;
  const int r0 = (item & 7) * 8, hd = (item >> 3) & 15, b = item >> 7;
  const int qi = lane & 15, g = lane >> 4;
  LAS float* EB = (LAS float*)(lds + NA8_TAB);
  LAS float* RW = EB + 960;
  const int R0 = min(max(r0 - 4, 0), 56), NR = min(15, 64 - R0);
  const u16* vB = (const u16*)(P.ws + A_VBT) + (size_t)(b * 16 + hd) * 32 * 4096;
  __syncthreads();
  {
    u32x4 vv[8];
#pragma unroll
    for (int k = 0; k < 8; ++k) {
      const int sg = (tid >> 3) + 64 * k, d = sg / NR, kr = sg - d * NR;
      vv[k] = *(const u32x4*)(vB + (size_t)min(d, 31) * 4096 + (R0 + min(kr, NR - 1)) * 64 + 8 * (tid & 7));
    }
    float mxa = 0.f;
    const float r0v = (tid < 465) ? P.rpb[hd * 465 + tid] : 0.f;
    mxa = fabsf(r0v);
#pragma unroll
    for (int o = 1; o < 64; o <<= 1) mxa = fmaxf(mxa, __shfl_xor(mxa, o));
    LAS float* red = (LAS float*)(lds + NA8_TAB + 7680);
    if (lane == 0) red[wave] = mxa;
#pragma unroll
    for (int k = 0; k < 8; ++k) {
      const int sg = (tid >> 3) + 64 * k, d = sg / NR, kr = sg - d * NR;
      if (sg < 32 * NR) *(LAS u32x4*)(lds + d * NA8_VSTRIDE + kr * 128 + 16 * (tid & 7)) = vv[k];
    }
    __syncthreads();
    const float m2 = (qkbound + fmaxf(fmaxf(fmaxf(red[0], red[1]), fmaxf(red[2], red[3])), fmaxf(fmaxf(red[4], red[5]), fmaxf(red[6], red[7])))) * LOG2E;
    for (int e = tid; e < 960; e += 512) {
      const int br = e >> 6, co = (e & 63) - 16;
      const float v = (co >= 0 && co <= 30) ? P.rpb[hd * 465 + br * 31 + co] * LOG2E - m2 : -1e30f;
      RW[e] = v;
      EB[e] = (co >= 7 && co <= 22) ? v : -1e30f;
    }
    __syncthreads();
  }
  const int r = r0 + wave;
  const int rs = min(max(r - 4, 0), 56), rb0 = rs - r + 7;
  const u16* qB = (const u16*)(P.ws + A_QB) + (size_t)(b * 16 + hd) * 4096 * 32;
  const u16* kBp = (const u16*)(P.ws + A_KB) + (size_t)(b * 16 + hd) * 4096 * 32;
  bf16x8 kf[16], qf;
  auto issue_kq = [&](int jq) {
    const int kb = min(min(max(16 * jq - 8, 0), 48), 32);
    const u16* kp = kBp + (size_t)(rs * 64 + kb + qi) * 32 + 8 * g;
    qf = *(const bf16x8*)(qB + (size_t)(r * 64 + 16 * jq + qi) * 32 + 8 * g);
#pragma unroll
    for (int ri = 0; ri < 8; ++ri)
#pragma unroll
      for (int t = 0; t < 2; ++t) kf[2 * ri + t] = *(const bf16x8*)(kp + (ri * 64 + 16 * t) * 32);
  };
  issue_kq(0);
#pragma unroll 1
  for (int jq = 0; jq < 4; ++jq) {
    const int kb = min(min(max(16 * jq - 8, 0), 48), 32);
    const LAS float* tb[2];
    {
      const int cobase = (jq == 0) ? 15 : ((jq == 3) ? -1 : 7);
#pragma unroll
      for (int t = 0; t < 2; ++t) {
        const int off = rb0 * 64 + cobase + 16 * t + 4 * g - qi + 16;
        const LAS float* pe = EB + off; const LAS float* pr = RW + off; const LAS float* pn = RW + 48;
        const LAS float* sel = pe;
        if (jq == 0 && qi < 8) sel = (t == 0) ? pr : pn;
        if (jq == 3 && qi > 8) sel = (t == 1) ? pr : pn;
        tb[t] = sel;
      }
    }
    f32x4 sa[8][2];
#pragma unroll
    for (int ri = 0; ri < 8; ++ri)
#pragma unroll
      for (int t = 0; t < 2; ++t) {
        const LAS float* tp = tb[t] + ri * 64;
        const f32x4 ci = {tp[0], tp[1], tp[2], tp[3]};
        sa[ri][t] = __builtin_amdgcn_mfma_f32_16x16x32_bf16(kf[2 * ri + t], qf, ci, 0, 0, 0);
      }
    __builtin_amdgcn_sched_barrier(0);
    if (jq + 1 < 4) issue_kq(jq + 1);
    __builtin_amdgcn_sched_barrier(0);
    float l = 0.f;
    f32x4 oa[2] = {{0.f, 0.f, 0.f, 0.f}, {0.f, 0.f, 0.f, 0.f}};
    ldsp vl = lds + qi * NA8_VSTRIDE + (rs - R0) * 128 + (kb + 4 * g) * 2;
#pragma unroll
    for (int ri = 0; ri < 8; ++ri) {
      float p[8];
#pragma unroll
      for (int t = 0; t < 2; ++t)
#pragma unroll
        for (int i = 0; i < 4; ++i) { const float e = __builtin_amdgcn_exp2f(sa[ri][t][i]); p[4 * t + i] = e; l += e; }
      u32x4 pp; pp[0] = pk2(p[0], p[1]); pp[1] = pk2(p[2], p[3]); pp[2] = pk2(p[4], p[5]); pp[3] = pk2(p[6], p[7]);
      const bf16x8 pfr = __builtin_bit_cast(bf16x8, pp);
#pragma unroll
      for (int dtl = 0; dtl < 2; ++dtl) {
        const s16x4 lo = *(LAS s16x4*)(vl + dtl * 16 * NA8_VSTRIDE + ri * 128), hi = *(LAS s16x4*)(vl + dtl * 16 * NA8_VSTRIDE + ri * 128 + 32);
        const bf16x8 vf = __builtin_shufflevector(lo, hi, 0, 1, 2, 3, 4, 5, 6, 7);
        oa[dtl] = __builtin_amdgcn_mfma_f32_16x16x32_bf16(vf, pfr, oa[dtl], 0, 0, 0);
      }
    }
    l += __shfl_xor(l, 16); l += __shfl_xor(l, 32);
    const float il = 1.0f / l;
    u16* dst = (u16*)(P.ws + A_AO) + ((size_t)b * 4096 + r * 64 + 16 * jq + qi) * 1024 + 512 + hd * 32;
#pragma unroll
    for (int dtl = 0; dtl < 2; ++dtl)
      *(uint2*)(dst + 16 * dtl + 4 * g) = make_uint2(pk2(oa[dtl][0] * il, oa[dtl][1] * il), pk2(oa[dtl][2] * il, oa[dtl][3] * il));
  }
}

DI void ph2_attn8(const Ptrs& P, ldsp lds, int bid, int G) {
  const float* sc = (const float*)(P.ws + WS_SCAL);
  const float lam = sc[0], m2 = sc[1], qkb = sc[2];
  if (m2 < 64.0f) { for (int it = bid; it < 256; it += G) da_item8<false>(P, lds, it, lam, m2); }
  else { for (int it = bid; it < 256; it += G) da_item8<true>(P, lds, it, lam, m2); }
  for (int it = bid; it < 512; it += G) na_block8(P, lds, it, qkb);
}

__global__ void __launch_bounds__(512, 2) mega8(Ptrs Pk, int ph_lo, int ph_hi) {
  extern __shared__ __attribute__((aligned(16))) unsigned char smem[];
  ldsp lds = (ldsp)smem;
  const int bid = blockIdx.x, G = gridDim.x;
  volatile LAS unsigned* st = (volatile LAS unsigned*)(lds + g8::LDS_EXTRA8 + 4080);
  XcdBarrier xb; xb.bar = (unsigned*)(Pk.ws + WS_CTL); xb.x = 0; xb.st = st;
  if (ph_hi - ph_lo > 1) {
    if (threadIdx.x == 0) { st[0] = 0u; st[1] = 0u; }
    __syncthreads();
    xb = xcd_barrier_post((unsigned*)(Pk.ws + WS_CTL), st);
  }
#define RUN_PHASE8(k, call) if (ph_lo <= k && k < ph_hi) { { const Ptrs P = load_args(); call; } if (k + 1 < ph_hi) xcd_barrier(xb); }
  RUN_PHASE8(0, ph0_prep(P, lds, bid, G))
  RUN_PHASE8(1, ph1_inproj8(P, lds, bid, G))
  RUN_PHASE8(2, ph2_attn8(P, lds, bid, G))
  RUN_PHASE8(3, ph3_outproj8(P, lds, bid, G))
  RUN_PHASE8(4, ph4_router(P, lds, bid, G))
  RUN_PHASE8(5, ph5_up8(P, lds, bid, G))
  RUN_PHASE8(6, ph6_down8(P, lds, bid, G))
  RUN_PHASE8(7, ph7_combine(P, lds, bid, G))
  RUN_PHASE8(8, ph8_final8(P, lds, bid, G))
}
extern "C" void kernel_launch(void* const* d_in, const int* in_sizes, int n_in, void* d_out, int out_size, void* d_ws, size_t ws_size,
                              hipStream_t stream) {
  static int grid = 0;
  if (grid == 0) {
    if (n_in != 25 || ws_size < WS_END || out_size != T * DM) { fprintf(stderr, "kernel_launch: unexpected n_in %d / out %d / ws_size %zu (need %zu)\\n", n_in, out_size, ws_size, (size_t)WS_END); grid = -1; return; }
    int dev = 0, cus = 0, per_cu = 0;
    (void)hipGetDevice(&dev);
    (void)hipDeviceGetAttribute(&cus, hipDeviceAttributeMultiprocessorCount, dev);
    (void)hipFuncSetAttribute((const void*)mega8, hipFuncAttributeMaxDynamicSharedMemorySize, g8::LDS_BYTES8);
    (void)hipOccupancyMaxActiveBlocksPerMultiprocessor(&per_cu, (const void*)mega8, 512, g8::LDS_BYTES8);
    if (per_cu < 1) { fprintf(stderr, "kernel_launch: occupancy query returned %d\\n", per_cu); grid = -1; return; }
    grid = cus;
  }
  if (grid < 0) return;
  Ptrs P{};
  const float** pp = (const float**)&P;
  for (int i = 0; i < 25; ++i) pp[i] = (const float*)d_in[i];
  P.out = (float*)d_out; P.ws = (unsigned char*)d_ws;
  (void)hipMemsetAsync((unsigned char*)d_ws + WS_CTL, 0, XCD_BAR_WORDS * 4, stream);
  mega8<<<grid, 512, g8::LDS_BYTES8, stream>>>(P, 0, 9);
}
```

```cpp
#define ONE_LAUNCH 2
#define NEW_MASK 0x1ff
#include <hip/hip_runtime.h>
#include <cstdio>
#include <cstdint>

typedef unsigned short u16;
#define DI __device__ __forceinline__

constexpr int T = 16384, S = 4096, DM = 1024, NB = 4;
constexpr int DIN = 3072, DPLE = 256;
constexpr int HA = 4, HB = 16;
constexpr int NE = 32, DE = 512;
constexpr float EPS = 1e-6f;
constexpr float LOG2E = 1.4426950408889634f;
constexpr float LAM_INIT = 0.2f;

constexpr size_t MiB = 1ull << 20;
constexpr size_t WS_WIN = 0, WS_WOUT = 6 * MiB, WS_W13 = 8 * MiB, WS_W2 = 72 * MiB, WS_WPLG = 104 * MiB,
                 WS_WPLE = 106 * MiB, WS_WR = 106 * MiB + 512 * 1024, WS_ROPE = 107 * MiB;
constexpr size_t WS_SMALL = 108 * MiB;
constexpr size_t WS_RSTDX = WS_SMALL;
constexpr size_t WS_SSQ1P = 250 * MiB;
constexpr size_t WS_SSQEP = 251 * MiB;
constexpr int SSQ_PARTS = 16;
constexpr size_t WS_RSTD1 = WS_RSTDX + 65536;
constexpr size_t WS_RSTD2 = WS_RSTD1 + 65536;
constexpr size_t WS_SCAL  = WS_RSTD2 + 65536;
constexpr size_t WS_CNT   = WS_SCAL + 256;
constexpr int CNT_STRIDE = 64;
constexpr size_t WS_PADST = WS_CNT + 8192;
constexpr size_t WS_CTL   = WS_PADST + 256;
constexpr size_t WS_RSTDE = WS_CTL + 16384;
constexpr size_t WS_PAR   = WS_SMALL + 1 * MiB;
constexpr int PAR_GQA = 0, PAR_GKA = 64, PAR_GSUB = 128, PAR_GQB = 256, PAR_GKB = 288, PAR_GPLE = 320, PAR_RPB = 1344, PAR_TOTAL = 1344 + 7440;
constexpr size_t WS_TOKL  = WS_SMALL + 2 * MiB;
constexpr size_t WS_WL    = WS_SMALL + 4 * MiB;
constexpr size_t WS_ACT   = 114 * MiB;
constexpr size_t A_XB = WS_ACT, A_AO = 260 * MiB, A_HID = WS_ACT, A_H2B = WS_ACT;
constexpr size_t A_PB = 252 * MiB;
constexpr size_t A_QA = WS_ACT + 40 * MiB, A_KA = WS_ACT + 56 * MiB, A_VAT = WS_ACT + 72 * MiB,
                 A_QB = WS_ACT + 88 * MiB, A_KB = WS_ACT + 104 * MiB, A_VBT = WS_ACT + 120 * MiB;
constexpr size_t A_RSL = 260 * MiB;
constexpr size_t A_H1B = WS_ACT + 40 * MiB, A_EBF = WS_ACT + 72 * MiB, A_Y0 = WS_ACT + 104 * MiB, A_Y1 = 260 * MiB;
constexpr size_t WS_END = 292 * MiB;

DI float bf2f(u16 u) { return __uint_as_float(((unsigned)u) << 16); }
DI u16 f2bf(float f) { __bf16 b = (__bf16)f; return __builtin_bit_cast(u16, b); }
DI int permpos(int s) { return (s & ~12) | ((s & 8) >> 1) | ((s & 4) << 1); }

struct Ptrs {
  const float *x, *p, *g_mix, *w_in, *g_qa, *g_ka, *lam_q1, *lam_k1, *lam_q2, *lam_k2, *g_sub, *g_qb, *g_kb, *rpb, *w_out,
      *g_ffn, *w_rg, *w_re, *w1, *w3, *w2, *g_plg, *w_plg, *w_ple, *g_ple;
  float* out;
  unsigned char* ws;
};

#define GAS __attribute__((address_space(1)))
#define LAS __attribute__((address_space(3)))
typedef LAS unsigned char* ldsp;
typedef __attribute__((ext_vector_type(8))) short bf16x8;
typedef __attribute__((ext_vector_type(16))) float f32x16;
typedef __attribute__((ext_vector_type(4))) float f32x4;
typedef __attribute__((ext_vector_type(2))) float f32x2v;
typedef __attribute__((ext_vector_type(2))) __bf16 bf16x2v;
DI unsigned pk2(float a, float b) { bf16x2v v = __builtin_convertvector((f32x2v){a, b}, bf16x2v); return __builtin_bit_cast(unsigned, v); }
DI float wave_sum(float v) {
#pragma unroll
  for (int o = 1; o < 64; o <<= 1) v += __shfl_xor(v, o);
  return v;
}
DI void glds16(const void* g, ldsp l) { __builtin_amdgcn_global_load_lds((const GAS unsigned*)g, (LAS unsigned*)l, 16, 0, 0); }
DI void lds_wave_sync() { asm volatile("s_waitcnt lgkmcnt(0)" ::: "memory"); }

#define XB_TMO      128
#define XB_XCNT(j)  (256  + 64 * (j))
#define XB_XSUB(j)  (1280 + 64 * (j))
#define XB_XGEN(j)  (2304 + 64 * (j))
#define XB_TOP      3328
#define XB_TOPGEN   3392
#define XCD_BAR_WORDS 3456
#define XB_SPIN_CAP (1u << 22)
DI unsigned xb_ld(unsigned* p) { return __hip_atomic_load(p, __ATOMIC_RELAXED, __HIP_MEMORY_SCOPE_AGENT); }
DI unsigned xb_add(unsigned* p, unsigned v) { return __hip_atomic_fetch_add(p, v, __ATOMIC_RELAXED, __HIP_MEMORY_SCOPE_AGENT); }
DI unsigned xb_xcc_id() { return (unsigned)__builtin_amdgcn_s_getreg((3 << 11) | 20) & 0xFu; }
#define XB_SPIN(cond, bar) do { unsigned _sp = 0; while (cond) { __builtin_amdgcn_s_sleep(1); \
    if ((++_sp & 255u) == 0u) { if (xb_ld(&(bar)[XB_TMO])) break; if (_sp > XB_SPIN_CAP) { atomicAdd(&(bar)[XB_TMO], 1u); break; } } } } while (0)
struct XcdBarrier { unsigned* bar; unsigned x; volatile LAS unsigned* st; };
DI XcdBarrier xcd_barrier_post(unsigned* bar, volatile LAS unsigned* st) {
  XcdBarrier b; b.bar = bar; b.x = xb_xcc_id(); b.st = st;
  if (threadIdx.x == 0) (void)xb_add(&bar[XB_XCNT(b.x)], 1u);
  return b;
}
DI void xcd_barrier_complete(unsigned* bar, unsigned x, unsigned& nloc, unsigned& nx) {
  const unsigned G = gridDim.x;
  unsigned sum, cnt, mine, sp = 0u;
  for (;;) {
    sum = 0u; cnt = 0u; mine = 0u;
#pragma unroll
    for (unsigned j = 0; j < 16; ++j) { const unsigned c = xb_ld(&bar[XB_XCNT(j)]); sum += c; cnt += (c > 0u) ? 1u : 0u; mine = (j == x) ? c : mine; }
    if (sum == G) break;
    __builtin_amdgcn_s_sleep(1);
    if ((++sp & 255u) == 0u) { if (xb_ld(&bar[XB_TMO])) break; if (sp > XB_SPIN_CAP) { atomicAdd(&bar[XB_TMO], 1u); break; } }
  }
  nloc = mine > 0u ? mine : 1u; nx = cnt > 0u ? cnt : 1u;
}
DI void xcd_barrier(const XcdBarrier& b) {
  asm volatile("s_waitcnt vmcnt(0)" ::: "memory");
  __syncthreads();
  if (threadIdx.x == 0) {
    unsigned* bar = b.bar;
    __builtin_amdgcn_s_waitcnt(0);
    unsigned nloc = b.st[0], nx = b.st[1];
    if (nloc == 0u) { xcd_barrier_complete(bar, b.x, nloc, nx); b.st[0] = nloc; b.st[1] = nx; }
    const unsigned old = xb_add(&bar[XB_XSUB(b.x)], 1u);
    const unsigned gen = old / nloc;
    if (old + 1u == (gen + 1u) * nloc) {
      __builtin_amdgcn_fence(__ATOMIC_RELEASE, "agent");
      asm volatile("s_waitcnt vmcnt(0)" ::: "memory");
      const unsigned og = xb_add(&bar[XB_TOP], 1u);
      const unsigned tg = og / nx;
      if (og + 1u == (tg + 1u) * nx) xb_add(&bar[XB_TOPGEN], 1u);
      else XB_SPIN(xb_ld(&bar[XB_TOPGEN]) == tg, bar);
      __builtin_amdgcn_fence(__ATOMIC_ACQUIRE, "agent");
      xb_add(&bar[XB_XGEN(b.x)], 1u);
      asm volatile("s_waitcnt vmcnt(0)" ::: "memory");
    } else {
      XB_SPIN(xb_ld(&bar[XB_XGEN(b.x)]) == gen, bar);
      __builtin_amdgcn_fence(__ATOMIC_ACQUIRE, "agent");
      asm volatile("s_waitcnt vmcnt(0)" ::: "memory");
    }
  }
  __syncthreads();
}

DI int win8_row(int f);
DI int perm256(int f);
DI int w13_row_w1(int f);
DI int w13_row_w3(int f);
typedef int (*rowmap_t)(int);
template <rowmap_t rowmap = (rowmap_t) nullptr>
DI void tr_item(const float* W, int ldw, int k0, int n0, const float* gk, u16* dst0, u16* dst1, int ldd, LAS float* scr, int lane) {
  float4 v[16];
  const float* src = W + (size_t)(k0 + (lane >> 4)) * ldw + n0 + 4 * (lane & 15);
#pragma unroll
  for (int j = 0; j < 16; ++j) { const f32x4 t = __builtin_nontemporal_load((const f32x4*)(src + (size_t)(4 * j) * ldw)); v[j] = make_float4(t[0], t[1], t[2], t[3]); }
  if (gk) {
#pragma unroll
    for (int j = 0; j < 16; ++j) { const float g = gk[k0 + 4 * j + (lane >> 4)]; v[j].x *= g; v[j].y *= g; v[j].z *= g; v[j].w *= g; }
  }
  LAS float* w = scr + (lane >> 4) * 65 + 4 * (lane & 15);
#pragma unroll
  for (int j = 0; j < 16; ++j) { w[(4 * j) * 65] = v[j].x; w[(4 * j) * 65 + 1] = v[j].y; w[(4 * j) * 65 + 2] = v[j].z; w[(4 * j) * 65 + 3] = v[j].w; }
  lds_wave_sync();
  const int c = lane & 7;
#pragma unroll
  for (int j = 0; j < 8; ++j) {
    const int n = (lane >> 3) + 8 * j;
    const LAS float* s = scr + (8 * c) * 65 + n;
    uint4 o;
    o.x = pk2(s[0 * 65], s[1 * 65]); o.y = pk2(s[2 * 65], s[3 * 65]); o.z = pk2(s[4 * 65], s[5 * 65]); o.w = pk2(s[6 * 65], s[7 * 65]);
    u16* d = rowmap ? (dst0 + (size_t)rowmap(n0 + n) * ldd) : ((j < 4) ? (dst0 + (size_t)n * ldd) : (dst1 + (size_t)(n - 32) * ldd));
    *(uint4*)(d + k0 + 8 * c) = o;
  }
  lds_wave_sync();
}

typedef const __attribute__((address_space(4))) Ptrs* kargp_t;
DI kargp_t kargs_now() {
#if defined(__HIP_DEVICE_COMPILE__)
  kargp_t kp = (kargp_t)__builtin_amdgcn_kernarg_segment_ptr(); asm volatile("" : "+s"(kp)); return kp;
#else
  return nullptr;
#endif
}
DI Ptrs load_args() {
#if defined(__HIP_DEVICE_COMPILE__)
  kargp_t kp = kargs_now(); Ptrs r; __builtin_memcpy(&r, (const void*)kp, sizeof(Ptrs)); return r;
#else
  return Ptrs{};
#endif
}
DI void late_weight_item(int r, LAS float* scr, int lane) {
  unsigned char* const wsb = kargs_now()->ws;
  if (r < 4096) {
    u16* W2T = (u16*)(wsb + WS_W2);
    const int e = r >> 7, q = r & 127, kb = q >> 4, nb = q & 15;
    tr_item<perm256>(kargs_now()->w2 + (size_t)e * 512 * 1024, 1024, kb * 64, nb * 64, nullptr, W2T + (size_t)e * 1024 * 512, nullptr, 512, scr, lane);
  } else {
    r -= 4096;
    const int kb = r >> 4, nb = r & 15;
    tr_item<perm256>(kargs_now()->w_plg, 1024, kb * 64, nb * 64, kargs_now()->g_plg, (u16*)(wsb + WS_WPLG), nullptr, 1024, scr, lane);
  }
}
DI void ph0_prep(const Ptrs& Punused, ldsp lds, int bid, int G) {
  unsigned char* const wsb = kargs_now()->ws;
  const int tid = threadIdx.x, lane = tid & 63, wave = tid >> 6;
  LAS float* scr = (LAS float*)(lds + wave * 16640);
  const int nwv = blockDim.x >> 6, gw = bid * nwv + wave, NGW = G * nwv;
  constexpr int I_W1 = 4096, I_W3 = 4096, I_W2 = 4096, I_X = 8192, I_WIN = 768, I_P = 2048, I_WOUT = 256, I_PLG = 256, I_PLE = 64,
                I_WR = 768, I_ROPE = 2048, I_PAR = (PAR_TOTAL + 63) / 64, I_SC = 1;
  constexpr int TOTAL = I_W1 + I_W3 + I_W2 + I_X + I_WIN + I_P + I_WOUT + I_PLG + I_PLE + I_WR + I_ROPE + I_PAR + I_SC;
  u16* W13T = (u16*)(wsb + WS_W13); u16* W2T = (u16*)(wsb + WS_W2);
  for (int r0_ = gw; r0_ < I_W1 + I_W3; r0_ += NGW) {
    int r = r0_;
      const int isw3 = r >= I_W1; if (isw3) r -= I_W1;
      const int e = r >> 7, q = r & 127, kb = q >> 3, nb = q & 7;
      u16* d0 = W13T + ((size_t)e * 1024 + nb * 128 + isw3 * 32) * 1024;
#if NEW_MASK & 0x20
      if (isw3) tr_item<w13_row_w3>(kargs_now()->w3 + (size_t)e * 1024 * 512, 512, kb * 64, nb * 64, kargs_now()->g_ffn, W13T + (size_t)e * 1024 * 1024, nullptr, 1024, scr, lane);
      else tr_item<w13_row_w1>(kargs_now()->w1 + (size_t)e * 1024 * 512, 512, kb * 64, nb * 64, kargs_now()->g_ffn, W13T + (size_t)e * 1024 * 1024, nullptr, 1024, scr, lane);
#else
      tr_item((isw3 ? kargs_now()->w3 : kargs_now()->w1) + (size_t)e * 1024 * 512, 512, kb * 64, nb * 64, kargs_now()->g_ffn, d0, d0 + 64 * 1024, 1024, scr, lane);
#endif
  }
  for (int r0_ = gw; r0_ < I_X; r0_ += NGW) {
    int r = r0_;
      const float4* xr = (const float4*)(kargs_now()->x + (size_t)r * 2048) + lane;
      float4 v[8];
#pragma unroll
      for (int j = 0; j < 8; ++j) { const f32x4 t = __builtin_nontemporal_load((const f32x4*)(xr + 64 * j)); v[j] = make_float4(t[0], t[1], t[2], t[3]); }
      float s0 = 0.f, s1 = 0.f;
#pragma unroll
      for (int j = 0; j < 4; ++j) { s0 += v[j].x * v[j].x + v[j].y * v[j].y + v[j].z * v[j].z + v[j].w * v[j].w; s1 += v[j + 4].x * v[j + 4].x + v[j + 4].y * v[j + 4].y + v[j + 4].z * v[j + 4].z + v[j + 4].w * v[j + 4].w; }
      s0 = wave_sum(s0); s1 = wave_sum(s1);
      if (lane == 0) { float* rx = (float*)(wsb + WS_RSTDX); rx[2 * r] = rsqrtf(s0 * (1.0f / 1024.0f) + EPS); rx[2 * r + 1] = rsqrtf(s1 * (1.0f / 1024.0f) + EPS); }
      uint2* o = (uint2*)((u16*)(wsb + A_XB) + (size_t)r * 2048) + lane;
#pragma unroll
      for (int j = 0; j < 8; ++j) o[64 * j] = make_uint2(pk2(v[j].x, v[j].y), pk2(v[j].z, v[j].w));
  }
  for (int r0_ = gw; r0_ < I_WIN; r0_ += NGW) {
    int r = r0_;
      const int kb = r / 48, nb = r % 48;
      u16* d0 = (u16*)(wsb + WS_WIN) + (size_t)(nb * 64) * 1024;
      tr_item<win8_row>(kargs_now()->w_in, DIN, kb * 64, nb * 64, kargs_now()->g_mix, (u16*)(wsb + WS_WIN), nullptr, 1024, scr, lane);
  }
  for (int r0_ = gw; r0_ < I_P; r0_ += NGW) {
    int r = r0_;
      const float4* pr = (const float4*)kargs_now()->p + (size_t)r * 512 + lane;
      uint2* o = (uint2*)(wsb + A_PB) + (size_t)r * 512 + lane;
      float4 v[8];
#pragma unroll
      for (int j = 0; j < 8; ++j) { const f32x4 t = __builtin_nontemporal_load((const f32x4*)(pr + 64 * j)); v[j] = make_float4(t[0], t[1], t[2], t[3]); }
#pragma unroll
      for (int j = 0; j < 8; ++j) o[64 * j] = make_uint2(pk2(v[j].x, v[j].y), pk2(v[j].z, v[j].w));
  }
  for (int r0_ = gw; r0_ < I_WOUT; r0_ += NGW) {
    int r = r0_;
      const int kb = r >> 4, nb = r & 15;
      u16* d0 = (u16*)(wsb + WS_WOUT) + (size_t)(nb * 64) * 1024;
#if NEW_MASK & 0x8
      tr_item<perm256>(kargs_now()->w_out, 1024, kb * 64, nb * 64, nullptr, (u16*)(wsb + WS_WOUT), nullptr, 1024, scr, lane);
#else
      tr_item(kargs_now()->w_out, 1024, kb * 64, nb * 64, nullptr, d0, d0 + 32 * 1024, 1024, scr, lane);
#endif
  }
  for (int r0_ = gw; r0_ < I_PLE; r0_ += NGW) {
    int r = r0_;
      const int kb = r >> 4, nb = r & 15;
      u16* d0 = (u16*)(wsb + WS_WPLE) + (size_t)(nb * 64) * 256;
#if NEW_MASK & 0x8
      tr_item<perm256>(kargs_now()->w_ple, 1024, kb * 64, nb * 64, nullptr, (u16*)(wsb + WS_WPLE), nullptr, 256, scr, lane);
#else
      tr_item(kargs_now()->w_ple, 1024, kb * 64, nb * 64, nullptr, d0, d0 + 32 * 256, 256, scr, lane);
#endif
  }
  for (int r0_ = gw; r0_ < I_WR; r0_ += NGW) {
    int r = r0_;
      const int idx = r * 64 + lane, rr = idx >> 10, k = idx & 1023;
      float v = 0.f;
      if (rr < 4) v = kargs_now()->w_rg[k * 4 + rr]; else if (rr < 36) v = kargs_now()->w_re[k * 32 + (rr - 4)];
      const float wv_ = v * kargs_now()->g_ffn[k];
      const unsigned hb_ = pk2(wv_, 0.f) & 0xffffu;
      const unsigned lb_ = pk2(wv_ - __uint_as_float(hb_ << 16), 0.f) & 0xffffu;
      ((u16*)(wsb + WS_WR))[idx] = (u16)hb_; ((u16*)(wsb + WS_WR))[48 * 1024 + idx] = (u16)lb_;
  }
  for (int r0_ = gw; r0_ < I_ROPE; r0_ += NGW) {
    int r = r0_;
      const int idx = r * 64 + lane, s = idx >> 5, i = idx & 31;
      const float inv = powf(10000.0f, -(float)(2 * i) / 64.0f);
      const float ang = (float)s * inv;
      float sn, cs; sincosf(ang, &sn, &cs);
      ((float2*)(wsb + WS_ROPE))[idx] = make_float2(cs, sn);
  }
  for (int r0_ = gw; r0_ < I_PAR; r0_ += NGW) {
    int r = r0_;
      const int idx = r * 64 + lane;
      if (idx < PAR_TOTAL) {
        float v;
        if (idx < PAR_GKA) v = kargs_now()->g_qa[idx]; else if (idx < PAR_GSUB) v = kargs_now()->g_ka[idx - PAR_GKA]; else if (idx < PAR_GQB) v = kargs_now()->g_sub[idx - PAR_GSUB];
        else if (idx < PAR_GKB) v = kargs_now()->g_qb[idx - PAR_GQB]; else if (idx < PAR_GPLE) v = kargs_now()->g_kb[idx - PAR_GKB]; else if (idx < PAR_RPB) v = kargs_now()->g_ple[idx - PAR_GPLE];
        else v = kargs_now()->rpb[idx - PAR_RPB];
        ((float*)(wsb + WS_PAR))[idx] = v;
      }
  }
  if (gw == 0) {
    if (lane == 0) {
      float s1 = 0, s2 = 0, mq = 0, mk = 0;
      for (int i = 0; i < 64; ++i) {
        s1 += kargs_now()->lam_q1[i] * kargs_now()->lam_k1[i]; s2 += kargs_now()->lam_q2[i] * kargs_now()->lam_k2[i];
        mq = fmaxf(mq, fabsf(kargs_now()->g_qa[i])); mk = fmaxf(mk, fabsf(kargs_now()->g_ka[i]));
      }
      float* sc = (float*)(wsb + WS_SCAL);
      sc[0] = expf(s1) - expf(s2) + LAM_INIT;
      sc[1] = 8.0f * mq * mk * LOG2E;
      float mqb = 0, mkb = 0;
      for (int i = 0; i < 32; ++i) { mqb = fmaxf(mqb, fabsf(kargs_now()->g_qb[i])); mkb = fmaxf(mkb, fabsf(kargs_now()->g_kb[i])); }
      sc[2] = 5.656854249f * mqb * mkb;
      int* cnt = (int*)(wsb + WS_CNT);
      for (int i = 0; i < 32; ++i) cnt[i * CNT_STRIDE] = 0;
    }
  }
}

DI uint4 pk8(const f32x4 a, const f32x4 b) { return make_uint4(pk2(a[0], a[1]), pk2(a[2], a[3]), pk2(b[0], b[1]), pk2(b[2], b[3])); }

typedef __attribute__((ext_vector_type(4))) unsigned u32x4;
DI bf16x8 packp(const f32x16& x, int s) {
  u32x4 p;
  p[0] = pk2(x[8 * s + 0], x[8 * s + 1]); p[1] = pk2(x[8 * s + 2], x[8 * s + 3]);
  p[2] = pk2(x[8 * s + 4], x[8 * s + 5]); p[3] = pk2(x[8 * s + 6], x[8 * s + 7]);
  return __builtin_bit_cast(bf16x8, p);
}
DI int grp_of(int kk) { return ((kk >> 2) == 1 || (kk >> 2) == 2 || (kk >> 2) == 4 || (kk >> 2) == 7) ? 1 : 0; }
DI int rank_of(int kk) { const int q = kk >> 2; return kk - ((q == 0) ? 0 : (q <= 2) ? 4 : (q == 3 || q == 4) ? 8 : (q <= 6) ? 12 : 16); }
DI int key_of(int grp, int jj) { return grp ? (jj < 8 ? jj + 4 : (jj < 12 ? jj + 8 : jj + 16)) : (jj < 4 ? jj : (jj < 8 ? jj + 8 : jj + 12)); }
constexpr int DA_STAGE = 33280, DA_VOFF = 16640;
typedef __attribute__((ext_vector_type(4))) short s16x4;
DI void ph4_router_t(const Ptrs& P, ldsp lds, int bid, int G) {
  const int tid = threadIdx.x, lane = tid & 63, wave = __builtin_amdgcn_readfirstlane(tid >> 6), t = lane & 15, kk = lane >> 4;
  LAS float* lg = (LAS float*)lds;
  const u16* h1 = (const u16*)(P.ws + A_H1B); const u16* WrH = (const u16*)(P.ws + WS_WR);
  for (int item = bid; item < 256; item += G) {
    const int tok0 = item * 64;
    float4 s0 = make_float4(0.f, 0.f, 0.f, 0.f), s1 = s0, s2 = s0, s3 = s0;
    if (wave == 0) {
      const float* sp = (const float*)(P.ws + WS_SSQ1P) + (size_t)(tok0 + lane) * SSQ_PARTS;
      s0 = *(const float4*)sp; s1 = *(const float4*)(sp + 4); s2 = *(const float4*)(sp + 8); s3 = *(const float4*)(sp + 12);
    }
    f32x4 acc[4][3];
#pragma unroll
    for (int tt = 0; tt < 4; ++tt)
#pragma unroll
      for (int et = 0; et < 3; ++et) acc[tt][et] = (f32x4){0.f, 0.f, 0.f, 0.f};
    const u16* ap = h1 + (size_t)(tok0 + t) * 1024 + 128 * wave + 8 * kk;
    const u16* bp = WrH + (size_t)t * 1024 + 128 * wave + 8 * kk;
#pragma unroll
    for (int s = 0; s < 4; ++s) {
      bf16x8 a[4];
#pragma unroll
      for (int tt = 0; tt < 4; ++tt) a[tt] = *(const bf16x8*)(ap + (size_t)tt * 16 * 1024 + 32 * s);
#pragma unroll
      for (int et = 0; et < 3; ++et) {
        const bf16x8 bh = *(const bf16x8*)(bp + et * 16 * 1024 + 32 * s), bl = *(const bf16x8*)(bp + (48 + et * 16) * 1024 + 32 * s);
#pragma unroll
        for (int tt = 0; tt < 4; ++tt) {
          acc[tt][et] = __builtin_amdgcn_mfma_f32_16x16x32_bf16(a[tt], bh, acc[tt][et], 0, 0, 0);
          acc[tt][et] = __builtin_amdgcn_mfma_f32_16x16x32_bf16(a[tt], bl, acc[tt][et], 0, 0, 0);
        }
      }
    }
    __syncthreads();
#pragma unroll
    for (int tt = 0; tt < 4; ++tt)
#pragma unroll
      for (int et = 0; et < 3; ++et)
#pragma unroll
        for (int i = 0; i < 4; ++i) lg[wave * (64 * 49) + (16 * tt + 4 * kk + i) * 49 + 16 * et + t] = acc[tt][et][i];
    __syncthreads();
    if (wave == 0) {
      const int tok = tok0 + lane;
      const float rstd = rsqrtf(((s0.x + s0.y + s0.z + s0.w) + (s1.x + s1.y + s1.z + s1.w) + (s2.x + s2.y + s2.z + s2.w) + (s3.x + s3.y + s3.z + s3.w)) * (1.0f / 1024.0f) + EPS);
      const LAS float* L = lg + lane * 49;
      float gl[4] = {0.f, 0.f, 0.f, 0.f};
#pragma unroll
      for (int w = 0; w < 8; ++w)
#pragma unroll
        for (int i = 0; i < 4; ++i) gl[i] += L[w * (64 * 49) + i];
      int gi = 0; float gm = gl[0];
#pragma unroll
      for (int i = 1; i < 4; ++i) { if (gl[i] > gm) { gm = gl[i]; gi = i; } }
      float gs = 0.f;
#pragma unroll
      for (int i = 0; i < 4; ++i) gs += expf((gl[i] - gm) * rstd);
      const float gate = 1.0f / gs;
      const LAS float* el = L + 4 + 8 * gi;
      float ev[8] = {0.f, 0.f, 0.f, 0.f, 0.f, 0.f, 0.f, 0.f};
#pragma unroll
      for (int w = 0; w < 8; ++w)
#pragma unroll
        for (int i = 0; i < 8; ++i) ev[i] += el[w * (64 * 49) + i];
      int e1 = 0; float m1 = ev[0];
#pragma unroll
      for (int i = 1; i < 8; ++i) { if (ev[i] > m1) { m1 = ev[i]; e1 = i; } }
      int e2 = 0; float m2v = -3.0e38f;
#pragma unroll
      for (int i = 0; i < 8; ++i) { if (i != e1 && ev[i] > m2v) { m2v = ev[i]; e2 = i; } }
      const float p2 = expf((m2v - m1) * rstd);
      const float wa = gate / (1.0f + p2), wb = gate * p2 / (1.0f + p2);
      int* cnt = (int*)(P.ws + WS_CNT); int* tokl = (int*)(P.ws + WS_TOKL); float* wl = (float*)(P.ws + WS_WL);
      const int ea = gi * 8 + e1, eb = gi * 8 + e2;
      ((float*)(P.ws + WS_RSTD1))[tok] = rstd;
      int mycnt = 0, ra = 0, rb = 0;
#pragma unroll 4
      for (int e = 0; e < 32; ++e) {
        const unsigned long long ma = __ballot(ea == e), mb = __ballot(eb == e);
        const int ca = __popcll(ma);
        if (lane == e) mycnt = ca + __popcll(mb);
        if (ea == e) ra = __builtin_amdgcn_mbcnt_hi((unsigned)(ma >> 32), __builtin_amdgcn_mbcnt_lo((unsigned)ma, 0u));
        if (eb == e) rb = ca + __builtin_amdgcn_mbcnt_hi((unsigned)(mb >> 32), __builtin_amdgcn_mbcnt_lo((unsigned)mb, 0u));
      }
      int base = 0;
      if (lane < 32 && mycnt > 0) base = atomicAdd(&cnt[lane * CNT_STRIDE], mycnt);
      const int pa = __shfl(base, ea) + ra, pb = __shfl(base, eb) + rb;
      float* rsl = (float*)(P.ws + A_RSL);
      tokl[ea * 16384 + pa] = tok * 2; wl[ea * 16384 + pa] = wa; rsl[ea * 16384 + pa] = rstd;
      tokl[eb * 16384 + pb] = tok * 2 + 1; wl[eb * 16384 + pb] = wb; rsl[eb * 16384 + pb] = rstd;
    }
  }
}

DI void ph4_router(const Ptrs& P, ldsp lds, int bid, int G) {
  ph4_router_t(P, lds, bid, G);
}

DI void ph7_combine(const Ptrs& P, ldsp lds, int bid, int G) {
  const int lane = threadIdx.x & 63, wave = threadIdx.x >> 6;
  const int nwv = blockDim.x >> 6;
  for (int tok = bid * nwv + wave; tok < T; tok += G * nwv) {
    const uint2* hr = (const uint2*)((const u16*)(P.ws + A_H1B) + (size_t)tok * 1024) + lane;
    const uint2* y0 = (const uint2*)((const u16*)(P.ws + A_Y0) + (size_t)tok * 1024) + lane;
    const uint2* y1 = (const uint2*)((const u16*)(P.ws + A_Y1) + (size_t)tok * 1024) + lane;
    uint2* o = (uint2*)((u16*)(P.ws + A_H2B) + (size_t)tok * 1024) + lane;
    float ss = 0.f;
#pragma unroll
    for (int j = 0; j < 4; ++j) {
      const uint2 hv = hr[64 * j], a = y0[64 * j], c = y1[64 * j];
      const float v0 = __uint_as_float(hv.x << 16) + __uint_as_float(a.x << 16) + __uint_as_float(c.x << 16);
      const float v1 = __uint_as_float(hv.x & 0xffff0000u) + __uint_as_float(a.x & 0xffff0000u) + __uint_as_float(c.x & 0xffff0000u);
      const float v2 = __uint_as_float(hv.y << 16) + __uint_as_float(a.y << 16) + __uint_as_float(c.y << 16);
      const float v3 = __uint_as_float(hv.y & 0xffff0000u) + __uint_as_float(a.y & 0xffff0000u) + __uint_as_float(c.y & 0xffff0000u);
      ss += v0 * v0 + v1 * v1 + v2 * v2 + v3 * v3;
      o[64 * j] = make_uint2(pk2(v0, v1), pk2(v2, v3));
    }
    ss = wave_sum(ss);
    float se = (lane < SSQ_PARTS) ? ((const float*)(P.ws + WS_SSQEP))[(size_t)tok * SSQ_PARTS + lane] : 0.f;
    se = wave_sum(se);
    if (lane == 0) {
      ((float*)(P.ws + WS_RSTD2))[tok] = rsqrtf(ss * (1.0f / 1024.0f) + EPS);
      ((float*)(P.ws + WS_RSTDE))[tok] = rsqrtf(se * (1.0f / 1024.0f) + EPS);
    }
  }
}

namespace g8 {
constexpr int BM = 256, BK = 64, HALF = 128, HTB = HALF * BK * 2, STAGE_BYTES = 8 * HTB, NXCD = 8, WGM = 8;
constexpr int LDS_EXTRA8 = STAGE_BYTES;
constexpr int LDS_BYTES8 = STAGE_BYTES + 4096;
DI int lds_byte(int r, int c) { const int st = (r >> 4) * 2 + (c >> 5), rr = r & 15, cc = c & 31, ob = rr * 64 + cc * 2; return st * 1024 + (ob ^ (((ob >> 9) & 1) << 5)); }
DI void stage_rc(int b, int& R, int& C) { const int st = b / 1024, sb = b % 1024, swz = sb ^ (((sb >> 9) & 1) << 5); R = (st >> 1) * 16 + swz / 64; C = (st & 1) * 32 + (swz % 64) / 2; }

struct Unit { int pm, pn, e, ce; };
struct GridOrder {
  int nM, nN, nwg, G, c; unsigned pnmap;
  DI void init(int nM_, int nN_, int G_, int c_, unsigned pnmap_ = 0u) { nM = nM_; nN = nN_; nwg = nM * nN; G = G_; c = c_; pnmap = pnmap_; }
  DI bool next(int i, Unit& u) const {
    const int L = i * G + c; if (L >= nwg) return false;
    int wgid = L; { const int q = nwg / NXCD, r = nwg % NXCD, xcd = wgid % NXCD, off = wgid / NXCD; wgid = (xcd < r ? xcd * (q + 1) : r * (q + 1) + (xcd - r) * q) + off; }
    const int nig = WGM * nN, gid = wgid / nig, fm = gid * WGM, gsz = (nM - fm) < WGM ? (nM - fm) : WGM;
    u.pm = fm + ((wgid % nig) % gsz); u.pn = (wgid % nig) / gsz; if (pnmap) u.pn = (int)((pnmap >> (4 * u.pn)) & 15u); u.e = 0; u.ce = 0; return true;
  }
};

template <class Epi, class Sched, bool SWAP, bool GATHER>
DI void gemm_phase(ldsp lds, const unsigned char* Abase, const unsigned char* Bbase, int K, const Sched& S, const Epi& E, int pA = 0, int pB = 0) {
  if (pA == 0) pA = K; if (pB == 0) pB = K;
  int tid = threadIdx.x; asm volatile("" : "+v"(tid));
  const int wid = __builtin_amdgcn_readfirstlane(tid >> 6), lane = tid & 63, wr = wid >> 2, wc = wid & 3, fr = lane & 15, fq = lane >> 4;
  const int nt = K / BK;
  int sR[2], sC[2];
  unsigned voffB[2], voffA[2];
#pragma unroll
  for (int i = 0; i < 2; ++i) { stage_rc(tid * 16 + i * 8192, sR[i], sC[i]); voffB[i] = (unsigned)(sR[i] * pB + sC[i]) * 2u; voffA[i] = (unsigned)(sR[i] * pA + sC[i]) * 2u; }
  const size_t tstepA = (size_t)BM * pA * 2;
  const size_t kstep = (size_t)(BK * 2);
  const size_t hstep = (size_t)HALF * pB * 2, hstepA = (size_t)HALF * pA * 2;
  const unsigned ldsw = (unsigned)wid * 1024u;
  const int aoff = lds_byte(wr * 64 + fr, fq * 8), boff = lds_byte(wc * 32 + fr, fq * 8);
#define G8_SA(b, h) (((b) * 2 + (h)) * HTB)
#define G8_SB(b, h) ((4 + (b) * 2 + (h)) * HTB)
#define G8_STAGE_B(bufoff, gbase) do { _Pragma("unroll") for (int _i = 0; _i < 2; ++_i) \
    __builtin_amdgcn_global_load_lds((const GAS unsigned*)((const unsigned char*)(gbase) + voffB[_i]), (LAS unsigned*)(lds + (bufoff) + ldsw + _i * 8192), 16, 0, 0); } while (0)
#define G8_STAGE_A(bufoff, hsel, nx, koff) do { _Pragma("unroll") for (int _i = 0; _i < 2; ++_i) { \
    const unsigned char* _p; \
    if (GATHER) _p = Abase + (size_t)((nx) ? ((hsel) ? nv1[_i] : nv0[_i]) : ((hsel) ? cv1[_i] : cv0[_i])) + (koff); \
    else _p = ((nx) ? nA : cA) + ((hsel) ? hstepA : (size_t)0) + voffA[_i] + (koff); \
    __builtin_amdgcn_global_load_lds((const GAS unsigned*)_p, (LAS unsigned*)(lds + (bufoff) + ldsw + _i * 8192), 16, 0, 0); } } while (0)
#define G8_LDA(dst, b, h) do { _Pragma("unroll") for (int m = 0; m < 4; ++m) _Pragma("unroll") for (int k = 0; k < 2; ++k) dst[m][k] = *(const LAS bf16x8*)(lds + G8_SA(b, h) + aoff + m * 2048 + k * 1024); } while (0)
#define G8_LDB(dst, b, h) do { _Pragma("unroll") for (int n = 0; n < 2; ++n) _Pragma("unroll") for (int k = 0; k < 2; ++k) dst[n][k] = *(const LAS bf16x8*)(lds + G8_SB(b, h) + boff + n * 2048 + k * 1024); } while (0)
#define G8_MMA(ai, bj, At, Bt) do { __builtin_amdgcn_s_setprio(1); \
    _Pragma("unroll") for (int m = 0; m < 4; ++m) _Pragma("unroll") for (int n = 0; n < 2; ++n) _Pragma("unroll") for (int k = 0; k < 2; ++k) \
        acc[ai][bj][m][n] = SWAP ? __builtin_amdgcn_mfma_f32_16x16x32_bf16(At[m][k], Bt[n][k], acc[ai][bj][m][n], 0, 0, 0) \
                                 : __builtin_amdgcn_mfma_f32_16x16x32_bf16(Bt[n][k], At[m][k], acc[ai][bj][m][n], 0, 0, 0); \
    __builtin_amdgcn_s_setprio(0); } while (0)
#define G8_WAIT_V(n) asm volatile("s_waitcnt vmcnt(" #n ")" ::: "memory")
#define G8_WAIT_L(n) asm volatile("s_waitcnt lgkmcnt(" #n ")" ::: "memory")
#define G8_BAR __builtin_amdgcn_s_barrier()
#define G8_SCHED __builtin_amdgcn_sched_barrier(0)
  Unit cur, nxt; int ui = 0;
  if (!S.next(0, cur)) return;
  f32x4 acc[2][2][4][2];
#pragma unroll
  for (int a = 0; a < 2; ++a)
#pragma unroll
    for (int b = 0; b < 2; ++b)
#pragma unroll
      for (int m = 0; m < 4; ++m)
#pragma unroll
        for (int n = 0; n < 2; ++n) acc[a][b][m][n] = (f32x4){0.f, 0.f, 0.f, 0.f};
  bf16x8 At[4][2], B0[2][2], B1[2][2];
  unsigned cv0[2] = {0u, 0u}, cv1[2] = {0u, 0u}, nv0[2] = {0u, 0u}, nv1[2] = {0u, 0u};
  const unsigned char* cA = Abase; const unsigned char* nA = Abase;
  if (GATHER) E.a_off(cur, sR, sC, cv0, cv1); else cA = Abase + (size_t)cur.pm * tstepA;
  const unsigned char* cB = Bbase + E.b_off(cur);
  G8_STAGE_B(G8_SB(0, 0), cB); G8_STAGE_A(G8_SA(0, 0), 0, false, 0); G8_STAGE_B(G8_SB(0, 1), cB + hstep); G8_STAGE_A(G8_SA(0, 1), 1, false, 0);
  if (wr == 1) G8_BAR;
  G8_WAIT_V(4); G8_BAR;
  G8_STAGE_B(G8_SB(1, 0), cB + kstep); G8_STAGE_A(G8_SA(1, 0), 0, false, kstep); G8_STAGE_B(G8_SB(1, 1), cB + hstep + kstep);
  G8_WAIT_V(6); G8_BAR;
  for (;;) {
    const bool has_next = S.next(ui + 1, nxt);
    if (GATHER) { if (has_next) E.a_off(nxt, sR, sC, nv0, nv1); else { nv0[0] = cv0[0]; nv0[1] = cv0[1]; nv1[0] = cv1[0]; nv1[1] = cv1[1]; } }
    else nA = has_next ? Abase + (size_t)nxt.pm * tstepA : cA;
    const unsigned char* nB = has_next ? Bbase + E.b_off(nxt) : cB;
#pragma unroll 1
    for (int t = 0; t < nt; t += 2) {
      const bool last = (t == nt - 2);
      const size_t k1 = (size_t)(t + 1) * kstep;
      const size_t k2 = last ? 0 : (size_t)(t + 2) * kstep, k3 = k2 + kstep;
      const unsigned char* b2 = last ? nB : cB + (size_t)(t + 2) * kstep; const unsigned char* b3 = b2 + kstep;
      G8_LDB(B0, 0, 0); G8_SCHED; G8_LDA(At, 0, 0); G8_STAGE_A(G8_SA(1, 1), 1, false, k1);
      G8_WAIT_L(8); G8_BAR; G8_WAIT_L(0); G8_MMA(0, 0, At, B0); G8_BAR; G8_SCHED;
      G8_LDB(B1, 0, 1); G8_STAGE_B(G8_SB(0, 0), b2);
      G8_BAR; G8_WAIT_L(0); G8_MMA(0, 1, At, B1); G8_BAR;
      G8_LDA(At, 0, 1); G8_STAGE_A(G8_SA(0, 0), 0, last, k2);
      G8_BAR; G8_WAIT_L(0); G8_MMA(1, 0, At, B0); G8_BAR; G8_SCHED;
      G8_STAGE_B(G8_SB(0, 1), b2 + hstep);
      G8_WAIT_V(6); G8_BAR; G8_MMA(1, 1, At, B1); G8_BAR;
      G8_LDB(B0, 1, 0); G8_SCHED; G8_LDA(At, 1, 0); G8_STAGE_A(G8_SA(0, 1), 1, last, k2);
      G8_WAIT_L(8); G8_BAR; G8_WAIT_L(0); G8_MMA(0, 0, At, B0); G8_BAR; G8_SCHED;
      G8_LDB(B1, 1, 1); G8_STAGE_B(G8_SB(1, 0), b3);
      G8_BAR; G8_WAIT_L(0); G8_MMA(0, 1, At, B1); G8_BAR;
      G8_LDA(At, 1, 1); G8_STAGE_A(G8_SA(1, 0), 0, last, k3);
      G8_BAR; G8_WAIT_L(0); G8_MMA(1, 0, At, B0); G8_BAR; G8_SCHED;
      G8_STAGE_B(G8_SB(1, 1), b3 + hstep);
      G8_WAIT_V(6); G8_BAR; G8_MMA(1, 1, At, B1); G8_BAR;
    }
    E(acc, cur, wr, wc, fr, fq);
    if (!has_next) break;
#pragma unroll
    for (int a = 0; a < 2; ++a)
#pragma unroll
      for (int b = 0; b < 2; ++b)
#pragma unroll
        for (int m = 0; m < 4; ++m)
#pragma unroll
          for (int n = 0; n < 2; ++n) acc[a][b][m][n] = (f32x4){0.f, 0.f, 0.f, 0.f};
    cur = nxt; cB = nB; cA = nA; ++ui;
    if (GATHER) { cv0[0] = nv0[0]; cv0[1] = nv0[1]; cv1[0] = nv1[0]; cv1[1] = nv1[1]; }
  }
  G8_WAIT_V(0);
  if (wr == 0) G8_BAR;
  G8_BAR;
#undef G8_SA
#undef G8_SB
#undef G8_STAGE_A
#undef G8_STAGE_B
#undef G8_LDA
#undef G8_LDB
#undef G8_MMA
#undef G8_WAIT_V
#undef G8_WAIT_L
#undef G8_BAR
#undef G8_SCHED
}
DI void dense_a_off(int pm, int K, const int (&sR)[2], const int (&sC)[2], unsigned (&v0)[2], unsigned (&v1)[2]) {
#pragma unroll
  for (int i = 0; i < 2; ++i) { v0[i] = (unsigned)((pm * BM + sR[i]) * K + sC[i]) * 2u; v1[i] = v0[i] + (unsigned)(HALF * K * 2); }
}
}

DI int win8_row(int f) {
  if (f < 1024) {
    const int rel = f & 511, pn = (f >> 9) * 2 + (rel >> 8), hl = (rel >> 7) & 1, comp = (rel >> 6) & 1, i = rel & 63;
    const int bj = i >> 5, ip = i & 31, fq = ip >> 3, n = (ip >> 2) & 1, j = ip & 3;
    return pn * 256 + 128 * bj + 32 * (2 * hl + comp) + 16 * n + 4 * fq + j;
  }
  if (f < 1536 || f >= 2560) return f;
  const int rel = (f - 1536) & 511, pn = 6 + ((f - 1536) >> 9) * 2 + (rel >> 8), hl = (rel >> 5) & 7, ip = rel & 31;
  const int bj = hl >> 2, wc = hl & 3, fq = ip >> 3, n = (ip >> 2) & 1, j = ip & 3;
  return pn * 256 + 128 * bj + 32 * wc + 16 * n + 4 * fq + j;
}
struct EpiInproj {
  const Ptrs* Pp;
  DI void a_off(const g8::Unit& u, const int (&sR)[2], const int (&sC)[2], unsigned (&v0)[2], unsigned (&v1)[2]) const { g8::dense_a_off(u.pm, 1024, sR, sC, v0, v1); }
  DI size_t b_off(const g8::Unit& u) const { return (size_t)u.pn * 256 * 1024 * 2; }
  DI void operator()(const f32x4 (&acc)[2][2][4][2], const g8::Unit& u, int wr, int wc, int fr, int fq) const {
    const Ptrs& P = *Pp;
    const float* rstdx = (const float*)(P.ws + WS_RSTDX);
    asm volatile("" : "+v"(rstdx));
    const int pn = u.pn, row00 = u.pm * 256 + wr * 64, b = row00 >> 12;
    float rsr[8];
#pragma unroll
    for (int k = 0; k < 8; ++k) rsr[k] = rstdx[row00 + 128 * (k >> 2) + 16 * (k & 3) + fr];
    const float qsA = 0.125f * LOG2E, qsB = 0.17677669529663687f * LOG2E;
    if (pn < 4) {
      const int isk = pn >= 2, head = 2 * (pn & 1) + (wc >> 1), comp = wc & 1;
      const float* gg = ((const float*)(P.ws + WS_PAR)) + (isk ? PAR_GKA : PAR_GQA);
      asm volatile("" : "+v"(gg));
      const float4 g1a = *(const float4*)(gg + 8 * fq), g1b = *(const float4*)(gg + 8 * fq + 4), g2a = *(const float4*)(gg + 32 + 8 * fq), g2b = *(const float4*)(gg + 36 + 8 * fq);
      const float ga[8] = {g1a.x, g1a.y, g1a.z, g1a.w, g1b.x, g1b.y, g1b.z, g1b.w}, gb[8] = {g2a.x, g2a.y, g2a.z, g2a.w, g2b.x, g2b.y, g2b.z, g2b.w};
      u16* dstb = (u16*)(P.ws + (isk ? A_KA : A_QA)) + (size_t)(b * 4 + head) * 4096 * 128 + comp * 64 + 8 * fq;
      const float2* rope = (const float2*)(P.ws + WS_ROPE);
      struct Rp { f32x4 c0, c1, c2, c3; };
      auto ldrope = [&](int k) { const int s = (row00 + 128 * (k >> 2) + 16 * (k & 3) + fr) & 4095; const f32x4* rp = (const f32x4*)(rope + (size_t)s * 32 + 8 * fq);
        Rp r; r.c0 = rp[0]; r.c1 = rp[1]; r.c2 = rp[2]; r.c3 = rp[3]; return r; };
      Rp cur = ldrope(0);
#pragma unroll
      for (int k = 0; k < 8; ++k) {
        const int ai = k >> 2, m = k & 3;
        Rp nxt = cur;
        if (k < 7) nxt = ldrope(k + 1);
        const int row = row00 + 128 * ai + 16 * m + fr, s = row & 4095;
        const float rs = rsr[k];
        float x1[8], x2[8]; float ss = 0.f;
#pragma unroll
        for (int n = 0; n < 2; ++n)
#pragma unroll
          for (int j = 0; j < 4; ++j) { x1[4 * n + j] = acc[ai][0][m][n][j] * rs; x2[4 * n + j] = acc[ai][1][m][n][j] * rs; ss += x1[4 * n + j] * x1[4 * n + j] + x2[4 * n + j] * x2[4 * n + j]; }
        ss += __shfl_xor(ss, 16); ss += __shfl_xor(ss, 32);
        const float rn = rsqrtf(ss * (1.0f / 64.0f) + EPS) * (isk ? 1.0f : qsA);
        const float cs[8] = {cur.c0[0], cur.c0[2], cur.c1[0], cur.c1[2], cur.c2[0], cur.c2[2], cur.c3[0], cur.c3[2]}, sn[8] = {cur.c0[1], cur.c0[3], cur.c1[1], cur.c1[3], cur.c2[1], cur.c2[3], cur.c3[1], cur.c3[3]};
        f32x4 o1a, o1b, o2a, o2b;
#pragma unroll
        for (int e = 0; e < 8; ++e) {
          const float y = x1[e] * rn * ga[e], z = x2[e] * rn * gb[e];
          const float p1 = y * cs[e] - z * sn[e], p2 = z * cs[e] + y * sn[e];
          if (e < 4) { o1a[e] = p1; o2a[e] = p2; } else { o1b[e - 4] = p1; o2b[e - 4] = p2; }
        }
        u16* d = dstb + (size_t)s * 128;
        *(uint4*)d = pk8(o1a, o1b);
        *(uint4*)(d + 32) = pk8(o2a, o2b);
        asm volatile("" ::: "memory");
        cur = nxt;
      }
    } else if (pn >= 6 && pn < 10) {
      const int isk = pn >= 8;
      const float* gg = ((const float*)(P.ws + WS_PAR)) + (isk ? PAR_GKB : PAR_GQB);
      asm volatile("" : "+v"(gg));
      const float4 g1a = *(const float4*)(gg + 8 * fq), g1b = *(const float4*)(gg + 8 * fq + 4);
      const float ga[8] = {g1a.x, g1a.y, g1a.z, g1a.w, g1b.x, g1b.y, g1b.z, g1b.w};
#pragma unroll
      for (int bj = 0; bj < 2; ++bj) {
        const int hd = 8 * (pn & 1) + 4 * bj + wc;
        u16* dstb = (u16*)(P.ws + (isk ? A_KB : A_QB)) + (size_t)(b * 16 + hd) * 4096 * 32 + 8 * fq;
#pragma unroll
        for (int ai = 0; ai < 2; ++ai)
#pragma unroll
          for (int m = 0; m < 4; ++m) {
            const int row = row00 + 128 * ai + 16 * m + fr, s = row & 4095;
            const float rs = rsr[4 * ai + m];
            float x[8]; float ss = 0.f;
#pragma unroll
            for (int n = 0; n < 2; ++n)
#pragma unroll
              for (int j = 0; j < 4; ++j) { x[4 * n + j] = acc[ai][bj][m][n][j] * rs; ss += x[4 * n + j] * x[4 * n + j]; }
            ss += __shfl_xor(ss, 16); ss += __shfl_xor(ss, 32);
            const float rn = rsqrtf(ss * (1.0f / 32.0f) + EPS) * (isk ? 1.0f : qsB);
            f32x4 oa, ob;
#pragma unroll
            for (int e = 0; e < 4; ++e) { oa[e] = x[e] * rn * ga[e]; ob[e] = x[4 + e] * rn * ga[4 + e]; }
            *(uint4*)(dstb + (size_t)s * 32) = pk8(oa, ob);
          }
      }
    } else {
      const int isA = pn < 6;
#pragma unroll
      for (int ai = 0; ai < 2; ++ai)
#pragma unroll
        for (int m = 0; m < 4; ++m) {
          const int row0 = row00 + 128 * ai + 16 * m + 4 * fq, s0 = row0 & 4095;
          const float4 rs = *(const float4*)(rstdx + row0);
          const int sp = isA ? permpos(s0) : s0;
#pragma unroll
          for (int bj = 0; bj < 2; ++bj)
#pragma unroll
            for (int n = 0; n < 2; ++n) {
              const int c = 128 * bj + 32 * wc + 16 * n + fr;
              u16* dst;
              if (isA) dst = (u16*)(P.ws + A_VAT) + ((size_t)(b * 4 + 2 * (pn - 4) + (c >> 7)) * 128 + (c & 127)) * 4096;
              else dst = (u16*)(P.ws + A_VBT) + ((size_t)(b * 16 + 8 * (pn - 10) + (c >> 5)) * 32 + (c & 31)) * 4096;
              const f32x4 v = acc[ai][bj][m][n];
              *(uint2*)(dst + sp) = make_uint2(pk2(v[0] * rs.x, v[1] * rs.y), pk2(v[2] * rs.z, v[3] * rs.w));
            }
        }
    }
  }
};
DI void ph1_inproj8(const Ptrs& P, ldsp lds, int bid, int G) {
  EpiInproj E; E.Pp = &P;
  {
    g8::GridOrder S; S.init(64, 8, G, bid, 0x98763210u);
    g8::gemm_phase<EpiInproj, g8::GridOrder, false, false>(lds, (const unsigned char*)(P.ws + A_XB), (const unsigned char*)(P.ws + WS_WIN), 1024, S, E);
  }
  {
    g8::GridOrder S; S.init(64, 4, G, bid, 0xBA54u);
    g8::gemm_phase<EpiInproj, g8::GridOrder, true, false>(lds, (const unsigned char*)(P.ws + A_XB), (const unsigned char*)(P.ws + WS_WIN), 1024, S, E);
  }
}

DI int p32(int ip) { return 16 * ((ip >> 2) & 1) + 4 * (ip >> 3) + (ip & 3); }
DI int perm256(int f) { return (f & ~31) | p32(f & 31); }
DI int w13_row_w1(int f) { return ((f >> 7) << 8) | (f & 96) | p32(f & 31); }
DI int w13_row_w3(int f) { return (((f >> 7) << 8) | (f & 96) | p32(f & 31)) + 128; }

template <bool PLE>
struct EpiOut {
  const Ptrs* Pp;
  DI void a_off(const g8::Unit&, const int (&)[2], const int (&)[2], unsigned (&)[2], unsigned (&)[2]) const {}
  DI size_t b_off(const g8::Unit& u) const { return (size_t)u.pn * 256 * (PLE ? 256 : 1024) * 2; }
  struct Ld { float4 a0, a1, b0, b1; };
  DI void operator()(const f32x4 (&acc)[2][2][4][2], const g8::Unit& u, int wr, int wc, int fr, int fq) const {
    const Ptrs& P = *Pp;
    float* ssqp = (float*)(P.ws + (PLE ? WS_SSQEP : WS_SSQ1P));
    const int row0 = u.pm * 256 + 64 * wr + fr, col0 = u.pn * 256 + 32 * wc + 8 * fq;
    auto load = [&](int gidx) { const int ai = gidx >> 2, m = gidx & 3; const size_t go = (size_t)(row0 + 128 * ai + 16 * m) * 1024 + col0;
      Ld l; if (!PLE) { const u16* xbp = (const u16*)(P.ws + A_XB) + go; const uint4 ua = *(const uint4*)xbp, ub = *(const uint4*)(xbp + 128);
        l.a0 = make_float4(__uint_as_float(ua.x << 16), __uint_as_float(ua.x & 0xffff0000u), __uint_as_float(ua.y << 16), __uint_as_float(ua.y & 0xffff0000u));
        l.a1 = make_float4(__uint_as_float(ua.z << 16), __uint_as_float(ua.z & 0xffff0000u), __uint_as_float(ua.w << 16), __uint_as_float(ua.w & 0xffff0000u));
        l.b0 = make_float4(__uint_as_float(ub.x << 16), __uint_as_float(ub.x & 0xffff0000u), __uint_as_float(ub.y << 16), __uint_as_float(ub.y & 0xffff0000u));
        l.b1 = make_float4(__uint_as_float(ub.z << 16), __uint_as_float(ub.z & 0xffff0000u), __uint_as_float(ub.w << 16), __uint_as_float(ub.w & 0xffff0000u)); }
      else { l.a0 = l.a1 = l.b0 = l.b1 = make_float4(0.f, 0.f, 0.f, 0.f); } return l; };
    Ld cur = load(0);
#pragma unroll
    for (int gidx = 0; gidx < 8; ++gidx) {
      const int ai = gidx >> 2, m = gidx & 3;
      Ld nxt = cur;
      if (gidx < 7) nxt = load(gidx + 1);
      const int row = row0 + 128 * ai + 16 * m;
      float ss = 0.f;
#pragma unroll
      for (int bj = 0; bj < 2; ++bj) {
        const size_t go = (size_t)row * 1024 + col0 + 128 * bj;
        f32x4 a = acc[ai][bj][m][0], c4 = acc[ai][bj][m][1];
        if (!PLE) {
          const float4 xa = bj ? cur.b0 : cur.a0, xb4 = bj ? cur.b1 : cur.a1;
          a[0] += xa.x; a[1] += xa.y; a[2] += xa.z; a[3] += xa.w; c4[0] += xb4.x; c4[1] += xb4.y; c4[2] += xb4.z; c4[3] += xb4.w;
          *(uint4*)((u16*)(P.ws + A_H1B) + go) = pk8(a, c4);
        } else {
          *(uint4*)((u16*)(P.ws + A_EBF) + go) = pk8(a, c4);
        }
        ss += a[0] * a[0] + a[1] * a[1] + a[2] * a[2] + a[3] * a[3] + c4[0] * c4[0] + c4[1] * c4[1] + c4[2] * c4[2] + c4[3] * c4[3];
      }
      ss += __shfl_xor(ss, 16); ss += __shfl_xor(ss, 32);
      if (fq == 0) ssqp[(size_t)row * 16 + u.pn * 4 + wc] = ss;
      asm volatile("" ::: "memory");
      cur = nxt;
    }
  }
};
DI void ph3_outproj8(const Ptrs& P, ldsp lds, int bid, int G) {
  { EpiOut<false> E; E.Pp = &P; g8::GridOrder S; S.init(64, 4, G, bid);
    g8::gemm_phase<EpiOut<false>, g8::GridOrder, false, false>(lds, (const unsigned char*)(P.ws + A_AO), (const unsigned char*)(P.ws + WS_WOUT), 1024, S, E); }
}

DI int moe_plan8(const Ptrs& P, ldsp lds) {
  LAS int* smb = (LAS int*)(lds + g8::LDS_EXTRA8);
  __syncthreads();
  if (threadIdx.x == 0) {
    const int* cnt = (const int*)(P.ws + WS_CNT);
    int a = 0;
    for (int e = 0; e < 32; ++e) { smb[e] = a; a += (cnt[e * CNT_STRIDE] + 255) >> 8; smb[64 + e] = cnt[e * CNT_STRIDE]; }
    smb[32] = a;
  }
  __syncthreads();
  return smb[32];
}
template <class T> DI T* uni_ptr(T* p) {
  const unsigned long long v = (unsigned long long)p;
  const unsigned lo = __builtin_amdgcn_readfirstlane((unsigned)v), hi = __builtin_amdgcn_readfirstlane((unsigned)(v >> 32));
  return (T*)(((unsigned long long)hi << 32) | lo);
}
struct MoeOrder {
  int MB, G, c; const LAS int* smb;
  DI bool next(int i, g8::Unit& u) const {
    const int L = i * G + c;
    if (L >= ((MB + 7) >> 3) * 32) return false;
    const int gmb = (L >> 5) * 8 + (L & 7);
    u.pn = (L >> 3) & 3;
    if (gmb >= MB) return false;
    int e = 0; while (gmb >= smb[e + 1]) ++e;
    e = __builtin_amdgcn_readfirstlane(e);
    u.pm = gmb; u.e = e; u.ce = __builtin_amdgcn_readfirstlane(smb[64 + e] - (gmb - smb[e]) * 256);
    return true;
  }
};
struct EpiUp {
  const Ptrs* Pp; const LAS int* smb;
  DI void a_off(const g8::Unit& u, const int (&sR)[2], const int (&sC)[2], unsigned (&v0)[2], unsigned (&v1)[2]) const {
    const int* tokl = uni_ptr((const int*)(Pp->ws + WS_TOKL) + __builtin_amdgcn_readfirstlane(u.e * 16384 + (u.pm - smb[u.e]) * 256));
#pragma unroll
    for (int i = 0; i < 2; ++i) {
      const int r0 = sR[i], r1 = 128 + sR[i];
      const int t0 = (r0 < u.ce) ? (tokl[r0] >> 1) : 0, t1 = (r1 < u.ce) ? (tokl[r1] >> 1) : 0;
      v0[i] = (unsigned)(t0 * 1024 + sC[i]) * 2u; v1[i] = (unsigned)(t1 * 1024 + sC[i]) * 2u;
    }
  }
  DI size_t b_off(const g8::Unit& u) const { return ((size_t)u.e * 1024 + u.pn * 256) * 1024 * 2; }
  DI void operator()(const f32x4 (&acc)[2][2][4][2], const g8::Unit& u, int wr, int wc, int fr, int fq) const {
    const Ptrs& P = *Pp;
    if (u.ce <= 0) return;
    const float* rsl = uni_ptr((const float*)(P.ws + A_RSL) + __builtin_amdgcn_readfirstlane(u.e * 16384 + (u.pm - smb[u.e]) * 256));
    u16* hid = (u16*)(P.ws + A_HID);
    float rsv[8];
#pragma unroll
    for (int k = 0; k < 8; ++k) { const int rl = 128 * (k >> 2) + 64 * wr + 16 * (k & 3) + fr; rsv[k] = (rl < u.ce) ? rsl[rl] : 0.0f; }
#pragma unroll
    for (int ai = 0; ai < 2; ++ai)
#pragma unroll
      for (int m = 0; m < 4; ++m) {
        const int rl = 128 * ai + 64 * wr + 16 * m + fr;
        const float rs = rsv[4 * ai + m];
        f32x4 h0, h1;
#pragma unroll
        for (int j = 0; j < 4; ++j) {
          const float a = acc[ai][0][m][0][j] * rs, b = acc[ai][0][m][1][j] * rs;
          h0[j] = a * __builtin_amdgcn_rcpf(1.0f + __expf(-a)) * (acc[ai][1][m][0][j] * rs); h1[j] = b * __builtin_amdgcn_rcpf(1.0f + __expf(-b)) * (acc[ai][1][m][1][j] * rs);
        }
        *(uint4*)(hid + (size_t)(u.pm * 256 + rl) * 512 + u.pn * 128 + 32 * wc + 8 * fq) = pk8(h0, h1);
      }
  }
};
DI void ph5_up8(const Ptrs& P, ldsp lds, int bid, int G) {
  const int MB = moe_plan8(P, lds);
  const LAS int* smb = (const LAS int*)(lds + g8::LDS_EXTRA8);
  MoeOrder S; S.MB = MB; S.G = G; S.c = bid; S.smb = smb;
  EpiUp E; E.Pp = &P; E.smb = smb;
  g8::gemm_phase<EpiUp, MoeOrder, false, true>(lds, (const unsigned char*)(P.ws + A_H1B), (const unsigned char*)(P.ws + WS_W13), 1024, S, E);
  {
    const int NU = ((MB + 7) >> 3) * 32, rem = NU % G, nl = rem ? G - rem : G, li = rem ? bid - rem : bid;
    if (li >= 0) {
      const int lane = threadIdx.x & 63, wave = threadIdx.x >> 6, nwv = blockDim.x >> 6;
      LAS float* scr = (LAS float*)(lds + wave * 16640);
      for (int r = li * nwv + wave; r < 4096 + 256; r += nl * nwv) late_weight_item(r, scr, lane);
    }
  }
}
struct EpiDown {
  const Ptrs* Pp; const LAS int* smb;
  DI void a_off(const g8::Unit&, const int (&)[2], const int (&)[2], unsigned (&)[2], unsigned (&)[2]) const {}
  DI size_t b_off(const g8::Unit& u) const { return ((size_t)u.e * 1024 + u.pn * 256) * 512 * 2; }
  DI void operator()(const f32x4 (&acc)[2][2][4][2], const g8::Unit& u, int wr, int wc, int fr, int fq) const {
    const Ptrs& P = *Pp;
    if (u.ce <= 0) return;
    const int base = __builtin_amdgcn_readfirstlane(u.e * 16384 + (u.pm - smb[u.e]) * 256);
    const int* tokl = (const int*)(P.ws + WS_TOKL) + base; const float* wl = (const float*)(P.ws + WS_WL) + base;
    int tkv[8]; float wv[8];
#pragma unroll
    for (int k = 0; k < 8; ++k) { const int rl = 128 * (k >> 2) + 64 * wr + 16 * (k & 3) + fr; const bool v = rl < u.ce; tkv[k] = v ? tokl[rl] : -1; wv[k] = v ? wl[rl] : 0.0f; }
#pragma unroll
    for (int ai = 0; ai < 2; ++ai)
#pragma unroll
      for (int m = 0; m < 4; ++m) {
        const int tk = tkv[4 * ai + m];
        if (tk >= 0) {
          const float w = wv[4 * ai + m];
          u16* y = (u16*)(P.ws + ((tk & 1) ? A_Y1 : A_Y0)) + (size_t)(tk >> 1) * 1024 + u.pn * 256 + 32 * wc + 8 * fq;
#pragma unroll
          for (int bj = 0; bj < 2; ++bj) {
            f32x4 a = acc[ai][bj][m][0], c4 = acc[ai][bj][m][1];
#pragma unroll
            for (int j = 0; j < 4; ++j) { a[j] *= w; c4[j] *= w; }
            *(uint4*)(y + 128 * bj) = pk8(a, c4);
          }
        }
      }
  }
};
DI void ph6_down8(const Ptrs& P, ldsp lds, int bid, int G) {
  const int MB = moe_plan8(P, lds);
  const LAS int* smb = (const LAS int*)(lds + g8::LDS_EXTRA8);
  MoeOrder S; S.MB = MB; S.G = G; S.c = bid; S.smb = smb;
  EpiDown E; E.Pp = &P; E.smb = smb;
  g8::gemm_phase<EpiDown, MoeOrder, false, false>(lds, (const unsigned char*)(P.ws + A_HID), (const unsigned char*)(P.ws + WS_W2), 512, S, E);
  {
    const int NU = ((MB + 7) >> 3) * 32, rem = NU % G, nl = rem ? G - rem : G, li = rem ? bid - rem : bid;
    EpiOut<true> E2; E2.Pp = &P; g8::GridOrder S2; S2.init(64, 4, nl, li < 0 ? 0 : li);
    if (li < 0) S2.nwg = 0;
    g8::gemm_phase<EpiOut<true>, g8::GridOrder, false, false>(lds, (const unsigned char*)(P.ws + A_PB), (const unsigned char*)(P.ws + WS_WPLE), 256, S2, E2);
  }
}

struct EpiFinal {
  const Ptrs* Pp;
  DI void a_off(const g8::Unit&, const int (&)[2], const int (&)[2], unsigned (&)[2], unsigned (&)[2]) const {}
  DI size_t b_off(const g8::Unit& u) const { return (size_t)u.pn * 256 * 1024 * 2; }
  struct Ld { u32x4 hh; u32x4 ee; };
  DI void operator()(const f32x4 (&acc)[2][2][4][2], const g8::Unit& u, int wr, int wc, int fr, int fq) const {
    const Ptrs& P = *Pp;
    const float* rstd2 = (const float*)(P.ws + WS_RSTD2); const float* rstdE = (const float*)(P.ws + WS_RSTDE);
    const int row0 = u.pm * 256 + 64 * wr + fr, col0 = u.pn * 256 + 32 * wc + 8 * fq;
    auto load = [&](int gidx) { const int bj = gidx >> 3, ai = (gidx >> 2) & 1, m = gidx & 3; const int row = row0 + 128 * ai + 16 * m; const size_t go = (size_t)row * 1024 + col0 + 128 * bj;
      Ld l;
      l.hh = *(const u32x4*)((const u16*)(P.ws + A_H2B) + go); l.ee = *(const u32x4*)((const u16*)(P.ws + A_EBF) + go); return l; };
    Ld cur = load(0);
    float gv[8];
#pragma unroll
    for (int gidx = 0; gidx < 16; ++gidx) {
      const int bj = gidx >> 3, ai = (gidx >> 2) & 1, m = gidx & 3;
      if ((gidx & 7) == 0) { const float4 ga = *(const float4*)(P.g_ple + col0 + 128 * bj), gb = *(const float4*)(P.g_ple + col0 + 128 * bj + 4);
        gv[0] = ga.x; gv[1] = ga.y; gv[2] = ga.z; gv[3] = ga.w; gv[4] = gb.x; gv[5] = gb.y; gv[6] = gb.z; gv[7] = gb.w; }
      Ld nxt = cur;
      if (gidx < 15) nxt = load(gidx + 1);
      const size_t go = (size_t)(row0 + 128 * ai + 16 * m) * 1024 + col0 + 128 * bj;
      const int row = row0 + 128 * ai + 16 * m;
      const float rs2 = rstd2[row], rE = rstdE[row];
      float hv[8];
#pragma unroll
      for (int k = 0; k < 8; ++k) hv[k] = __uint_as_float((cur.hh[k >> 1] << ((k & 1) ? 0u : 16u)) & 0xffff0000u);
      const f32x4 a = acc[ai][bj][m][0], c4 = acc[ai][bj][m][1];
      const float av[8] = {a[0], a[1], a[2], a[3], c4[0], c4[1], c4[2], c4[3]};
      const unsigned eeu[4] = {cur.ee[0], cur.ee[1], cur.ee[2], cur.ee[3]};
#pragma unroll
      for (int k = 0; k < 8; ++k) {
        const unsigned sh = (k & 1) ? 0u : 16u;
        const float ev = __uint_as_float((eeu[k >> 1] << sh) & 0xffff0000u);
        const float sg = __builtin_amdgcn_rcpf(1.0f + __expf(-av[k] * rs2));
        hv[k] = hv[k] + ev * rE * gv[k] * sg;
      }
      float* wr_ = P.out + go;
      __builtin_nontemporal_store((f32x4){hv[0], hv[1], hv[2], hv[3]}, (f32x4*)wr_); __builtin_nontemporal_store((f32x4){hv[4], hv[5], hv[6], hv[7]}, (f32x4*)(wr_ + 4));
      asm volatile("" ::: "memory");
      cur = nxt;
    }
  }
};
DI void ph8_final8(const Ptrs& P, ldsp lds, int bid, int G) {
  EpiFinal E; E.Pp = &P; g8::GridOrder S; S.init(64, 4, G, bid);
  g8::gemm_phase<EpiFinal, g8::GridOrder, false, false>(lds, (const unsigned char*)(P.ws + A_H2B), (const unsigned char*)(P.ws + WS_WPLG), 1024, S, E);
}

template <bool SHIFT>
DI void da_item8(const Ptrs& P, ldsp lds, int item, float lam, float m2) {
  const int tid = threadIdx.x, lane = tid & 63, wave = __builtin_amdgcn_readfirstlane(tid >> 6), h = lane >> 5, i31 = lane & 31;
  const int xcd = item & 7, loc = item >> 3, bh = 2 * xcd + (loc >> 4), qblk = loc & 15;
  const u16* qA = (const u16*)(P.ws + A_QA) + (size_t)bh * 4096 * 128;
  const u16* kA = (const u16*)(P.ws + A_KA) + (size_t)bh * 4096 * 128;
  const u16* vAt = (const u16*)(P.ws + A_VAT) + (size_t)bh * 128 * 4096;
  const int q = qblk * 256 + 32 * wave + i31;
  bf16x8 qf[2][4];
#pragma unroll
  for (int c = 0; c < 2; ++c)
#pragma unroll
    for (int s = 0; s < 4; ++s) qf[c][s] = *(const bf16x8*)(qA + (size_t)q * 128 + c * 64 + 16 * s + 8 * h);
  auto stage = [&](int buf, int tile) {
    int ln = lane; asm volatile("" : "+v"(ln));
    ldsp lk = lds + buf * DA_STAGE;
    const u16* kt = kA + (size_t)tile * 64 * 128;
    const u16* vt = vAt + tile * 64;
#pragma unroll
    for (int qq = 0; qq < 2; ++qq) {
      const int jj = 2 * wave + qq;
      const int ra = key_of(0, jj), rb = key_of(1, jj);
      const int ku = ln >> 4, key = 32 * (ku >> 1) + ((ku & 1) ? rb : ra);
      glds16(kt + key * 128 + (ln & 15) * 8, lk + jj * 1040);
      const int vu = ln >> 3, d = 32 * (vu >> 1) + ((vu & 1) ? rb : ra);
      glds16(vt + d * 4096 + (ln & 7) * 8, lk + DA_VOFF + jj * 1040);
    }
  };
  const int rk = rank_of(i31), gr = grp_of(i31);
  const int kbase = rk * 1040 + gr * 256 + h * 16;
  const int vbase = DA_VOFF + rk * 1040 + gr * 128 + h * 16;
  f32x16 O1[4], O2[4];
#pragma unroll
  for (int dt = 0; dt < 4; ++dt)
#pragma unroll
    for (int e = 0; e < 16; ++e) { O1[dt][e] = 0.f; O2[dt][e] = 0.f; }
  float l1 = 0.f, l2 = 0.f;
  bf16x8 pf[2][2];
  auto se = [&](ldsp lk) {
    f32x16 sa0, sa1;
#pragma unroll
    for (int e = 0; e < 16; ++e) { sa0[e] = 0.f; sa1[e] = 0.f; }
#pragma unroll
    for (int s = 0; s < 4; ++s) {
      const bf16x8 k0 = *(LAS bf16x8*)(lk + s * 32), k1 = *(LAS bf16x8*)(lk + 128 + s * 32);
      sa0 = __builtin_amdgcn_mfma_f32_32x32x16_bf16(k0, qf[0][s], sa0, 0, 0, 0);
      sa1 = __builtin_amdgcn_mfma_f32_32x32x16_bf16(k1, qf[1][s], sa1, 0, 0, 0);
    }
    __builtin_amdgcn_sched_barrier(0);
    float ls = 0.f;
#pragma unroll
    for (int e = 0; e < 16; ++e) { sa0[e] = __builtin_amdgcn_exp2f(SHIFT ? sa0[e] - m2 : sa0[e]); ls += sa0[e]; }
    l1 += ls;
    pf[0][0] = packp(sa0, 0); pf[0][1] = packp(sa0, 1);
    ls = 0.f;
#pragma unroll
    for (int e = 0; e < 16; ++e) { sa1[e] = __builtin_amdgcn_exp2f(SHIFT ? sa1[e] - m2 : sa1[e]); ls += sa1[e]; }
    l2 += ls;
    pf[1][0] = packp(sa1, 0); pf[1][1] = packp(sa1, 1);
  };
  auto pv = [&](ldsp lv) {
    bf16x8 va = *(LAS bf16x8*)(lv), vb = *(LAS bf16x8*)(lv + 256);
#pragma unroll
    for (int st = 0; st < 4; ++st) {
      const int s2 = st >> 1, dtp = st & 1;
      bf16x8 na = va, nb = vb;
      if (st < 3) { const int s2n = (st + 1) >> 1, dn = (st + 1) & 1; na = *(LAS bf16x8*)(lv + s2n * 32 + dn * 512); nb = *(LAS bf16x8*)(lv + s2n * 32 + dn * 512 + 256); }
      __builtin_amdgcn_sched_barrier(0);
      __builtin_amdgcn_s_setprio(1);
      O1[2 * dtp] = __builtin_amdgcn_mfma_f32_32x32x16_bf16(va, pf[0][s2], O1[2 * dtp], 0, 0, 0);
      O2[2 * dtp] = __builtin_amdgcn_mfma_f32_32x32x16_bf16(va, pf[1][s2], O2[2 * dtp], 0, 0, 0);
      O1[2 * dtp + 1] = __builtin_amdgcn_mfma_f32_32x32x16_bf16(vb, pf[0][s2], O1[2 * dtp + 1], 0, 0, 0);
      O2[2 * dtp + 1] = __builtin_amdgcn_mfma_f32_32x32x16_bf16(vb, pf[1][s2], O2[2 * dtp + 1], 0, 0, 0);
      __builtin_amdgcn_s_setprio(0);
      __builtin_amdgcn_sched_barrier(0);
      va = na; vb = nb;
    }
  };
  __syncthreads();
  stage(0, 0);
  stage(1, 1);
  asm volatile("s_waitcnt vmcnt(4)" ::: "memory");
  __builtin_amdgcn_s_barrier();
  if (wave < 4) {
    for (int tile = 0; tile < 64; ++tile) {
      if (tile + 2 < 64) stage((tile + 2) & 3, tile + 2);
      ldsp lb = lds + (tile & 3) * DA_STAGE;
#pragma unroll 1
      for (int kt2 = 0; kt2 < 2; ++kt2) {
        se(lb + kbase + kt2 * 512);
        __builtin_amdgcn_sched_barrier(0);
        pv(lb + vbase + kt2 * 64);
      }
      if (tile + 2 < 64) asm volatile("s_waitcnt vmcnt(4)" ::: "memory"); else asm volatile("s_waitcnt vmcnt(0)" ::: "memory");
      __builtin_amdgcn_s_barrier();
    }
  } else {
    for (int tile = 0; tile < 64; ++tile) {
      if (tile + 2 < 64) stage((tile + 2) & 3, tile + 2);
      ldsp lb = lds + (tile & 3) * DA_STAGE;
      ldsp lbp = lds + ((tile + 3) & 3) * DA_STAGE;
#pragma unroll 1
      for (int kt2 = 0; kt2 < 2; ++kt2) {
        if (tile + kt2 > 0) pv(kt2 == 0 ? lbp + vbase + 64 : lb + vbase);
        __builtin_amdgcn_sched_barrier(0);
        se(lb + kbase + kt2 * 512);
        __builtin_amdgcn_sched_barrier(0);
      }
      if (tile + 2 < 64) asm volatile("s_waitcnt vmcnt(4)" ::: "memory"); else asm volatile("s_waitcnt vmcnt(0)" ::: "memory");
      __builtin_amdgcn_s_barrier();
    }
    pv(lds + 3 * DA_STAGE + vbase + 64);
  }
  l1 += __shfl_xor(l1, 32); l2 += __shfl_xor(l2, 32);
  const float i1 = 1.0f / l1, i2 = lam / l2;
  float ss = 0.f;
#pragma unroll
  for (int dt = 0; dt < 4; ++dt)
#pragma unroll
    for (int e = 0; e < 16; ++e) { const float o = O1[dt][e] * i1 - O2[dt][e] * i2; O1[dt][e] = o; ss += o * o; }
  ss += __shfl_xor(ss, 32);
  const float rn = rsqrtf(ss * (1.0f / 128.0f) + EPS) * (1.0f - LAM_INIT);
  const int b = bh >> 2, hh = bh & 3;
  u16* dst = (u16*)(P.ws + A_AO) + ((size_t)b * 4096 + q) * 1024 + hh * 128;
#pragma unroll
  for (int dt = 0; dt < 4; ++dt)
#pragma unroll
    for (int g = 0; g < 4; ++g) {
      const int d0 = 32 * dt + 8 * g + 4 * h;
      const float4 gs = *(const float4*)(kargs_now()->g_sub + d0);
      *(uint2*)(dst + d0) = make_uint2(pk2(O1[dt][4 * g] * rn * gs.x, O1[dt][4 * g + 1] * rn * gs.y), pk2(O1[dt][4 * g + 2] * rn * gs.z, O1[dt][4 * g + 3] * rn * gs.w));
    }
}

constexpr int NA8_VSTRIDE = 1936;
constexpr int NA8_TAB = 32 * NA8_VSTRIDE;
DI void na_block8(const Ptrs& P, ldsp lds, int item, float qkbound) {
  const int tid = threadIdx.x, lane = tid & 63, wave = tid >> 6;
  const int r0 = (item & 7) * 8, hd = (item >> 3) & 15, b = item >> 7;
  const int qi = lane & 15, g = lane >> 4;
  LAS float* EB = (LAS float*)(lds + NA8_TAB);
  LAS float* RW = EB + 960;
  const int R0 = min(max(r0 - 4, 0), 56), NR = min(15, 64 - R0);
  const u16* vB = (const u16*)(P.ws + A_VBT) + (size_t)(b * 16 + hd) * 32 * 4096;
  __syncthreads();
  {
    u32x4 vv[8];
#pragma unroll
    for (int k = 0; k < 8; ++k) {
      const int sg = (tid >> 3) + 64 * k, d = sg / NR, kr = sg - d * NR;
      vv[k] = *(const u32x4*)(vB + (size_t)min(d, 31) * 4096 + (R0 + min(kr, NR - 1)) * 64 + 8 * (tid & 7));
    }
    float mxa = 0.f;
    const float r0v = (tid < 465) ? P.rpb[hd * 465 + tid] : 0.f;
    mxa = fabsf(r0v);
#pragma unroll
    for (int o = 1; o < 64; o <<= 1) mxa = fmaxf(mxa, __shfl_xor(mxa, o));
    LAS float* red = (LAS float*)(lds + NA8_TAB + 7680);
    if (lane == 0) red[wave] = mxa;
#pragma unroll
    for (int k = 0; k < 8; ++k) {
      const int sg = (tid >> 3) + 64 * k, d = sg / NR, kr = sg - d * NR;
      if (sg < 32 * NR) *(LAS u32x4*)(lds + d * NA8_VSTRIDE + kr * 128 + 16 * (tid & 7)) = vv[k];
    }
    __syncthreads();
    const float m2 = (qkbound + fmaxf(fmaxf(fmaxf(red[0], red[1]), fmaxf(red[2], red[3])), fmaxf(fmaxf(red[4], red[5]), fmaxf(red[6], red[7])))) * LOG2E;
    for (int e = tid; e < 960; e += 512) {
      const int br = e >> 6, co = (e & 63) - 16;
      const float v = (co >= 0 && co <= 30) ? P.rpb[hd * 465 + br * 31 + co] * LOG2E - m2 : -1e30f;
      RW[e] = v;
      EB[e] = (co >= 7 && co <= 22) ? v : -1e30f;
    }
    __syncthreads();
  }
  const int r = r0 + wave;
  const int rs = min(max(r - 4, 0), 56), rb0 = rs - r + 7;
  const u16* qB = (const u16*)(P.ws + A_QB) + (size_t)(b * 16 + hd) * 4096 * 32;
  const u16* kBp = (const u16*)(P.ws + A_KB) + (size_t)(b * 16 + hd) * 4096 * 32;
  bf16x8 kf[16], qf;
  auto issue_kq = [&](int jq) {
    const int kb = min(min(max(16 * jq - 8, 0), 48), 32);
    const u16* kp = kBp + (size_t)(rs * 64 + kb + qi) * 32 + 8 * g;
    qf = *(const bf16x8*)(qB + (size_t)(r * 64 + 16 * jq + qi) * 32 + 8 * g);
#pragma unroll
    for (int ri = 0; ri < 8; ++ri)
#pragma unroll
      for (int t = 0; t < 2; ++t) kf[2 * ri + t] = *(const bf16x8*)(kp + (ri * 64 + 16 * t) * 32);
  };
  issue_kq(0);
#pragma unroll 1
  for (int jq = 0; jq < 4; ++jq) {
    const int kb = min(min(max(16 * jq - 8, 0), 48), 32);
    const LAS float* tb[2];
    {
      const int cobase = (jq == 0) ? 15 : ((jq == 3) ? -1 : 7);
#pragma unroll
      for (int t = 0; t < 2; ++t) {
        const int off = rb0 * 64 + cobase + 16 * t + 4 * g - qi + 16;
        const LAS float* pe = EB + off; const LAS float* pr = RW + off; const LAS float* pn = RW + 48;
        const LAS float* sel = pe;
        if (jq == 0 && qi < 8) sel = (t == 0) ? pr : pn;
        if (jq == 3 && qi > 8) sel = (t == 1) ? pr : pn;
        tb[t] = sel;
      }
    }
    f32x4 sa[8][2];
#pragma unroll
    for (int ri = 0; ri < 8; ++ri)
#pragma unroll
      for (int t = 0; t < 2; ++t) {
        const LAS float* tp = tb[t] + ri * 64;
        const f32x4 ci = {tp[0], tp[1], tp[2], tp[3]};
        sa[ri][t] = __builtin_amdgcn_mfma_f32_16x16x32_bf16(kf[2 * ri + t], qf, ci, 0, 0, 0);
      }
    __builtin_amdgcn_sched_barrier(0);
    if (jq + 1 < 4) issue_kq(jq + 1);
    __builtin_amdgcn_sched_barrier(0);
    float l = 0.f;
    f32x4 oa[2] = {{0.f, 0.f, 0.f, 0.f}, {0.f, 0.f, 0.f, 0.f}};
    ldsp vl = lds + qi * NA8_VSTRIDE + (rs - R0) * 128 + (kb + 4 * g) * 2;
#pragma unroll
    for (int ri = 0; ri < 8; ++ri) {
      float p[8];
#pragma unroll
      for (int t = 0; t < 2; ++t)
#pragma unroll
        for (int i = 0; i < 4; ++i) { const float e = __builtin_amdgcn_exp2f(sa[ri][t][i]); p[4 * t + i] = e; l += e; }
      u32x4 pp; pp[0] = pk2(p[0], p[1]); pp[1] = pk2(p[2], p[3]); pp[2] = pk2(p[4], p[5]); pp[3] = pk2(p[6], p[7]);
      const bf16x8 pfr = __builtin_bit_cast(bf16x8, pp);
#pragma unroll
      for (int dtl = 0; dtl < 2; ++dtl) {
        const s16x4 lo = *(LAS s16x4*)(vl + dtl * 16 * NA8_VSTRIDE + ri * 128), hi = *(LAS s16x4*)(vl + dtl * 16 * NA8_VSTRIDE + ri * 128 + 32);
        const bf16x8 vf = __builtin_shufflevector(lo, hi, 0, 1, 2, 3, 4, 5, 6, 7);
        oa[dtl] = __builtin_amdgcn_mfma_f32_16x16x32_bf16(vf, pfr, oa[dtl], 0, 0, 0);
      }
    }
    l += __shfl_xor(l, 16); l += __shfl_xor(l, 32);
    const float il = 1.0f / l;
    u16* dst = (u16*)(P.ws + A_AO) + ((size_t)b * 4096 + r * 64 + 16 * jq + qi) * 1024 + 512 + hd * 32;
#pragma unroll
    for (int dtl = 0; dtl < 2; ++dtl)
      *(uint2*)(dst + 16 * dtl + 4 * g) = make_uint2(pk2(oa[dtl][0] * il, oa[dtl][1] * il), pk2(oa[dtl][2] * il, oa[dtl][3] * il));
  }
}

DI void ph2_attn8(const Ptrs& P, ldsp lds, int bid, int G) {
  const float* sc = (const float*)(P.ws + WS_SCAL);
  const float lam = sc[0], m2 = sc[1], qkb = sc[2];
  if (m2 < 64.0f) { for (int it = bid; it < 256; it += G) da_item8<false>(P, lds, it, lam, m2); }
  else { for (int it = bid; it < 256; it += G) da_item8<true>(P, lds, it, lam, m2); }
  for (int it = bid; it < 512; it += G) na_block8(P, lds, it, qkb);
}

__global__ void __launch_bounds__(512, 2) mega8(Ptrs Pk, int ph_lo, int ph_hi) {
  extern __shared__ __attribute__((aligned(16))) unsigned char smem[];
  ldsp lds = (ldsp)smem;
  const int bid = blockIdx.x, G = gridDim.x;
  volatile LAS unsigned* st = (volatile LAS unsigned*)(lds + g8::LDS_EXTRA8 + 4080);
  XcdBarrier xb; xb.bar = (unsigned*)(Pk.ws + WS_CTL); xb.x = 0; xb.st = st;
  if (ph_hi - ph_lo > 1) {
    if (threadIdx.x == 0) { st[0] = 0u; st[1] = 0u; }
    __syncthreads();
    xb = xcd_barrier_post((unsigned*)(Pk.ws + WS_CTL), st);
  }
#define RUN_PHASE8(k, call) if (ph_lo <= k && k < ph_hi) { { const Ptrs P = load_args(); call; } if (k + 1 < ph_hi) xcd_barrier(xb); }
  RUN_PHASE8(0, ph0_prep(P, lds, bid, G))
  RUN_PHASE8(1, ph1_inproj8(P, lds, bid, G))
  RUN_PHASE8(2, ph2_attn8(P, lds, bid, G))
  RUN_PHASE8(3, ph3_outproj8(P, lds, bid, G))
  RUN_PHASE8(4, ph4_router(P, lds, bid, G))
  RUN_PHASE8(5, ph5_up8(P, lds, bid, G))
  RUN_PHASE8(6, ph6_down8(P, lds, bid, G))
  RUN_PHASE8(7, ph7_combine(P, lds, bid, G))
  RUN_PHASE8(8, ph8_final8(P, lds, bid, G))
}
extern "C" void kernel_launch(void* const* d_in, const int* in_sizes, int n_in, void* d_out, int out_size, void* d_ws, size_t ws_size,
                              hipStream_t stream) {
  static int grid = 0;
  if (grid == 0) {
    if (n_in != 25 || ws_size < WS_END || out_size != T * DM) { fprintf(stderr, "kernel_launch: unexpected n_in %d / out %d / ws_size %zu (need %zu)\\n", n_in, out_size, ws_size, (size_t)WS_END); grid = -1; return; }
    int dev = 0, cus = 0, per_cu = 0;
    (void)hipGetDevice(&dev);
    (void)hipDeviceGetAttribute(&cus, hipDeviceAttributeMultiprocessorCount, dev);
    (void)hipFuncSetAttribute((const void*)mega8, hipFuncAttributeMaxDynamicSharedMemorySize, g8::LDS_BYTES8);
    (void)hipOccupancyMaxActiveBlocksPerMultiprocessor(&per_cu, (const void*)mega8, 512, g8::LDS_BYTES8);
    if (per_cu < 1) { fprintf(stderr, "kernel_launch: occupancy query returned %d\\n", per_cu); grid = -1; return; }
    grid = cus;
  }
  if (grid < 0) return;
  Ptrs P{};
  const float** pp = (const float**)&P;
  for (int i = 0; i < 25; ++i) pp[i] = (const float*)d_in[i];
  P.out = (float*)d_out; P.ws = (unsigned char*)d_ws;
  (void)hipMemsetAsync((unsigned char*)d_ws + WS_CTL, 0, XCD_BAR_WORDS * 4, stream);
  mega8<<<grid, 512, g8::LDS_BYTES8, stream>>>(P, 0, 9);
}
```

```cpp
#define ONE_LAUNCH 2
#define NEW_MASK 0x1ff
#include <hip/hip_runtime.h>
#include <cstdio>
#include <cstdint>

typedef unsigned short u16;
#define DI __device__ __forceinline__

constexpr int T = 16384, S = 4096, DM = 1024, NB = 4;
constexpr int DIN = 3072, DPLE = 256;
constexpr int HA = 4, HB = 16;
constexpr int NE = 32, DE = 512;
constexpr float EPS = 1e-6f;
constexpr float LOG2E = 1.4426950408889634f;
constexpr float LAM_INIT = 0.2f;

constexpr size_t MiB = 1ull << 20;
constexpr size_t WS_WIN = 0, WS_WOUT = 6 * MiB, WS_W13 = 8 * MiB, WS_W2 = 72 * MiB, WS_WPLG = 104 * MiB,
                 WS_WPLE = 106 * MiB, WS_WR = 106 * MiB + 512 * 1024, WS_ROPE = 107 * MiB;
constexpr size_t WS_SMALL = 108 * MiB;
constexpr size_t WS_RSTDX = WS_SMALL;
constexpr size_t WS_SSQ1P = 250 * MiB;
constexpr size_t WS_SSQEP = 251 * MiB;
constexpr int SSQ_PARTS = 16;
constexpr size_t WS_RSTD1 = WS_RSTDX + 65536;
constexpr size_t WS_RSTD2 = WS_RSTD1 + 65536;
constexpr size_t WS_SCAL  = WS_RSTD2 + 65536;
constexpr size_t WS_CNT   = WS_SCAL + 256;
constexpr int CNT_STRIDE = 64;
constexpr size_t WS_PADST = WS_CNT + 8192;
constexpr size_t WS_CTL   = WS_PADST + 256;
constexpr size_t WS_RSTDE = WS_CTL + 16384;
constexpr size_t WS_PAR   = WS_SMALL + 1 * MiB;
constexpr int PAR_GQA = 0, PAR_GKA = 64, PAR_GSUB = 128, PAR_GQB = 256, PAR_GKB = 288, PAR_GPLE = 320, PAR_RPB = 1344, PAR_TOTAL = 1344 + 7440;
constexpr size_t WS_TOKL  = WS_SMALL + 2 * MiB;
constexpr size_t WS_WL    = WS_SMALL + 4 * MiB;
constexpr size_t WS_ACT   = 114 * MiB;
constexpr size_t A_XB = WS_ACT, A_AO = 260 * MiB, A_HID = WS_ACT, A_H2B = WS_ACT;
constexpr size_t A_PB = 252 * MiB;
constexpr size_t A_QA = WS_ACT + 40 * MiB, A_KA = WS_ACT + 56 * MiB, A_VAT = WS_ACT + 72 * MiB,
                 A_QB = WS_ACT + 88 * MiB, A_KB = WS_ACT + 104 * MiB, A_VBT = WS_ACT + 120 * MiB;
constexpr size_t A_RSL = 260 * MiB;
constexpr size_t A_H1B = WS_ACT + 40 * MiB, A_EBF = WS_ACT + 72 * MiB, A_Y0 = WS_ACT + 104 * MiB, A_Y1 = 260 * MiB;
constexpr size_t WS_END = 292 * MiB;

DI float bf2f(u16 u) { return __uint_as_float(((unsigned)u) << 16); }
DI u16 f2bf(float f) { __bf16 b = (__bf16)f; return __builtin_bit_cast(u16, b); }
DI int permpos(int s) { return (s & ~12) | ((s & 8) >> 1) | ((s & 4) << 1); }

struct Ptrs {
  const float *x, *p, *g_mix, *w_in, *g_qa, *g_ka, *lam_q1, *lam_k1, *lam_q2, *lam_k2, *g_sub, *g_qb, *g_kb, *rpb, *w_out,
      *g_ffn, *w_rg, *w_re, *w1, *w3, *w2, *g_plg, *w_plg, *w_ple, *g_ple;
  float* out;
  unsigned char* ws;
};

#define GAS __attribute__((address_space(1)))
#define LAS __attribute__((address_space(3)))
typedef LAS unsigned char* ldsp;
typedef __attribute__((ext_vector_type(8))) short bf16x8;
typedef __attribute__((ext_vector_type(16))) float f32x16;
typedef __attribute__((ext_vector_type(4))) float f32x4;
typedef __attribute__((ext_vector_type(2))) float f32x2v;
typedef __attribute__((ext_vector_type(2))) __bf16 bf16x2v;
DI unsigned pk2(float a, float b) { bf16x2v v = __builtin_convertvector((f32x2v){a, b}, bf16x2v); return __builtin_bit_cast(unsigned, v); }
DI float wave_sum(float v) {
#pragma unroll
  for (int o = 1; o < 64; o <<= 1) v += __shfl_xor(v, o);
  return v;
}
DI void glds16(const void* g, ldsp l) { __builtin_amdgcn_global_load_lds((const GAS unsigned*)g, (LAS unsigned*)l, 16, 0, 0); }
DI void lds_wave_sync() { asm volatile("s_waitcnt lgkmcnt(0)" ::: "memory"); }

#define XB_TMO      128
#define XB_XCNT(j)  (256  + 64 * (j))
#define XB_XSUB(j)  (1280 + 64 * (j))
#define XB_XGEN(j)  (2304 + 64 * (j))
#define XB_TOP      3328
#define XB_TOPGEN   3392
#define XCD_BAR_WORDS 3456
#define XB_SPIN_CAP (1u << 22)
DI unsigned xb_ld(unsigned* p) { return __hip_atomic_load(p, __ATOMIC_RELAXED, __HIP_MEMORY_SCOPE_AGENT); }
DI unsigned xb_add(unsigned* p, unsigned v) { return __hip_atomic_fetch_add(p, v, __ATOMIC_RELAXED, __HIP_MEMORY_SCOPE_AGENT); }
DI unsigned xb_xcc_id() { return (unsigned)__builtin_amdgcn_s_getreg((3 << 11) | 20) & 0xFu; }
#define XB_SPIN(cond, bar) do { unsigned _sp = 0; while (cond) { __builtin_amdgcn_s_sleep(1); \
    if ((++_sp & 255u) == 0u) { if (xb_ld(&(bar)[XB_TMO])) break; if (_sp > XB_SPIN_CAP) { atomicAdd(&(bar)[XB_TMO], 1u); break; } } } } while (0)
struct XcdBarrier { unsigned* bar; unsigned x; volatile LAS unsigned* st; };
DI XcdBarrier xcd_barrier_post(unsigned* bar, volatile LAS unsigned* st) {
  XcdBarrier b; b.bar = bar; b.x = xb_xcc_id(); b.st = st;
  if (threadIdx.x == 0) { const unsigned o = xb_add(&bar[XB_XCNT(b.x)], 1u); st[3] = (o == 0u) ? 1u : 0u; }
  return b;
}
DI void xcd_barrier_complete(unsigned* bar, unsigned x, unsigned& nloc, unsigned& nx) {
  const unsigned G = gridDim.x;
  unsigned sum, cnt, mine, sp = 0u;
  for (;;) {
    sum = 0u; cnt = 0u; mine = 0u;
#pragma unroll
    for (unsigned j = 0; j < 16; ++j) { const unsigned c = xb_ld(&bar[XB_XCNT(j)]); sum += c; cnt += (c > 0u) ? 1u : 0u; mine = (j == x) ? c : mine; }
    if (sum == G) break;
    __builtin_amdgcn_s_sleep(1);
    if ((++sp & 255u) == 0u) { if (xb_ld(&bar[XB_TMO])) break; if (sp > XB_SPIN_CAP) { atomicAdd(&bar[XB_TMO], 1u); break; } }
  }
  nloc = mine > 0u ? mine : 1u; nx = cnt > 0u ? cnt : 1u;
}
DI void xcd_barrier(const XcdBarrier& b) {
  asm volatile("s_waitcnt vmcnt(0)" ::: "memory");
  __syncthreads();
  if (threadIdx.x == 0) {
    unsigned* bar = b.bar;
    __builtin_amdgcn_s_waitcnt(0);
    unsigned nloc = b.st[0], nx = b.st[1];
    if (nloc == 0u) { xcd_barrier_complete(bar, b.x, nloc, nx); b.st[0] = nloc; b.st[1] = nx; }
    const unsigned gen = b.st[2] + 1u; b.st[2] = gen;
    (void)xb_add(&bar[XB_XSUB(b.x)], 1u);
    if (b.st[3]) {
      XB_SPIN(xb_ld(&bar[XB_XSUB(b.x)]) < gen * nloc, bar);
      __builtin_amdgcn_fence(__ATOMIC_RELEASE, "agent");
      asm volatile("s_waitcnt vmcnt(0)" ::: "memory");
      (void)xb_add(&bar[XB_TOP], 1u);
    }
    __builtin_amdgcn_fence(__ATOMIC_ACQUIRE, "agent");
    asm volatile("s_waitcnt vmcnt(0)" ::: "memory");
    XB_SPIN(xb_ld(&bar[XB_TOP]) < gen * nx, bar);
    asm volatile("s_waitcnt vmcnt(0)" ::: "memory");
  }
  __syncthreads();
}

DI int win8_row(int f);
DI int perm256(int f);
DI int w13_row_w1(int f);
DI int w13_row_w3(int f);
typedef int (*rowmap_t)(int);
template <rowmap_t rowmap = (rowmap_t) nullptr>
DI void tr_item(const float* W, int ldw, int k0, int n0, const float* gk, u16* dst0, u16* dst1, int ldd, LAS float* scr, int lane) {
  float4 v[16];
  const float* src = W + (size_t)(k0 + (lane >> 4)) * ldw + n0 + 4 * (lane & 15);
#pragma unroll
  for (int j = 0; j < 16; ++j) { const f32x4 t = __builtin_nontemporal_load((const f32x4*)(src + (size_t)(4 * j) * ldw)); v[j] = make_float4(t[0], t[1], t[2], t[3]); }
  if (gk) {
#pragma unroll
    for (int j = 0; j < 16; ++j) { const float g = gk[k0 + 4 * j + (lane >> 4)]; v[j].x *= g; v[j].y *= g; v[j].z *= g; v[j].w *= g; }
  }
  LAS float* w = scr + (lane >> 4) * 65 + 4 * (lane & 15);
#pragma unroll
  for (int j = 0; j < 16; ++j) { w[(4 * j) * 65] = v[j].x; w[(4 * j) * 65 + 1] = v[j].y; w[(4 * j) * 65 + 2] = v[j].z; w[(4 * j) * 65 + 3] = v[j].w; }
  lds_wave_sync();
  const int c = lane & 7;
#pragma unroll
  for (int j = 0; j < 8; ++j) {
    const int n = (lane >> 3) + 8 * j;
    const LAS float* s = scr + (8 * c) * 65 + n;
    uint4 o;
    o.x = pk2(s[0 * 65], s[1 * 65]); o.y = pk2(s[2 * 65], s[3 * 65]); o.z = pk2(s[4 * 65], s[5 * 65]); o.w = pk2(s[6 * 65], s[7 * 65]);
    u16* d = rowmap ? (dst0 + (size_t)rowmap(n0 + n) * ldd) : ((j < 4) ? (dst0 + (size_t)n * ldd) : (dst1 + (size_t)(n - 32) * ldd));
    *(uint4*)(d + k0 + 8 * c) = o;
  }
  lds_wave_sync();
}

typedef const __attribute__((address_space(4))) Ptrs* kargp_t;
DI kargp_t kargs_now() {
#if defined(__HIP_DEVICE_COMPILE__)
  kargp_t kp = (kargp_t)__builtin_amdgcn_kernarg_segment_ptr(); asm volatile("" : "+s"(kp)); return kp;
#else
  return nullptr;
#endif
}
DI Ptrs load_args() {
#if defined(__HIP_DEVICE_COMPILE__)
  kargp_t kp = kargs_now(); Ptrs r; __builtin_memcpy(&r, (const void*)kp, sizeof(Ptrs)); return r;
#else
  return Ptrs{};
#endif
}
DI void late_weight_item(int r, LAS float* scr, int lane) {
  unsigned char* const wsb = kargs_now()->ws;
  if (r < 4096) {
    u16* W2T = (u16*)(wsb + WS_W2);
    const int e = r >> 7, q = r & 127, kb = q >> 4, nb = q & 15;
    tr_item<perm256>(kargs_now()->w2 + (size_t)e * 512 * 1024, 1024, kb * 64, nb * 64, nullptr, W2T + (size_t)e * 1024 * 512, nullptr, 512, scr, lane);
  } else if (r < 4096 + 256) {
    r -= 4096;
    const int kb = r >> 4, nb = r & 15;
    tr_item<perm256>(kargs_now()->w_plg, 1024, kb * 64, nb * 64, kargs_now()->g_plg, (u16*)(wsb + WS_WPLG), nullptr, 1024, scr, lane);
  } else {
    r -= 4096 + 256;
    const float4* pr = (const float4*)kargs_now()->p + (size_t)r * 512 + lane;
    uint2* o = (uint2*)(wsb + A_PB) + (size_t)r * 512 + lane;
    float4 v[8];
#pragma unroll
    for (int j = 0; j < 8; ++j) { const f32x4 t = __builtin_nontemporal_load((const f32x4*)(pr + 64 * j)); v[j] = make_float4(t[0], t[1], t[2], t[3]); }
#pragma unroll
    for (int j = 0; j < 8; ++j) o[64 * j] = make_uint2(pk2(v[j].x, v[j].y), pk2(v[j].z, v[j].w));
  }
}
DI void ph0_prep(const Ptrs& Punused, ldsp lds, int bid, int G) {
  unsigned char* const wsb = kargs_now()->ws;
  const int tid = threadIdx.x, lane = tid & 63, wave = tid >> 6;
  LAS float* scr = (LAS float*)(lds + wave * 16640);
  const int nwv = blockDim.x >> 6, gw = bid * nwv + wave, NGW = G * nwv;
  constexpr int I_W1 = 4096, I_W3 = 4096, I_W2 = 4096, I_X = 8192, I_WIN = 768, I_P = 2048, I_WOUT = 256, I_PLG = 256, I_PLE = 64,
                I_WR = 768, I_ROPE = 2048, I_PAR = (PAR_TOTAL + 63) / 64, I_SC = 1;
  constexpr int TOTAL = I_W1 + I_W3 + I_W2 + I_X + I_WIN + I_P + I_WOUT + I_PLG + I_PLE + I_WR + I_ROPE + I_PAR + I_SC;
  u16* W13T = (u16*)(wsb + WS_W13); u16* W2T = (u16*)(wsb + WS_W2);
  for (int r0_ = gw; r0_ < I_W1 + I_W3; r0_ += NGW) {
    int r = r0_;
      const int isw3 = r >= I_W1; if (isw3) r -= I_W1;
      const int e = r >> 7, q = r & 127, kb = q >> 3, nb = q & 7;
      u16* d0 = W13T + ((size_t)e * 1024 + nb * 128 + isw3 * 32) * 1024;
#if NEW_MASK & 0x20
      if (isw3) tr_item<w13_row_w3>(kargs_now()->w3 + (size_t)e * 1024 * 512, 512, kb * 64, nb * 64, kargs_now()->g_ffn, W13T + (size_t)e * 1024 * 1024, nullptr, 1024, scr, lane);
      else tr_item<w13_row_w1>(kargs_now()->w1 + (size_t)e * 1024 * 512, 512, kb * 64, nb * 64, kargs_now()->g_ffn, W13T + (size_t)e * 1024 * 1024, nullptr, 1024, scr, lane);
#else
      tr_item((isw3 ? kargs_now()->w3 : kargs_now()->w1) + (size_t)e * 1024 * 512, 512, kb * 64, nb * 64, kargs_now()->g_ffn, d0, d0 + 64 * 1024, 1024, scr, lane);
#endif
  }
  for (int r0_ = gw; r0_ < I_X; r0_ += NGW) {
    int r = r0_;
      const float4* xr = (const float4*)(kargs_now()->x + (size_t)r * 2048) + lane;
      float4 v[8];
#pragma unroll
      for (int j = 0; j < 8; ++j) { const f32x4 t = __builtin_nontemporal_load((const f32x4*)(xr + 64 * j)); v[j] = make_float4(t[0], t[1], t[2], t[3]); }
      float s0 = 0.f, s1 = 0.f;
#pragma unroll
      for (int j = 0; j < 4; ++j) { s0 += v[j].x * v[j].x + v[j].y * v[j].y + v[j].z * v[j].z + v[j].w * v[j].w; s1 += v[j + 4].x * v[j + 4].x + v[j + 4].y * v[j + 4].y + v[j + 4].z * v[j + 4].z + v[j + 4].w * v[j + 4].w; }
      s0 = wave_sum(s0); s1 = wave_sum(s1);
      if (lane == 0) { float* rx = (float*)(wsb + WS_RSTDX); rx[2 * r] = rsqrtf(s0 * (1.0f / 1024.0f) + EPS); rx[2 * r + 1] = rsqrtf(s1 * (1.0f / 1024.0f) + EPS); }
      uint2* o = (uint2*)((u16*)(wsb + A_XB) + (size_t)r * 2048) + lane;
#pragma unroll
      for (int j = 0; j < 8; ++j) o[64 * j] = make_uint2(pk2(v[j].x, v[j].y), pk2(v[j].z, v[j].w));
  }
  for (int r0_ = gw; r0_ < I_WIN; r0_ += NGW) {
    int r = r0_;
      const int kb = r / 48, nb = r % 48;
      u16* d0 = (u16*)(wsb + WS_WIN) + (size_t)(nb * 64) * 1024;
      tr_item<win8_row>(kargs_now()->w_in, DIN, kb * 64, nb * 64, kargs_now()->g_mix, (u16*)(wsb + WS_WIN), nullptr, 1024, scr, lane);
  }
  for (int r0_ = (gw + NGW - (768 % NGW)) % NGW; r0_ < I_WOUT; r0_ += NGW) {
    int r = r0_;
      const int kb = r >> 4, nb = r & 15;
      u16* d0 = (u16*)(wsb + WS_WOUT) + (size_t)(nb * 64) * 1024;
#if NEW_MASK & 0x8
      tr_item<perm256>(kargs_now()->w_out, 1024, kb * 64, nb * 64, nullptr, (u16*)(wsb + WS_WOUT), nullptr, 1024, scr, lane);
#else
      tr_item(kargs_now()->w_out, 1024, kb * 64, nb * 64, nullptr, d0, d0 + 32 * 1024, 1024, scr, lane);
#endif
  }
  for (int r0_ = (gw + NGW - (1024 % NGW)) % NGW; r0_ < I_PLE; r0_ += NGW) {
    int r = r0_;
      const int kb = r >> 4, nb = r & 15;
      u16* d0 = (u16*)(wsb + WS_WPLE) + (size_t)(nb * 64) * 256;
#if NEW_MASK & 0x8
      tr_item<perm256>(kargs_now()->w_ple, 1024, kb * 64, nb * 64, nullptr, (u16*)(wsb + WS_WPLE), nullptr, 256, scr, lane);
#else
      tr_item(kargs_now()->w_ple, 1024, kb * 64, nb * 64, nullptr, d0, d0 + 32 * 256, 256, scr, lane);
#endif
  }
  for (int r0_ = (gw + NGW - (1088 % NGW)) % NGW; r0_ < I_WR; r0_ += NGW) {
    int r = r0_;
      const int idx = r * 64 + lane, rr = idx >> 10, k = idx & 1023;
      float v = 0.f;
      if (rr < 4) v = kargs_now()->w_rg[k * 4 + rr]; else if (rr < 36) v = kargs_now()->w_re[k * 32 + (rr - 4)];
      const float wv_ = v * kargs_now()->g_ffn[k];
      const unsigned hb_ = pk2(wv_, 0.f) & 0xffffu;
      const unsigned lb_ = pk2(wv_ - __uint_as_float(hb_ << 16), 0.f) & 0xffffu;
      ((u16*)(wsb + WS_WR))[idx] = (u16)hb_; ((u16*)(wsb + WS_WR))[48 * 1024 + idx] = (u16)lb_;
  }
  for (int r0_ = gw; r0_ < I_ROPE; r0_ += NGW) {
    int r = r0_;
      const int idx = r * 64 + lane, s = idx >> 5, i = idx & 31;
      const float inv = __builtin_amdgcn_exp2f(-(float)(2 * i) * (13.287712379549449f / 64.0f));
      const float ang = (float)s * inv;
      const float rev = ang * 0.15915494309189535f, fr_ = rev - floorf(rev);
      const float sn = __builtin_amdgcn_sinf(fr_), cs = __builtin_amdgcn_cosf(fr_);
      ((float2*)(wsb + WS_ROPE))[idx] = make_float2(cs, sn);
  }
  for (int r0_ = (gw + NGW - (1856 % NGW)) % NGW; r0_ < I_PAR; r0_ += NGW) {
    int r = r0_;
      const int idx = r * 64 + lane;
      if (idx < PAR_TOTAL) {
        float v;
        if (idx < PAR_GKA) v = kargs_now()->g_qa[idx]; else if (idx < PAR_GSUB) v = kargs_now()->g_ka[idx - PAR_GKA]; else if (idx < PAR_GQB) v = kargs_now()->g_sub[idx - PAR_GSUB];
        else if (idx < PAR_GKB) v = kargs_now()->g_qb[idx - PAR_GQB]; else if (idx < PAR_GPLE) v = kargs_now()->g_kb[idx - PAR_GKB]; else if (idx < PAR_RPB) v = kargs_now()->g_ple[idx - PAR_GPLE];
        else v = kargs_now()->rpb[idx - PAR_RPB];
        ((float*)(wsb + WS_PAR))[idx] = v;
      }
  }
  if (gw == NGW - 1) {
    const float a1 = kargs_now()->lam_q1[lane] * kargs_now()->lam_k1[lane], a2 = kargs_now()->lam_q2[lane] * kargs_now()->lam_k2[lane];
    float mq = fabsf(kargs_now()->g_qa[lane]), mk = fabsf(kargs_now()->g_ka[lane]);
    float mqb = fabsf(kargs_now()->g_qb[lane & 31]), mkb = fabsf(kargs_now()->g_kb[lane & 31]);
    const float s1 = wave_sum(a1), s2 = wave_sum(a2);
#pragma unroll
    for (int o = 1; o < 64; o <<= 1) { mq = fmaxf(mq, __shfl_xor(mq, o)); mk = fmaxf(mk, __shfl_xor(mk, o)); mqb = fmaxf(mqb, __shfl_xor(mqb, o)); mkb = fmaxf(mkb, __shfl_xor(mkb, o)); }
    if (lane == 0) {
      float* sc = (float*)(wsb + WS_SCAL);
      sc[0] = expf(s1) - expf(s2) + LAM_INIT;
      sc[1] = 8.0f * mq * mk * LOG2E;
      sc[2] = 5.656854249f * mqb * mkb;
    }
    if (lane < 32) ((int*)(wsb + WS_CNT))[lane * CNT_STRIDE] = 0;
  }
  if (gw >= NGW - 17 && gw < NGW - 1) {
    const int hd = gw - (NGW - 17);
    float mx = 0.f;
    for (int i = lane; i < 465; i += 64) mx = fmaxf(mx, fabsf(kargs_now()->rpb[hd * 465 + i]));
#pragma unroll
    for (int o = 1; o < 64; o <<= 1) mx = fmaxf(mx, __shfl_xor(mx, o));
    if (lane == 0) ((float*)(wsb + WS_SCAL))[16 + hd] = mx;
  }
}

DI uint4 pk8(const f32x4 a, const f32x4 b) { return make_uint4(pk2(a[0], a[1]), pk2(a[2], a[3]), pk2(b[0], b[1]), pk2(b[2], b[3])); }

typedef __attribute__((ext_vector_type(4))) unsigned u32x4;
DI bf16x8 packp(const f32x16& x, int s) {
  u32x4 p;
  p[0] = pk2(x[8 * s + 0], x[8 * s + 1]); p[1] = pk2(x[8 * s + 2], x[8 * s + 3]);
  p[2] = pk2(x[8 * s + 4], x[8 * s + 5]); p[3] = pk2(x[8 * s + 6], x[8 * s + 7]);
  return __builtin_bit_cast(bf16x8, p);
}
DI int grp_of(int kk) { return ((kk >> 2) == 1 || (kk >> 2) == 2 || (kk >> 2) == 4 || (kk >> 2) == 7) ? 1 : 0; }
DI int rank_of(int kk) { const int q = kk >> 2; return kk - ((q == 0) ? 0 : (q <= 2) ? 4 : (q == 3 || q == 4) ? 8 : (q <= 6) ? 12 : 16); }
DI int key_of(int grp, int jj) { return grp ? (jj < 8 ? jj + 4 : (jj < 12 ? jj + 8 : jj + 16)) : (jj < 4 ? jj : (jj < 8 ? jj + 8 : jj + 12)); }
constexpr int DA_STAGE = 33280, DA_VOFF = 16640;
typedef __attribute__((ext_vector_type(4))) short s16x4;
DI void ph4_router_t(const Ptrs& P, ldsp lds, int bid, int G) {
  const int tid = threadIdx.x, lane = tid & 63, wave = __builtin_amdgcn_readfirstlane(tid >> 6), t = lane & 15, kk = lane >> 4;
  LAS float* lg = (LAS float*)lds;
  const u16* h1 = (const u16*)(P.ws + A_H1B); const u16* WrH = (const u16*)(P.ws + WS_WR);
  for (int item = bid; item < 256; item += G) {
    const int tok0 = item * 64;
    float4 s0 = make_float4(0.f, 0.f, 0.f, 0.f), s1 = s0, s2 = s0, s3 = s0;
    if (wave == 0) {
      const float* sp = (const float*)(P.ws + WS_SSQ1P) + (size_t)(tok0 + lane) * SSQ_PARTS;
      s0 = *(const float4*)sp; s1 = *(const float4*)(sp + 4); s2 = *(const float4*)(sp + 8); s3 = *(const float4*)(sp + 12);
    }
    f32x4 acc[4][3];
#pragma unroll
    for (int tt = 0; tt < 4; ++tt)
#pragma unroll
      for (int et = 0; et < 3; ++et) acc[tt][et] = (f32x4){0.f, 0.f, 0.f, 0.f};
    const u16* ap = h1 + (size_t)(tok0 + t) * 1024 + 128 * wave + 8 * kk;
    const u16* bp = WrH + (size_t)t * 1024 + 128 * wave + 8 * kk;
#pragma unroll
    for (int s = 0; s < 4; ++s) {
      bf16x8 a[4];
#pragma unroll
      for (int tt = 0; tt < 4; ++tt) a[tt] = *(const bf16x8*)(ap + (size_t)tt * 16 * 1024 + 32 * s);
#pragma unroll
      for (int et = 0; et < 3; ++et) {
        const bf16x8 bh = *(const bf16x8*)(bp + et * 16 * 1024 + 32 * s), bl = *(const bf16x8*)(bp + (48 + et * 16) * 1024 + 32 * s);
#pragma unroll
        for (int tt = 0; tt < 4; ++tt) {
          acc[tt][et] = __builtin_amdgcn_mfma_f32_16x16x32_bf16(a[tt], bh, acc[tt][et], 0, 0, 0);
          acc[tt][et] = __builtin_amdgcn_mfma_f32_16x16x32_bf16(a[tt], bl, acc[tt][et], 0, 0, 0);
        }
      }
    }
    __syncthreads();
#pragma unroll
    for (int tt = 0; tt < 4; ++tt)
#pragma unroll
      for (int et = 0; et < 3; ++et)
#pragma unroll
        for (int i = 0; i < 4; ++i) lg[wave * (64 * 49) + (16 * tt + 4 * kk + i) * 49 + 16 * et + t] = acc[tt][et][i];
    __syncthreads();
    if (wave == 0) {
      const int tok = tok0 + lane;
      const float rstd = rsqrtf(((s0.x + s0.y + s0.z + s0.w) + (s1.x + s1.y + s1.z + s1.w) + (s2.x + s2.y + s2.z + s2.w) + (s3.x + s3.y + s3.z + s3.w)) * (1.0f / 1024.0f) + EPS);
      const LAS float* L = lg + lane * 49;
      float gl[4] = {0.f, 0.f, 0.f, 0.f};
#pragma unroll
      for (int w = 0; w < 8; ++w)
#pragma unroll
        for (int i = 0; i < 4; ++i) gl[i] += L[w * (64 * 49) + i];
      int gi = 0; float gm = gl[0];
#pragma unroll
      for (int i = 1; i < 4; ++i) { if (gl[i] > gm) { gm = gl[i]; gi = i; } }
      float gs = 0.f;
#pragma unroll
      for (int i = 0; i < 4; ++i) gs += __expf((gl[i] - gm) * rstd);
      const float gate = 1.0f / gs;
      const LAS float* el = L + 4 + 8 * gi;
      float ev[8] = {0.f, 0.f, 0.f, 0.f, 0.f, 0.f, 0.f, 0.f};
#pragma unroll
      for (int w = 0; w < 8; ++w)
#pragma unroll
        for (int i = 0; i < 8; ++i) ev[i] += el[w * (64 * 49) + i];
      int e1 = 0; float m1 = ev[0];
#pragma unroll
      for (int i = 1; i < 8; ++i) { if (ev[i] > m1) { m1 = ev[i]; e1 = i; } }
      int e2 = 0; float m2v = -3.0e38f;
#pragma unroll
      for (int i = 0; i < 8; ++i) { if (i != e1 && ev[i] > m2v) { m2v = ev[i]; e2 = i; } }
      const float p2 = __expf((m2v - m1) * rstd);
      const float wa = gate / (1.0f + p2), wb = gate * p2 / (1.0f + p2);
      int* cnt = (int*)(P.ws + WS_CNT); int* tokl = (int*)(P.ws + WS_TOKL); float* wl = (float*)(P.ws + WS_WL);
      const int ea = gi * 8 + e1, eb = gi * 8 + e2;
      ((float*)(P.ws + WS_RSTD1))[tok] = rstd;
      LAS int* hist = (LAS int*)(lds + 8 * 64 * 49 * 4);
      if (lane < 32) hist[lane] = 0;
      asm volatile("s_waitcnt lgkmcnt(0)" ::: "memory");
      const int ra = __hip_atomic_fetch_add(hist + ea, 1, __ATOMIC_RELAXED, __HIP_MEMORY_SCOPE_WORKGROUP);
      const int rb = __hip_atomic_fetch_add(hist + eb, 1, __ATOMIC_RELAXED, __HIP_MEMORY_SCOPE_WORKGROUP);
      asm volatile("s_waitcnt lgkmcnt(0)" ::: "memory");
      const int mycnt = (lane < 32) ? hist[lane] : 0;
      int base = 0;
      if (lane < 32 && mycnt > 0) base = atomicAdd(&cnt[lane * CNT_STRIDE], mycnt);
      const int pa = __shfl(base, ea) + ra, pb = __shfl(base, eb) + rb;
      float* rsl = (float*)(P.ws + A_RSL);
      tokl[ea * 16384 + pa] = tok * 2; wl[ea * 16384 + pa] = wa; rsl[ea * 16384 + pa] = rstd;
      tokl[eb * 16384 + pb] = tok * 2 + 1; wl[eb * 16384 + pb] = wb; rsl[eb * 16384 + pb] = rstd;
    }
  }
}

DI void ph4_router(const Ptrs& P, ldsp lds, int bid, int G) {
  ph4_router_t(P, lds, bid, G);
}

DI void ph7_combine(const Ptrs& P, ldsp lds, int bid, int G) {
  const int lane = threadIdx.x & 63, wave = __builtin_amdgcn_readfirstlane(threadIdx.x >> 6);
  const int nwv = blockDim.x >> 6;
  constexpr int TB = 2;
  for (int tok0 = (bid * nwv + wave) * TB; tok0 < T; tok0 += G * nwv * TB) {
    u32x4 hv[TB][2], ya[TB][2], yc[TB][2];
    float se[TB];
#pragma unroll
    for (int t = 0; t < TB; ++t) {
      const size_t ro = (size_t)(tok0 + t) * 1024 + 8 * lane;
#pragma unroll
      for (int j = 0; j < 2; ++j) {
        hv[t][j] = __builtin_nontemporal_load((const u32x4*)((const u16*)(P.ws + A_H1B) + ro + 512 * j));
        ya[t][j] = __builtin_nontemporal_load((const u32x4*)((const u16*)(P.ws + A_Y0) + ro + 512 * j));
        yc[t][j] = __builtin_nontemporal_load((const u32x4*)((const u16*)(P.ws + A_Y1) + ro + 512 * j));
      }
      se[t] = (lane < SSQ_PARTS) ? ((const float*)(P.ws + WS_SSQEP))[(size_t)(tok0 + t) * SSQ_PARTS + lane] : 0.f;
    }
    float ss[TB];
#pragma unroll
    for (int t = 0; t < TB; ++t) {
      ss[t] = 0.f;
#pragma unroll
      for (int j = 0; j < 2; ++j) {
        unsigned ow[4];
#pragma unroll
        for (int k = 0; k < 4; ++k) {
          const unsigned hw = hv[t][j][k], aw = ya[t][j][k], cw = yc[t][j][k];
          const float v0 = __uint_as_float(hw << 16) + __uint_as_float(aw << 16) + __uint_as_float(cw << 16);
          const float v1 = __uint_as_float(hw & 0xffff0000u) + __uint_as_float(aw & 0xffff0000u) + __uint_as_float(cw & 0xffff0000u);
          ss[t] += v0 * v0 + v1 * v1;
          ow[k] = pk2(v0, v1);
        }
        *(uint4*)((u16*)(P.ws + A_H2B) + (size_t)(tok0 + t) * 1024 + 8 * lane + 512 * j) = make_uint4(ow[0], ow[1], ow[2], ow[3]);
      }
    }
#pragma unroll
    for (int o = 1; o < 64; o <<= 1) {
#pragma unroll
      for (int t = 0; t < TB; ++t) { ss[t] += __shfl_xor(ss[t], o); se[t] += __shfl_xor(se[t], o); }
    }
    if (lane == 0) {
#pragma unroll
      for (int t = 0; t < TB; ++t) {
        ((float*)(P.ws + WS_RSTD2))[tok0 + t] = rsqrtf(ss[t] * (1.0f / 1024.0f) + EPS);
        ((float*)(P.ws + WS_RSTDE))[tok0 + t] = rsqrtf(se[t] * (1.0f / 1024.0f) + EPS);
      }
    }
  }
}

namespace g8 {
constexpr int BM = 256, BK = 64, HALF = 128, HTB = HALF * BK * 2, STAGE_BYTES = 8 * HTB, NXCD = 8, WGM = 8;
constexpr int LDS_EXTRA8 = STAGE_BYTES;
constexpr int LDS_BYTES8 = STAGE_BYTES + 4096;
DI int lds_byte(int r, int c) { const int st = (r >> 4) * 2 + (c >> 5), rr = r & 15, cc = c & 31, ob = rr * 64 + cc * 2; return st * 1024 + (ob ^ (((ob >> 9) & 1) << 5)); }
DI void stage_rc(int b, int& R, int& C) { const int st = b / 1024, sb = b % 1024, swz = sb ^ (((sb >> 9) & 1) << 5); R = (st >> 1) * 16 + swz / 64; C = (st & 1) * 32 + (swz % 64) / 2; }

struct Unit { int pm, pn, e, ce; };
struct GridOrder {
  int nM, nN, nwg, G, c; unsigned pnmap;
  DI void init(int nM_, int nN_, int G_, int c_, unsigned pnmap_ = 0u) { nM = nM_; nN = nN_; nwg = nM * nN; G = G_; c = c_; pnmap = pnmap_; }
  DI bool next(int i, Unit& u) const {
    const int L = i * G + c; if (L >= nwg) return false;
    int wgid = L; { const int q = nwg / NXCD, r = nwg % NXCD, xcd = wgid % NXCD, off = wgid / NXCD; wgid = (xcd < r ? xcd * (q + 1) : r * (q + 1) + (xcd - r) * q) + off; }
    const int nig = WGM * nN, gid = wgid / nig, fm = gid * WGM, gsz = (nM - fm) < WGM ? (nM - fm) : WGM;
    u.pm = fm + ((wgid % nig) % gsz); u.pn = (wgid % nig) / gsz; if (pnmap) u.pn = (int)((pnmap >> (4 * u.pn)) & 15u); u.e = 0; u.ce = 0; return true;
  }
};

template <class Epi, class Sched, bool SWAP, bool GATHER>
DI void gemm_phase(ldsp lds, const unsigned char* Abase, const unsigned char* Bbase, int K, const Sched& S, const Epi& E, int pA = 0, int pB = 0) {
  if (pA == 0) pA = K; if (pB == 0) pB = K;
  int tid = threadIdx.x; asm volatile("" : "+v"(tid));
  const int wid = __builtin_amdgcn_readfirstlane(tid >> 6), lane = tid & 63, wr = wid >> 2, wc = wid & 3, fr = lane & 15, fq = lane >> 4;
  const int nt = K / BK;
  int sR[2], sC[2];
  unsigned voffB[2], voffA[2];
#pragma unroll
  for (int i = 0; i < 2; ++i) { stage_rc(tid * 16 + i * 8192, sR[i], sC[i]); voffB[i] = (unsigned)(sR[i] * pB + sC[i]) * 2u; voffA[i] = (unsigned)(sR[i] * pA + sC[i]) * 2u; }
  const size_t tstepA = (size_t)BM * pA * 2;
  const size_t kstep = (size_t)(BK * 2);
  const size_t hstep = (size_t)HALF * pB * 2, hstepA = (size_t)HALF * pA * 2;
  const unsigned ldsw = (unsigned)wid * 1024u;
  const int aoff = lds_byte(wr * 64 + fr, fq * 8), boff = lds_byte(wc * 32 + fr, fq * 8);
#define G8_SA(b, h) (((b) * 2 + (h)) * HTB)
#define G8_SB(b, h) ((4 + (b) * 2 + (h)) * HTB)
#define G8_STAGE_B(bufoff, gbase) do { _Pragma("unroll") for (int _i = 0; _i < 2; ++_i) \
    __builtin_amdgcn_global_load_lds((const GAS unsigned*)((const unsigned char*)(gbase) + voffB[_i]), (LAS unsigned*)(lds + (bufoff) + ldsw + _i * 8192), 16, 0, 0); } while (0)
#define G8_STAGE_A(bufoff, hsel, nx, koff) do { _Pragma("unroll") for (int _i = 0; _i < 2; ++_i) { \
    const unsigned char* _p; \
    if (GATHER) _p = Abase + (size_t)((nx) ? ((hsel) ? nv1[_i] : nv0[_i]) : ((hsel) ? cv1[_i] : cv0[_i])) + (koff); \
    else _p = ((nx) ? nA : cA) + ((hsel) ? hstepA : (size_t)0) + voffA[_i] + (koff); \
    __builtin_amdgcn_global_load_lds((const GAS unsigned*)_p, (LAS unsigned*)(lds + (bufoff) + ldsw + _i * 8192), 16, 0, 0); } } while (0)
#define G8_LDA(dst, b, h) do { _Pragma("unroll") for (int m = 0; m < 4; ++m) _Pragma("unroll") for (int k = 0; k < 2; ++k) dst[m][k] = *(const LAS bf16x8*)(lds + G8_SA(b, h) + aoff + m * 2048 + k * 1024); } while (0)
#define G8_LDB(dst, b, h) do { _Pragma("unroll") for (int n = 0; n < 2; ++n) _Pragma("unroll") for (int k = 0; k < 2; ++k) dst[n][k] = *(const LAS bf16x8*)(lds + G8_SB(b, h) + boff + n * 2048 + k * 1024); } while (0)
#define G8_MMA(ai, bj, At, Bt) do { __builtin_amdgcn_s_setprio(1); \
    _Pragma("unroll") for (int m = 0; m < 4; ++m) _Pragma("unroll") for (int n = 0; n < 2; ++n) _Pragma("unroll") for (int k = 0; k < 2; ++k) \
        acc[ai][bj][m][n] = SWAP ? __builtin_amdgcn_mfma_f32_16x16x32_bf16(At[m][k], Bt[n][k], acc[ai][bj][m][n], 0, 0, 0) \
                                 : __builtin_amdgcn_mfma_f32_16x16x32_bf16(Bt[n][k], At[m][k], acc[ai][bj][m][n], 0, 0, 0); \
    __builtin_amdgcn_s_setprio(0); } while (0)
#define G8_WAIT_V(n) asm volatile("s_waitcnt vmcnt(" #n ")" ::: "memory")
#define G8_WAIT_L(n) asm volatile("s_waitcnt lgkmcnt(" #n ")" ::: "memory")
#define G8_BAR __builtin_amdgcn_s_barrier()
#define G8_SCHED __builtin_amdgcn_sched_barrier(0)
  Unit cur, nxt; int ui = 0;
  if (!S.next(0, cur)) return;
  f32x4 acc[2][2][4][2];
#pragma unroll
  for (int a = 0; a < 2; ++a)
#pragma unroll
    for (int b = 0; b < 2; ++b)
#pragma unroll
      for (int m = 0; m < 4; ++m)
#pragma unroll
        for (int n = 0; n < 2; ++n) acc[a][b][m][n] = (f32x4){0.f, 0.f, 0.f, 0.f};
  bf16x8 At[4][2], B0[2][2], B1[2][2];
  unsigned cv0[2] = {0u, 0u}, cv1[2] = {0u, 0u}, nv0[2] = {0u, 0u}, nv1[2] = {0u, 0u};
  const unsigned char* cA = Abase; const unsigned char* nA = Abase;
  if (GATHER) E.a_off(cur, sR, sC, cv0, cv1); else cA = Abase + (size_t)cur.pm * tstepA;
  const unsigned char* cB = Bbase + E.b_off(cur);
  G8_STAGE_B(G8_SB(0, 0), cB); G8_STAGE_A(G8_SA(0, 0), 0, false, 0); G8_STAGE_B(G8_SB(0, 1), cB + hstep); G8_STAGE_A(G8_SA(0, 1), 1, false, 0);
  if (wr == 1) G8_BAR;
  G8_WAIT_V(4); G8_BAR;
  G8_STAGE_B(G8_SB(1, 0), cB + kstep); G8_STAGE_A(G8_SA(1, 0), 0, false, kstep); G8_STAGE_B(G8_SB(1, 1), cB + hstep + kstep);
  G8_WAIT_V(6); G8_BAR;
  for (;;) {
    const bool has_next = S.next(ui + 1, nxt);
    if (GATHER) { if (has_next) E.a_off(nxt, sR, sC, nv0, nv1); else { nv0[0] = cv0[0]; nv0[1] = cv0[1]; nv1[0] = cv1[0]; nv1[1] = cv1[1]; } }
    else nA = has_next ? Abase + (size_t)nxt.pm * tstepA : cA;
    const unsigned char* nB = has_next ? Bbase + E.b_off(nxt) : cB;
#pragma unroll 1
    for (int t = 0; t < nt; t += 2) {
      const bool last = (t == nt - 2);
      const size_t k1 = (size_t)(t + 1) * kstep;
      const size_t k2 = last ? 0 : (size_t)(t + 2) * kstep, k3 = k2 + kstep;
      const unsigned char* b2 = last ? nB : cB + (size_t)(t + 2) * kstep; const unsigned char* b3 = b2 + kstep;
      G8_LDB(B0, 0, 0); G8_SCHED; G8_LDA(At, 0, 0); G8_STAGE_A(G8_SA(1, 1), 1, false, k1);
      G8_WAIT_L(8); G8_BAR; G8_WAIT_L(0); G8_MMA(0, 0, At, B0); G8_BAR; G8_SCHED;
      G8_LDB(B1, 0, 1); G8_STAGE_B(G8_SB(0, 0), b2);
      G8_BAR; G8_WAIT_L(0); G8_MMA(0, 1, At, B1); G8_BAR;
      G8_LDA(At, 0, 1); G8_STAGE_A(G8_SA(0, 0), 0, last, k2);
      G8_BAR; G8_WAIT_L(0); G8_MMA(1, 0, At, B0); G8_BAR; G8_SCHED;
      G8_STAGE_B(G8_SB(0, 1), b2 + hstep);
      G8_WAIT_V(6); G8_BAR; G8_MMA(1, 1, At, B1); G8_BAR;
      G8_LDB(B0, 1, 0); G8_SCHED; G8_LDA(At, 1, 0); G8_STAGE_A(G8_SA(0, 1), 1, last, k2);
      G8_WAIT_L(8); G8_BAR; G8_WAIT_L(0); G8_MMA(0, 0, At, B0); G8_BAR; G8_SCHED;
      G8_LDB(B1, 1, 1); G8_STAGE_B(G8_SB(1, 0), b3);
      G8_BAR; G8_WAIT_L(0); G8_MMA(0, 1, At, B1); G8_BAR;
      G8_LDA(At, 1, 1); G8_STAGE_A(G8_SA(1, 0), 0, last, k3);
      G8_BAR; G8_WAIT_L(0); G8_MMA(1, 0, At, B0); G8_BAR; G8_SCHED;
      G8_STAGE_B(G8_SB(1, 1), b3 + hstep);
      G8_WAIT_V(6); G8_BAR; G8_MMA(1, 1, At, B1); G8_BAR;
    }
    E(acc, cur, wr, wc, fr, fq);
    if (!has_next) break;
#pragma unroll
    for (int a = 0; a < 2; ++a)
#pragma unroll
      for (int b = 0; b < 2; ++b)
#pragma unroll
        for (int m = 0; m < 4; ++m)
#pragma unroll
          for (int n = 0; n < 2; ++n) acc[a][b][m][n] = (f32x4){0.f, 0.f, 0.f, 0.f};
    cur = nxt; cB = nB; cA = nA; ++ui;
    if (GATHER) { cv0[0] = nv0[0]; cv0[1] = nv0[1]; cv1[0] = nv1[0]; cv1[1] = nv1[1]; }
  }
  G8_WAIT_V(0);
  if (wr == 0) G8_BAR;
  G8_BAR;
#undef G8_SA
#undef G8_SB
#undef G8_STAGE_A
#undef G8_STAGE_B
#undef G8_LDA
#undef G8_LDB
#undef G8_MMA
#undef G8_WAIT_V
#undef G8_WAIT_L
#undef G8_BAR
#undef G8_SCHED
}
DI void dense_a_off(int pm, int K, const int (&sR)[2], const int (&sC)[2], unsigned (&v0)[2], unsigned (&v1)[2]) {
#pragma unroll
  for (int i = 0; i < 2; ++i) { v0[i] = (unsigned)((pm * BM + sR[i]) * K + sC[i]) * 2u; v1[i] = v0[i] + (unsigned)(HALF * K * 2); }
}
}

DI int win8_row(int f) {
  if (f < 1024) {
    const int rel = f & 511, pn = (f >> 9) * 2 + (rel >> 8), hl = (rel >> 7) & 1, comp = (rel >> 6) & 1, i = rel & 63;
    const int bj = i >> 5, ip = i & 31, fq = ip >> 3, n = (ip >> 2) & 1, j = ip & 3;
    return pn * 256 + 128 * bj + 32 * (2 * hl + comp) + 16 * n + 4 * fq + j;
  }
  if (f < 1536 || f >= 2560) return f;
  const int rel = (f - 1536) & 511, pn = 6 + ((f - 1536) >> 9) * 2 + (rel >> 8), hl = (rel >> 5) & 7, ip = rel & 31;
  const int bj = hl >> 2, wc = hl & 3, fq = ip >> 3, n = (ip >> 2) & 1, j = ip & 3;
  return pn * 256 + 128 * bj + 32 * wc + 16 * n + 4 * fq + j;
}
struct EpiInproj {
  const Ptrs* Pp;
  DI void a_off(const g8::Unit& u, const int (&sR)[2], const int (&sC)[2], unsigned (&v0)[2], unsigned (&v1)[2]) const { g8::dense_a_off(u.pm, 1024, sR, sC, v0, v1); }
  DI size_t b_off(const g8::Unit& u) const { return (size_t)u.pn * 256 * 1024 * 2; }
  DI void operator()(const f32x4 (&acc)[2][2][4][2], const g8::Unit& u, int wr, int wc, int fr, int fq) const {
    const Ptrs& P = *Pp;
    const float* rstdx = (const float*)(P.ws + WS_RSTDX);
    asm volatile("" : "+v"(rstdx));
    const int pn = u.pn, row00 = u.pm * 256 + wr * 64, b = row00 >> 12;
    float rsr[8];
#pragma unroll
    for (int k = 0; k < 8; ++k) rsr[k] = rstdx[row00 + 128 * (k >> 2) + 16 * (k & 3) + fr];
    const float qsA = 0.125f * LOG2E, qsB = 0.17677669529663687f * LOG2E;
    if (pn < 4) {
      const int isk = pn >= 2, head = 2 * (pn & 1) + (wc >> 1), comp = wc & 1;
      const float* gg = ((const float*)(P.ws + WS_PAR)) + (isk ? PAR_GKA : PAR_GQA);
      asm volatile("" : "+v"(gg));
      const float4 g1a = *(const float4*)(gg + 8 * fq), g1b = *(const float4*)(gg + 8 * fq + 4), g2a = *(const float4*)(gg + 32 + 8 * fq), g2b = *(const float4*)(gg + 36 + 8 * fq);
      const float ga[8] = {g1a.x, g1a.y, g1a.z, g1a.w, g1b.x, g1b.y, g1b.z, g1b.w}, gb[8] = {g2a.x, g2a.y, g2a.z, g2a.w, g2b.x, g2b.y, g2b.z, g2b.w};
      u16* dstb = (u16*)(P.ws + (isk ? A_KA : A_QA)) + (size_t)(b * 4 + head) * 4096 * 128 + comp * 64 + 8 * fq;
      const float2* rope = (const float2*)(P.ws + WS_ROPE);
      struct Rp { f32x4 c0, c1, c2, c3; };
      auto ldrope = [&](int k) { const int s = (row00 + 128 * (k >> 2) + 16 * (k & 3) + fr) & 4095; const f32x4* rp = (const f32x4*)(rope + (size_t)s * 32 + 8 * fq);
        Rp r; r.c0 = rp[0]; r.c1 = rp[1]; r.c2 = rp[2]; r.c3 = rp[3]; return r; };
      Rp cur = ldrope(0);
#pragma unroll
      for (int k = 0; k < 8; ++k) {
        const int ai = k >> 2, m = k & 3;
        Rp nxt = cur;
        if (k < 7) nxt = ldrope(k + 1);
        const int row = row00 + 128 * ai + 16 * m + fr, s = row & 4095;
        const float rs = rsr[k];
        float x1[8], x2[8]; float ss = 0.f;
#pragma unroll
        for (int n = 0; n < 2; ++n)
#pragma unroll
          for (int j = 0; j < 4; ++j) { x1[4 * n + j] = acc[ai][0][m][n][j] * rs; x2[4 * n + j] = acc[ai][1][m][n][j] * rs; ss += x1[4 * n + j] * x1[4 * n + j] + x2[4 * n + j] * x2[4 * n + j]; }
        ss += __shfl_xor(ss, 16); ss += __shfl_xor(ss, 32);
        const float rn = rsqrtf(ss * (1.0f / 64.0f) + EPS) * (isk ? 1.0f : qsA);
        const float cs[8] = {cur.c0[0], cur.c0[2], cur.c1[0], cur.c1[2], cur.c2[0], cur.c2[2], cur.c3[0], cur.c3[2]}, sn[8] = {cur.c0[1], cur.c0[3], cur.c1[1], cur.c1[3], cur.c2[1], cur.c2[3], cur.c3[1], cur.c3[3]};
        f32x4 o1a, o1b, o2a, o2b;
#pragma unroll
        for (int e = 0; e < 8; ++e) {
          const float y = x1[e] * rn * ga[e], z = x2[e] * rn * gb[e];
          const float p1 = y * cs[e] - z * sn[e], p2 = z * cs[e] + y * sn[e];
          if (e < 4) { o1a[e] = p1; o2a[e] = p2; } else { o1b[e - 4] = p1; o2b[e - 4] = p2; }
        }
        u16* d = dstb + (size_t)s * 128;
        *(uint4*)d = pk8(o1a, o1b);
        *(uint4*)(d + 32) = pk8(o2a, o2b);
        asm volatile("" ::: "memory");
        cur = nxt;
      }
    } else if (pn >= 6 && pn < 10) {
      const int isk = pn >= 8;
      const float* gg = ((const float*)(P.ws + WS_PAR)) + (isk ? PAR_GKB : PAR_GQB);
      asm volatile("" : "+v"(gg));
      const float4 g1a = *(const float4*)(gg + 8 * fq), g1b = *(const float4*)(gg + 8 * fq + 4);
      const float ga[8] = {g1a.x, g1a.y, g1a.z, g1a.w, g1b.x, g1b.y, g1b.z, g1b.w};
#pragma unroll
      for (int bj = 0; bj < 2; ++bj) {
        const int hd = 8 * (pn & 1) + 4 * bj + wc;
        u16* dstb = (u16*)(P.ws + (isk ? A_KB : A_QB)) + (size_t)(b * 16 + hd) * 4096 * 32 + 8 * fq;
#pragma unroll
        for (int ai = 0; ai < 2; ++ai)
#pragma unroll
          for (int m = 0; m < 4; ++m) {
            const int row = row00 + 128 * ai + 16 * m + fr, s = row & 4095;
            const float rs = rsr[4 * ai + m];
            float x[8]; float ss = 0.f;
#pragma unroll
            for (int n = 0; n < 2; ++n)
#pragma unroll
              for (int j = 0; j < 4; ++j) { x[4 * n + j] = acc[ai][bj][m][n][j] * rs; ss += x[4 * n + j] * x[4 * n + j]; }
            ss += __shfl_xor(ss, 16); ss += __shfl_xor(ss, 32);
            const float rn = rsqrtf(ss * (1.0f / 32.0f) + EPS) * (isk ? 1.0f : qsB);
            f32x4 oa, ob;
#pragma unroll
            for (int e = 0; e < 4; ++e) { oa[e] = x[e] * rn * ga[e]; ob[e] = x[4 + e] * rn * ga[4 + e]; }
            *(uint4*)(dstb + (size_t)s * 32) = pk8(oa, ob);
          }
      }
    } else {
      const int isA = pn < 6;
#pragma unroll
      for (int ai = 0; ai < 2; ++ai)
#pragma unroll
        for (int m = 0; m < 4; ++m) {
          const int row0 = row00 + 128 * ai + 16 * m + 4 * fq, s0 = row0 & 4095;
          const float4 rs = *(const float4*)(rstdx + row0);
          const int sp = isA ? permpos(s0) : s0;
#pragma unroll
          for (int bj = 0; bj < 2; ++bj)
#pragma unroll
            for (int n = 0; n < 2; ++n) {
              const int c = 128 * bj + 32 * wc + 16 * n + fr;
              u16* dst;
              if (isA) dst = (u16*)(P.ws + A_VAT) + ((size_t)(b * 4 + 2 * (pn - 4) + (c >> 7)) * 128 + (c & 127)) * 4096;
              else dst = (u16*)(P.ws + A_VBT) + ((size_t)(b * 16 + 8 * (pn - 10) + (c >> 5)) * 32 + (c & 31)) * 4096;
              const f32x4 v = acc[ai][bj][m][n];
              *(uint2*)(dst + sp) = make_uint2(pk2(v[0] * rs.x, v[1] * rs.y), pk2(v[2] * rs.z, v[3] * rs.w));
            }
        }
    }
  }
};
DI void ph1_inproj8(const Ptrs& P, ldsp lds, int bid, int G) {
  EpiInproj E; E.Pp = &P;
  {
    g8::GridOrder S; S.init(64, 8, G, bid, 0x98763210u);
    g8::gemm_phase<EpiInproj, g8::GridOrder, false, false>(lds, (const unsigned char*)(P.ws + A_XB), (const unsigned char*)(P.ws + WS_WIN), 1024, S, E);
  }
  {
    g8::GridOrder S; S.init(64, 4, G, bid, 0xBA54u);
    g8::gemm_phase<EpiInproj, g8::GridOrder, true, false>(lds, (const unsigned char*)(P.ws + A_XB), (const unsigned char*)(P.ws + WS_WIN), 1024, S, E);
  }
}

DI int p32(int ip) { return 16 * ((ip >> 2) & 1) + 4 * (ip >> 3) + (ip & 3); }
DI int perm256(int f) { return (f & ~31) | p32(f & 31); }
DI int w13_row_w1(int f) { return ((f >> 7) << 8) | (f & 96) | p32(f & 31); }
DI int w13_row_w3(int f) { return (((f >> 7) << 8) | (f & 96) | p32(f & 31)) + 128; }

template <bool PLE>
struct EpiOut {
  const Ptrs* Pp;
  DI void a_off(const g8::Unit&, const int (&)[2], const int (&)[2], unsigned (&)[2], unsigned (&)[2]) const {}
  DI size_t b_off(const g8::Unit& u) const { return (size_t)u.pn * 256 * (PLE ? 256 : 1024) * 2; }
  struct Ld { float4 a0, a1, b0, b1; };
  DI void operator()(const f32x4 (&acc)[2][2][4][2], const g8::Unit& u, int wr, int wc, int fr, int fq) const {
    const Ptrs& P = *Pp;
    float* ssqp = (float*)(P.ws + (PLE ? WS_SSQEP : WS_SSQ1P));
    const int row0 = u.pm * 256 + 64 * wr + fr, col0 = u.pn * 256 + 32 * wc + 8 * fq;
    auto load = [&](int gidx) { const int ai = gidx >> 2, m = gidx & 3; const size_t go = (size_t)(row0 + 128 * ai + 16 * m) * 1024 + col0;
      Ld l; if (!PLE) { const u16* xbp = (const u16*)(P.ws + A_XB) + go; const uint4 ua = *(const uint4*)xbp, ub = *(const uint4*)(xbp + 128);
        l.a0 = make_float4(__uint_as_float(ua.x << 16), __uint_as_float(ua.x & 0xffff0000u), __uint_as_float(ua.y << 16), __uint_as_float(ua.y & 0xffff0000u));
        l.a1 = make_float4(__uint_as_float(ua.z << 16), __uint_as_float(ua.z & 0xffff0000u), __uint_as_float(ua.w << 16), __uint_as_float(ua.w & 0xffff0000u));
        l.b0 = make_float4(__uint_as_float(ub.x << 16), __uint_as_float(ub.x & 0xffff0000u), __uint_as_float(ub.y << 16), __uint_as_float(ub.y & 0xffff0000u));
        l.b1 = make_float4(__uint_as_float(ub.z << 16), __uint_as_float(ub.z & 0xffff0000u), __uint_as_float(ub.w << 16), __uint_as_float(ub.w & 0xffff0000u)); }
      else { l.a0 = l.a1 = l.b0 = l.b1 = make_float4(0.f, 0.f, 0.f, 0.f); } return l; };
    Ld cur = load(0);
#pragma unroll
    for (int gidx = 0; gidx < 8; ++gidx) {
      const int ai = gidx >> 2, m = gidx & 3;
      Ld nxt = cur;
      if (gidx < 7) nxt = load(gidx + 1);
      const int row = row0 + 128 * ai + 16 * m;
      float ss = 0.f;
#pragma unroll
      for (int bj = 0; bj < 2; ++bj) {
        const size_t go = (size_t)row * 1024 + col0 + 128 * bj;
        f32x4 a = acc[ai][bj][m][0], c4 = acc[ai][bj][m][1];
        if (!PLE) {
          const float4 xa = bj ? cur.b0 : cur.a0, xb4 = bj ? cur.b1 : cur.a1;
          a[0] += xa.x; a[1] += xa.y; a[2] += xa.z; a[3] += xa.w; c4[0] += xb4.x; c4[1] += xb4.y; c4[2] += xb4.z; c4[3] += xb4.w;
          *(uint4*)((u16*)(P.ws + A_H1B) + go) = pk8(a, c4);
        } else {
          *(uint4*)((u16*)(P.ws + A_EBF) + go) = pk8(a, c4);
        }
        ss += a[0] * a[0] + a[1] * a[1] + a[2] * a[2] + a[3] * a[3] + c4[0] * c4[0] + c4[1] * c4[1] + c4[2] * c4[2] + c4[3] * c4[3];
      }
      ss += __shfl_xor(ss, 16); ss += __shfl_xor(ss, 32);
      if (fq == 0) ssqp[(size_t)row * 16 + u.pn * 4 + wc] = ss;
      asm volatile("" ::: "memory");
      cur = nxt;
    }
  }
};
DI void ph3_outproj8(const Ptrs& P, ldsp lds, int bid, int G) {
  { EpiOut<false> E; E.Pp = &P; g8::GridOrder S; S.init(64, 4, G, bid);
    g8::gemm_phase<EpiOut<false>, g8::GridOrder, false, false>(lds, (const unsigned char*)(P.ws + A_AO), (const unsigned char*)(P.ws + WS_WOUT), 1024, S, E); }
}

DI int moe_plan8(const Ptrs& P, ldsp lds) {
  LAS int* smb = (LAS int*)(lds + g8::LDS_EXTRA8 + 3584);
  __syncthreads();
  if (threadIdx.x < 64) {
    const int lane = threadIdx.x, e = lane & 31;
    const int c = ((const int*)(P.ws + WS_CNT))[e * CNT_STRIDE];
    const int nb = (c + 255) >> 8;
    int inc = nb;
#pragma unroll
    for (int o = 1; o < 32; o <<= 1) { const int t = __shfl_up(inc, o, 32); if (e >= o) inc += t; }
    if (lane < 32) { smb[e] = inc - nb; smb[64 + e] = c; if (e == 31) smb[32] = inc; }
  }
  __syncthreads();
  return smb[32];
}
template <class T> DI T* uni_ptr(T* p) {
  const unsigned long long v = (unsigned long long)p;
  const unsigned lo = __builtin_amdgcn_readfirstlane((unsigned)v), hi = __builtin_amdgcn_readfirstlane((unsigned)(v >> 32));
  return (T*)(((unsigned long long)hi << 32) | lo);
}
struct MoeOrder {
  int MB, G, c; const LAS int* smb;
  DI bool next(int i, g8::Unit& u) const {
    const int L = i * G + c;
    if (L >= ((MB + 7) >> 3) * 32) return false;
    const int gmb = (L >> 5) * 8 + (L & 7);
    u.pn = (L >> 3) & 3;
    if (gmb >= MB) return false;
    int e = 0; while (gmb >= smb[e + 1]) ++e;
    e = __builtin_amdgcn_readfirstlane(e);
    u.pm = gmb; u.e = e; u.ce = __builtin_amdgcn_readfirstlane(smb[64 + e] - (gmb - smb[e]) * 256);
    return true;
  }
};
struct EpiUp {
  const Ptrs* Pp; const LAS int* smb;
  DI void a_off(const g8::Unit& u, const int (&sR)[2], const int (&sC)[2], unsigned (&v0)[2], unsigned (&v1)[2]) const {
    const int* tokl = uni_ptr((const int*)(Pp->ws + WS_TOKL) + __builtin_amdgcn_readfirstlane(u.e * 16384 + (u.pm - smb[u.e]) * 256));
#pragma unroll
    for (int i = 0; i < 2; ++i) {
      const int r0 = sR[i], r1 = 128 + sR[i];
      const int t0 = (r0 < u.ce) ? (tokl[r0] >> 1) : 0, t1 = (r1 < u.ce) ? (tokl[r1] >> 1) : 0;
      v0[i] = (unsigned)(t0 * 1024 + sC[i]) * 2u; v1[i] = (unsigned)(t1 * 1024 + sC[i]) * 2u;
    }
  }
  DI size_t b_off(const g8::Unit& u) const { return ((size_t)u.e * 1024 + u.pn * 256) * 1024 * 2; }
  DI void operator()(const f32x4 (&acc)[2][2][4][2], const g8::Unit& u, int wr, int wc, int fr, int fq) const {
    const Ptrs& P = *Pp;
    if (u.ce <= 0) return;
    const float* rsl = uni_ptr((const float*)(P.ws + A_RSL) + __builtin_amdgcn_readfirstlane(u.e * 16384 + (u.pm - smb[u.e]) * 256));
    u16* hid = (u16*)(P.ws + A_HID);
    float rsv[8];
#pragma unroll
    for (int k = 0; k < 8; ++k) { const int rl = 128 * (k >> 2) + 64 * wr + 16 * (k & 3) + fr; rsv[k] = (rl < u.ce) ? rsl[rl] : 0.0f; }
#pragma unroll
    for (int ai = 0; ai < 2; ++ai)
#pragma unroll
      for (int m = 0; m < 4; ++m) {
        const int rl = 128 * ai + 64 * wr + 16 * m + fr;
        const float rs = rsv[4 * ai + m];
        f32x4 h0, h1;
#pragma unroll
        for (int j = 0; j < 4; ++j) {
          const float a = acc[ai][0][m][0][j] * rs, b = acc[ai][0][m][1][j] * rs;
          h0[j] = a * __builtin_amdgcn_rcpf(1.0f + __expf(-a)) * (acc[ai][1][m][0][j] * rs); h1[j] = b * __builtin_amdgcn_rcpf(1.0f + __expf(-b)) * (acc[ai][1][m][1][j] * rs);
        }
        *(uint4*)(hid + (size_t)(u.pm * 256 + rl) * 512 + u.pn * 128 + 32 * wc + 8 * fq) = pk8(h0, h1);
      }
  }
};
DI void ph5_up8(const Ptrs& P, ldsp lds, int bid, int G) {
  const int MB = moe_plan8(P, lds);
  const LAS int* smb = (const LAS int*)(lds + g8::LDS_EXTRA8 + 3584);
  MoeOrder S; S.MB = MB; S.G = G; S.c = bid; S.smb = smb;
  EpiUp E; E.Pp = &P; E.smb = smb;
  g8::gemm_phase<EpiUp, MoeOrder, false, true>(lds, (const unsigned char*)(P.ws + A_H1B), (const unsigned char*)(P.ws + WS_W13), 1024, S, E);
  {
    const int NU = ((MB + 7) >> 3) * 32, rem = NU % G, nl = rem ? G - rem : G, li = rem ? bid - rem : bid;
    if (li >= 0) {
      const int lane = threadIdx.x & 63, wave = threadIdx.x >> 6, nwv = blockDim.x >> 6;
      LAS float* scr = (LAS float*)(lds + wave * 16640);
      for (int r = li * nwv + wave; r < 4096 + 256 + 2048; r += nl * nwv) late_weight_item(r, scr, lane);
    }
  }
}
struct EpiDown {
  const Ptrs* Pp; const LAS int* smb;
  DI void a_off(const g8::Unit&, const int (&)[2], const int (&)[2], unsigned (&)[2], unsigned (&)[2]) const {}
  DI size_t b_off(const g8::Unit& u) const { return ((size_t)u.e * 1024 + u.pn * 256) * 512 * 2; }
  DI void operator()(const f32x4 (&acc)[2][2][4][2], const g8::Unit& u, int wr, int wc, int fr, int fq) const {
    const Ptrs& P = *Pp;
    if (u.ce <= 0) return;
    const int base = __builtin_amdgcn_readfirstlane(u.e * 16384 + (u.pm - smb[u.e]) * 256);
    const int* tokl = (const int*)(P.ws + WS_TOKL) + base; const float* wl = (const float*)(P.ws + WS_WL) + base;
    int tkv[8]; float wv[8];
#pragma unroll
    for (int k = 0; k < 8; ++k) { const int rl = 128 * (k >> 2) + 64 * wr + 16 * (k & 3) + fr; const bool v = rl < u.ce; tkv[k] = v ? tokl[rl] : -1; wv[k] = v ? wl[rl] : 0.0f; }
#pragma unroll
    for (int ai = 0; ai < 2; ++ai)
#pragma unroll
      for (int m = 0; m < 4; ++m) {
        const int tk = tkv[4 * ai + m];
        if (tk >= 0) {
          const float w = wv[4 * ai + m];
          u16* y = (u16*)(P.ws + ((tk & 1) ? A_Y1 : A_Y0)) + (size_t)(tk >> 1) * 1024 + u.pn * 256 + 32 * wc + 8 * fq;
#pragma unroll
          for (int bj = 0; bj < 2; ++bj) {
            f32x4 a = acc[ai][bj][m][0], c4 = acc[ai][bj][m][1];
#pragma unroll
            for (int j = 0; j < 4; ++j) { a[j] *= w; c4[j] *= w; }
            *(uint4*)(y + 128 * bj) = pk8(a, c4);
          }
        }
      }
  }
};
struct MoeOrderD {
  MoeOrder m; int nown, extraL;
  DI bool next(int i, g8::Unit& u) const {
    if (i < nown) return m.next(i, u);
    if (i == nown && extraL >= 0) { MoeOrder t = m; t.c = extraL; return t.next(0, u); }
    return false;
  }
};
struct PleOrder {
  g8::GridOrder g; int cnt;
  DI bool next(int i, g8::Unit& u) const { if (i >= cnt) return false; return g.next(i, u); }
};
DI void ph6_down8(const Ptrs& P, ldsp lds, int bid, int G) {
  const int MB = ((const LAS int*)(lds + g8::LDS_EXTRA8 + 3584))[32];
  const LAS int* smb = (const LAS int*)(lds + g8::LDS_EXTRA8 + 3584);
  const int NU = ((MB + 7) >> 3) * 32, rem = NU % G, Rr = NU / G;
  const bool bal = (G == 256) && rem > 0 && 3 * rem <= G && Rr >= 1;
  MoeOrderD S; S.m.MB = MB; S.m.G = G; S.m.c = bid; S.m.smb = smb; S.nown = 1 << 20; S.extraL = -1;
  PleOrder S2;
  {
    const int nl = rem ? G - rem : G, li = rem ? bid - rem : bid;
    S2.g.init(64, 4, nl, li < 0 ? 0 : li); S2.cnt = li < 0 ? 0 : (1 << 20);
  }
  if (bal) {
    if (bid < rem) { S.nown = Rr + 1; S2.cnt = 0; }
    else if (bid < 2 * rem) { S.nown = Rr; S.extraL = (bid - rem) + (G - rem) + (Rr - 1) * G; S2.cnt = 0; }
    else if (bid < G - rem) { S.nown = Rr; S2.g.init(64, 4, 1, bid - 2 * rem); S2.cnt = 1; }
    else { S.nown = Rr - 1; S2.g.init(64, 4, 1, (G - 3 * rem) + 3 * (bid - (G - rem))); S2.cnt = 3; }
  }
  EpiDown E; E.Pp = &P; E.smb = smb;
  g8::gemm_phase<EpiDown, MoeOrderD, false, false>(lds, (const unsigned char*)(P.ws + A_HID), (const unsigned char*)(P.ws + WS_W2), 512, S, E);
  {
    EpiOut<true> E2; E2.Pp = &P;
    g8::gemm_phase<EpiOut<true>, PleOrder, false, false>(lds, (const unsigned char*)(P.ws + A_PB), (const unsigned char*)(P.ws + WS_WPLE), 256, S2, E2);
  }
}

struct EpiFinal {
  const Ptrs* Pp;
  DI void a_off(const g8::Unit&, const int (&)[2], const int (&)[2], unsigned (&)[2], unsigned (&)[2]) const {}
  DI size_t b_off(const g8::Unit& u) const { return (size_t)u.pn * 256 * 1024 * 2; }
  struct Ld { u32x4 hh; u32x4 ee; };
  DI void operator()(const f32x4 (&acc)[2][2][4][2], const g8::Unit& u, int wr, int wc, int fr, int fq) const {
    const Ptrs& P = *Pp;
    const float* rstd2 = (const float*)(P.ws + WS_RSTD2); const float* rstdE = (const float*)(P.ws + WS_RSTDE);
    const int row0 = u.pm * 256 + 64 * wr + fr, col0 = u.pn * 256 + 32 * wc + 8 * fq;
    auto load = [&](int gidx) { const int bj = gidx >> 3, ai = (gidx >> 2) & 1, m = gidx & 3; const int row = row0 + 128 * ai + 16 * m; const size_t go = (size_t)row * 1024 + col0 + 128 * bj;
      Ld l;
      l.hh = *(const u32x4*)((const u16*)(P.ws + A_H2B) + go); l.ee = *(const u32x4*)((const u16*)(P.ws + A_EBF) + go); return l; };
    Ld cur = load(0);
    float rs2v[8], rEv[8];
#pragma unroll
    for (int k = 0; k < 8; ++k) { const int row = row0 + 128 * (k >> 2) + 16 * (k & 3); rs2v[k] = rstd2[row]; rEv[k] = rstdE[row]; }
    float gv[8];
#pragma unroll
    for (int gidx = 0; gidx < 16; ++gidx) {
      const int bj = gidx >> 3, ai = (gidx >> 2) & 1, m = gidx & 3;
      if ((gidx & 7) == 0) { const float4 ga = *(const float4*)(P.g_ple + col0 + 128 * bj), gb = *(const float4*)(P.g_ple + col0 + 128 * bj + 4);
        gv[0] = ga.x; gv[1] = ga.y; gv[2] = ga.z; gv[3] = ga.w; gv[4] = gb.x; gv[5] = gb.y; gv[6] = gb.z; gv[7] = gb.w; }
      Ld nxt = cur;
      if (gidx < 15) nxt = load(gidx + 1);
      const size_t go = (size_t)(row0 + 128 * ai + 16 * m) * 1024 + col0 + 128 * bj;
      const int row = row0 + 128 * ai + 16 * m;
      const float rs2 = rs2v[gidx & 7], rE = rEv[gidx & 7];
      float hv[8];
#pragma unroll
      for (int k = 0; k < 8; ++k) hv[k] = __uint_as_float((cur.hh[k >> 1] << ((k & 1) ? 0u : 16u)) & 0xffff0000u);
      const f32x4 a = acc[ai][bj][m][0], c4 = acc[ai][bj][m][1];
      const float av[8] = {a[0], a[1], a[2], a[3], c4[0], c4[1], c4[2], c4[3]};
      const unsigned eeu[4] = {cur.ee[0], cur.ee[1], cur.ee[2], cur.ee[3]};
#pragma unroll
      for (int k = 0; k < 8; ++k) {
        const unsigned sh = (k & 1) ? 0u : 16u;
        const float ev = __uint_as_float((eeu[k >> 1] << sh) & 0xffff0000u);
        const float sg = __builtin_amdgcn_rcpf(1.0f + __expf(-av[k] * rs2));
        hv[k] = hv[k] + ev * rE * gv[k] * sg;
      }
      float* wr_ = P.out + go;
      __builtin_nontemporal_store((f32x4){hv[0], hv[1], hv[2], hv[3]}, (f32x4*)wr_); __builtin_nontemporal_store((f32x4){hv[4], hv[5], hv[6], hv[7]}, (f32x4*)(wr_ + 4));
      asm volatile("" ::: "memory");
      cur = nxt;
    }
  }
};
DI void ph8_final8(const Ptrs& P, ldsp lds, int bid, int G) {
  EpiFinal E; E.Pp = &P; g8::GridOrder S; S.init(64, 4, G, bid);
  g8::gemm_phase<EpiFinal, g8::GridOrder, false, false>(lds, (const unsigned char*)(P.ws + A_H2B), (const unsigned char*)(P.ws + WS_WPLG), 1024, S, E);
}

template <bool SHIFT>
DI void da_item8(const Ptrs& P, ldsp lds, int item, float lam, float m2) {
  const int tid = threadIdx.x, lane = tid & 63, wave = __builtin_amdgcn_readfirstlane(tid >> 6), h = lane >> 5, i31 = lane & 31;
  const int xcd = item & 7, loc = item >> 3, bh = 2 * xcd + (loc >> 4), qblk = loc & 15;
  const u16* qA = (const u16*)(P.ws + A_QA) + (size_t)bh * 4096 * 128;
  const u16* kA = (const u16*)(P.ws + A_KA) + (size_t)bh * 4096 * 128;
  const u16* vAt = (const u16*)(P.ws + A_VAT) + (size_t)bh * 128 * 4096;
  const int q = qblk * 256 + 32 * wave + i31;
  bf16x8 qf[2][4];
#pragma unroll
  for (int c = 0; c < 2; ++c)
#pragma unroll
    for (int s = 0; s < 4; ++s) qf[c][s] = *(const bf16x8*)(qA + (size_t)q * 128 + c * 64 + 16 * s + 8 * h);
  unsigned koff, voff;
  {
    const int ra = key_of(0, 2 * wave), rb = key_of(1, 2 * wave);
    const int ku = lane >> 4, key = 32 * (ku >> 1) + ((ku & 1) ? rb : ra);
    const int vu = lane >> 3, d = 32 * (vu >> 1) + ((vu & 1) ? rb : ra);
    koff = (unsigned)(key * 128 + (lane & 15) * 8) * 2u; voff = (unsigned)(d * 4096 + (lane & 7) * 8) * 2u;
  }
  auto stage = [&](int buf, int tile) {
    ldsp lk = lds + buf * DA_STAGE + 2 * wave * 1040;
    const unsigned char* kt = (const unsigned char*)(kA + (size_t)tile * 64 * 128);
    const unsigned char* vt = (const unsigned char*)(vAt + tile * 64);
    glds16(kt + koff, lk);
    glds16(vt + voff, lk + DA_VOFF);
    glds16(kt + 256 + koff, lk + 1040);
    glds16(vt + 8192 + voff, lk + DA_VOFF + 1040);
  };
  const int rk = rank_of(i31), gr = grp_of(i31);
  const int kbase = rk * 1040 + gr * 256 + h * 16;
  const int vbase = DA_VOFF + rk * 1040 + gr * 128 + h * 16;
  f32x16 O1[4], O2[4];
#pragma unroll
  for (int dt = 0; dt < 4; ++dt)
#pragma unroll
    for (int e = 0; e < 16; ++e) { O1[dt][e] = 0.f; O2[dt][e] = 0.f; }
  float l1 = 0.f, l2 = 0.f;
  bf16x8 pf[2][2];
  auto se = [&](ldsp lk) {
    f32x16 sa0, sa1;
#pragma unroll
    for (int e = 0; e < 16; ++e) { sa0[e] = 0.f; sa1[e] = 0.f; }
#pragma unroll
    for (int s = 0; s < 4; ++s) {
      const bf16x8 k0 = *(LAS bf16x8*)(lk + s * 32), k1 = *(LAS bf16x8*)(lk + 128 + s * 32);
      sa0 = __builtin_amdgcn_mfma_f32_32x32x16_bf16(k0, qf[0][s], sa0, 0, 0, 0);
      sa1 = __builtin_amdgcn_mfma_f32_32x32x16_bf16(k1, qf[1][s], sa1, 0, 0, 0);
    }
    __builtin_amdgcn_sched_barrier(0);
    float ls = 0.f;
#pragma unroll
    for (int e = 0; e < 16; ++e) { sa0[e] = __builtin_amdgcn_exp2f(SHIFT ? sa0[e] - m2 : sa0[e]); ls += sa0[e]; }
    l1 += ls;
    pf[0][0] = packp(sa0, 0); pf[0][1] = packp(sa0, 1);
    ls = 0.f;
#pragma unroll
    for (int e = 0; e < 16; ++e) { sa1[e] = __builtin_amdgcn_exp2f(SHIFT ? sa1[e] - m2 : sa1[e]); ls += sa1[e]; }
    l2 += ls;
    pf[1][0] = packp(sa1, 0); pf[1][1] = packp(sa1, 1);
  };
  auto pv = [&](ldsp lv) {
    bf16x8 va = *(LAS bf16x8*)(lv), vb = *(LAS bf16x8*)(lv + 256);
#pragma unroll
    for (int st = 0; st < 4; ++st) {
      const int s2 = st >> 1, dtp = st & 1;
      bf16x8 na = va, nb = vb;
      if (st < 3) { const int s2n = (st + 1) >> 1, dn = (st + 1) & 1; na = *(LAS bf16x8*)(lv + s2n * 32 + dn * 512); nb = *(LAS bf16x8*)(lv + s2n * 32 + dn * 512 + 256); }
      __builtin_amdgcn_sched_barrier(0);
      __builtin_amdgcn_s_setprio(1);
      O1[2 * dtp] = __builtin_amdgcn_mfma_f32_32x32x16_bf16(va, pf[0][s2], O1[2 * dtp], 0, 0, 0);
      O2[2 * dtp] = __builtin_amdgcn_mfma_f32_32x32x16_bf16(va, pf[1][s2], O2[2 * dtp], 0, 0, 0);
      O1[2 * dtp + 1] = __builtin_amdgcn_mfma_f32_32x32x16_bf16(vb, pf[0][s2], O1[2 * dtp + 1], 0, 0, 0);
      O2[2 * dtp + 1] = __builtin_amdgcn_mfma_f32_32x32x16_bf16(vb, pf[1][s2], O2[2 * dtp + 1], 0, 0, 0);
      __builtin_amdgcn_s_setprio(0);
      __builtin_amdgcn_sched_barrier(0);
      va = na; vb = nb;
    }
  };
  __syncthreads();
  stage(0, 0);
  stage(1, 1);
  asm volatile("s_waitcnt vmcnt(4)" ::: "memory");
  __builtin_amdgcn_s_barrier();
  if (wave < 4) {
    for (int tile = 0; tile < 64; ++tile) {
      if (tile + 2 < 64) stage((tile + 2) & 3, tile + 2);
      ldsp lb = lds + (tile & 3) * DA_STAGE;
#pragma unroll 1
      for (int kt2 = 0; kt2 < 2; ++kt2) {
        se(lb + kbase + kt2 * 512);
        __builtin_amdgcn_sched_barrier(0);
        pv(lb + vbase + kt2 * 64);
      }
      if (tile + 2 < 64) asm volatile("s_waitcnt vmcnt(4)" ::: "memory"); else asm volatile("s_waitcnt vmcnt(0)" ::: "memory");
      __builtin_amdgcn_s_barrier();
    }
  } else {
    for (int tile = 0; tile < 64; ++tile) {
      if (tile + 2 < 64) stage((tile + 2) & 3, tile + 2);
      ldsp lb = lds + (tile & 3) * DA_STAGE;
      ldsp lbp = lds + ((tile + 3) & 3) * DA_STAGE;
#pragma unroll 1
      for (int kt2 = 0; kt2 < 2; ++kt2) {
        if (tile + kt2 > 0) pv(kt2 == 0 ? lbp + vbase + 64 : lb + vbase);
        __builtin_amdgcn_sched_barrier(0);
        se(lb + kbase + kt2 * 512);
        __builtin_amdgcn_sched_barrier(0);
      }
      if (tile + 2 < 64) asm volatile("s_waitcnt vmcnt(4)" ::: "memory"); else asm volatile("s_waitcnt vmcnt(0)" ::: "memory");
      __builtin_amdgcn_s_barrier();
    }
    pv(lds + 3 * DA_STAGE + vbase + 64);
  }
  float4 gsv[16];
  {
    const float* gsp = kargs_now()->g_sub + 4 * h;
#pragma unroll
    for (int i = 0; i < 16; ++i) gsv[i] = *(const float4*)(gsp + 8 * i);
  }
  l1 += __shfl_xor(l1, 32); l2 += __shfl_xor(l2, 32);
  const float i1 = 1.0f / l1, i2 = lam / l2;
  float ss = 0.f;
#pragma unroll
  for (int dt = 0; dt < 4; ++dt)
#pragma unroll
    for (int e = 0; e < 16; ++e) { const float o = O1[dt][e] * i1 - O2[dt][e] * i2; O1[dt][e] = o; ss += o * o; }
  ss += __shfl_xor(ss, 32);
  const float rn = rsqrtf(ss * (1.0f / 128.0f) + EPS) * (1.0f - LAM_INIT);
  const int b = bh >> 2, hh = bh & 3;
  u16* dst = (u16*)(P.ws + A_AO) + ((size_t)b * 4096 + q) * 1024 + hh * 128;
#pragma unroll
  for (int dt = 0; dt < 4; ++dt)
#pragma unroll
    for (int gp = 0; gp < 2; ++gp) {
      uint2 pk[2];
#pragma unroll
      for (int k = 0; k < 2; ++k) {
        const int g = 2 * gp + k;
        const float4 gs = gsv[4 * dt + g];
        pk[k] = make_uint2(pk2(O1[dt][4 * g] * rn * gs.x, O1[dt][4 * g + 1] * rn * gs.y), pk2(O1[dt][4 * g + 2] * rn * gs.z, O1[dt][4 * g + 3] * rn * gs.w));
      }
      const auto rx = __builtin_amdgcn_permlane32_swap(pk[0].x, pk[1].x, false, false);
      const auto ry = __builtin_amdgcn_permlane32_swap(pk[0].y, pk[1].y, false, false);
      *(uint4*)(dst + 32 * dt + 16 * gp + 8 * h) = make_uint4(rx[0], ry[0], rx[1], ry[1]);
    }
}

constexpr int NA8_VSTRIDE = 1936;
constexpr int NA8_TAB = 32 * NA8_VSTRIDE;
constexpr int NA8_K = 70656;
DI void na_block8(const Ptrs& P, ldsp lds, int item, float qkbound, const bool build) {
  const int tid = threadIdx.x, lane = tid & 63, wave = tid >> 6;
  const int r0 = (item & 7) * 8, hd = (item >> 3) & 15, b = item >> 7;
  const int qi = lane & 15, g = lane >> 4;
  LAS float* EB = (LAS float*)(lds + NA8_TAB);
  LAS float* RW = EB + 960;
  const int R0 = min(max(r0 - 4, 0), 56), NR = min(15, 64 - R0);
  const u16* vB = (const u16*)(P.ws + A_VBT) + (size_t)(b * 16 + hd) * 32 * 4096;
  const u16* kBp = (const u16*)(P.ws + A_KB) + (size_t)(b * 16 + hd) * 4096 * 32;
  __syncthreads();
  {
    const unsigned char* ksrc = (const unsigned char*)(kBp + (size_t)R0 * 64 * 32);
    const int wv = __builtin_amdgcn_readfirstlane(wave);
    for (int pz = wv; pz < NR * 4; pz += 8) glds16(ksrc + pz * 1024 + lane * 16, lds + NA8_K + pz * 1024);
  }
  {
    u32x4 vv[8];
#pragma unroll
    for (int k = 0; k < 8; ++k) {
      const int sg = (tid >> 3) + 64 * k, d = sg / NR, kr = sg - d * NR;
      vv[k] = *(const u32x4*)(vB + (size_t)min(d, 31) * 4096 + (R0 + min(kr, NR - 1)) * 64 + 8 * (tid & 7));
    }
    if (build) {
      const float m2 = (qkbound + ((const float*)(P.ws + WS_SCAL))[16 + hd]) * LOG2E;
      for (int e = tid; e < 960; e += 512) {
        const int br = e >> 6, co = (e & 63) - 16;
        const float v = (co >= 0 && co <= 30) ? P.rpb[hd * 465 + br * 31 + co] * LOG2E - m2 : -1e30f;
        RW[e] = v;
        EB[e] = (co >= 7 && co <= 22) ? v : -1e30f;
      }
    }
#pragma unroll
    for (int k = 0; k < 8; ++k) {
      const int sg = (tid >> 3) + 64 * k, d = sg / NR, kr = sg - d * NR;
      if (sg < 32 * NR) *(LAS u32x4*)(lds + d * NA8_VSTRIDE + kr * 128 + 16 * (tid & 7)) = vv[k];
    }
    asm volatile("s_waitcnt vmcnt(0)" ::: "memory");
    __syncthreads();
  }
  const int r = r0 + wave;
  const int rs = min(max(r - 4, 0), 56), rb0 = rs - r + 7;
  const u16* qB = (const u16*)(P.ws + A_QB) + (size_t)(b * 16 + hd) * 4096 * 32;
  bf16x8 qf, qn;
  auto issue_q = [&](int jq) { return *(const bf16x8*)(qB + (size_t)(r * 64 + 16 * jq + qi) * 32 + 8 * g); };
  qf = issue_q(0);
#pragma unroll 1
  for (int jq = 0; jq < 4; ++jq) {
    const int kb = min(min(max(16 * jq - 8, 0), 48), 32);
    const LAS float* tb[2];
    {
      const int cobase = (jq == 0) ? 15 : ((jq == 3) ? -1 : 7);
#pragma unroll
      for (int t = 0; t < 2; ++t) {
        const int off = rb0 * 64 + cobase + 16 * t + 4 * g - qi + 16;
        const LAS float* pe = EB + off; const LAS float* pr = RW + off; const LAS float* pn = RW + 48;
        const LAS float* sel = pe;
        if (jq == 0 && qi < 8) sel = (t == 0) ? pr : pn;
        if (jq == 3 && qi > 8) sel = (t == 1) ? pr : pn;
        tb[t] = sel;
      }
    }
    f32x4 sa[8][2];
    ldsp kl = lds + NA8_K + ((rs - R0) * 64 + kb + qi) * 64 + g * 16;
    qn = qf;
    if (jq + 1 < 4) qn = issue_q(jq + 1);
    {
      bf16x8 kfa[16];
#pragma unroll
      for (int ri = 0; ri < 8; ++ri)
#pragma unroll
        for (int t = 0; t < 2; ++t) {
          const LAS float* tp = tb[t] + ri * 64;
          sa[ri][t] = (f32x4){tp[0], tp[1], tp[2], tp[3]};
          kfa[2 * ri + t] = *(LAS bf16x8*)(kl + (ri * 64 + 16 * t) * 64);
        }
      __builtin_amdgcn_sched_barrier(0);
#pragma unroll
      for (int ri = 0; ri < 8; ++ri)
#pragma unroll
        for (int t = 0; t < 2; ++t) sa[ri][t] = __builtin_amdgcn_mfma_f32_16x16x32_bf16(kfa[2 * ri + t], qf, sa[ri][t], 0, 0, 0);
    }
    __builtin_amdgcn_sched_barrier(0);
    float l = 0.f;
    f32x4 oa[2] = {{0.f, 0.f, 0.f, 0.f}, {0.f, 0.f, 0.f, 0.f}};
    ldsp vl = lds + qi * NA8_VSTRIDE + (rs - R0) * 128 + (kb + 4 * g) * 2;
#pragma unroll
    for (int ri = 0; ri < 8; ++ri) {
      float p[8];
#pragma unroll
      for (int t = 0; t < 2; ++t)
#pragma unroll
        for (int i = 0; i < 4; ++i) { const float e = __builtin_amdgcn_exp2f(sa[ri][t][i]); p[4 * t + i] = e; l += e; }
      u32x4 pp; pp[0] = pk2(p[0], p[1]); pp[1] = pk2(p[2], p[3]); pp[2] = pk2(p[4], p[5]); pp[3] = pk2(p[6], p[7]);
      const bf16x8 pfr = __builtin_bit_cast(bf16x8, pp);
#pragma unroll
      for (int dtl = 0; dtl < 2; ++dtl) {
        const s16x4 lo = *(LAS s16x4*)(vl + dtl * 16 * NA8_VSTRIDE + ri * 128), hi = *(LAS s16x4*)(vl + dtl * 16 * NA8_VSTRIDE + ri * 128 + 32);
        const bf16x8 vf = __builtin_shufflevector(lo, hi, 0, 1, 2, 3, 4, 5, 6, 7);
        oa[dtl] = __builtin_amdgcn_mfma_f32_16x16x32_bf16(vf, pfr, oa[dtl], 0, 0, 0);
      }
    }
    l += __shfl_xor(l, 16); l += __shfl_xor(l, 32);
    const float il = 1.0f / l;
    u16* dst = (u16*)(P.ws + A_AO) + ((size_t)b * 4096 + r * 64 + 16 * jq + qi) * 1024 + 512 + hd * 32;
#pragma unroll
    for (int dtl = 0; dtl < 2; ++dtl)
      *(uint2*)(dst + 16 * dtl + 4 * g) = make_uint2(pk2(oa[dtl][0] * il, oa[dtl][1] * il), pk2(oa[dtl][2] * il, oa[dtl][3] * il));
    qf = qn;
  }
}

DI void ph2_attn8(const Ptrs& P, ldsp lds, int bid, int G) {
  const float* sc = (const float*)(P.ws + WS_SCAL);
  const float lam = sc[0], m2 = sc[1], qkb = sc[2];
  if (m2 < 64.0f) { for (int it = bid; it < 256; it += G) da_item8<false>(P, lds, it, lam, m2); }
  else { for (int it = bid; it < 256; it += G) da_item8<true>(P, lds, it, lam, m2); }
  { int phd = -1; for (int it = bid; it < 512; it += G) { const int hd = (it >> 3) & 15; na_block8(P, lds, it, qkb, hd != phd); phd = hd; } }
}

__global__ void __launch_bounds__(512, 2) mega8(Ptrs Pk, int ph_lo, int ph_hi) {
  extern __shared__ __attribute__((aligned(16))) unsigned char smem[];
  ldsp lds = (ldsp)smem;
  const int bid = blockIdx.x, G = gridDim.x;
  volatile LAS unsigned* st = (volatile LAS unsigned*)(lds + g8::LDS_EXTRA8 + 4080);
  XcdBarrier xb; xb.bar = (unsigned*)(Pk.ws + WS_CTL); xb.x = 0; xb.st = st;
  if (ph_hi - ph_lo > 1) {
    if (threadIdx.x == 0) { st[0] = 0u; st[1] = 0u; st[2] = 0u; st[3] = 0u; }
    __syncthreads();
    xb = xcd_barrier_post((unsigned*)(Pk.ws + WS_CTL), st);
  }
#define RUN_PHASE8(k, call) if (ph_lo <= k && k < ph_hi) { { const Ptrs P = load_args(); call; } if (k + 1 < ph_hi) xcd_barrier(xb); }
  RUN_PHASE8(0, ph0_prep(P, lds, bid, G))
  RUN_PHASE8(1, ph1_inproj8(P, lds, bid, G))
  RUN_PHASE8(2, ph2_attn8(P, lds, bid, G))
  RUN_PHASE8(3, ph3_outproj8(P, lds, bid, G))
  RUN_PHASE8(4, ph4_router(P, lds, bid, G))
  RUN_PHASE8(5, ph5_up8(P, lds, bid, G))
  RUN_PHASE8(6, ph6_down8(P, lds, bid, G))
  RUN_PHASE8(7, ph7_combine(P, lds, bid, G))
  RUN_PHASE8(8, ph8_final8(P, lds, bid, G))
}
extern "C" void kernel_launch(void* const* d_in, const int* in_sizes, int n_in, void* d_out, int out_size, void* d_ws, size_t ws_size,
                              hipStream_t stream) {
  static int grid = 0;
  if (grid == 0) {
    if (n_in != 25 || ws_size < WS_END || out_size != T * DM) { fprintf(stderr, "kernel_launch: unexpected n_in %d / out %d / ws_size %zu (need %zu)\\n", n_in, out_size, ws_size, (size_t)WS_END); grid = -1; return; }
    int dev = 0, cus = 0, per_cu = 0;
    (void)hipGetDevice(&dev);
    (void)hipDeviceGetAttribute(&cus, hipDeviceAttributeMultiprocessorCount, dev);
    (void)hipFuncSetAttribute((const void*)mega8, hipFuncAttributeMaxDynamicSharedMemorySize, g8::LDS_BYTES8);
    (void)hipOccupancyMaxActiveBlocksPerMultiprocessor(&per_cu, (const void*)mega8, 512, g8::LDS_BYTES8);
    if (per_cu < 1) { fprintf(stderr, "kernel_launch: occupancy query returned %d\\n", per_cu); grid = -1; return; }
    grid = cus;
  }
  if (grid < 0) return;
  Ptrs P{};
  const float** pp = (const float**)&P;
  for (int i = 0; i < 25; ++i) pp[i] = (const float*)d_in[i];
  P.out = (float*)d_out; P.ws = (unsigned char*)d_ws;
  (void)hipMemsetAsync((unsigned char*)d_ws + WS_CTL, 0, XCD_BAR_WORDS * 4, stream);
  mega8<<<grid, 512, g8::LDS_BYTES8, stream>>>(P, 0, 9);
}
```
